# Optimizing an MI355X kernel written in HIP

```python
import math
import jax, jax.numpy as jnp
from jax import lax
import numpy as np

D_MODEL = 1024
BATCH = 8
SEQ = 4096
DEPTH = 1

HEAD_DIM = 64
ROPE_THETA = 10000.0
EPS = 1e-6
NEG_INF = -1e30

DIL_GROUPS = ((128, 1), (512, 4), (2048, 16))
N_DIL_GROUPS = 3
DIL_HEADS_PER_GROUP = 4
DIL_HEADS = N_DIL_GROUPS * DIL_HEADS_PER_GROUP
DIL_WIDTH = DIL_HEADS * HEAD_DIM
DIL_OUT = DIL_HEADS_PER_GROUP * HEAD_DIM

DIFF_HEADS = D_MODEL // (2 * HEAD_DIM)
DIFF_QK_WIDTH = DIFF_HEADS * 2 * HEAD_DIM
DIFF_V_WIDTH = DIFF_HEADS * 2 * HEAD_DIM
DIFF_Q_BLOCK = 128

N_BRANCHES = 2
GATE_WIDTH = N_BRANCHES * D_MODEL
IN_WIDTH = 3 * DIL_WIDTH + 2 * DIFF_QK_WIDTH + DIFF_V_WIDTH + GATE_WIDTH
IN_SPLITS = (DIL_WIDTH, 2 * DIL_WIDTH, 3 * DIL_WIDTH,
             3 * DIL_WIDTH + DIFF_QK_WIDTH,
             3 * DIL_WIDTH + 2 * DIFF_QK_WIDTH,
             3 * DIL_WIDTH + 2 * DIFF_QK_WIDTH + DIFF_V_WIDTH)

PEER_HEADS = 8
PEER_N_KEYS = 128
PEER_N_EXPERTS = PEER_N_KEYS * PEER_N_KEYS
PEER_TOPK = 16
PEER_QUERY_DIM = 256
PEER_HALF = PEER_QUERY_DIM // 2
PEER_CHUNK = 128

kernel_name = "hybrid_dilated_diffattn_peer_block"


def rms_norm(x, g):
    xf = x.astype(jnp.float32)
    y = xf * lax.rsqrt(jnp.mean(xf * xf, axis=-1, keepdims=True) + EPS)
    return (y * g.astype(jnp.float32)).astype(x.dtype)


def rope(x, positions):
    hd = x.shape[-1]
    inv_freq = 1.0 / (ROPE_THETA ** (jnp.arange(0, hd, 2, dtype=jnp.float32) / hd))
    ang = positions.astype(jnp.float32)[:, :, None, None] * inv_freq
    cos, sin = jnp.cos(ang), jnp.sin(ang)
    xf = x.astype(jnp.float32)
    x1, x2 = xf[..., : hd // 2], xf[..., hd // 2:]
    return jnp.concatenate([x1 * cos - x2 * sin, x2 * cos + x1 * sin], axis=-1).astype(x.dtype)


def dilated_window_attention(q, k, v, window, dilation):
    b, s, h, hd = q.shape
    m = window // (2 * dilation)
    blk = m
    L = s // dilation
    nb = -(-L // blk)
    Lp = nb * blk

    def to_res(t):
        return t.reshape(b, L, dilation, h, hd).transpose(0, 2, 3, 1, 4)

    qr = jnp.pad(to_res(q), ((0, 0), (0, 0), (0, 0), (0, Lp - L), (0, 0)))
    kpad = ((0, 0), (0, 0), (0, 0), (blk, Lp - L + blk), (0, 0))
    kp = jnp.pad(to_res(k), kpad)
    vp = jnp.pad(to_res(v), kpad)
    qb = qr.reshape(b, dilation, h, nb, blk, hd)

    def band(t):
        tb = t.reshape(b, dilation, h, nb + 2, blk, hd)
        return jnp.concatenate([tb[:, :, :, :-2], tb[:, :, :, 1:-1], tb[:, :, :, 2:]], axis=4)

    kb, vb = band(kp), band(vp)
    scores = jnp.einsum('brhnqc,brhnkc->brhnqk', qb, kb).astype(jnp.float32) * (hd ** -0.5)
    qi = jnp.arange(nb)[:, None, None] * blk + jnp.arange(blk)[None, :, None]
    ki = jnp.arange(nb)[:, None, None] * blk - blk + jnp.arange(3 * blk)[None, None, :]
    mask = (jnp.abs(ki - qi) <= m) & (ki >= 0) & (ki < L)
    scores = jnp.where(mask, scores, NEG_INF)
    lse = jax.nn.logsumexp(scores, axis=-1)
    p = jnp.exp(scores - lse[..., None])
    out = jnp.einsum('brhnqk,brhnkc->brhnqc', p.astype(v.dtype), vb)
    out = out.reshape(b, dilation, h, Lp, hd)[:, :, :, :L]
    out = out.transpose(0, 3, 1, 2, 4).reshape(b, s, h, hd)
    lse = lse.reshape(b, dilation, h, Lp)[..., :L].transpose(0, 3, 1, 2).reshape(b, s, h)
    return out, lse


def differential_attention(q1, q2, k1, k2, v, lam):
    b, s, h, hd = q1.shape
    nqb = s // DIFF_Q_BLOCK
    scale = hd ** -0.5

    def blockify(t):
        return t.reshape(b, nqb, DIFF_Q_BLOCK, h, hd).transpose(1, 0, 2, 3, 4)

    def one_block(qs):
        qa, qb = qs
        s1 = jnp.einsum('bqhc,bkhc->bhqk', qa, k1).astype(jnp.float32) * scale
        s2 = jnp.einsum('bqhc,bkhc->bhqk', qb, k2).astype(jnp.float32) * scale
        a = jax.nn.softmax(s1, axis=-1) - lam * jax.nn.softmax(s2, axis=-1)
        return jnp.einsum('bhqk,bkhc->bqhc', a.astype(v.dtype), v)

    out = lax.map(one_block, (blockify(q1), blockify(q2)))
    return out.transpose(1, 0, 2, 3, 4).reshape(b, s, h, 2 * hd)


def peer_ffn(h, w_query, sub_keys, expert_u, expert_v):
    b, s, d = h.shape
    tokens = h.reshape((b * s) // PEER_CHUNK, PEER_CHUNK, d)

    def chunk(xc):
        q = (xc @ w_query).reshape(PEER_CHUNK, PEER_HEADS, 2, PEER_HALF)
        s1 = jnp.einsum('thc,hnc->thn', q[:, :, 0], sub_keys[:, 0]).astype(jnp.float32)
        s2 = jnp.einsum('thc,hnc->thn', q[:, :, 1], sub_keys[:, 1]).astype(jnp.float32)
        v1, i1 = lax.top_k(s1, PEER_TOPK)
        v2, i2 = lax.top_k(s2, PEER_TOPK)
        cand = (v1[..., :, None] + v2[..., None, :]).reshape(PEER_CHUNK, PEER_HEADS, PEER_TOPK * PEER_TOPK)
        top, ci = lax.top_k(cand, PEER_TOPK)
        e1 = jnp.take_along_axis(i1, ci // PEER_TOPK, axis=-1)
        e2 = jnp.take_along_axis(i2, ci % PEER_TOPK, axis=-1)
        eidx = e1 * PEER_N_KEYS + e2
        gate = jax.nn.softmax(top, axis=-1)
        u = expert_u[eidx]
        vv = expert_v[eidx]
        act = jax.nn.gelu(jnp.einsum('td,thkd->thk', xc, u).astype(jnp.float32), approximate=False)
        wts = (gate * act).astype(xc.dtype)
        return jnp.einsum('thk,thkd->td', wts, vv)

    return lax.map(chunk, tokens).reshape(b, s, d)


def hybrid_layer(x, c, positions, lam_init, w_ada, b_ada, norm1_g, w_in, b_gate,
                 qn_a, kn_a, w_proj_a, qn_b, kn_b, lam_q1, lam_k1, lam_q2, lam_k2,
                 subln_g, w_proj_b, w_out, norm2_g, w_query, sub_keys, expert_u, expert_v):
    b, s, d = x.shape
    mod = jax.nn.silu(c) @ w_ada + b_ada
    sh1, sc1, g1, sh2, sc2, g2 = [m[:, None, :] for m in jnp.split(mod, 6, axis=-1)]

    h = rms_norm(x, norm1_g) * (1 + sc1) + sh1
    proj = h @ w_in
    qa, ka, va, qb, kb, vb, gl = jnp.split(proj, IN_SPLITS, axis=-1)

    qa = rope(rms_norm(qa.reshape(b, s, DIL_HEADS, HEAD_DIM), qn_a), positions)
    ka = rope(rms_norm(ka.reshape(b, s, DIL_HEADS, HEAD_DIM), kn_a), positions)
    va = va.reshape(b, s, DIL_HEADS, HEAD_DIM)
    outs, lses = [], []
    for gi, (win, dil) in enumerate(DIL_GROUPS):
        sl = slice(gi * DIL_HEADS_PER_GROUP, (gi + 1) * DIL_HEADS_PER_GROUP)
        o, l = dilated_window_attention(qa[:, :, sl], ka[:, :, sl], va[:, :, sl], win, dil)
        outs.append(o)
        lses.append(l)
    wg = jax.nn.softmax(jnp.stack(lses), axis=0)
    oa = jnp.sum(wg[..., None] * jnp.stack(outs).astype(jnp.float32), axis=0).astype(x.dtype)
    branch_a = oa.reshape(b, s, DIL_OUT) @ w_proj_a

    qb = rms_norm(qb.reshape(b, s, DIFF_HEADS, 2, HEAD_DIM), qn_b)
    kb = rms_norm(kb.reshape(b, s, DIFF_HEADS, 2, HEAD_DIM), kn_b)
    q1, q2 = rope(qb[:, :, :, 0], positions), rope(qb[:, :, :, 1], positions)
    k1, k2 = rope(kb[:, :, :, 0], positions), rope(kb[:, :, :, 1], positions)
    f32 = jnp.float32
    lam = (jnp.exp(jnp.sum(lam_q1.astype(f32) * lam_k1.astype(f32)))
           - jnp.exp(jnp.sum(lam_q2.astype(f32) * lam_k2.astype(f32))) + lam_init)
    ob = differential_attention(q1, q2, k1, k2, vb.reshape(b, s, DIFF_HEADS, 2 * HEAD_DIM), lam)
    ob = rms_norm(ob, subln_g) * (1.0 - lam_init)
    branch_b = ob.reshape(b, s, DIFF_V_WIDTH) @ w_proj_b

    gates = jax.nn.sigmoid((gl + b_gate).astype(f32)).astype(x.dtype).reshape(b, s, N_BRANCHES, d)
    mixed = gates[:, :, 0] * branch_a + gates[:, :, 1] * branch_b
    x = x + g1 * (mixed @ w_out)

    h2 = rms_norm(x, norm2_g) * (1 + sc2) + sh2
    x = x + g2 * peer_ffn(h2, w_query, sub_keys, expert_u, expert_v)
    return x


def setup_inputs(seed: int = 0) -> dict:
    key = jax.random.key(seed)
    ks = jax.random.split(key, 32)
    f32 = jnp.float32

    def nrm(k, shape, scale):
        return jax.random.normal(k, shape, f32) * scale

    def gain(k, shape):
        return 1.0 + 0.02 * jax.random.normal(k, shape, f32)

    L = DEPTH
    D = D_MODEL
    return {
        "x": jax.random.normal(ks[0], (BATCH, SEQ, D), f32),
        "c": jax.random.normal(ks[1], (BATCH, D), f32),
        "positions": jnp.broadcast_to(jnp.arange(SEQ, dtype=jnp.int32), (BATCH, SEQ)),
        "w_ada": nrm(ks[2], (L, D, 6 * D), 0.5 * D ** -0.5),
        "b_ada": nrm(ks[3], (L, 6 * D), 0.02),
        "norm1_g": gain(ks[4], (L, D)),
        "w_in": nrm(ks[5], (L, D, IN_WIDTH), D ** -0.5),
        "b_gate": nrm(ks[6], (L, GATE_WIDTH), 0.02),
        "qn_a": gain(ks[7], (L, HEAD_DIM)),
        "kn_a": gain(ks[8], (L, HEAD_DIM)),
        "w_proj_a": nrm(ks[9], (L, DIL_OUT, D), DIL_OUT ** -0.5),
        "qn_b": gain(ks[10], (L, HEAD_DIM)),
        "kn_b": gain(ks[11], (L, HEAD_DIM)),
        "lam_q1": nrm(ks[12], (L, HEAD_DIM), 0.1),
        "lam_k1": nrm(ks[13], (L, HEAD_DIM), 0.1),
        "lam_q2": nrm(ks[14], (L, HEAD_DIM), 0.1),
        "lam_k2": nrm(ks[15], (L, HEAD_DIM), 0.1),
        "subln_g": gain(ks[16], (L, 2 * HEAD_DIM)),
        "w_proj_b": nrm(ks[17], (L, DIFF_V_WIDTH, D), DIFF_V_WIDTH ** -0.5),
        "w_out": nrm(ks[18], (L, D, D), D ** -0.5),
        "norm2_g": gain(ks[19], (L, D)),
        "w_query": nrm(ks[20], (L, D, PEER_HEADS * PEER_QUERY_DIM), D ** -0.5),
        "sub_keys": nrm(ks[21], (L, PEER_HEADS, 2, PEER_N_KEYS, PEER_HALF), PEER_HALF ** -0.5),
        "expert_u": nrm(ks[22], (L, PEER_N_EXPERTS, D), D ** -0.5),
        "expert_v": nrm(ks[23], (L, PEER_N_EXPERTS, D), PEER_HEADS ** -0.5),
    }


def reference(x, c, positions, w_ada, b_ada, norm1_g, w_in, b_gate, qn_a, kn_a, w_proj_a,
              qn_b, kn_b, lam_q1, lam_k1, lam_q2, lam_k2, subln_g, w_proj_b, w_out,
              norm2_g, w_query, sub_keys, expert_u, expert_v):
    for l in range(DEPTH):
        lam_init = 0.8 - 0.6 * math.exp(-0.3 * l)
        x = hybrid_layer(x, c, positions, lam_init, w_ada[l], b_ada[l], norm1_g[l], w_in[l],
                         b_gate[l], qn_a[l], kn_a[l], w_proj_a[l], qn_b[l], kn_b[l],
                         lam_q1[l], lam_k1[l], lam_q2[l], lam_k2[l], subln_g[l], w_proj_b[l],
                         w_out[l], norm2_g[l], w_query[l], sub_keys[l], expert_u[l], expert_v[l])
    return x
```

```cpp
#include <hip/hip_runtime.h>
#include <hip/hip_bf16.h>
#include <cstdio>
#include <cstdint>
#include <cmath>

#ifndef MK_N_LAUNCHES
#define MK_N_LAUNCHES 0
#endif

constexpr int BATCH = 8, SEQ = 4096, D = 1024, T = BATCH * SEQ;
constexpr int DIL_W = 768, DIL_HEADS = 12, DIL_OUT = 256;
constexpr int DIFF_W = 1024, DIFF_HEADS = 8;
constexpr int IN_W = 7424, GATE_W = 2048;
constexpr int PEER_H = 8, PEER_NK = 128, PEER_QW = 2048, NEXP = 16384;
constexpr float EPS = 1e-6f;
constexpr float LAM_INIT = 0.2f;
constexpr float QSCALE = 0.125f * 1.4426950408889634f;

namespace pg8 {
#define PG8_LAS __attribute__((address_space(3)))
typedef unsigned short bf16_t;
typedef short bf16x8 __attribute__((ext_vector_type(8)));
typedef float f32x4 __attribute__((ext_vector_type(4)));
typedef unsigned u32x4 __attribute__((ext_vector_type(4)));
constexpr int BM = 256, BK = 64, HALF = 128, HTB = HALF * BK * 2  , STAGE_BYTES = 8 * HTB, NXCD = 8, WGM = 8;

__host__ __device__ __forceinline__ int lds_byte(int r, int c) { const int st = (r >> 4) * 2 + (c >> 5), rr = r & 15, cc = c & 31, ob = rr * 64 + cc * 2; return st * 1024 + (ob ^ (((ob >> 9) & 1) << 5)); }
__host__ __device__ __forceinline__ void stage_rc(int b, int& R, int& C) { const int st = b / 1024, sb = b % 1024, swz = sb ^ (((sb >> 9) & 1) << 5); R = (st >> 1) * 16 + swz / 64; C = (st & 1) * 32 + (swz % 64) / 2; }
__host__ __device__ __forceinline__ int perm32(int rho) { const int n = rho >> 4, i = rho & 15; return 8 * (i >> 2) + 4 * n + (i & 3); }

struct Unit { int pm, pn; };
struct Gemm { const bf16_t* A; const bf16_t* Bt; int M, N, K; };

struct StaticOrder {
    int nM, nN, nwg, G, c;
    __host__ __device__ void init(int M, int N, int G_, int c_) { nM = M / BM; nN = N / BM; nwg = nM * nN; G = G_; c = c_; }
    __host__ __device__ bool next(int i, Unit& u) const {
        const long L = (long)i * G + c; if (L >= nwg) return false;
        int wgid = (int)L; { const int q = nwg / NXCD, r = nwg % NXCD, xcd = wgid % NXCD, off = wgid / NXCD; wgid = (xcd < r ? xcd * (q + 1) : r * (q + 1) + (xcd - r) * q) + off; }
        const int nig = WGM * nN, gid = wgid / nig, fm = gid * WGM, gsz = (nM - fm) < WGM ? (nM - fm) : WGM;
        u.pm = fm + ((wgid % nig) % gsz); u.pn = (wgid % nig) / gsz; return true;
    }
    __device__ __forceinline__ void a_ready(const Unit&) const {}
    __device__ __forceinline__ void done(const Unit&) const {}
};

__device__ __forceinline__ unsigned cvt_pk_bf16(float lo, float hi) { unsigned r; asm volatile("v_cvt_pk_bf16_f32 %0, %1, %2" : "=v"(r) : "v"(lo), "v"(hi)); return r; }
typedef float f32x2 __attribute__((ext_vector_type(2)));
typedef unsigned u32x2 __attribute__((ext_vector_type(2)));
__device__ __forceinline__ float bf_lo(unsigned w) { return __uint_as_float(w << 16); }
__device__ __forceinline__ float bf_hi(unsigned w) { return __uint_as_float(w & 0xffff0000u); }

struct EpiBf16 {
    static constexpr bool PERM = true, AFTER_DRAIN = false;
    bf16_t* O; int ldc;
    __device__ __forceinline__ void operator()(const f32x4 (&acc)[2][2][4][2], const Unit& u, int wr, int wc, int fr, int fq) const {
        const int row0 = u.pm * BM + wr * 64 + fr; const int col0 = u.pn * BM + wc * 32 + 8 * fq;
#pragma unroll
        for (int ai = 0; ai < 2; ++ai)
#pragma unroll
            for (int m = 0; m < 4; ++m) { bf16_t* rowp = O + (size_t)(row0 + ai * HALF + m * 16) * ldc + col0;
#pragma unroll
                for (int bj = 0; bj < 2; ++bj) { const f32x4 v0 = acc[ai][bj][m][0], v1 = acc[ai][bj][m][1];
                    u32x4 w; w.x = cvt_pk_bf16(v0[0], v0[1]); w.y = cvt_pk_bf16(v0[2], v0[3]); w.z = cvt_pk_bf16(v1[0], v1[1]); w.w = cvt_pk_bf16(v1[2], v1[3]);
                    *(u32x4*)(rowp + bj * HALF) = w; } }
    }
};

struct EpiInProj {
    static constexpr bool PERM = true, AFTER_DRAIN = false;
    bf16_t *QA, *KA, *VA, *QB, *KB, *VB, *G; const float* b_gate;
    __device__ __forceinline__ void operator()(const f32x4 (&acc)[2][2][4][2], const Unit& u, int wr, int wc, int fr, int fq) const {
        const int pn = u.pn; bf16_t* base; int ldc, colt; bool gate = false;
        if (pn < 3)       { base = QA; ldc = 768;  colt = pn * BM; }
        else if (pn < 6)  { base = KA; ldc = 768;  colt = (pn - 3) * BM; }
        else if (pn < 9)  { base = VA; ldc = 768;  colt = (pn - 6) * BM; }
        else if (pn < 13) { base = QB; ldc = 1024; colt = (pn - 9) * BM; }
        else if (pn < 17) { base = KB; ldc = 1024; colt = (pn - 13) * BM; }
        else if (pn < 21) { base = VB; ldc = 1024; colt = (pn - 17) * BM; }
        else              { base = G;  ldc = 2048; colt = (pn - 21) * BM; gate = true; }
        const int row0 = u.pm * BM + wr * 64 + fr; const int col0 = colt + wc * 32 + 8 * fq;
        f32x4 bv[2][2];
#pragma unroll
        for (int bj = 0; bj < 2; ++bj)
#pragma unroll
            for (int n = 0; n < 2; ++n) bv[bj][n] = gate ? *(const f32x4*)(b_gate + col0 + bj * HALF + 4 * n) : (f32x4){0.f, 0.f, 0.f, 0.f};
#pragma unroll
        for (int ai = 0; ai < 2; ++ai)
#pragma unroll
            for (int m = 0; m < 4; ++m) { bf16_t* rowp = base + (size_t)(row0 + ai * HALF + m * 16) * ldc + col0;
#pragma unroll
                for (int bj = 0; bj < 2; ++bj) { f32x4 v0 = acc[ai][bj][m][0], v1 = acc[ai][bj][m][1];
                    if (gate) {
                        v0 = v0 + bv[bj][0]; v1 = v1 + bv[bj][1];
#pragma unroll
                        for (int e = 0; e < 4; ++e) { v0[e] = 1.0f / (1.0f + __expf(-v0[e])); v1[e] = 1.0f / (1.0f + __expf(-v1[e])); }
                    }
                    u32x4 w; w.x = cvt_pk_bf16(v0[0], v0[1]); w.y = cvt_pk_bf16(v0[2], v0[3]); w.z = cvt_pk_bf16(v1[0], v1[1]); w.w = cvt_pk_bf16(v1[2], v1[3]);
                    *(u32x4*)(rowp + bj * HALF) = w; } }
    }
};

struct EpiBranchB {
    static constexpr bool PERM = false, AFTER_DRAIN = false;
    const bf16_t* ta; const bf16_t* G; bf16_t* mixed;
    __device__ __forceinline__ void operator()(const f32x4 (&acc)[2][2][4][2], const Unit& u, int wr, int wc, int fr, int fq) const {
        const int row0 = u.pm * BM + wr * 64 + fr; const int col0 = u.pn * BM + wc * 32 + 4 * fq;
#pragma unroll
        for (int ai = 0; ai < 2; ++ai)
#pragma unroll
            for (int m = 0; m < 4; ++m) { const size_t row = (size_t)(row0 + ai * HALF + m * 16);
#pragma unroll
                for (int bj = 0; bj < 2; ++bj)
#pragma unroll
                    for (int n = 0; n < 2; ++n) { const int c = col0 + bj * HALF + n * 16;
                        const u32x2 g0 = *(const u32x2*)(G + row * 2048 + c), g1 = *(const u32x2*)(G + row * 2048 + 1024 + c), t = *(const u32x2*)(ta + row * 1024 + c); const f32x4 a = acc[ai][bj][m][n];
                        u32x2 w; w.x = cvt_pk_bf16(bf_lo(t.x) * bf_lo(g0.x) + a[0] * bf_lo(g1.x), bf_hi(t.x) * bf_hi(g0.x) + a[1] * bf_hi(g1.x));
                        w.y = cvt_pk_bf16(bf_lo(t.y) * bf_lo(g0.y) + a[2] * bf_lo(g1.y), bf_hi(t.y) * bf_hi(g0.y) + a[3] * bf_hi(g1.y));
                        *(u32x2*)(mixed + row * 1024 + c) = w; }
                asm volatile("" ::: "memory"); }
    }
};
struct EpiOut {
    static constexpr bool PERM = false, AFTER_DRAIN = false;
    const float* x; const float* mod; float* out;
    __device__ __forceinline__ void operator()(const f32x4 (&acc)[2][2][4][2], const Unit& u, int wr, int wc, int fr, int fq) const {
        const int row0 = u.pm * BM + wr * 64 + fr; const int col0 = u.pn * BM + wc * 32 + 4 * fq;
        const int b = (u.pm * BM) >> 12;
        f32x4 gv[2][2];
#pragma unroll
        for (int bj = 0; bj < 2; ++bj)
#pragma unroll
            for (int n = 0; n < 2; ++n) gv[bj][n] = *(const f32x4*)(mod + (size_t)b * 6144 + 2048 + col0 + bj * HALF + n * 16);
#pragma unroll
        for (int ai = 0; ai < 2; ++ai)
#pragma unroll
            for (int m = 0; m < 4; ++m) { const size_t row = (size_t)(row0 + ai * HALF + m * 16);
#pragma unroll
                for (int bj = 0; bj < 2; ++bj)
#pragma unroll
                    for (int n = 0; n < 2; ++n) { const int c = col0 + bj * HALF + n * 16;
                        const f32x4 xv = *(const f32x4*)(x + row * 1024 + c);
                        *(f32x4*)(out + row * 1024 + c) = xv + gv[bj][n] * acc[ai][bj][m][n]; }
                asm volatile("" ::: "memory"); }
    }
};

template <class Epi, class Sched, bool ALIGN_EPI = false, bool SP2 = false>
__device__ __forceinline__ void gemm_phase(PG8_LAS unsigned char* lds, const Gemm g, const Sched& S, const Epi& E) {
    const int tid = threadIdx.x, wid = __builtin_amdgcn_readfirstlane(tid >> 6), lane = tid & 63, wr = wid >> 2, wc = wid & 3, fr = lane & 15, fq = lane >> 4;
    const int K = g.K, nt = K / BK;
    unsigned voffA[2], voffB[2];
#pragma unroll
    for (int i = 0; i < 2; ++i) { int R, C; stage_rc(tid * 16 + i * 8192, R, C); const int Rb = Epi::PERM ? ((R & ~31) + perm32(R & 31)) : R;
        voffA[i] = (unsigned)(R * K + C) * 2u; voffB[i] = (unsigned)(Rb * K + C) * 2u; }
    const size_t kstep = (size_t)(BK * 2);
    const size_t hstep = (size_t)HALF * K * 2;
    const size_t tstep = 2 * hstep;
    const unsigned ldsw = (unsigned)wid * 1024u;
    const int aoff = lds_byte(wr * 64 + fr, fq * 8), boff = lds_byte(wc * 32 + fr, fq * 8);
#define PG8_SA(b, h) (((b) * 2 + (h)) * HTB)
#define PG8_SB(b, h) ((4 + (b) * 2 + (h)) * HTB)
#define PG8_STAGE(bufoff, gbase, voff) do { _Pragma("unroll") for (int _i = 0; _i < 2; ++_i) \
        __builtin_amdgcn_global_load_lds((const unsigned*)((const char*)(gbase) + (voff)[_i]), (PG8_LAS unsigned*)(lds + (bufoff) + ldsw + _i * 8192), 16, 0, 0); } while (0)
#define PG8_LDA(dst, b, h) do { _Pragma("unroll") for (int m = 0; m < 4; ++m) _Pragma("unroll") for (int k = 0; k < 2; ++k) dst[m][k] = *(const PG8_LAS bf16x8*)(lds + PG8_SA(b, h) + aoff + m * 2048 + k * 1024); } while (0)
#define PG8_LDB(dst, b, h) do { _Pragma("unroll") for (int n = 0; n < 2; ++n) _Pragma("unroll") for (int k = 0; k < 2; ++k) dst[n][k] = *(const PG8_LAS bf16x8*)(lds + PG8_SB(b, h) + boff + n * 2048 + k * 1024); } while (0)
#define PG8_MMA(ai, bj, At, Bt) do { __builtin_amdgcn_s_setprio(1); _Pragma("unroll") for (int m = 0; m < 4; ++m) _Pragma("unroll") for (int n = 0; n < 2; ++n) _Pragma("unroll") for (int k = 0; k < 2; ++k) \
        acc[ai][bj][m][n] = __builtin_amdgcn_mfma_f32_16x16x32_bf16(Bt[n][k], At[m][k], acc[ai][bj][m][n], 0, 0, 0); __builtin_amdgcn_s_setprio(0); } while (0)
#define PG8_WAIT_V(n) asm volatile("s_waitcnt vmcnt(" #n ")" ::: "memory")
#define PG8_WAIT_L(n) asm volatile("s_waitcnt lgkmcnt(" #n ")" ::: "memory")
#define PG8_BAR __builtin_amdgcn_s_barrier()
#define PG8_SCHED __builtin_amdgcn_sched_barrier(0)
    Unit cur, nxt; int ui = 0;
    if (!S.next(0, cur)) return;
    f32x4 acc[2][2][4][2];
#pragma unroll
    for (int a = 0; a < 2; ++a)
#pragma unroll
        for (int b = 0; b < 2; ++b)
#pragma unroll
            for (int m = 0; m < 4; ++m)
#pragma unroll
                for (int n = 0; n < 2; ++n) acc[a][b][m][n] = (f32x4){0.f, 0.f, 0.f, 0.f};
    bf16x8 At[4][2], B0[2][2], B1[2][2];
    const char* cA = (const char*)g.A + (size_t)cur.pm * tstep; const char* cB = (const char*)g.Bt + (size_t)cur.pn * tstep;
    S.a_ready(cur);
    if constexpr (SP2) {
        PG8_STAGE(PG8_SB(0, 0), cB, voffB); PG8_STAGE(PG8_SB(0, 1), cB + hstep, voffB); PG8_STAGE(PG8_SA(0, 0), cA, voffA); PG8_STAGE(PG8_SA(0, 1), cA + hstep, voffA);
        if (wr == 1) PG8_BAR;
        PG8_WAIT_V(2); PG8_BAR;
        PG8_STAGE(PG8_SB(1, 0), cB + kstep, voffB); PG8_STAGE(PG8_SA(1, 0), cA + kstep, voffA); PG8_STAGE(PG8_SB(1, 1), cB + hstep + kstep, voffB);
        PG8_WAIT_V(6); PG8_BAR;
    } else {
        PG8_STAGE(PG8_SB(0, 0), cB, voffB); PG8_STAGE(PG8_SA(0, 0), cA, voffA); PG8_STAGE(PG8_SB(0, 1), cB + hstep, voffB); PG8_STAGE(PG8_SA(0, 1), cA + hstep, voffA);
        if (wr == 1) PG8_BAR;
        PG8_WAIT_V(4); PG8_BAR;
        PG8_STAGE(PG8_SB(1, 0), cB + kstep, voffB); PG8_STAGE(PG8_SA(1, 0), cA + kstep, voffA); PG8_STAGE(PG8_SB(1, 1), cB + hstep + kstep, voffB);
        PG8_WAIT_V(6); PG8_BAR;
    }
    for (;;) {
        const bool has_next = S.next(ui + 1, nxt);
        const char* nA = has_next ? (const char*)g.A + (size_t)nxt.pm * tstep : cA; const char* nB = has_next ? (const char*)g.Bt + (size_t)nxt.pn * tstep : cB;
        for (int t = 0; t < nt; t += 2) {
            const bool last = (t == nt - 2);
            const char* a1 = cA + (size_t)(t + 1) * kstep;
            const char* a2 = last ? nA : cA + (size_t)(t + 2) * kstep; const char* b2 = last ? nB : cB + (size_t)(t + 2) * kstep;
            const char* a3 = a2 + kstep; const char* b3 = b2 + kstep;
            if (last && has_next) S.a_ready(nxt);
            if constexpr (SP2) {
            PG8_LDB(B0, 0, 0); PG8_LDB(B1, 0, 1); PG8_SCHED; PG8_LDA(At, 0, 0); PG8_STAGE(PG8_SA(1, 1), a1 + hstep, voffA);
            PG8_WAIT_V(8); PG8_WAIT_L(0); PG8_BAR; PG8_MMA(0, 0, At, B0); PG8_MMA(0, 1, At, B1); PG8_BAR; PG8_SCHED;
            PG8_LDA(At, 0, 1); PG8_STAGE(PG8_SB(0, 0), b2, voffB); PG8_STAGE(PG8_SB(0, 1), b2 + hstep, voffB); PG8_STAGE(PG8_SA(0, 0), a2, voffA);
            PG8_WAIT_V(8); PG8_WAIT_L(0); PG8_BAR; PG8_MMA(1, 0, At, B0); PG8_MMA(1, 1, At, B1); PG8_BAR; PG8_SCHED;
            PG8_LDB(B0, 1, 0); PG8_LDB(B1, 1, 1); PG8_SCHED; PG8_LDA(At, 1, 0); PG8_STAGE(PG8_SA(0, 1), a2 + hstep, voffA);
            PG8_WAIT_V(8); PG8_WAIT_L(0); PG8_BAR; PG8_MMA(0, 0, At, B0); PG8_MMA(0, 1, At, B1); PG8_BAR; PG8_SCHED;
            PG8_LDA(At, 1, 1); PG8_STAGE(PG8_SB(1, 0), b3, voffB); PG8_STAGE(PG8_SB(1, 1), b3 + hstep, voffB); PG8_STAGE(PG8_SA(1, 0), a3, voffA);
            PG8_WAIT_V(8); PG8_WAIT_L(0); PG8_BAR; PG8_MMA(1, 0, At, B0); PG8_MMA(1, 1, At, B1); PG8_BAR; PG8_SCHED;
            } else {
            PG8_LDB(B0, 0, 0); PG8_SCHED; PG8_LDA(At, 0, 0); PG8_STAGE(PG8_SA(1, 1), a1 + hstep, voffA);
            PG8_WAIT_L(8); PG8_BAR; PG8_WAIT_L(0); PG8_MMA(0, 0, At, B0); PG8_BAR; PG8_SCHED;
            PG8_LDB(B1, 0, 1); PG8_STAGE(PG8_SB(0, 0), b2, voffB);
            PG8_BAR; PG8_WAIT_L(0); PG8_MMA(0, 1, At, B1); PG8_BAR;
            PG8_LDA(At, 0, 1); PG8_STAGE(PG8_SA(0, 0), a2, voffA);
            PG8_BAR; PG8_WAIT_L(0); PG8_MMA(1, 0, At, B0); PG8_BAR; PG8_SCHED;
            PG8_STAGE(PG8_SB(0, 1), b2 + hstep, voffB);
            PG8_WAIT_V(6); PG8_BAR; PG8_MMA(1, 1, At, B1); PG8_BAR;
            PG8_LDB(B0, 1, 0); PG8_SCHED; PG8_LDA(At, 1, 0); PG8_STAGE(PG8_SA(0, 1), a2 + hstep, voffA);
            PG8_WAIT_L(8); PG8_BAR; PG8_WAIT_L(0); PG8_MMA(0, 0, At, B0); PG8_BAR; PG8_SCHED;
            PG8_LDB(B1, 1, 1); PG8_STAGE(PG8_SB(1, 0), b3, voffB);
            PG8_BAR; PG8_WAIT_L(0); PG8_MMA(0, 1, At, B1); PG8_BAR;
            PG8_LDA(At, 1, 1); PG8_STAGE(PG8_SA(1, 0), a3, voffA);
            PG8_BAR; PG8_WAIT_L(0); PG8_MMA(1, 0, At, B0); PG8_BAR; PG8_SCHED;
            PG8_STAGE(PG8_SB(1, 1), b3 + hstep, voffB);
            PG8_WAIT_V(6); PG8_BAR; PG8_MMA(1, 1, At, B1); PG8_BAR;
            }
        }
        if constexpr (ALIGN_EPI) { if (wr == 0) PG8_BAR; }
        if constexpr (!Epi::AFTER_DRAIN) { E(acc, cur, wr, wc, fr, fq); S.done(cur); }
        if (!has_next) break;
#pragma unroll
        for (int a = 0; a < 2; ++a)
#pragma unroll
            for (int b = 0; b < 2; ++b)
#pragma unroll
                for (int m = 0; m < 4; ++m)
#pragma unroll
                    for (int n = 0; n < 2; ++n) acc[a][b][m][n] = (f32x4){0.f, 0.f, 0.f, 0.f};
        cur = nxt; cA = nA; cB = nB; ++ui;
        if constexpr (ALIGN_EPI) { if (wr == 1) PG8_BAR; }
    }
    PG8_WAIT_V(0);
    if constexpr (!ALIGN_EPI) { if (wr == 0) PG8_BAR; }
    PG8_BAR;
    if constexpr (Epi::AFTER_DRAIN) { E.fused(acc, cur, wr, wc, fr, fq, lds, wid, lane); S.done(cur); }
#undef PG8_SA
#undef PG8_SB
#undef PG8_STAGE
#undef PG8_LDA
#undef PG8_LDB
#undef PG8_MMA
#undef PG8_WAIT_V
#undef PG8_WAIT_L
#undef PG8_BAR
#undef PG8_SCHED
}
}
#include <hip/hip_bf16.h>
#include <cmath>
namespace attn_body {
using bf16=__hip_bfloat16;
using bf16x8=__attribute__((ext_vector_type(8)))short;
using s16x4=__attribute__((ext_vector_type(4)))short;
using f32x16=__attribute__((ext_vector_type(16)))float;
using u32x4=__attribute__((ext_vector_type(4)))unsigned;
constexpr int BATCH=8,NHEAD=16,SEQ=4096,D=64,DM=NHEAD*D;
constexpr int NW=8,QBLK=32,QB=QBLK*NW,KVBLK=64,NQB=SEQ/QB;
constexpr int ATTN_PITCH=DM, ATTN_UNIT_ROWS=QB;
__device__ __forceinline__ int crow(int r,int hi){return (r&3)+8*(r>>2)+4*hi;}
#define SBAR() __builtin_amdgcn_sched_barrier(0)
__device__ __forceinline__ void cmask(f32x16&p0,f32x16&p1,int jb,int qrel,int hi){
  const float NEG=-INFINITY; int kb=64*jb+4*hi;
  #pragma unroll
  for(int r=0;r<16;++r){int kv=kb+(r&3)+8*(r>>2); if(kv>qrel)p0[r]=NEG; if(kv+32>qrel)p1[r]=NEG;}
}

constexpr int NSLOT=3, SLOTB=8192;
constexpr int LDS_K=0, LDS_V=NSLOT*SLOTB, LDS_WS=2*NSLOT*SLOTB, LDS_OST=LDS_WS+NW*64*4, LDS_BYTES=LDS_OST+NW*4096;
constexpr float C2=0.125f*1.4426950408889634f;
__device__ __forceinline__ void glds16(const void*gsrc,unsigned lds_dst){unsigned keep;
  asm volatile("s_mov_b32 %0, m0\n\ts_mov_b32 m0, %2\n\ts_nop 0\n\tglobal_load_lds_dwordx4 %1, off\n\ts_mov_b32 m0, %0":"=&s"(keep):"v"(gsrc),"s"(lds_dst):"memory");}
__device__ __forceinline__ float max3f(float a,float b,float c){float r;asm("v_max3_f32 %0, %1, %2, %3":"=v"(r):"v"(a),"v"(b),"v"(c));return r;}
__device__ __forceinline__ float max2f(float a,float b){float r;asm("v_max_f32_e32 %0, %1, %2":"=v"(r):"v"(a),"v"(b));return r;}
__device__ __forceinline__ float fadd_s(float a,float b){float r;asm("v_add_f32_e32 %0, %1, %2":"=v"(r):"v"(a),"v"(b));return r;}
__device__ __forceinline__ float fsub_s(float a,float b){float r;asm("v_sub_f32_e32 %0, %1, %2":"=v"(r):"v"(a),"v"(b));return r;}
typedef float f32x2_t __attribute__((ext_vector_type(2))); typedef __bf16 bf16x2_t __attribute__((ext_vector_type(2)));
__device__ __forceinline__ unsigned cvtpk_s(float lo,float hi){f32x2_t v={lo,hi};bf16x2_t b=__builtin_convertvector(v,bf16x2_t);return __builtin_bit_cast(unsigned,b);}
#define WAIT_BAR(N) asm volatile("s_waitcnt vmcnt(" #N ") lgkmcnt(0)\n\ts_barrier":::"memory")

__device__ __forceinline__ void qkt(f32x16&p0,f32x16&p1,const char*Kslot,const bf16x8*qr,const f32x16&negm,int r32,int hi){
  const char*kb=Kslot+hi*1024+r32*16;
  #pragma unroll
  for(int d0=0;d0<4;++d0){
    const bf16x8 b0=*reinterpret_cast<const bf16x8*>(kb+d0*2048);
    const bf16x8 b1=*reinterpret_cast<const bf16x8*>(kb+d0*2048+512);
    if(d0==0){p0=__builtin_amdgcn_mfma_f32_32x32x16_bf16(b0,qr[0],negm,0,0,0);p1=__builtin_amdgcn_mfma_f32_32x32x16_bf16(b1,qr[0],negm,0,0,0);}
    else{p0=__builtin_amdgcn_mfma_f32_32x32x16_bf16(b0,qr[d0],p0,0,0,0);p1=__builtin_amdgcn_mfma_f32_32x32x16_bf16(b1,qr[d0],p1,0,0,0);}}
}
typedef __attribute__((address_space(3))) const char* lds_cptr;
typedef short v4i16_t __attribute__((ext_vector_type(4)));
__device__ __forceinline__ void kload8(bf16x8*kf,lds_cptr kp){
  kf[0]=*(const __attribute__((address_space(3))) bf16x8*)(kp);      kf[1]=*(const __attribute__((address_space(3))) bf16x8*)(kp+512);
  kf[2]=*(const __attribute__((address_space(3))) bf16x8*)(kp+2048); kf[3]=*(const __attribute__((address_space(3))) bf16x8*)(kp+2560);
  kf[4]=*(const __attribute__((address_space(3))) bf16x8*)(kp+4096); kf[5]=*(const __attribute__((address_space(3))) bf16x8*)(kp+4608);
  kf[6]=*(const __attribute__((address_space(3))) bf16x8*)(kp+6144); kf[7]=*(const __attribute__((address_space(3))) bf16x8*)(kp+6656);
}
__device__ __forceinline__ void kload2(bf16x8*kf,lds_cptr kp,int j){ kf[2*j]=*(const __attribute__((address_space(3))) bf16x8*)(kp+j*2048); kf[2*j+1]=*(const __attribute__((address_space(3))) bf16x8*)(kp+j*2048+512); }
__device__ __forceinline__ s16x4 vtr(lds_cptr p){ return __builtin_bit_cast(s16x4,__builtin_amdgcn_ds_read_tr16_b64_v4i16((__attribute__((address_space(3))) v4i16_t*)p)); }
__device__ __forceinline__ float rowmax(const f32x16&p0,const f32x16&p1){
  float a=max3f(p0[0],p0[1],p1[0]),b=max3f(p0[2],p0[3],p1[1]);a=max3f(a,p1[2],p1[3]);
  #pragma unroll
  for(int r=4;r<16;r+=4){a=max3f(a,p0[r],p0[r+1]);b=max3f(b,p0[r+2],p0[r+3]);a=max3f(a,p1[r],p1[r+1]);b=max3f(b,p1[r+2],p1[r+3]);}
  const float m=max2f(a,b);
  auto rr=__builtin_amdgcn_permlane32_swap(__float_as_uint(m),__float_as_uint(m),false,false);
  return max2f(__uint_as_float(rr[0]),__uint_as_float(rr[1]));
}
__device__ __forceinline__ void pv(f32x16*o,int vb,bf16x8 pa0,bf16x8 pa1,bf16x8 pa2,bf16x8 pa3){
  #pragma unroll
  for(int d0=0;d0<2;++d0){s16x4 lo[4],hi[4];
    #pragma unroll
    for(int ks=0;ks<4;++ks){
      asm volatile("ds_read_b64_tr_b16 %0,%1 offset:%c2":"=&v"(lo[ks]):"v"(vb),"i"(d0*4096+ks*1024):"memory");
      asm volatile("ds_read_b64_tr_b16 %0,%1 offset:%c2":"=&v"(hi[ks]):"v"(vb),"i"(d0*4096+ks*1024+512):"memory");}
    asm volatile("s_waitcnt lgkmcnt(0)":::"memory");SBAR();
    #define PK(k) (bf16x8){lo[k][0],lo[k][1],lo[k][2],lo[k][3],hi[k][0],hi[k][1],hi[k][2],hi[k][3]}
    o[d0]=__builtin_amdgcn_mfma_f32_32x32x16_bf16(pa0,PK(0),o[d0],0,0,0);
    o[d0]=__builtin_amdgcn_mfma_f32_32x32x16_bf16(pa1,PK(1),o[d0],0,0,0);
    o[d0]=__builtin_amdgcn_mfma_f32_32x32x16_bf16(pa2,PK(2),o[d0],0,0,0);
    o[d0]=__builtin_amdgcn_mfma_f32_32x32x16_bf16(pa3,PK(3),o[d0],0,0,0);
    #undef PK
  }
}

#ifndef ATTN_STORE16
#define ATTN_STORE16(p,v) (*(u32x4*)(p)=(v))
#endif
template<int THRL> __device__ __forceinline__ void attn_unit(int b,int h,int qb,const bf16*Q,const bf16*__restrict__ K,const bf16*__restrict__ V,bf16*O,char*shm){
  const int tid=threadIdx.x,lane=tid&63,r32=lane&31,hi=lane>>5; const int wid=__builtin_amdgcn_readfirstlane(tid>>6);
  const long rowbase=(long)b*SEQ; const int q0=qb*QB;
  const bf16*Qw=Q+(rowbase+q0+wid*QBLK)*DM+h*D;
  const bf16*Kh=K+rowbase*DM+h*D,*Vh=V+rowbase*DM+h*D;
  const unsigned lds0=(unsigned)(uintptr_t)shm;
  float*wsf=(float*)(shm+LDS_WS)+wid*64;
  const bf16*ksrc=Kh+(long)lane*DM+wid*8;
  const bf16*vsrc=Vh+(long)(16*(wid&3)+(lane>>2))*DM+(wid>>2)*32+(lane&3)*8;
  const unsigned kdst=lds0+LDS_K+wid*1024, vdst=lds0+LDS_V+wid*1024;
  #define DMA_K(t,slot) glds16(ksrc+(long)(t)*KVBLK*DM,(unsigned)__builtin_amdgcn_readfirstlane(kdst+(slot)))
  #define DMA_V(t,slot) glds16(vsrc+(long)(t)*KVBLK*DM,(unsigned)__builtin_amdgcn_readfirstlane(vdst+(slot)))
  const int vb0=(int)(lds0+LDS_V)+((lane>>4)&1)*32+(lane&3)*8+(4*hi+((lane&15)>>2))*64;
  const char*Kbase=shm+LDS_K; bf16x8 kf[8];
  const lds_cptr shm3=(lds_cptr)shm; const lds_cptr kp0=shm3+LDS_K+hi*1024+r32*16; const lds_cptr vp0=shm3+LDS_V+((lane>>4)&1)*32+(lane&3)*8+(4*hi+((lane&15)>>2))*64;
  const int NT=SEQ/KVBLK;
  DMA_K(0,0);DMA_V(0,0);DMA_K(1,SLOTB);
  bf16x8 qr[4];
  #pragma unroll
  for(int d0=0;d0<4;++d0)qr[d0]=*reinterpret_cast<const bf16x8*>(&Qw[(long)r32*DM+d0*16+hi*8]);
  float mhat=0.f,l_reg=0.f;f32x16 o[2];o[0]=f32x16{};o[1]=f32x16{};f32x16 negm=f32x16{};asm volatile("":"+v"(negm));
  const int qrel=wid*QBLK+r32;
  #define CMASK(P0,P1,t) do{}while(0)
  bool resc=false;
  #define START(P0,P1) do{ const float rm=rowmax(P0,P1); resc=false; \
    { const float dl=rm; mhat=fadd_s(mhat,dl); \
      _Pragma("unroll") for(int r=0;r<16;++r){P0[r]=fsub_s(P0[r],dl);P1[r]=fsub_s(P1[r],dl);} \
      _Pragma("unroll") for(int r=0;r<16;++r)negm[r]=-mhat; asm volatile("":"+v"(negm)); } \
    _Pragma("unroll") for(int r=0;r<16;++r)P0[r]=__builtin_amdgcn_exp2f(P0[r]); }while(0)
  #define RESC() do{ if(resc){ asm volatile("s_waitcnt lgkmcnt(0)":::"memory"); \
      _Pragma("unroll") for(int d_=0;d_<2;++d_) _Pragma("unroll") for(int r=0;r<16;++r)o[d_][r]*=wsf[crow(r,hi)]; } }while(0)
  f32x16 pA0,pA1,pB0,pB1;
  int sl_prev=0,sl_cur=0,sl_next=SLOTB;
  #define ROT() do{sl_prev=sl_cur;sl_cur=sl_next;sl_next=(sl_next==(NSLOT-1)*SLOTB)?0:sl_next+SLOTB;}while(0)
  DMA_K(2,2*SLOTB);
  WAIT_BAR(3);
  qkt(pA0,pA1,Kbase,qr,negm,r32,hi);asm volatile("s_nop 15\n\ts_nop 7":"+v"(pA0),"+v"(pA1));CMASK(pA0,pA1,0);
  START(pA0,pA1);
  _Pragma("unroll") for(int r=0;r<16;++r)pA1[r]=__builtin_amdgcn_exp2f(pA1[r]);
  WAIT_BAR(0);
  DMA_K(3,0);DMA_V(1,SLOTB);
  ROT();
  kload8(kf,kp0+sl_cur);
  WAIT_BAR(2);
  s16x4 vlo[8],vhi[8]; u32x4 pw0,pw1,pw2,pw3;
  #define PKW(P,B) cvtpk_s(P[B],P[B+1])
  #define PAF(k) __builtin_bit_cast(bf16x8,pw##k)
  #define VFR(i) (bf16x8){vlo[i][0],vlo[i][1],vlo[i][2],vlo[i][3],vhi[i][0],vhi[i][1],vhi[i][2],vhi[i][3]}
  #define PIN(x) asm volatile("":"+v"(x))
  #define MX3(a,b,c) __builtin_fmaxf(__builtin_fmaxf((a),(b)),(c))
  #define GAPA(MF,A0,A1,A2,A3,W0,W1,PW) do{ MF; sacc+=A0; sacc+=A1; sacc+=A2; sacc+=A3; PIN(sacc); W0; W1; PIN(PW); SBAR(); }while(0)
  #define EX(v) __builtin_amdgcn_exp2f(v)
  #define GAPB(MF,X,B) do{ MF; X[B]=EX(X[B]); X[B+1]=EX(X[B+1]); X[B+2]=EX(X[B+2]); X[B+3]=EX(X[B+3]); PIN(X); SBAR(); }while(0)
  #define VRD(i) do{ vlo[i]=vtr(vp_+(((i)>>2)*4096+((i)&3)*1024)); vhi[i]=vtr(vp_+(((i)>>2)*4096+((i)&3)*1024+512)); }while(0)
  #define KRD(G,j) do{ if(G){ kload2(kf,kp0+sl_next,j); SBAR(); } }while(0)
  #define STEP(C0,C1,P0,P1,t,GK,GV,GL) do{ SBAR(); \
    const lds_cptr vp_=vp0+sl_prev; \
    VRD(0); SBAR(); float sacc=(P0[0]+P0[1]); \
    GAPA(C0=__builtin_amdgcn_mfma_f32_32x32x16_bf16(kf[0],qr[0],negm,0,0,0), P0[2],P0[3],P0[4],P0[5],     pw0[0]=PKW(P0,0), pw0[1]=PKW(P0,2), pw0); \
    VRD(4); SBAR(); GAPA(C1=__builtin_amdgcn_mfma_f32_32x32x16_bf16(kf[1],qr[0],negm,0,0,0), P0[6],P0[7],P0[8],P0[9],     pw0[2]=PKW(P0,4), pw0[3]=PKW(P0,6), pw0); \
    VRD(1); SBAR(); GAPA(C0=__builtin_amdgcn_mfma_f32_32x32x16_bf16(kf[2],qr[1],C0,0,0,0),   P0[10],P0[11],P0[12],P0[13], pw1[0]=PKW(P0,8), pw1[1]=PKW(P0,10), pw1); \
    VRD(5); SBAR(); GAPA(C1=__builtin_amdgcn_mfma_f32_32x32x16_bf16(kf[3],qr[1],C1,0,0,0),   P0[14],P0[15],P1[0],P1[1],   pw1[2]=PKW(P0,12),pw1[3]=PKW(P0,14), pw1); \
    VRD(2); SBAR(); GAPA(C0=__builtin_amdgcn_mfma_f32_32x32x16_bf16(kf[4],qr[2],C0,0,0,0),   P1[2],P1[3],P1[4],P1[5],     pw2[0]=PKW(P1,0), pw2[1]=PKW(P1,2), pw2); \
    VRD(6); SBAR(); GAPA(C1=__builtin_amdgcn_mfma_f32_32x32x16_bf16(kf[5],qr[2],C1,0,0,0),   P1[6],P1[7],P1[8],P1[9],     pw2[2]=PKW(P1,4), pw2[3]=PKW(P1,6), pw2); \
    VRD(3); SBAR(); GAPA(C0=__builtin_amdgcn_mfma_f32_32x32x16_bf16(kf[6],qr[3],C0,0,0,0),   P1[10],P1[11],P1[12],P1[13], pw3[0]=PKW(P1,8), pw3[1]=PKW(P1,10), pw3); \
    VRD(7); SBAR(); GAPA(C1=__builtin_amdgcn_mfma_f32_32x32x16_bf16(kf[7],qr[3],C1,0,0,0),   P1[14],P1[15],0.f,0.f,       pw3[2]=PKW(P1,12),pw3[3]=PKW(P1,14), pw3); \
    l_reg+=sacc; \
    if(GK){DMA_K((t)+3,sl_cur);} if(GV){DMA_V((t)+1,sl_next);} \
    CMASK(C0,C1,t); \
    { float a=MX3(C0[0],C0[1],C1[0]),b=MX3(C0[2],C0[3],C1[1]); a=MX3(a,C1[2],C1[3]); \
      _Pragma("unroll") for(int r=4;r<16;r+=4){a=MX3(a,C0[r],C0[r+1]);b=MX3(b,C0[r+2],C0[r+3]);a=MX3(a,C1[r],C1[r+1]);b=MX3(b,C1[r+2],C1[r+3]);} \
      float rm=__builtin_fmaxf(a,b); { auto rr=__builtin_amdgcn_permlane32_swap(__float_as_uint(rm),__float_as_uint(rm),false,false); rm=__builtin_fmaxf(__uint_as_float(rr[0]),__uint_as_float(rr[1])); } \
      resc=false; \
      if(__builtin_expect(__any(rm>(float)THRL),0)){ const float dl=__builtin_fmaxf(rm,0.f); mhat+=dl; \
        _Pragma("unroll") for(int r=0;r<16;++r){C0[r]-=dl;C1[r]-=dl;} \
        _Pragma("unroll") for(int r=0;r<16;++r)negm[r]=-mhat; asm volatile("":"+v"(negm)); \
        const float f=__builtin_amdgcn_exp2f(-dl); l_reg*=f; if(hi==0)wsf[r32]=f; resc=true; } } \
    SBAR(); \
    GAPB(o[0]=__builtin_amdgcn_mfma_f32_32x32x16_bf16(PAF(0),VFR(0),o[0],0,0,0), C0,0); \
    GAPB(o[1]=__builtin_amdgcn_mfma_f32_32x32x16_bf16(PAF(0),VFR(4),o[1],0,0,0), C0,4); \
    KRD(GL,0); GAPB(o[0]=__builtin_amdgcn_mfma_f32_32x32x16_bf16(PAF(1),VFR(1),o[0],0,0,0), C0,8); \
    KRD(GL,1); GAPB(o[1]=__builtin_amdgcn_mfma_f32_32x32x16_bf16(PAF(1),VFR(5),o[1],0,0,0), C0,12); \
    KRD(GL,2); GAPB(o[0]=__builtin_amdgcn_mfma_f32_32x32x16_bf16(PAF(2),VFR(2),o[0],0,0,0), C1,0); \
    KRD(GL,3); GAPB(o[1]=__builtin_amdgcn_mfma_f32_32x32x16_bf16(PAF(2),VFR(6),o[1],0,0,0), C1,4); \
    GAPB(o[0]=__builtin_amdgcn_mfma_f32_32x32x16_bf16(PAF(3),VFR(3),o[0],0,0,0), C1,8); \
    GAPB(o[1]=__builtin_amdgcn_mfma_f32_32x32x16_bf16(PAF(3),VFR(7),o[1],0,0,0), C1,12); \
    }while(0)
  int t=1;
  #undef CMASK
  #define CMASK(P0,P1,t) do{}while(0)
  for(;t+5<NT;t+=2){
    STEP(pB0,pB1,pA0,pA1,t,true,true,true);     WAIT_BAR(2); RESC(); ROT();
    STEP(pA0,pA1,pB0,pB1,t+1,true,true,true);   WAIT_BAR(2); RESC(); ROT();
  }
  #undef CMASK
  #define CMASK(P0,P1,t) do{}while(0)
  #define ENDW(tt) do{ if((tt)+3<NT){WAIT_BAR(2);} else if((tt)+2<NT){WAIT_BAR(1);} else {WAIT_BAR(0);} }while(0)
  for(;t+1<NT;t+=2){
    STEP(pB0,pB1,pA0,pA1,t,(t+3<NT),(t+1<NT),(t+1<NT));       ENDW(t);   RESC(); ROT();
    STEP(pA0,pA1,pB0,pB1,t+1,(t+4<NT),(t+2<NT),(t+2<NT));     ENDW(t+1); RESC(); ROT();
  }
  STEP(pB0,pB1,pA0,pA1,NT-1,false,false,false); RESC();
  { float sacc=pB0[0]+pB0[1]; _Pragma("unroll") for(int r=2;r<16;++r)sacc+=pB0[r]; _Pragma("unroll") for(int r=0;r<16;++r)sacc+=pB1[r]; l_reg+=sacc;
    pw0=(u32x4){PKW(pB0,0),PKW(pB0,2),PKW(pB0,4),PKW(pB0,6)};pw1=(u32x4){PKW(pB0,8),PKW(pB0,10),PKW(pB0,12),PKW(pB0,14)};pw2=(u32x4){PKW(pB1,0),PKW(pB1,2),PKW(pB1,4),PKW(pB1,6)};pw3=(u32x4){PKW(pB1,8),PKW(pB1,10),PKW(pB1,12),PKW(pB1,14)};
    SBAR(); pv(o,vb0+sl_cur,PAF(0),PAF(1),PAF(2),PAF(3)); }
  #undef PKW
  #undef PAF
  #undef VFR
  #undef PIN
  #undef MX3
  #undef GAPA
  #undef GAPB
  #undef EX
  #undef VRD
  #undef KRD
  #undef STEP
  #undef ENDW
  {auto rr=__builtin_amdgcn_permlane32_swap(__float_as_uint(l_reg),__float_as_uint(l_reg),false,false);l_reg=__uint_as_float(rr[0])+__uint_as_float(rr[1]);}
  if(hi==0)wsf[32+r32]=l_reg;asm volatile("s_waitcnt lgkmcnt(0)":::"memory");
  float rli[16];
  #pragma unroll
  for(int r=0;r<16;++r)rli[r]=__builtin_amdgcn_rcpf(wsf[32+crow(r,hi)]);
  bf16*Ow=O+(rowbase+q0+wid*QBLK)*DM+h*D;
  { bf16*stg=(bf16*)(shm+LDS_OST)+wid*2048;
    #pragma unroll
    for(int r=0;r<16;++r){const int orow=crow(r,hi);
      #pragma unroll
      for(int d0=0;d0<2;++d0)stg[orow*64+d0*32+r32]=__float2bfloat16(o[d0][r]*rli[r]);}
    asm volatile("s_waitcnt lgkmcnt(0)":::"memory");
    #pragma unroll
    for(int i=0;i<4;++i){const int row=i*8+(lane>>3),ch=lane&7; const u32x4 v=*(const u32x4*)(stg+row*64+ch*8); ATTN_STORE16(Ow+(long)row*DM+ch*8,v);} }
  asm volatile("s_waitcnt lgkmcnt(0)\n\ts_barrier":::"memory");
  #undef DMA_K
  #undef DMA_V
  #undef CMASK
  #undef START
  #undef RESC
  #undef ROT
}
constexpr int ATTN_LDS_BYTES=LDS_BYTES;
struct AttnUnit { int pair; int qb; };
struct DiffOrder {
  int vcu,G,blk;
  __device__ __forceinline__ explicit DiffOrder(int grid,int block):vcu((block%8)*(grid/8)+block/8),G(grid),blk(block){}
  __device__ __forceinline__ bool next(int i,AttnUnit&u)const{
    if(G==256){ if(i>=16)return false; u.pair=(vcu&~31)+2*i+((vcu>>4)&1); u.qb=vcu&15; return true; }
    const int L=i*G+blk; if(L>=4096)return false; u.pair=L>>4; u.qb=L&15; return true; }
};
template<int THRL=8> __device__ __forceinline__ void diff_attn_phase(char*lds,const bf16*QB,const bf16*KB,const bf16*VB,bf16*O1,bf16*O2,const DiffOrder&S){
  AttnUnit u;
  for(int i=0;S.next(i,u);++i){ const int b=u.pair>>5,vh=u.pair&31,h=vh>>2,m=(vh>>1)&1,c=vh&1;
    attn_unit<THRL>(b,0,u.qb,QB+h*128+m*64,KB+h*128+m*64,VB+h*128+c*64,(m?O2:O1)+h*128+c*64,lds); }
}
#undef SBAR
#undef WAIT_BAR
}

constexpr int NWAVES = 8;
constexpr size_t MiB = 1u << 20;
constexpr size_t WS_CTL = 0, CTL_ZERO_BYTES = 1 * MiB;
constexpr size_t WS_MOD = 1 * MiB;
constexpr int MOD_LAM = 8 * 6144;
constexpr size_t WS_WIN = 2 * MiB, WS_WPA = 17 * MiB, WS_WPB = 18 * MiB, WS_WOUT = 20 * MiB, WS_WQ = 22 * MiB, WS_SK = 26 * MiB;
constexpr size_t WS_R1 = 32 * MiB;
constexpr size_t WS_QA = 96 * MiB, WS_KA = 144 * MiB, WS_VA = 192 * MiB;
constexpr size_t WS_O2 = 96 * MiB, WS_OA = 160 * MiB, WS_OB = 176 * MiB;
constexpr size_t WS_EU = 96 * MiB, WS_EV = 128 * MiB;
constexpr size_t WS_QB = 240 * MiB, WS_KB = 304 * MiB, WS_VB = 368 * MiB;
constexpr size_t WS_MIX = 240 * MiB, WS_TMP = 304 * MiB;
constexpr size_t WS_QP = 240 * MiB;
constexpr size_t WS_OUTG = 432 * MiB, WS_LSE = 480 * MiB;
constexpr size_t WS_IDX = 432 * MiB, WS_GATE = 448 * MiB;
constexpr size_t WS_END = 512 * MiB;
constexpr int CW_TMO = 0, CW_BAR = 4096;
constexpr int RING_OFF = 0, RING_BYTES = 131072;
constexpr int LDSCTL_OFF = RING_BYTES, MISC_OFF = LDSCTL_OFF + 320;
constexpr int LDS_BYTES = 147456;
constexpr int N_PHASES = 13;

#define GAS __attribute__((address_space(1)))
#define LAS __attribute__((address_space(3)))
typedef unsigned short bf16;
typedef unsigned v4u __attribute__((ext_vector_type(4)));
typedef float f32x4 __attribute__((ext_vector_type(4)));
typedef short bf16x8 __attribute__((ext_vector_type(8)));
typedef GAS unsigned gu32;
typedef GAS unsigned long long gu64;
#define RLX_AGENT __ATOMIC_RELAXED, __HIP_MEMORY_SCOPE_AGENT
#define LDS_WAIT() asm volatile("s_waitcnt lgkmcnt(0)" ::: "memory")
#define VM_WAIT() asm volatile("s_waitcnt vmcnt(0)" ::: "memory")
__device__ __forceinline__ unsigned long long rt() { return __builtin_amdgcn_s_memrealtime(); }
__device__ __forceinline__ unsigned f2bf(float f) { unsigned u = __builtin_bit_cast(unsigned, f); return (u + 0x7fffu + ((u >> 16) & 1u)) >> 16; }
__device__ __forceinline__ unsigned pk2(float lo, float hi) { return f2bf(lo) | (f2bf(hi) << 16); }

#define XB_TMO      128
#define XB_XCNT(j)  (256  + 64 * (j))
#define XB_XSUB(j)  (1280 + 64 * (j))
#define XB_XGEN(j)  (2304 + 64 * (j))
#define XB_TOP      3328
#define XB_TOPGEN   3392
#define XCD_BAR_WORDS 3456
#define XB_SPIN_CAP (1u << 18)

__device__ __forceinline__ unsigned xb_ld(unsigned* p)              { return __hip_atomic_load(p, __ATOMIC_RELAXED, __HIP_MEMORY_SCOPE_AGENT); }
__device__ __forceinline__ unsigned xb_add(unsigned* p, unsigned v) { return __hip_atomic_fetch_add(p, v, __ATOMIC_RELAXED, __HIP_MEMORY_SCOPE_AGENT); }
__device__ __forceinline__ unsigned xb_xcc_id() { return (unsigned)__builtin_amdgcn_s_getreg((3 << 11) | 20) & 0xFu; }
#define XB_SPIN(cond, bar) do { unsigned _sp = 0; while (cond) { __builtin_amdgcn_s_sleep(1); \
    if ((++_sp & 255u) == 0u) { if (xb_ld(&(bar)[XB_TMO])) break; if (_sp > XB_SPIN_CAP) { atomicAdd(&(bar)[XB_TMO], 1u); break; } } } } while (0)

struct XcdBarrier {
    unsigned* bar; unsigned x;
    volatile LAS unsigned* st;
};

__device__ __forceinline__ XcdBarrier xcd_barrier_post(unsigned* bar, volatile LAS unsigned* st) {
    XcdBarrier b; b.bar = bar; b.x = xb_xcc_id(); b.st = st;
    if (threadIdx.x == 0) (void)xb_add(&bar[XB_XCNT(b.x)], 1u);
    return b;
}
__device__ __forceinline__ void xcd_barrier_complete(unsigned* bar, unsigned x, unsigned& nloc, unsigned& nx) {
    const unsigned G = gridDim.x * gridDim.y * gridDim.z;
    unsigned sum, cnt, mine, sp = 0u;
    for (;;) {
        sum = 0u; cnt = 0u; mine = 0u;
#pragma unroll
        for (unsigned j = 0; j < 16; ++j) { const unsigned c = xb_ld(&bar[XB_XCNT(j)]); sum += c; cnt += (c > 0u) ? 1u : 0u; mine = (j == x) ? c : mine; }
        if (sum == G) break;
        __builtin_amdgcn_s_sleep(1);
        if ((++sp & 255u) == 0u) { if (xb_ld(&bar[XB_TMO])) break; if (sp > XB_SPIN_CAP) { atomicAdd(&bar[XB_TMO], 1u); break; } }
    }
    nloc = mine > 0u ? mine : 1u; nx = cnt > 0u ? cnt : 1u;
}

__device__ __forceinline__ void xcd_barrier(const XcdBarrier& b) {
    asm volatile("s_waitcnt vmcnt(0)" ::: "memory");
    __syncthreads();
    if (threadIdx.x == 0) {
        unsigned* bar = b.bar;
        __builtin_amdgcn_s_waitcnt(0);
        unsigned nloc = b.st[0], nx = b.st[1];
        if (nloc == 0u) { xcd_barrier_complete(bar, b.x, nloc, nx); b.st[0] = nloc; b.st[1] = nx; }
        const unsigned old = xb_add(&bar[XB_XSUB(b.x)], 1u);
        const unsigned gen = old / nloc;
        if (old + 1u == (gen + 1u) * nloc) {
            __builtin_amdgcn_fence(__ATOMIC_RELEASE, "agent");
            asm volatile("s_waitcnt vmcnt(0)" ::: "memory");
            const unsigned og = xb_add(&bar[XB_TOP], 1u);
            const unsigned tg = og / nx;
            if (og + 1u == (tg + 1u) * nx) xb_add(&bar[XB_TOPGEN], 1u);
            else XB_SPIN(xb_ld(&bar[XB_TOPGEN]) == tg, bar);
            __builtin_amdgcn_fence(__ATOMIC_ACQUIRE, "agent");
            xb_add(&bar[XB_XGEN(b.x)], 1u);
            asm volatile("s_waitcnt vmcnt(0)" ::: "memory");
        } else {
            XB_SPIN(xb_ld(&bar[XB_XGEN(b.x)]) == gen, bar);
            __builtin_amdgcn_fence(__ATOMIC_ACQUIRE, "agent");
            asm volatile("s_waitcnt vmcnt(0)" ::: "memory");
        }
    }
    __syncthreads();
}
__device__ __forceinline__ float wave_sum(float v) {
#pragma unroll
    for (int o = 1; o < 64; o <<= 1) v += __shfl_xor(v, o);
    return v;
}
__device__ __forceinline__ void p0_transpose_item(const float* W, int K, int N, bf16* WT, int row_off, LAS float* scr, int item, int lane) {
    const int nblk = N / 32, kb = item / nblk, nb = item % nblk, k0 = 64 * kb, n0 = 32 * nb;
#pragma unroll 8
    for (int i = 0; i < 32; ++i) { const int kk = 2 * i + (lane >> 5); scr[kk * 33 + (lane & 31)] = W[(size_t)(k0 + kk) * N + n0 + (lane & 31)]; }
    LDS_WAIT(); asm volatile("" ::: "memory");
    const int c = lane & 7;
#pragma unroll
    for (int j = 0; j < 4; ++j) { const int n = (lane >> 3) + 8 * j; const LAS float* s = scr + (8 * c) * 33 + n;
        v4u o; o.x = pk2(s[0 * 33], s[1 * 33]); o.y = pk2(s[2 * 33], s[3 * 33]); o.z = pk2(s[4 * 33], s[5 * 33]); o.w = pk2(s[6 * 33], s[7 * 33]);
        *(GAS v4u*)(WT + (size_t)(row_off + n0 + n) * K + k0 + 8 * c) = o; }
    LDS_WAIT(); asm volatile("" ::: "memory");
}

typedef float f32x16 __attribute__((ext_vector_type(16)));
typedef unsigned u32x2 __attribute__((ext_vector_type(2)));
typedef __bf16 bf16x2v __attribute__((ext_vector_type(2)));
struct Frame {
    LAS unsigned char* lds;
    volatile LAS unsigned* MISC;
    gu32* ctl;
    int tid, lane, wave;
    int vcu, G;
};
struct Args { const void* in[25]; float* out; unsigned char* ws; int ph_lo, ph_hi; };

__device__ __forceinline__ float bflo(unsigned w) { return __uint_as_float(w << 16); }
__device__ __forceinline__ float bfhi(unsigned w) { return __uint_as_float(w & 0xffff0000u); }
__device__ __forceinline__ float dot2bf(unsigned a, unsigned b, float acc) { return __builtin_amdgcn_fdot2_f32_bf16(__builtin_bit_cast(bf16x2v, a), __builtin_bit_cast(bf16x2v, b), acc, false); }

__device__ __forceinline__ void p0_prologue(Frame& F, const Args& a) {
    float* modp = (float*)(a.ws + WS_MOD);
    {
        LAS float* sc = (LAS float*)F.lds;
        LAS float* red = (LAS float*)(F.lds + 32768);
        const float* c = (const float*)a.in[1]; const float* w_ada = (const float*)a.in[3]; const float* b_ada = (const float*)a.in[4];
        bool did = false;
        for (int u = F.vcu; u < 192; u += F.G) {
            if (!did) { for (int i = F.tid; i < 8192; i += NWAVES * 64) { const float v = c[i]; sc[i] = v / (1.f + __expf(-v)); } __syncthreads(); did = true; }
            const int cc = F.tid & 31, kg = F.tid >> 5, col = u * 32 + cc;
            float acc[8];
#pragma unroll
            for (int b = 0; b < 8; ++b) acc[b] = 0.f;
#pragma unroll 8
            for (int k = kg * 64; k < kg * 64 + 64; ++k) { const float w = w_ada[(size_t)k * 6144 + col];
#pragma unroll
                for (int b = 0; b < 8; ++b) acc[b] += sc[b * 1024 + k] * w; }
#pragma unroll
            for (int b = 0; b < 8; ++b) red[(kg * 8 + b) * 32 + cc] = acc[b];
            __syncthreads();
            if (F.tid < 256) { const int b = F.tid >> 5; float s = b_ada[col];
#pragma unroll
                for (int g = 0; g < 16; ++g) s += red[(g * 8 + b) * 32 + cc];
                modp[b * 6144 + col] = s; }
            __syncthreads();
        }
        if (F.vcu == F.G - 1 && F.wave == 0) {
            const float p1 = ((const float*)a.in[13])[F.lane] * ((const float*)a.in[14])[F.lane];
            const float p2 = ((const float*)a.in[15])[F.lane] * ((const float*)a.in[16])[F.lane];
            const float s1 = wave_sum(p1), s2 = wave_sum(p2);
            if (F.lane == 0) modp[MOD_LAM] = expf(s1) - expf(s2) + LAM_INIT;
        }
        __syncthreads();
    }
    LAS float* scr = (LAS float*)(F.lds + RING_OFF + F.wave * 16384);
    const int gw = F.vcu * NWAVES + F.wave, NGW = F.G * NWAVES;
    constexpr int I_IN = (D / 64) * (IN_W / 32), I_PA = (DIL_OUT / 64) * (D / 32), I_PB = (D / 64) * (D / 32), I_OUT = I_PB, I_Q = (D / 64) * (PEER_QW / 32);
    constexpr int NITEMS = I_IN + I_PA + I_PB + I_OUT + I_Q;
    for (int it = gw; it < NITEMS; it += NGW) {
        int r = it;
        if (r < I_IN) { p0_transpose_item((const float*)a.in[6], D, IN_W, (bf16*)(a.ws + WS_WIN), 0, scr, r, F.lane); continue; } r -= I_IN;
        if (r < I_PA) { p0_transpose_item((const float*)a.in[10], DIL_OUT, D, (bf16*)(a.ws + WS_WPA), 0, scr, r, F.lane); continue; } r -= I_PA;
        if (r < I_PB) { p0_transpose_item((const float*)a.in[18], D, D, (bf16*)(a.ws + WS_WPB), 0, scr, r, F.lane); continue; } r -= I_PB;
        if (r < I_OUT) { p0_transpose_item((const float*)a.in[19], D, D, (bf16*)(a.ws + WS_WOUT), 0, scr, r, F.lane); continue; } r -= I_OUT;
        p0_transpose_item((const float*)a.in[21], D, PEER_QW, (bf16*)(a.ws + WS_WQ), 0, scr, r, F.lane);
    }
    { const float* sk = (const float*)a.in[22]; bf16* o = (bf16*)(a.ws + WS_SK);
      for (int i = (F.vcu * NWAVES * 64 + F.tid); i < 8 * 2 * 128 * 128 / 8; i += F.G * NWAVES * 64) {
          const f32x4 v0 = *(const GAS f32x4*)(sk + (size_t)i * 8), v1 = *(const GAS f32x4*)(sk + (size_t)i * 8 + 4);
          v4u w; w.x = pk2(v0.x, v0.y); w.y = pk2(v0.z, v0.w); w.z = pk2(v1.x, v1.y); w.w = pk2(v1.z, v1.w);
          *(GAS v4u*)(o + (size_t)i * 8) = w; } }
}

__device__ __forceinline__ void convert_bf16(Frame& F, const float* src, bf16* dst, size_t n8) {
    for (size_t i = (size_t)F.vcu * NWAVES * 64 + F.tid; i < n8; i += (size_t)F.G * NWAVES * 64) {
        const f32x4 v0 = *(const GAS f32x4*)(src + i * 8), v1 = *(const GAS f32x4*)(src + i * 8 + 4);
        v4u w; w.x = pk2(v0.x, v0.y); w.y = pk2(v0.z, v0.w); w.z = pk2(v1.x, v1.y); w.w = pk2(v1.z, v1.w);
        *(GAS v4u*)(dst + i * 8) = w; }
}

__device__ __forceinline__ void norm_mod_rows(Frame& F, const float* xin, const float* g, const float* modp, int sh_off, int sc_off, bf16* out) {
    const int gw = F.vcu * NWAVES + F.wave, NGW = F.G * NWAVES;
    f32x4 gg[4];
#pragma unroll
    for (int j = 0; j < 4; ++j) gg[j] = ((const GAS f32x4*)g)[F.lane + 64 * j];
    for (int m = gw; m < T; m += NGW) {
        const int b = m >> 12;
        const GAS f32x4* xr = (const GAS f32x4*)(xin + (size_t)m * D) + F.lane;
        f32x4 v[4]; float s = 0.f;
#pragma unroll
        for (int j = 0; j < 4; ++j) { v[j] = xr[64 * j]; s += (v[j].x * v[j].x + v[j].y * v[j].y) + (v[j].z * v[j].z + v[j].w * v[j].w); }
        const float rstd = 1.f / sqrtf(wave_sum(s) * (1.f / D) + EPS);
        const GAS f32x4* shp = (const GAS f32x4*)(modp + (size_t)b * 6144 + sh_off) + F.lane;
        const GAS f32x4* scp = (const GAS f32x4*)(modp + (size_t)b * 6144 + sc_off) + F.lane;
        GAS unsigned long long* o8 = (GAS unsigned long long*)(out + (size_t)m * D) + F.lane;
#pragma unroll
        for (int j = 0; j < 4; ++j) { const f32x4 sc = scp[64 * j], sh = shp[64 * j];
            const f32x4 y = v[j] * rstd * gg[j] * (sc + 1.0f) + sh;
            o8[64 * j] = (unsigned long long)pk2(y.x, y.y) | ((unsigned long long)pk2(y.z, y.w) << 32); }
    }
}

template <int NIT>
__device__ __forceinline__ void normrope_buf(bf16* base, int hq, int dd, const float (&g)[4], float c0, float s0, float c1, float s1, float qs) {
    unsigned lo[NIT], hi[NIT];
#pragma unroll
    for (int it = 0; it < NIT; ++it) { const bf16* p = base + (it * 4 + hq) * 64 + dd; lo[it] = *(const GAS unsigned*)p; hi[it] = *(const GAS unsigned*)(p + 32); }
#pragma unroll
    for (int it = 0; it < NIT; ++it) {
        const float x1a = bflo(lo[it]), x1b = bfhi(lo[it]), x2a = bflo(hi[it]), x2b = bfhi(hi[it]);
        float ss = (x1a * x1a + x1b * x1b) + (x2a * x2a + x2b * x2b);
        ss += __shfl_xor(ss, 1); ss += __shfl_xor(ss, 2); ss += __shfl_xor(ss, 4); ss += __shfl_xor(ss, 8);
        const float rstd = 1.f / sqrtf(ss * (1.f / 64.f) + EPS);
        const float y1a = x1a * rstd * g[0], y1b = x1b * rstd * g[1], y2a = x2a * rstd * g[2], y2b = x2b * rstd * g[3];
        const float o1a = (y1a * c0 - y2a * s0) * qs, o2a = (y2a * c0 + y1a * s0) * qs;
        const float o1b = (y1b * c1 - y2b * s1) * qs, o2b = (y2b * c1 + y1b * s1) * qs;
        bf16* p = base + (it * 4 + hq) * 64 + dd;
        *(GAS unsigned*)p = pk2(o1a, o1b); *(GAS unsigned*)(p + 32) = pk2(o2a, o2b);
    }
}
__device__ __forceinline__ void p3_normrope(Frame& F, const Args& a) {
    const int gw = F.vcu * NWAVES + F.wave, NGW = F.G * NWAVES;
    const int sub = F.lane & 15, hq = F.lane >> 4, dd = 2 * sub;
    bf16* QA = (bf16*)(a.ws + WS_QA); bf16* KA = (bf16*)(a.ws + WS_KA); bf16* QB = (bf16*)(a.ws + WS_QB); bf16* KB = (bf16*)(a.ws + WS_KB);
    const int* positions = (const int*)a.in[2];
    float g[4][4];
    { const float* gp[4] = {(const float*)a.in[8], (const float*)a.in[9], (const float*)a.in[11], (const float*)a.in[12]};
#pragma unroll
      for (int i = 0; i < 4; ++i) { g[i][0] = gp[i][dd]; g[i][1] = gp[i][dd + 1]; g[i][2] = gp[i][dd + 32]; g[i][3] = gp[i][dd + 33]; } }
    constexpr float L2T = 13.287712379549449f / 32.f;
    const float f0 = exp2f(-(float)dd * L2T), f1 = exp2f(-(float)(dd + 1) * L2T);
    for (int t = gw; t < T; t += NGW) {
        const float pos = (float)positions[t];
        float s0, c0, s1, c1; sincosf(pos * f0, &s0, &c0); sincosf(pos * f1, &s1, &c1);
        normrope_buf<3>(QA + (size_t)t * 768, hq, dd, g[0], c0, s0, c1, s1, QSCALE);
        normrope_buf<3>(KA + (size_t)t * 768, hq, dd, g[1], c0, s0, c1, s1, 1.0f);
        normrope_buf<4>(QB + (size_t)t * 1024, hq, dd, g[2], c0, s0, c1, s1, QSCALE);
        normrope_buf<4>(KB + (size_t)t * 1024, hq, dd, g[3], c0, s0, c1, s1, 1.0f);
    }
}

__device__ __forceinline__ void p4_dilated(Frame& F, const Args& a) {
    constexpr int ROWB = 144;
    const bf16* QA = (const bf16*)(a.ws + WS_QA); const bf16* KA = (const bf16*)(a.ws + WS_KA); const bf16* VA = (const bf16*)(a.ws + WS_VA);
    bf16* OUTG = (bf16*)(a.ws + WS_OUTG); float* LSE = (float*)(a.ws + WS_LSE);
    LAS unsigned char* Ks = F.lds; LAS unsigned char* Vs = F.lds + 384 * ROWB;
    const int tid = F.tid, l = F.lane, qi = F.wave * 32 + (l & 31), hf = l >> 5;
    for (int u = F.vcu; u < 1536; u += F.G) {
        const int rc = u & 15, bh = u >> 4, head = bh % 12, b = bh / 12, g = head >> 2, hslot = head & 3;
        const int dsh = 2 * g, L = SEQ >> dsh, nchunk = L >> 8;
        const int r = rc / nchunk, chunk = rc % nchunk, j0 = chunk << 8;
#pragma unroll
        for (int p = 0; p < 6; ++p) { const int row = p * 64 + (tid >> 3), ch = tid & 7, jj = j0 - 64 + row;
            v4u kv = (v4u){0u, 0u, 0u, 0u}, vv = (v4u){0u, 0u, 0u, 0u};
            if ((unsigned)jj < (unsigned)L) { const size_t tok = (size_t)b * SEQ + r + ((size_t)jj << dsh);
                kv = *(const GAS v4u*)(KA + tok * 768 + head * 64 + ch * 8); vv = *(const GAS v4u*)(VA + tok * 768 + head * 64 + ch * 8); }
            *(LAS v4u*)(Ks + row * ROWB + ch * 16) = kv; *(LAS v4u*)(Vs + row * ROWB + ch * 16) = vv; }
        const int j = j0 + qi; const size_t qtok = (size_t)b * SEQ + r + ((size_t)j << dsh);
        unsigned q[32];
#pragma unroll
        for (int c = 0; c < 8; ++c) { const v4u t4 = *(const GAS v4u*)(QA + qtok * 768 + head * 64 + c * 8); q[4 * c] = t4.x; q[4 * c + 1] = t4.y; q[4 * c + 2] = t4.z; q[4 * c + 3] = t4.w; }
        __syncthreads();
        float m = -INFINITY, lsum = 0.f; float o[64];
#pragma unroll
        for (int i = 0; i < 64; ++i) o[i] = 0.f;
        const int rowbase = qi + hf * 64, nk = 64 + hf;
        for (int kk = 0; kk < nk; ++kk) {
            const int row = rowbase + kk, jj = j0 - 64 + row;
            if ((unsigned)jj < (unsigned)L) {
                const LAS v4u* kp = (const LAS v4u*)(Ks + row * ROWB);
                float s0 = 0.f, s1 = 0.f, s2 = 0.f, s3 = 0.f;
#pragma unroll
                for (int c = 0; c < 8; ++c) { const v4u kv = kp[c]; s0 = dot2bf(kv.x, q[4 * c], s0); s1 = dot2bf(kv.y, q[4 * c + 1], s1); s2 = dot2bf(kv.z, q[4 * c + 2], s2); s3 = dot2bf(kv.w, q[4 * c + 3], s3); }
                const float s = (s0 + s1) + (s2 + s3);
                if (s > m + 8.f) { const float f = exp2f(m - s); lsum *= f;
#pragma unroll
                    for (int i = 0; i < 64; ++i) o[i] *= f;
                    m = s; }
                const float p = exp2f(s - m); lsum += p;
                const LAS v4u* vp = (const LAS v4u*)(Vs + row * ROWB);
#pragma unroll
                for (int c = 0; c < 8; ++c) { const v4u vv = vp[c];
                    o[8 * c + 0] += p * bflo(vv.x); o[8 * c + 1] += p * bfhi(vv.x); o[8 * c + 2] += p * bflo(vv.y); o[8 * c + 3] += p * bfhi(vv.y);
                    o[8 * c + 4] += p * bflo(vv.z); o[8 * c + 5] += p * bfhi(vv.z); o[8 * c + 6] += p * bflo(vv.w); o[8 * c + 7] += p * bfhi(vv.w); }
            }
        }
        const float mo = __shfl_xor(m, 32), M = fmaxf(m, mo);
        const float f = exp2f(m - M);
        float lt = lsum * f; lt += __shfl_xor(lt, 32);
        const float inv = 1.f / lt;
        unsigned pk[16];
#pragma unroll
        for (int i = 0; i < 32; i += 2) {
            float a0 = o[i] * f, a1 = o[i + 1] * f, b0 = o[32 + i] * f, b1 = o[33 + i] * f;
            a0 += __shfl_xor(a0, 32); a1 += __shfl_xor(a1, 32); b0 += __shfl_xor(b0, 32); b1 += __shfl_xor(b1, 32);
            pk[i >> 1] = hf ? pk2(b0 * inv, b1 * inv) : pk2(a0 * inv, a1 * inv);
        }
        bf16* op = OUTG + ((size_t)g * T + qtok) * 256 + hslot * 64 + hf * 32;
#pragma unroll
        for (int c = 0; c < 4; ++c) *(GAS v4u*)(op + c * 8) = (v4u){pk[4 * c], pk[4 * c + 1], pk[4 * c + 2], pk[4 * c + 3]};
        if (hf == 0) LSE[((size_t)g * T + qtok) * 4 + hslot] = M + log2f(lt);
        __syncthreads();
    }
}

__device__ __forceinline__ void p6_combine(Frame& F, const Args& a) {
    const int gw = F.vcu * NWAVES + F.wave, NGW = F.G * NWAVES, l = F.lane;
    const bf16* OUTG = (const bf16*)(a.ws + WS_OUTG); const float* LSE = (const float*)(a.ws + WS_LSE);
    const bf16* O1 = (const bf16*)(a.ws + WS_R1); const bf16* O2 = (const bf16*)(a.ws + WS_O2);
    bf16* OA = (bf16*)(a.ws + WS_OA); bf16* OB = (bf16*)(a.ws + WS_OB);
    const float lam = ((const float*)(a.ws + WS_MOD))[MOD_LAM];
    float sg[16];
#pragma unroll
    for (int i = 0; i < 16; ++i) sg[i] = ((const float*)a.in[17])[(l & 7) * 16 + i] * (1.0f - LAM_INIT);
    for (int t = gw; t < T; t += NGW) {
        {   const int hslot = l >> 4, d4 = (l & 15) * 4;
            float ls[3];
#pragma unroll
            for (int g = 0; g < 3; ++g) ls[g] = LSE[((size_t)g * T + t) * 4 + hslot];
            const float M = fmaxf(fmaxf(ls[0], ls[1]), ls[2]);
            float acc0 = 0.f, acc1 = 0.f, acc2 = 0.f, acc3 = 0.f, wsum = 0.f;
#pragma unroll
            for (int g = 0; g < 3; ++g) { const float w = exp2f(ls[g] - M); wsum += w;
                const u32x2 v = *(const GAS u32x2*)(OUTG + ((size_t)g * T + t) * 256 + hslot * 64 + d4);
                acc0 += w * bflo(v.x); acc1 += w * bfhi(v.x); acc2 += w * bflo(v.y); acc3 += w * bfhi(v.y); }
            const float iw = 1.f / wsum;
            u32x2 w2; w2.x = pk2(acc0 * iw, acc1 * iw); w2.y = pk2(acc2 * iw, acc3 * iw);
            *(GAS u32x2*)(OA + (size_t)t * 256 + hslot * 64 + d4) = w2;
        }
        {   const size_t off = (size_t)t * 1024 + (l >> 3) * 128 + (l & 7) * 16;
            const v4u a0 = *(const GAS v4u*)(O1 + off), a1 = *(const GAS v4u*)(O1 + off + 8), b0 = *(const GAS v4u*)(O2 + off), b1 = *(const GAS v4u*)(O2 + off + 8);
            float v[16];
            v[0] = bflo(a0.x) - lam * bflo(b0.x); v[1] = bfhi(a0.x) - lam * bfhi(b0.x); v[2] = bflo(a0.y) - lam * bflo(b0.y); v[3] = bfhi(a0.y) - lam * bfhi(b0.y);
            v[4] = bflo(a0.z) - lam * bflo(b0.z); v[5] = bfhi(a0.z) - lam * bfhi(b0.z); v[6] = bflo(a0.w) - lam * bflo(b0.w); v[7] = bfhi(a0.w) - lam * bfhi(b0.w);
            v[8] = bflo(a1.x) - lam * bflo(b1.x); v[9] = bfhi(a1.x) - lam * bfhi(b1.x); v[10] = bflo(a1.y) - lam * bflo(b1.y); v[11] = bfhi(a1.y) - lam * bfhi(b1.y);
            v[12] = bflo(a1.z) - lam * bflo(b1.z); v[13] = bfhi(a1.z) - lam * bfhi(b1.z); v[14] = bflo(a1.w) - lam * bflo(b1.w); v[15] = bfhi(a1.w) - lam * bfhi(b1.w);
            float ss = 0.f;
#pragma unroll
            for (int i = 0; i < 16; ++i) ss += v[i] * v[i];
            ss += __shfl_xor(ss, 1); ss += __shfl_xor(ss, 2); ss += __shfl_xor(ss, 4);
            const float rstd = 1.f / sqrtf(ss * (1.f / 128.f) + EPS);
            v4u w0, w1;
            w0.x = pk2(v[0] * rstd * sg[0], v[1] * rstd * sg[1]); w0.y = pk2(v[2] * rstd * sg[2], v[3] * rstd * sg[3]); w0.z = pk2(v[4] * rstd * sg[4], v[5] * rstd * sg[5]); w0.w = pk2(v[6] * rstd * sg[6], v[7] * rstd * sg[7]);
            w1.x = pk2(v[8] * rstd * sg[8], v[9] * rstd * sg[9]); w1.y = pk2(v[10] * rstd * sg[10], v[11] * rstd * sg[11]); w1.z = pk2(v[12] * rstd * sg[12], v[13] * rstd * sg[13]); w1.w = pk2(v[14] * rstd * sg[14], v[15] * rstd * sg[15]);
            *(GAS v4u*)(OB + off) = w0; *(GAS v4u*)(OB + off + 8) = w1;
        }
    }
}

__device__ __forceinline__ void p11_peer_topk(Frame& F, const Args& a) {
    constexpr int RS = 132;
    const bf16* QP = (const bf16*)(a.ws + WS_QP); const bf16* SK = (const bf16*)(a.ws + WS_SK);
    int* IDX = (int*)(a.ws + WS_IDX); float* GATE = (float*)(a.ws + WS_GATE);
    LAS float* sc = (LAS float*)F.lds;
    LAS float* tv = (LAS float*)(F.lds + 67584);
    LAS int*   ti = (LAS int*)(F.lds + 67584 + 8192);
    LAS float* sv = (LAS float*)(F.lds + 67584 + 16384);
    LAS int*   si = (LAS int*)(F.lds + 67584 + 20480);
    const int tid = F.tid, l = F.lane, w = F.wave;
    for (int u = F.vcu; u < 4096; u += F.G) {
        const int h = u & 7, t0 = (u >> 3) * 64;
        {   const int half = w >> 2, kt = w & 3, r32 = l & 31, hi = l >> 5;
            f32x16 acc0, acc1;
#pragma unroll
            for (int i = 0; i < 16; ++i) { acc0[i] = 0.f; acc1[i] = 0.f; }
            const bf16* ap0 = QP + (size_t)(t0 + r32) * 2048 + h * 256 + half * 128 + hi * 8;
            const bf16* ap1 = ap0 + (size_t)32 * 2048;
            const bf16* bp = SK + ((size_t)((h * 2 + half) * 128 + kt * 32 + r32)) * 128 + hi * 8;
#pragma unroll
            for (int s = 0; s < 8; ++s) {
                const bf16x8 a0 = *(const GAS bf16x8*)(ap0 + 16 * s), a1 = *(const GAS bf16x8*)(ap1 + 16 * s), bb = *(const GAS bf16x8*)(bp + 16 * s);
                acc0 = __builtin_amdgcn_mfma_f32_32x32x16_bf16(a0, bb, acc0, 0, 0, 0);
                acc1 = __builtin_amdgcn_mfma_f32_32x32x16_bf16(a1, bb, acc1, 0, 0, 0);
            }
#pragma unroll
            for (int r = 0; r < 16; ++r) { const int row = (r & 3) + 8 * (r >> 2) + 4 * hi;
                sc[(half * 64 + row) * RS + kt * 32 + r32] = acc0[r]; sc[(half * 64 + 32 + row) * RS + kt * 32 + r32] = acc1[r]; }
        }
        __syncthreads();
        {
            const int row = tid >> 2, part = tid & 3;
            float v[32];
#pragma unroll
            for (int k = 0; k < 32; ++k) v[k] = sc[row * RS + 4 * k + part];
            for (int pass = 0; pass < 16; ++pass) {
                float best = v[0]; int bi = 0;
#pragma unroll
                for (int k = 1; k < 32; ++k) { if (v[k] > best) { best = v[k]; bi = k; } }
                int gi = 4 * bi + part;
#pragma unroll
                for (int x = 1; x <= 2; x <<= 1) { const float ob = __shfl_xor(best, x); const int oi = __shfl_xor(gi, x); if (ob > best || (ob == best && oi < gi)) { best = ob; gi = oi; } }
                if (part == 0) { tv[row * 16 + pass] = best; ti[row * 16 + pass] = gi; }
#pragma unroll
                for (int k = 0; k < 32; ++k) v[k] = (4 * k + part == gi) ? -INFINITY : v[k];
            }
        }
        __syncthreads();
        {
            const int tok = tid >> 3, part = tid & 7;
            float c[32];
            const float a0 = tv[tok * 16 + 2 * part], a1 = tv[tok * 16 + 2 * part + 1];
#pragma unroll
            for (int j = 0; j < 16; ++j) { const float b = tv[(64 + tok) * 16 + j]; c[j] = a0 + b; c[16 + j] = a1 + b; }
            for (int pass = 0; pass < 16; ++pass) {
                float best = c[0]; int bi = 0;
#pragma unroll
                for (int k = 1; k < 32; ++k) { if (c[k] > best) { best = c[k]; bi = k; } }
                int gi = part * 32 + bi;
#pragma unroll
                for (int x = 1; x <= 4; x <<= 1) { const float ob = __shfl_xor(best, x); const int oi = __shfl_xor(gi, x); if (ob > best || (ob == best && oi < gi)) { best = ob; gi = oi; } }
                if (part == 0) { sv[tok * 16 + pass] = best; si[tok * 16 + pass] = gi; }
#pragma unroll
                for (int k = 0; k < 32; ++k) c[k] = (part * 32 + k == gi) ? -INFINITY : c[k];
            }
        }
        __syncthreads();
        {   const int tok = tid >> 3, part = tid & 7;
            const float mx = sv[tok * 16]; float den = 0.f;
#pragma unroll
            for (int k = 0; k < 16; ++k) den += __expf(sv[tok * 16 + k] - mx);
            const float iden = 1.f / den;
#pragma unroll
            for (int kk = 0; kk < 2; ++kk) { const int k = 2 * part + kk; const int ci = si[tok * 16 + k];
                const int e1 = ti[tok * 16 + (ci >> 4)], e2 = ti[(64 + tok) * 16 + (ci & 15)];
                IDX[(size_t)(t0 + tok) * 128 + h * 16 + k] = e1 * 128 + e2;
                GATE[(size_t)(t0 + tok) * 128 + h * 16 + k] = __expf(sv[tok * 16 + k] - mx) * iden; }
        }
        __syncthreads();
    }
}

__device__ __forceinline__ float gelu_erf(float x) { return 0.5f * x * (1.0f + erff(x * 0.70710678118654752f)); }
__device__ __forceinline__ void p12_gather(Frame& F, const Args& a) {
    const int gw = F.vcu * NWAVES + F.wave, NGW = F.G * NWAVES, l = F.lane;
    const bf16* H2 = (const bf16*)(a.ws + WS_R1); const int* IDX = (const int*)(a.ws + WS_IDX); const float* GATE = (const float*)(a.ws + WS_GATE);
    const bf16* EU = (const bf16*)(a.ws + WS_EU); const bf16* EV = (const bf16*)(a.ws + WS_EV);
    const float* modp = (const float*)(a.ws + WS_MOD); float* out = a.out;
    for (int t = gw; t < T; t += NGW) {
        unsigned hx[8];
        { const v4u x0 = *(const GAS v4u*)(H2 + (size_t)t * 1024 + l * 16), x1 = *(const GAS v4u*)(H2 + (size_t)t * 1024 + l * 16 + 8);
          hx[0] = x0.x; hx[1] = x0.y; hx[2] = x0.z; hx[3] = x0.w; hx[4] = x1.x; hx[5] = x1.y; hx[6] = x1.z; hx[7] = x1.w; }
        const int e_lo = IDX[(size_t)t * 128 + l], e_hi = IDX[(size_t)t * 128 + 64 + l];
        const float g_lo = GATE[(size_t)t * 128 + l], g_hi = GATE[(size_t)t * 128 + 64 + l];
        float acc[16];
#pragma unroll
        for (int i = 0; i < 16; ++i) acc[i] = 0.f;
        for (int kb = 0; kb < 128; kb += 8) {
            const int esrc = kb < 64 ? e_lo : e_hi; const float gsrc = kb < 64 ? g_lo : g_hi;
            int e[8]; float gt[8]; v4u ua[8], ub[8], va[8], vb[8];
#pragma unroll
            for (int i = 0; i < 8; ++i) { e[i] = __builtin_amdgcn_readlane(esrc, (kb + i) & 63); gt[i] = __uint_as_float(__builtin_amdgcn_readlane(__float_as_uint(gsrc), (kb + i) & 63)); }
#pragma unroll
            for (int i = 0; i < 8; ++i) { const bf16* up = EU + (size_t)e[i] * 1024 + l * 16; ua[i] = *(const GAS v4u*)up; ub[i] = *(const GAS v4u*)(up + 8); }
#pragma unroll
            for (int i = 0; i < 8; ++i) { const bf16* vp = EV + (size_t)e[i] * 1024 + l * 16; va[i] = *(const GAS v4u*)vp; vb[i] = *(const GAS v4u*)(vp + 8); }
            float wg[8];
#pragma unroll
            for (int i = 0; i < 8; ++i) {
                float d0 = dot2bf(ua[i].x, hx[0], 0.f), d1 = dot2bf(ua[i].y, hx[1], 0.f);
                d0 = dot2bf(ua[i].z, hx[2], d0); d1 = dot2bf(ua[i].w, hx[3], d1);
                d0 = dot2bf(ub[i].x, hx[4], d0); d1 = dot2bf(ub[i].y, hx[5], d1);
                d0 = dot2bf(ub[i].z, hx[6], d0); d1 = dot2bf(ub[i].w, hx[7], d1);
                const float dsum = wave_sum(d0 + d1);
                wg[i] = gt[i] * gelu_erf(dsum);
            }
#pragma unroll
            for (int i = 0; i < 8; ++i) { const float wv = wg[i];
                acc[0] += wv * bflo(va[i].x); acc[1] += wv * bfhi(va[i].x); acc[2] += wv * bflo(va[i].y); acc[3] += wv * bfhi(va[i].y);
                acc[4] += wv * bflo(va[i].z); acc[5] += wv * bfhi(va[i].z); acc[6] += wv * bflo(va[i].w); acc[7] += wv * bfhi(va[i].w);
                acc[8] += wv * bflo(vb[i].x); acc[9] += wv * bfhi(vb[i].x); acc[10] += wv * bflo(vb[i].y); acc[11] += wv * bfhi(vb[i].y);
                acc[12] += wv * bflo(vb[i].z); acc[13] += wv * bfhi(vb[i].z); acc[14] += wv * bflo(vb[i].w); acc[15] += wv * bfhi(vb[i].w); }
        }
        const int b = t >> 12;
        float* op = out + (size_t)t * 1024 + l * 16; const float* gp = modp + (size_t)b * 6144 + 5120 + l * 16;
#pragma unroll
        for (int c = 0; c < 4; ++c) { const f32x4 xv = *(const GAS f32x4*)(op + 4 * c), gv = *(const GAS f32x4*)(gp + 4 * c);
            f32x4 r; r.x = xv.x + gv.x * acc[4 * c]; r.y = xv.y + gv.y * acc[4 * c + 1]; r.z = xv.z + gv.z * acc[4 * c + 2]; r.w = xv.w + gv.w * acc[4 * c + 3];
            *(GAS f32x4*)(op + 4 * c) = r; }
    }
}


__global__ void __launch_bounds__(NWAVES * 64, 2) fwd_kernel(Args args) {
    extern __shared__ __attribute__((aligned(16))) unsigned char lds[];
    Frame F;
    F.lds = (LAS unsigned char*)lds;
    F.MISC = (volatile LAS unsigned*)(F.lds + MISC_OFF);
    F.tid = threadIdx.x; F.lane = F.tid & 63; F.wave = __builtin_amdgcn_readfirstlane(F.tid >> 6);
    F.G = gridDim.x; { const int bx = blockIdx.x; F.vcu = (F.G % 8 == 0) ? (bx % 8) * (F.G / 8) + bx / 8 : bx; }
    unsigned char* ws = args.ws;
    F.ctl = (gu32*)(ws + WS_CTL);
    for (int u = F.tid; u < (LDS_BYTES - LDSCTL_OFF) / 4; u += NWAVES * 64) ((LAS unsigned*)(F.lds + LDSCTL_OFF))[u] = 0u;
    __syncthreads();
    const int lo = args.ph_lo, hi = args.ph_hi;
    const bool fused = (hi - lo) > 1;
    XcdBarrier bar; bar.bar = (unsigned*)(F.ctl + CW_BAR); bar.x = 0; bar.st = nullptr;
    if (fused) bar = xcd_barrier_post((unsigned*)(F.ctl + CW_BAR), F.MISC + 8);
#ifndef PHASE_MASK
#define PHASE_MASK 0xFFFF
#endif
#define IN(k) (((PHASE_MASK >> (k)) & 1) && lo <= (k) && (k) < hi)
#define SEAM(k) do { if (IN(k) && IN((k) + 1)) xcd_barrier(bar); } while (0)

    bf16* XN = (bf16*)(ws + WS_R1);
    float* modp = (float*)(ws + WS_MOD);

    if (IN(0)) { p0_prologue(F, args); } SEAM(0);
    if (IN(1)) { norm_mod_rows(F, (const float*)args.in[0], (const float*)args.in[5], modp, 0, 1024, XN); } SEAM(1);
    if (IN(2)) {
        pg8::Gemm g{XN, (const bf16*)(ws + WS_WIN), T, IN_W, D}; pg8::StaticOrder S; S.init(T, IN_W, F.G, (int)blockIdx.x);
        pg8::EpiInProj E{(bf16*)(ws + WS_QA), (bf16*)(ws + WS_KA), (bf16*)(ws + WS_VA), (bf16*)(ws + WS_QB), (bf16*)(ws + WS_KB), (bf16*)(ws + WS_VB), (bf16*)args.out, (const float*)args.in[7]};
        pg8::gemm_phase<pg8::EpiInProj, pg8::StaticOrder, true, true>(F.lds + RING_OFF, g, S, E);
    } SEAM(2);
    if (IN(3)) { p3_normrope(F, args); } SEAM(3);
    if (IN(4)) { p4_dilated(F, args); } SEAM(4);
    if (IN(5)) {
        const attn_body::DiffOrder S((int)F.G, (int)blockIdx.x);
        attn_body::diff_attn_phase<8>((char*)lds + RING_OFF, (const attn_body::bf16*)(ws + WS_QB), (const attn_body::bf16*)(ws + WS_KB), (const attn_body::bf16*)(ws + WS_VB),
                                      (attn_body::bf16*)(ws + WS_R1), (attn_body::bf16*)(ws + WS_O2), S);
    } SEAM(5);
    if (IN(6)) { p6_combine(F, args); } SEAM(6);
    if (IN(7)) {
        { pg8::Gemm g{(const bf16*)(ws + WS_OA), (const bf16*)(ws + WS_WPA), T, D, DIL_OUT}; pg8::StaticOrder S; S.init(T, D, F.G, (int)blockIdx.x);
          pg8::EpiBf16 E{(bf16*)(ws + WS_TMP), D};
          pg8::gemm_phase<pg8::EpiBf16, pg8::StaticOrder, true, true>(F.lds + RING_OFF, g, S, E); }
        { pg8::Gemm g{(const bf16*)(ws + WS_OB), (const bf16*)(ws + WS_WPB), T, D, D}; pg8::StaticOrder S; S.init(T, D, F.G, (int)blockIdx.x);
          pg8::EpiBranchB E{(const bf16*)(ws + WS_TMP), (const bf16*)args.out, (bf16*)(ws + WS_MIX)};
          pg8::gemm_phase<pg8::EpiBranchB, pg8::StaticOrder, true, true>(F.lds + RING_OFF, g, S, E); }
    } SEAM(7);
    if (IN(8)) {
        pg8::Gemm g{(const bf16*)(ws + WS_MIX), (const bf16*)(ws + WS_WOUT), T, D, D}; pg8::StaticOrder S; S.init(T, D, F.G, (int)blockIdx.x);
        pg8::EpiOut E{(const float*)args.in[0], modp, args.out};
        pg8::gemm_phase<pg8::EpiOut, pg8::StaticOrder, true, true>(F.lds + RING_OFF, g, S, E);
    } SEAM(8);
    if (IN(9)) {
        norm_mod_rows(F, args.out, (const float*)args.in[20], modp, 3072, 4096, XN);
        convert_bf16(F, (const float*)args.in[23], (bf16*)(ws + WS_EU), (size_t)NEXP * D / 8);
        convert_bf16(F, (const float*)args.in[24], (bf16*)(ws + WS_EV), (size_t)NEXP * D / 8);
    } SEAM(9);
    if (IN(10)) {
        pg8::Gemm g{XN, (const bf16*)(ws + WS_WQ), T, PEER_QW, D}; pg8::StaticOrder S; S.init(T, PEER_QW, F.G, (int)blockIdx.x);
        pg8::EpiBf16 E{(bf16*)(ws + WS_QP), PEER_QW};
        pg8::gemm_phase<pg8::EpiBf16, pg8::StaticOrder, true, true>(F.lds + RING_OFF, g, S, E);
    } SEAM(10);
    if (IN(11)) { p11_peer_topk(F, args); } SEAM(11);
    if (IN(12)) { p12_gather(F, args); }
#undef IN
#undef SEAM
}

extern "C" void kernel_launch(void* const* d_in, const int* in_sizes, int n_in, void* d_out, int out_size, void* d_ws, size_t ws_size, hipStream_t stream) {
    static int grid = 0;
    if (grid == 0) {
        if (n_in != 25 || in_sizes[0] != T * D || out_size != T * D || ws_size < WS_END) {
            fprintf(stderr, "kernel_launch: built for 25 inputs, x and out of %d floats, >= %zu bytes of workspace; got n_in %d, in0 %d, out %d, ws %zu; nothing launched\n", T * D, (size_t)WS_END, n_in, n_in > 0 ? in_sizes[0] : -1, out_size, ws_size); grid = -1; return; }
        int dev = 0, cus = 0, per_cu = 0;
        if (hipGetDevice(&dev) != hipSuccess || hipDeviceGetAttribute(&cus, hipDeviceAttributeMultiprocessorCount, dev) != hipSuccess) { fprintf(stderr, "kernel_launch: hipGetDevice / hipDeviceGetAttribute failed\n"); grid = -1; return; }
        if (hipFuncSetAttribute((const void*)fwd_kernel, hipFuncAttributeMaxDynamicSharedMemorySize, LDS_BYTES) != hipSuccess) { fprintf(stderr, "kernel_launch: hipFuncSetAttribute failed\n"); grid = -1; return; }
        if (hipOccupancyMaxActiveBlocksPerMultiprocessor(&per_cu, (const void*)fwd_kernel, NWAVES * 64, LDS_BYTES) != hipSuccess || per_cu < 1)
            fprintf(stderr, "kernel_launch: note: occupancy query reports %d workgroups per CU\n", per_cu);
        (void)hipGetLastError();
        grid = cus;
    }
    if (grid < 0) return;
    if (hipMemsetAsync((char*)d_ws + WS_CTL, 0, CTL_ZERO_BYTES, stream) != hipSuccess) { fprintf(stderr, "kernel_launch: hipMemsetAsync failed\n"); return; }
    Args a{};
    for (int i = 0; i < 25; ++i) a.in[i] = d_in[i];
    a.out = (float*)d_out; a.ws = (unsigned char*)d_ws;
#if MK_N_LAUNCHES == 1
    a.ph_lo = 0; a.ph_hi = N_PHASES;
    hipLaunchKernelGGL(fwd_kernel, dim3(grid), dim3(NWAVES * 64), LDS_BYTES, stream, a);
#else
    for (int p = 0; p < N_PHASES; ++p) { a.ph_lo = p; a.ph_hi = p + 1;
        hipLaunchKernelGGL(fwd_kernel, dim3(grid), dim3(NWAVES * 64), LDS_BYTES, stream, a); }
#endif
    const hipError_t le = hipPeekAtLastError();
    if (le != hipSuccess) fprintf(stderr, "kernel_launch: launch failed: %s\n", hipGetErrorName(le));
}
```

```cpp
#include <hip/hip_runtime.h>
#include <hip/hip_bf16.h>
#include <cstdio>
#include <cstdint>
#include <cmath>

#ifndef MK_N_LAUNCHES
#define MK_N_LAUNCHES 1
#endif

constexpr int BATCH = 8, SEQ = 4096, D = 1024, T = BATCH * SEQ;
constexpr int DIL_W = 768, DIL_HEADS = 12, DIL_OUT = 256;
constexpr int DIFF_W = 1024, DIFF_HEADS = 8;
constexpr int IN_W = 7424, GATE_W = 2048;
constexpr int PEER_H = 8, PEER_NK = 128, PEER_QW = 2048, NEXP = 16384;
constexpr float EPS = 1e-6f;
constexpr float LAM_INIT = 0.2f;
constexpr float QSCALE = 0.125f * 1.4426950408889634f;

namespace pg8 {
#define PG8_LAS __attribute__((address_space(3)))
typedef unsigned short bf16_t;
typedef short bf16x8 __attribute__((ext_vector_type(8)));
typedef float f32x4 __attribute__((ext_vector_type(4)));
typedef unsigned u32x4 __attribute__((ext_vector_type(4)));
typedef int v4i32_t __attribute__((ext_vector_type(4)));
typedef int v8i32_t __attribute__((ext_vector_type(8)));
constexpr int BM = 256, BK = 64, HALF = 128, HTB = HALF * BK * 2  , STAGE_BYTES = 8 * HTB, NXCD = 8, WGM = 8;

__host__ __device__ __forceinline__ int lds_byte(int r, int c) { const int st = (r >> 4) * 2 + (c >> 5), rr = r & 15, cc = c & 31, ob = rr * 64 + cc * 2; return st * 1024 + (ob ^ (((ob >> 9) & 1) << 5)); }
__host__ __device__ __forceinline__ void stage_rc(int b, int& R, int& C) { const int st = b / 1024, sb = b % 1024, swz = sb ^ (((sb >> 9) & 1) << 5); R = (st >> 1) * 16 + swz / 64; C = (st & 1) * 32 + (swz % 64) / 2; }
__host__ __device__ __forceinline__ int perm32(int rho) { const int n = rho >> 4, i = rho & 15; return 8 * (i >> 2) + 4 * n + (i & 3); }

struct Unit { int pm, pn; };
struct Gemm { const bf16_t* A; const bf16_t* Bt; int M, N, K; };

struct StaticOrder {
    int nM, nN, nwg, G, c;
    __host__ __device__ void init(int M, int N, int G_, int c_) { nM = M / BM; nN = N / BM; nwg = nM * nN; G = G_; c = c_; }
    __host__ __device__ bool next(int i, Unit& u) const {
        const long L = (long)i * G + c; if (L >= nwg) return false;
        int wgid = (int)L; { const int q = nwg / NXCD, r = nwg % NXCD, xcd = wgid % NXCD, off = wgid / NXCD; wgid = (xcd < r ? xcd * (q + 1) : r * (q + 1) + (xcd - r) * q) + off; }
        const int nig = WGM * nN, gid = wgid / nig, fm = gid * WGM, gsz = (nM - fm) < WGM ? (nM - fm) : WGM;
        u.pm = fm + ((wgid % nig) % gsz); u.pn = (wgid % nig) / gsz; return true;
    }
    __device__ __forceinline__ void a_ready(const Unit&) const {}
    __device__ __forceinline__ void done(const Unit&) const {}
};

__device__ __forceinline__ unsigned cvt_pk_bf16(float lo, float hi) { unsigned r; asm volatile("v_cvt_pk_bf16_f32 %0, %1, %2" : "=v"(r) : "v"(lo), "v"(hi)); return r; }
typedef float f32x2 __attribute__((ext_vector_type(2)));
typedef unsigned u32x2 __attribute__((ext_vector_type(2)));
#ifndef QK_FP8
#define QK_FP8 1
#endif
#ifndef G_FP8
#define G_FP8 0
#endif
__device__ __forceinline__ float bf_lo(unsigned w) { return __uint_as_float(w << 16); }
__device__ __forceinline__ float bf_hi(unsigned w) { return __uint_as_float(w & 0xffff0000u); }

struct EpiBf16 {
    static constexpr bool PERM = true, AFTER_DRAIN = false;
    bf16_t* O; int ldc;
    __device__ __forceinline__ void operator()(const f32x4 (&acc)[2][2][4][2], const Unit& u, int wr, int wc, int fr, int fq) const {
        const int row0 = u.pm * BM + wr * 64 + fr; const int col0 = u.pn * BM + wc * 32 + 8 * fq;
#pragma unroll
        for (int ai = 0; ai < 2; ++ai)
#pragma unroll
            for (int m = 0; m < 4; ++m) { bf16_t* rowp = O + (size_t)(row0 + ai * HALF + m * 16) * ldc + col0;
#pragma unroll
                for (int bj = 0; bj < 2; ++bj) { const f32x4 v0 = acc[ai][bj][m][0], v1 = acc[ai][bj][m][1];
                    u32x4 w; w.x = cvt_pk_bf16(v0[0], v0[1]); w.y = cvt_pk_bf16(v0[2], v0[3]); w.z = cvt_pk_bf16(v1[0], v1[1]); w.w = cvt_pk_bf16(v1[2], v1[3]);
                    *(u32x4*)(rowp + bj * HALF) = w; } }
    }
};

struct EpiQF {
    static constexpr bool PERM = true, AFTER_DRAIN = false;
    bf16_t* O;
    __device__ __forceinline__ void operator()(const f32x4 (&acc)[2][2][4][2], const Unit& u, int wr, int wc, int fr, int fq) const {
#pragma unroll
        for (int ai = 0; ai < 2; ++ai)
#pragma unroll
            for (int m = 0; m < 4; ++m) { const int rb = u.pm * 8 + ai * 4 + wr * 2 + (m >> 1), r32 = (m & 1) * 16 + fr;
#pragma unroll
                for (int bj = 0; bj < 2; ++bj) { const f32x4 v0 = acc[ai][bj][m][0], v1 = acc[ai][bj][m][1];
                    u32x4 w; w.x = cvt_pk_bf16(v0[0], v0[1]); w.y = cvt_pk_bf16(v0[2], v0[3]); w.z = cvt_pk_bf16(v1[0], v1[1]); w.w = cvt_pk_bf16(v1[2], v1[3]);
                    const size_t off = ((((size_t)(rb * 8 + u.pn) * 2 + bj) * 8 + 2 * wc + (fq >> 1)) * 64 + (fq & 1) * 32 + r32) * 8;
                    *(u32x4*)(O + off) = w; } }
    }
};

struct EpiInProj {
    static constexpr bool PERM = true, AFTER_DRAIN = false;
    bf16_t *QA, *KA, *VA, *QB, *KB, *VB, *G; const float* b_gate; const float *qn_a, *kn_a, *qn_b, *kn_b; const float* CS; float qscale;
    const float* sA; const float* sW;
    __device__ __forceinline__ void operator()(const f32x4 (&acc)[2][2][4][2], const Unit& u, int wr, int wc, int fr, int fq) const {
        const int pn = u.pn; bf16_t* base; int ldc, colt; int mode = 0; const float* gn = nullptr; float qs = 1.f;
        bool f8 = false;
        if (pn < 3)       { base = QA; ldc = 768;  colt = pn * BM; mode = 2; gn = qn_a; qs = qscale; }
        else if (pn < 6)  { base = KA; ldc = 768;  colt = (pn - 3) * BM; mode = 2; gn = kn_a; }
        else if (pn < 9)  { base = VA; ldc = 768;  colt = (pn - 6) * BM; }
        else if (pn < 13) { base = QB; ldc = 1024; colt = (pn - 9) * BM; mode = 2; gn = qn_b; qs = qscale * (QK_FP8 ? 64.f : 1.f); f8 = QK_FP8; }
        else if (pn < 17) { base = KB; ldc = 1024; colt = (pn - 13) * BM; mode = 2; gn = kn_b; qs = QK_FP8 ? 16.f : 1.f; f8 = QK_FP8; }
        else if (pn < 21) { base = VB; ldc = 1024; colt = (pn - 17) * BM; mode = 3; }
        else              { base = G;  ldc = 2048; colt = (pn - 21) * BM; mode = 1; }
        const int row0 = u.pm * BM + wr * 64 + fr;
        if (mode == 2) {
            const f32x4 g1a = *(const f32x4*)(gn + 8 * fq), g1b = *(const f32x4*)(gn + 8 * fq + 4), g2a = *(const f32x4*)(gn + 32 + 8 * fq), g2b = *(const f32x4*)(gn + 32 + 8 * fq + 4);
            const int col0 = colt + wc * 64 + 8 * fq;
            float rav[2][4];
#pragma unroll
            for (int ai = 0; ai < 2; ++ai)
#pragma unroll
                for (int m = 0; m < 4; ++m) rav[ai][m] = sA[row0 + ai * HALF + m * 16];
            const float* swp = sW + pn * BM + wc * 32 + 8 * fq;
            const f32x4 w1a = *(const f32x4*)swp, w1b = *(const f32x4*)(swp + 4), w2a = *(const f32x4*)(swp + HALF), w2b = *(const f32x4*)(swp + HALF + 4);
#pragma unroll
            for (int ai = 0; ai < 2; ++ai)
#pragma unroll
                for (int m = 0; m < 4; ++m) { const size_t row = (size_t)(row0 + ai * HALF + m * 16);
                    const float ra = rav[ai][m];
                    const f32x4 x1a = acc[ai][0][m][0] * w1a * ra, x1b = acc[ai][0][m][1] * w1b * ra, x2a = acc[ai][1][m][0] * w2a * ra, x2b = acc[ai][1][m][1] * w2b * ra;
                    const float* cp = CS + row * 64 + 8 * fq;
                    const f32x4 ca = *(const f32x4*)cp, cb = *(const f32x4*)(cp + 4), sa = *(const f32x4*)(cp + 32), sb = *(const f32x4*)(cp + 36);
                    float ss = 0.f;
#pragma unroll
                    for (int e = 0; e < 4; ++e) ss += (x1a[e] * x1a[e] + x1b[e] * x1b[e]) + (x2a[e] * x2a[e] + x2b[e] * x2b[e]);
                    ss += __shfl_xor(ss, 16); ss += __shfl_xor(ss, 32);
                    const float rs = qs / sqrtf(ss * (1.f / 64.f) + 1e-6f);
                    const f32x4 y1a = x1a * g1a * rs, y1b = x1b * g1b * rs, y2a = x2a * g2a * rs, y2b = x2b * g2b * rs;
                    const f32x4 o1a = y1a * ca - y2a * sa, o1b = y1b * cb - y2b * sb, o2a = y2a * ca + y1a * sa, o2b = y2b * cb + y1b * sb;
                    if (f8) {
                        int t0 = __builtin_amdgcn_cvt_pk_fp8_f32(o1a[0], o1a[1], 0, false); t0 = __builtin_amdgcn_cvt_pk_fp8_f32(o1a[2], o1a[3], t0, true);
                        int t1 = __builtin_amdgcn_cvt_pk_fp8_f32(o1b[0], o1b[1], 0, false); t1 = __builtin_amdgcn_cvt_pk_fp8_f32(o1b[2], o1b[3], t1, true);
                        int t2 = __builtin_amdgcn_cvt_pk_fp8_f32(o2a[0], o2a[1], 0, false); t2 = __builtin_amdgcn_cvt_pk_fp8_f32(o2a[2], o2a[3], t2, true);
                        int t3 = __builtin_amdgcn_cvt_pk_fp8_f32(o2b[0], o2b[1], 0, false); t3 = __builtin_amdgcn_cvt_pk_fp8_f32(o2b[2], o2b[3], t3, true);
                        unsigned char* rp8 = (unsigned char*)base + row * 1024 + col0;
                        *(u32x2*)rp8 = (u32x2){(unsigned)t0, (unsigned)t1}; *(u32x2*)(rp8 + 32) = (u32x2){(unsigned)t2, (unsigned)t3};
                        if (m == 3) asm volatile("" ::: "memory");
                        continue; }
                    u32x4 w1, w2;
                    w1.x = cvt_pk_bf16(o1a[0], o1a[1]); w1.y = cvt_pk_bf16(o1a[2], o1a[3]); w1.z = cvt_pk_bf16(o1b[0], o1b[1]); w1.w = cvt_pk_bf16(o1b[2], o1b[3]);
                    w2.x = cvt_pk_bf16(o2a[0], o2a[1]); w2.y = cvt_pk_bf16(o2a[2], o2a[3]); w2.z = cvt_pk_bf16(o2b[0], o2b[1]); w2.w = cvt_pk_bf16(o2b[2], o2b[3]);
                    bf16_t* rowp = base + row * ldc + col0;
                    *(u32x4*)rowp = w1; *(u32x4*)(rowp + 32) = w2;
                    if (m == 3) asm volatile("" ::: "memory"); }
            return;
        }
        const bool gate = mode == 1;
        const int col0 = colt + wc * 32 + 8 * fq;
        f32x4 bv[2][2], sw[2][2];
#pragma unroll
        for (int bj = 0; bj < 2; ++bj)
#pragma unroll
            for (int n = 0; n < 2; ++n) { bv[bj][n] = gate ? *(const f32x4*)(b_gate + col0 + bj * HALF + 4 * n) : (f32x4){0.f, 0.f, 0.f, 0.f}; sw[bj][n] = *(const f32x4*)(sW + pn * BM + wc * 32 + 8 * fq + bj * HALF + 4 * n); }
#pragma unroll
        for (int ai = 0; ai < 2; ++ai)
#pragma unroll
            for (int m = 0; m < 4; ++m) { bf16_t* rowp = base + (size_t)(row0 + ai * HALF + m * 16) * ldc + col0; const float ra = sA[row0 + ai * HALF + m * 16];
#pragma unroll
                for (int bj = 0; bj < 2; ++bj) { f32x4 v0 = acc[ai][bj][m][0] * sw[bj][0] * ra, v1 = acc[ai][bj][m][1] * sw[bj][1] * ra;
                    if (gate) {
                        v0 = v0 + bv[bj][0]; v1 = v1 + bv[bj][1];
#pragma unroll
                        for (int e = 0; e < 4; ++e) { v0[e] = 1.0f / (1.0f + __expf(-v0[e])); v1[e] = 1.0f / (1.0f + __expf(-v1[e])); }
                    }
                    if (mode == 3) {
#define V8C(x) __builtin_amdgcn_fmed3f((x) * 8.f, -448.f, 448.f)
                        int t0 = __builtin_amdgcn_cvt_pk_fp8_f32(V8C(v0[0]), V8C(v0[1]), 0, false); t0 = __builtin_amdgcn_cvt_pk_fp8_f32(V8C(v0[2]), V8C(v0[3]), t0, true);
                        int t1 = __builtin_amdgcn_cvt_pk_fp8_f32(V8C(v1[0]), V8C(v1[1]), 0, false); t1 = __builtin_amdgcn_cvt_pk_fp8_f32(V8C(v1[2]), V8C(v1[3]), t1, true);
#undef V8C
                        *(u32x2*)((unsigned char*)base + (size_t)(row0 + ai * HALF + m * 16) * 1024 + col0 + bj * HALF) = (u32x2){(unsigned)t0, (unsigned)t1};
                    } else if (G_FP8 && gate) {
                        int t0 = __builtin_amdgcn_cvt_pk_fp8_f32(v0[0], v0[1], 0, false); t0 = __builtin_amdgcn_cvt_pk_fp8_f32(v0[2], v0[3], t0, true);
                        int t1 = __builtin_amdgcn_cvt_pk_fp8_f32(v1[0], v1[1], 0, false); t1 = __builtin_amdgcn_cvt_pk_fp8_f32(v1[2], v1[3], t1, true);
                        *(u32x2*)((unsigned char*)base + (size_t)(row0 + ai * HALF + m * 16) * 2048 + col0 + bj * HALF) = (u32x2){(unsigned)t0, (unsigned)t1};
                    } else {
                    u32x4 w; w.x = cvt_pk_bf16(v0[0], v0[1]); w.y = cvt_pk_bf16(v0[2], v0[3]); w.z = cvt_pk_bf16(v1[0], v1[1]); w.w = cvt_pk_bf16(v1[2], v1[3]);
                    *(u32x4*)(rowp + bj * HALF) = w; } } }
    }
};

struct EpiBranchB {
    static constexpr bool PERM = true, AFTER_DRAIN = false;
    const bf16_t* ta; const unsigned char* G; bf16_t* mixed;
    __device__ __forceinline__ void operator()(const f32x4 (&acc)[2][2][4][2], const Unit& u, int wr, int wc, int fr, int fq) const {
        const int row0 = u.pm * BM + wr * 64 + fr; const int col0 = u.pn * BM + wc * 32 + 8 * fq;
#pragma unroll
        for (int ai = 0; ai < 2; ++ai)
#pragma unroll
            for (int m = 0; m < 4; ++m) { const size_t row = (size_t)(row0 + ai * HALF + m * 16);
                const bf16_t* tp = ta + row * 1024 + col0; bf16_t* mp = mixed + row * 1024 + col0;
#pragma unroll
                for (int bj = 0; bj < 2; ++bj) { const int c = bj * HALF;
                    const u32x4 t = *(const u32x4*)(tp + c); const f32x4 a0 = acc[ai][bj][m][0], a1 = acc[ai][bj][m][1];
                    float g0[8], g1[8];
                    if (G_FP8) { const unsigned char* gp = G + row * 2048 + col0 + c; const u32x2 q0 = *(const u32x2*)gp, q1 = *(const u32x2*)(gp + 1024);
                        const f32x2 x0 = __builtin_amdgcn_cvt_pk_f32_fp8((int)q0.x, false), x1 = __builtin_amdgcn_cvt_pk_f32_fp8((int)q0.x, true), x2 = __builtin_amdgcn_cvt_pk_f32_fp8((int)q0.y, false), x3 = __builtin_amdgcn_cvt_pk_f32_fp8((int)q0.y, true);
                        const f32x2 y0 = __builtin_amdgcn_cvt_pk_f32_fp8((int)q1.x, false), y1 = __builtin_amdgcn_cvt_pk_f32_fp8((int)q1.x, true), y2 = __builtin_amdgcn_cvt_pk_f32_fp8((int)q1.y, false), y3 = __builtin_amdgcn_cvt_pk_f32_fp8((int)q1.y, true);
                        g0[0] = x0.x; g0[1] = x0.y; g0[2] = x1.x; g0[3] = x1.y; g0[4] = x2.x; g0[5] = x2.y; g0[6] = x3.x; g0[7] = x3.y;
                        g1[0] = y0.x; g1[1] = y0.y; g1[2] = y1.x; g1[3] = y1.y; g1[4] = y2.x; g1[5] = y2.y; g1[6] = y3.x; g1[7] = y3.y; }
                    else { const bf16_t* gp = (const bf16_t*)G + row * 2048 + col0 + c; const u32x4 q0 = *(const u32x4*)gp, q1 = *(const u32x4*)(gp + 1024);
                        g0[0] = bf_lo(q0.x); g0[1] = bf_hi(q0.x); g0[2] = bf_lo(q0.y); g0[3] = bf_hi(q0.y); g0[4] = bf_lo(q0.z); g0[5] = bf_hi(q0.z); g0[6] = bf_lo(q0.w); g0[7] = bf_hi(q0.w);
                        g1[0] = bf_lo(q1.x); g1[1] = bf_hi(q1.x); g1[2] = bf_lo(q1.y); g1[3] = bf_hi(q1.y); g1[4] = bf_lo(q1.z); g1[5] = bf_hi(q1.z); g1[6] = bf_lo(q1.w); g1[7] = bf_hi(q1.w); }
                    u32x4 w;
                    w.x = cvt_pk_bf16(bf_lo(t.x) * g0[0] + a0[0] * g1[0], bf_hi(t.x) * g0[1] + a0[1] * g1[1]);
                    w.y = cvt_pk_bf16(bf_lo(t.y) * g0[2] + a0[2] * g1[2], bf_hi(t.y) * g0[3] + a0[3] * g1[3]);
                    w.z = cvt_pk_bf16(bf_lo(t.z) * g0[4] + a1[0] * g1[4], bf_hi(t.z) * g0[5] + a1[1] * g1[5]);
                    w.w = cvt_pk_bf16(bf_lo(t.w) * g0[6] + a1[2] * g1[6], bf_hi(t.w) * g0[7] + a1[3] * g1[7]);
                    *(u32x4*)(mp + c) = w; }
                asm volatile("" ::: "memory"); }
    }
};
struct EpiOut {
    static constexpr bool PERM = true, AFTER_DRAIN = false;
    const float* mod; bf16_t* delta;
    __device__ __forceinline__ void operator()(const f32x4 (&acc)[2][2][4][2], const Unit& u, int wr, int wc, int fr, int fq) const {
        const int row0 = u.pm * BM + wr * 64 + fr; const int col0 = u.pn * BM + wc * 32 + 8 * fq;
        const int b = (u.pm * BM) >> 12;
        f32x4 gv[2][2];
#pragma unroll
        for (int bj = 0; bj < 2; ++bj)
#pragma unroll
            for (int n = 0; n < 2; ++n) gv[bj][n] = *(const f32x4*)(mod + (size_t)b * 6144 + 2048 + col0 + bj * HALF + 4 * n);
#pragma unroll
        for (int ai = 0; ai < 2; ++ai)
#pragma unroll
            for (int m = 0; m < 4; ++m) { bf16_t* rowp = delta + (size_t)(row0 + ai * HALF + m * 16) * 1024 + col0;
#pragma unroll
                for (int bj = 0; bj < 2; ++bj) { const f32x4 v0 = gv[bj][0] * acc[ai][bj][m][0], v1 = gv[bj][1] * acc[ai][bj][m][1];
                    u32x4 w; w.x = cvt_pk_bf16(v0[0], v0[1]); w.y = cvt_pk_bf16(v0[2], v0[3]); w.z = cvt_pk_bf16(v1[0], v1[1]); w.w = cvt_pk_bf16(v1[2], v1[3]);
                    *(u32x4*)(rowp + bj * HALF) = w; } }
    }
};


template <class Epi, class Sched, bool ALIGN_EPI = false, bool SP2 = false, bool FP8 = false>
__device__ __forceinline__ void gemm_phase(PG8_LAS unsigned char* lds, const Gemm g, const Sched& S, const Epi& E, float* gstamp = nullptr) {
    const int tid = threadIdx.x, wid = __builtin_amdgcn_readfirstlane(tid >> 6), lane = tid & 63, wr = wid >> 2, wc = wid & 3, fr = lane & 15, fq = lane >> 4;
    const int K = g.K, nt = K / BK;
    unsigned voffA[2], voffB[2];
#pragma unroll
    for (int i = 0; i < 2; ++i) { int R, C; stage_rc(tid * 16 + i * 8192, R, C); const int Rb = Epi::PERM ? ((R & ~31) + perm32(R & 31)) : R;
        voffA[i] = (unsigned)(R * K + C) * 2u; voffB[i] = (unsigned)(Rb * K + C) * 2u; }
    const size_t kstep = (size_t)(BK * 2);
    const size_t hstep = (size_t)HALF * K * 2;
    const size_t tstep = 2 * hstep;
    const unsigned ldsw = (unsigned)wid * 1024u;
    const int aoff = FP8 ? lds_byte(wr * 64 + fr, fq * 16) : lds_byte(wr * 64 + fr, fq * 8), boff = FP8 ? lds_byte(wc * 32 + fr, fq * 16) : lds_byte(wc * 32 + fr, fq * 8);
#define PG8_SA(b, h) (((b) * 2 + (h)) * HTB)
#define PG8_SB(b, h) ((4 + (b) * 2 + (h)) * HTB)
#define PG8_STAGE(bufoff, gbase, voff) do { _Pragma("unroll") for (int _i = 0; _i < 2; ++_i) \
        __builtin_amdgcn_global_load_lds((const unsigned*)((const char*)(gbase) + (voff)[_i]), (PG8_LAS unsigned*)(lds + (bufoff) + ldsw + _i * 8192), 16, 0, 0); } while (0)
#define PG8_LD32(p) __builtin_shufflevector(*(const PG8_LAS v4i32_t*)(p), *(const PG8_LAS v4i32_t*)((p) + 16), 0, 1, 2, 3, 4, 5, 6, 7)
#define PG8_LDA(dst, b, h) do { if constexpr (FP8) { _Pragma("unroll") for (int m = 0; m < 4; ++m) dst##8[m] = PG8_LD32(lds + PG8_SA(b, h) + aoff + m * 2048); } \
        else { _Pragma("unroll") for (int m = 0; m < 4; ++m) _Pragma("unroll") for (int k = 0; k < 2; ++k) dst[m][k] = *(const PG8_LAS bf16x8*)(lds + PG8_SA(b, h) + aoff + m * 2048 + k * 1024); } } while (0)
#define PG8_LDB(dst, b, h) do { if constexpr (FP8) { _Pragma("unroll") for (int n = 0; n < 2; ++n) dst##8[n] = PG8_LD32(lds + PG8_SB(b, h) + boff + n * 2048); } \
        else { _Pragma("unroll") for (int n = 0; n < 2; ++n) _Pragma("unroll") for (int k = 0; k < 2; ++k) dst[n][k] = *(const PG8_LAS bf16x8*)(lds + PG8_SB(b, h) + boff + n * 2048 + k * 1024); } } while (0)
#define PG8_MMA(ai, bj, At, Bt) do { __builtin_amdgcn_s_setprio(1); \
        if constexpr (FP8) { _Pragma("unroll") for (int m = 0; m < 4; ++m) _Pragma("unroll") for (int n = 0; n < 2; ++n) \
            asm volatile("v_mfma_scale_f32_16x16x128_f8f6f4 %0, %1, %2, %0, %3, %3 op_sel_hi:[0,0,0]" : "+v"(acc[ai][bj][m][n]) : "v"(Bt##8[n]), "v"(At##8[m]), "v"(mxone)); } \
        else { _Pragma("unroll") for (int m = 0; m < 4; ++m) _Pragma("unroll") for (int n = 0; n < 2; ++n) _Pragma("unroll") for (int k = 0; k < 2; ++k) \
            acc[ai][bj][m][n] = __builtin_amdgcn_mfma_f32_16x16x32_bf16(Bt[n][k], At[m][k], acc[ai][bj][m][n], 0, 0, 0); } \
        __builtin_amdgcn_s_setprio(0); } while (0)
#define PG8_WAIT_V(n) asm volatile("s_waitcnt vmcnt(" #n ")" ::: "memory")
#define PG8_WAIT_L(n) asm volatile("s_waitcnt lgkmcnt(" #n ")" ::: "memory")
#define PG8_BAR __builtin_amdgcn_s_barrier()
#define PG8_SCHED __builtin_amdgcn_sched_barrier(0)
    Unit cur, nxt; int ui = 0;
    if (!S.next(0, cur)) return;
    f32x4 acc[2][2][4][2];
#pragma unroll
    for (int a = 0; a < 2; ++a)
#pragma unroll
        for (int b = 0; b < 2; ++b)
#pragma unroll
            for (int m = 0; m < 4; ++m)
#pragma unroll
                for (int n = 0; n < 2; ++n) acc[a][b][m][n] = (f32x4){0.f, 0.f, 0.f, 0.f};
    bf16x8 At[4][2], B0[2][2], B1[2][2]; v8i32_t At8[4], B08[2], B18[2];
    int mxone = 0x7F7F7F7F; asm volatile("" : "+v"(mxone));
    const char* cA = (const char*)g.A + (size_t)cur.pm * tstep; const char* cB = (const char*)g.Bt + (size_t)cur.pn * tstep;
    S.a_ready(cur);
    if constexpr (SP2) {
        PG8_STAGE(PG8_SB(0, 0), cB, voffB); PG8_STAGE(PG8_SB(0, 1), cB + hstep, voffB); PG8_STAGE(PG8_SA(0, 0), cA, voffA); PG8_STAGE(PG8_SA(0, 1), cA + hstep, voffA);
        if (wr == 1) PG8_BAR;
        PG8_WAIT_V(2); PG8_BAR;
        PG8_STAGE(PG8_SB(1, 0), cB + kstep, voffB); PG8_STAGE(PG8_SA(1, 0), cA + kstep, voffA); PG8_STAGE(PG8_SB(1, 1), cB + hstep + kstep, voffB);
        PG8_WAIT_V(6); PG8_BAR;
    } else {
        PG8_STAGE(PG8_SB(0, 0), cB, voffB); PG8_STAGE(PG8_SA(0, 0), cA, voffA); PG8_STAGE(PG8_SB(0, 1), cB + hstep, voffB); PG8_STAGE(PG8_SA(0, 1), cA + hstep, voffA);
        if (wr == 1) PG8_BAR;
        PG8_WAIT_V(4); PG8_BAR;
        PG8_STAGE(PG8_SB(1, 0), cB + kstep, voffB); PG8_STAGE(PG8_SA(1, 0), cA + kstep, voffA); PG8_STAGE(PG8_SB(1, 1), cB + hstep + kstep, voffB);
        PG8_WAIT_V(6); PG8_BAR;
    }
#if defined(PROBE_GSTAMP)
    unsigned long long tu0_; asm volatile("s_memtime %0\n\ts_waitcnt lgkmcnt(0)" : "=s"(tu0_) :: "memory");
#endif
    for (;;) {
        const bool has_next = S.next(ui + 1, nxt);
        const char* nA = has_next ? (const char*)g.A + (size_t)nxt.pm * tstep : cA; const char* nB = has_next ? (const char*)g.Bt + (size_t)nxt.pn * tstep : cB;
        for (int t = 0; t < nt; t += 2) {
            const bool last = (t == nt - 2);
            const char* a1 = cA + (size_t)(t + 1) * kstep;
            const char* a2 = last ? nA : cA + (size_t)(t + 2) * kstep; const char* b2 = last ? nB : cB + (size_t)(t + 2) * kstep;
            const char* a3 = a2 + kstep; const char* b3 = b2 + kstep;
            if (last && has_next) S.a_ready(nxt);
            if constexpr (SP2) {
            PG8_LDB(B0, 0, 0); PG8_LDB(B1, 0, 1); PG8_SCHED; PG8_LDA(At, 0, 0); PG8_STAGE(PG8_SA(1, 1), a1 + hstep, voffA);
            PG8_WAIT_V(8); PG8_WAIT_L(0); PG8_BAR; PG8_MMA(0, 0, At, B0); PG8_MMA(0, 1, At, B1); PG8_BAR; PG8_SCHED;
            PG8_LDA(At, 0, 1); PG8_STAGE(PG8_SB(0, 0), b2, voffB); PG8_STAGE(PG8_SB(0, 1), b2 + hstep, voffB); PG8_STAGE(PG8_SA(0, 0), a2, voffA);
            PG8_WAIT_V(8); PG8_WAIT_L(0); PG8_BAR; PG8_MMA(1, 0, At, B0); PG8_MMA(1, 1, At, B1); PG8_BAR; PG8_SCHED;
            PG8_LDB(B0, 1, 0); PG8_LDB(B1, 1, 1); PG8_SCHED; PG8_LDA(At, 1, 0); PG8_STAGE(PG8_SA(0, 1), a2 + hstep, voffA);
            PG8_WAIT_V(8); PG8_WAIT_L(0); PG8_BAR; PG8_MMA(0, 0, At, B0); PG8_MMA(0, 1, At, B1); PG8_BAR; PG8_SCHED;
            PG8_LDA(At, 1, 1); PG8_STAGE(PG8_SB(1, 0), b3, voffB); PG8_STAGE(PG8_SB(1, 1), b3 + hstep, voffB); PG8_STAGE(PG8_SA(1, 0), a3, voffA);
            PG8_WAIT_V(8); PG8_WAIT_L(0); PG8_BAR; PG8_MMA(1, 0, At, B0); PG8_MMA(1, 1, At, B1); PG8_BAR; PG8_SCHED;
            } else {
            PG8_LDB(B0, 0, 0); PG8_SCHED; PG8_LDA(At, 0, 0); PG8_STAGE(PG8_SA(1, 1), a1 + hstep, voffA);
            PG8_WAIT_L(8); PG8_BAR; PG8_WAIT_L(0); PG8_MMA(0, 0, At, B0); PG8_BAR; PG8_SCHED;
            PG8_LDB(B1, 0, 1); PG8_STAGE(PG8_SB(0, 0), b2, voffB);
            PG8_BAR; PG8_WAIT_L(0); PG8_MMA(0, 1, At, B1); PG8_BAR;
            PG8_LDA(At, 0, 1); PG8_STAGE(PG8_SA(0, 0), a2, voffA);
            PG8_BAR; PG8_WAIT_L(0); PG8_MMA(1, 0, At, B0); PG8_BAR; PG8_SCHED;
            PG8_STAGE(PG8_SB(0, 1), b2 + hstep, voffB);
            PG8_WAIT_V(6); PG8_BAR; PG8_MMA(1, 1, At, B1); PG8_BAR;
            PG8_LDB(B0, 1, 0); PG8_SCHED; PG8_LDA(At, 1, 0); PG8_STAGE(PG8_SA(0, 1), a2 + hstep, voffA);
            PG8_WAIT_L(8); PG8_BAR; PG8_WAIT_L(0); PG8_MMA(0, 0, At, B0); PG8_BAR; PG8_SCHED;
            PG8_LDB(B1, 1, 1); PG8_STAGE(PG8_SB(1, 0), b3, voffB);
            PG8_BAR; PG8_WAIT_L(0); PG8_MMA(0, 1, At, B1); PG8_BAR;
            PG8_LDA(At, 1, 1); PG8_STAGE(PG8_SA(1, 0), a3, voffA);
            PG8_BAR; PG8_WAIT_L(0); PG8_MMA(1, 0, At, B0); PG8_BAR; PG8_SCHED;
            PG8_STAGE(PG8_SB(1, 1), b3 + hstep, voffB);
            PG8_WAIT_V(6); PG8_BAR; PG8_MMA(1, 1, At, B1); PG8_BAR;
            }
        }
        if constexpr (FP8) asm volatile("s_nop 15\n\ts_nop 15" ::: "memory");
        if constexpr (ALIGN_EPI) { if (wr == 0) PG8_BAR; }
#if defined(PROBE_GSTAMP)
        unsigned long long te0_; asm volatile("s_memtime %0\n\ts_waitcnt lgkmcnt(0)" : "=s"(te0_) :: "memory");
#endif
        if constexpr (!Epi::AFTER_DRAIN) { E(acc, cur, wr, wc, fr, fq); S.done(cur); }
#if defined(PROBE_GSTAMP)
        if (gstamp) { asm volatile("s_waitcnt vmcnt(0)" ::: "memory"); unsigned long long te1_; asm volatile("s_memtime %0\n\ts_waitcnt lgkmcnt(0)" : "=s"(te1_) :: "memory");
            if (blockIdx.x == 0 && threadIdx.x == 0) { gstamp[0] += (float)(te1_ - te0_); gstamp[1] += (float)(te1_ - tu0_); } tu0_ = te1_; }
#endif
        if (!has_next) break;
#pragma unroll
        for (int a = 0; a < 2; ++a)
#pragma unroll
            for (int b = 0; b < 2; ++b)
#pragma unroll
                for (int m = 0; m < 4; ++m)
#pragma unroll
                    for (int n = 0; n < 2; ++n) acc[a][b][m][n] = (f32x4){0.f, 0.f, 0.f, 0.f};
        cur = nxt; cA = nA; cB = nB; ++ui;
        if constexpr (ALIGN_EPI) { if (wr == 1) PG8_BAR; }
    }
    PG8_WAIT_V(0);
    if constexpr (!ALIGN_EPI) { if (wr == 0) PG8_BAR; }
    PG8_BAR;
    if constexpr (Epi::AFTER_DRAIN) { E.fused(acc, cur, wr, wc, fr, fq, lds, wid, lane); S.done(cur); }
#undef PG8_SA
#undef PG8_SB
#undef PG8_STAGE
#undef PG8_LDA
#undef PG8_LDB
#undef PG8_MMA
#undef PG8_LD32
#undef PG8_WAIT_V
#undef PG8_WAIT_L
#undef PG8_BAR
#undef PG8_SCHED
}
}
#include <hip/hip_bf16.h>
#include <cmath>
namespace attn_body {
using bf16=__hip_bfloat16;
using bf16x8=__attribute__((ext_vector_type(8)))short;
using s16x4=__attribute__((ext_vector_type(4)))short;
using f32x16=__attribute__((ext_vector_type(16)))float;
using u32x4=__attribute__((ext_vector_type(4)))unsigned;
constexpr int BATCH=8,NHEAD=16,SEQ=4096,D=64,DM=NHEAD*D;
constexpr int NW=8,QBLK=32,QB=QBLK*NW,KVBLK=64,NQB=SEQ/QB;
constexpr int ATTN_PITCH=DM, ATTN_UNIT_ROWS=QB;
__device__ __forceinline__ int crow(int r,int hi){return (r&3)+8*(r>>2)+4*hi;}
#define SBAR() __builtin_amdgcn_sched_barrier(0)
__device__ __forceinline__ void cmask(f32x16&p0,f32x16&p1,int jb,int qrel,int hi){
  const float NEG=-INFINITY; int kb=64*jb+4*hi;
  #pragma unroll
  for(int r=0;r<16;++r){int kv=kb+(r&3)+8*(r>>2); if(kv>qrel)p0[r]=NEG; if(kv+32>qrel)p1[r]=NEG;}
}

constexpr int NSLOT=3, SLOTB=8192;
constexpr int LDS_K=0, LDS_V=NSLOT*SLOTB, LDS_WS=2*NSLOT*SLOTB, LDS_OST=LDS_WS+NW*64*4, LDS_BYTES=LDS_OST+NW*4096;
constexpr float C2=0.125f*1.4426950408889634f;
__device__ __forceinline__ void glds16(const void*gsrc,unsigned lds_dst){unsigned keep;
  asm volatile("s_mov_b32 %0, m0\n\ts_mov_b32 m0, %2\n\ts_nop 0\n\tglobal_load_lds_dwordx4 %1, off\n\ts_mov_b32 m0, %0":"=&s"(keep):"v"(gsrc),"s"(lds_dst):"memory");}
__device__ __forceinline__ float max3f(float a,float b,float c){float r;asm("v_max3_f32 %0, %1, %2, %3":"=v"(r):"v"(a),"v"(b),"v"(c));return r;}
__device__ __forceinline__ float max2f(float a,float b){float r;asm("v_max_f32_e32 %0, %1, %2":"=v"(r):"v"(a),"v"(b));return r;}
__device__ __forceinline__ float fadd_s(float a,float b){float r;asm("v_add_f32_e32 %0, %1, %2":"=v"(r):"v"(a),"v"(b));return r;}
__device__ __forceinline__ float fsub_s(float a,float b){float r;asm("v_sub_f32_e32 %0, %1, %2":"=v"(r):"v"(a),"v"(b));return r;}
typedef float f32x2_t __attribute__((ext_vector_type(2))); typedef __bf16 bf16x2_t __attribute__((ext_vector_type(2)));
__device__ __forceinline__ unsigned cvtpk_s(float lo,float hi){f32x2_t v={lo,hi};bf16x2_t b=__builtin_convertvector(v,bf16x2_t);return __builtin_bit_cast(unsigned,b);}
#define WAIT_BAR(N) asm volatile("s_waitcnt vmcnt(" #N ") lgkmcnt(0)\n\ts_barrier":::"memory")

__device__ __forceinline__ void qkt(f32x16&p0,f32x16&p1,const char*Kslot,const bf16x8*qr,const f32x16&negm,int r32,int hi){
  const char*kb=Kslot+hi*1024+r32*16;
  #pragma unroll
  for(int d0=0;d0<4;++d0){
    const bf16x8 b0=*reinterpret_cast<const bf16x8*>(kb+d0*2048);
    const bf16x8 b1=*reinterpret_cast<const bf16x8*>(kb+d0*2048+512);
    if(d0==0){p0=__builtin_amdgcn_mfma_f32_32x32x16_bf16(b0,qr[0],negm,0,0,0);p1=__builtin_amdgcn_mfma_f32_32x32x16_bf16(b1,qr[0],negm,0,0,0);}
    else{p0=__builtin_amdgcn_mfma_f32_32x32x16_bf16(b0,qr[d0],p0,0,0,0);p1=__builtin_amdgcn_mfma_f32_32x32x16_bf16(b1,qr[d0],p1,0,0,0);}}
}
typedef __attribute__((address_space(3))) const char* lds_cptr;
typedef short v4i16_t __attribute__((ext_vector_type(4)));
__device__ __forceinline__ void kload8(bf16x8*kf,lds_cptr kp){
  kf[0]=*(const __attribute__((address_space(3))) bf16x8*)(kp);      kf[1]=*(const __attribute__((address_space(3))) bf16x8*)(kp+512);
  kf[2]=*(const __attribute__((address_space(3))) bf16x8*)(kp+2048); kf[3]=*(const __attribute__((address_space(3))) bf16x8*)(kp+2560);
  kf[4]=*(const __attribute__((address_space(3))) bf16x8*)(kp+4096); kf[5]=*(const __attribute__((address_space(3))) bf16x8*)(kp+4608);
  kf[6]=*(const __attribute__((address_space(3))) bf16x8*)(kp+6144); kf[7]=*(const __attribute__((address_space(3))) bf16x8*)(kp+6656);
}
__device__ __forceinline__ void kload2(bf16x8*kf,lds_cptr kp,int j){ kf[2*j]=*(const __attribute__((address_space(3))) bf16x8*)(kp+j*2048); kf[2*j+1]=*(const __attribute__((address_space(3))) bf16x8*)(kp+j*2048+512); }
__device__ __forceinline__ s16x4 vtr(lds_cptr p){ return __builtin_bit_cast(s16x4,__builtin_amdgcn_ds_read_tr16_b64_v4i16((__attribute__((address_space(3))) v4i16_t*)p)); }
__device__ __forceinline__ float rowmax(const f32x16&p0,const f32x16&p1){
  float a=max3f(p0[0],p0[1],p1[0]),b=max3f(p0[2],p0[3],p1[1]);a=max3f(a,p1[2],p1[3]);
  #pragma unroll
  for(int r=4;r<16;r+=4){a=max3f(a,p0[r],p0[r+1]);b=max3f(b,p0[r+2],p0[r+3]);a=max3f(a,p1[r],p1[r+1]);b=max3f(b,p1[r+2],p1[r+3]);}
  const float m=max2f(a,b);
  auto rr=__builtin_amdgcn_permlane32_swap(__float_as_uint(m),__float_as_uint(m),false,false);
  return max2f(__uint_as_float(rr[0]),__uint_as_float(rr[1]));
}
__device__ __forceinline__ void pv(f32x16*o,int vb,bf16x8 pa0,bf16x8 pa1,bf16x8 pa2,bf16x8 pa3){
  #pragma unroll
  for(int d0=0;d0<2;++d0){s16x4 lo[4],hi[4];
    #pragma unroll
    for(int ks=0;ks<4;++ks){
      asm volatile("ds_read_b64_tr_b16 %0,%1 offset:%c2":"=&v"(lo[ks]):"v"(vb),"i"(d0*4096+ks*1024):"memory");
      asm volatile("ds_read_b64_tr_b16 %0,%1 offset:%c2":"=&v"(hi[ks]):"v"(vb),"i"(d0*4096+ks*1024+512):"memory");}
    asm volatile("s_waitcnt lgkmcnt(0)":::"memory");SBAR();
    #define PK(k) (bf16x8){lo[k][0],lo[k][1],lo[k][2],lo[k][3],hi[k][0],hi[k][1],hi[k][2],hi[k][3]}
    o[d0]=__builtin_amdgcn_mfma_f32_32x32x16_bf16(pa0,PK(0),o[d0],0,0,0);
    o[d0]=__builtin_amdgcn_mfma_f32_32x32x16_bf16(pa1,PK(1),o[d0],0,0,0);
    o[d0]=__builtin_amdgcn_mfma_f32_32x32x16_bf16(pa2,PK(2),o[d0],0,0,0);
    o[d0]=__builtin_amdgcn_mfma_f32_32x32x16_bf16(pa3,PK(3),o[d0],0,0,0);
    #undef PK
  }
}

#ifndef ATTN_STORE16
#define ATTN_STORE16(p,v) (*(u32x4*)(p)=(v))
#endif
template<int THRL> __device__ __forceinline__ void attn_unit(int b,int h,int qb,const bf16*Q,const bf16*__restrict__ K,const bf16*__restrict__ V,bf16*O,char*shm){
  const int tid=threadIdx.x,lane=tid&63,r32=lane&31,hi=lane>>5; const int wid=__builtin_amdgcn_readfirstlane(tid>>6);
  const long rowbase=(long)b*SEQ; const int q0=qb*QB;
  const bf16*Qw=Q+(rowbase+q0+wid*QBLK)*DM+h*D;
  const bf16*Kh=K+rowbase*DM+h*D,*Vh=V+rowbase*DM+h*D;
  const unsigned lds0=(unsigned)(uintptr_t)shm;
  float*wsf=(float*)(shm+LDS_WS)+wid*64;
  const bf16*ksrc=Kh+(long)lane*DM+wid*8;
  const bf16*vsrc=Vh+(long)(16*(wid&3)+(lane>>2))*DM+(wid>>2)*32+(lane&3)*8;
  const unsigned kdst=lds0+LDS_K+wid*1024, vdst=lds0+LDS_V+wid*1024;
  #define DMA_K(t,slot) glds16(ksrc+(long)(t)*KVBLK*DM,(unsigned)__builtin_amdgcn_readfirstlane(kdst+(slot)))
  #define DMA_V(t,slot) glds16(vsrc+(long)(t)*KVBLK*DM,(unsigned)__builtin_amdgcn_readfirstlane(vdst+(slot)))
  const int vb0=(int)(lds0+LDS_V)+((lane>>4)&1)*32+(lane&3)*8+(4*hi+((lane&15)>>2))*64;
  const char*Kbase=shm+LDS_K; bf16x8 kf[8];
  const lds_cptr shm3=(lds_cptr)shm; const lds_cptr kp0=shm3+LDS_K+hi*1024+r32*16; const lds_cptr vp0=shm3+LDS_V+((lane>>4)&1)*32+(lane&3)*8+(4*hi+((lane&15)>>2))*64;
  const int NT=SEQ/KVBLK;
  DMA_K(0,0);DMA_V(0,0);DMA_K(1,SLOTB);
  bf16x8 qr[4];
  #pragma unroll
  for(int d0=0;d0<4;++d0)qr[d0]=*reinterpret_cast<const bf16x8*>(&Qw[(long)r32*DM+d0*16+hi*8]);
  float mhat=0.f,l_reg=0.f;f32x16 o[2];o[0]=f32x16{};o[1]=f32x16{};f32x16 negm=f32x16{};asm volatile("":"+v"(negm));
  const int qrel=wid*QBLK+r32;
  #define CMASK(P0,P1,t) do{}while(0)
  bool resc=false;
  #define START(P0,P1) do{ const float rm=rowmax(P0,P1); resc=false; \
    { const float dl=rm; mhat=fadd_s(mhat,dl); \
      _Pragma("unroll") for(int r=0;r<16;++r){P0[r]=fsub_s(P0[r],dl);P1[r]=fsub_s(P1[r],dl);} \
      _Pragma("unroll") for(int r=0;r<16;++r)negm[r]=-mhat; asm volatile("":"+v"(negm)); } \
    _Pragma("unroll") for(int r=0;r<16;++r)P0[r]=__builtin_amdgcn_exp2f(P0[r]); }while(0)
  #define RESC() do{ if(resc){ asm volatile("s_waitcnt lgkmcnt(0)":::"memory"); \
      _Pragma("unroll") for(int d_=0;d_<2;++d_) _Pragma("unroll") for(int r=0;r<16;++r)o[d_][r]*=wsf[crow(r,hi)]; } }while(0)
  f32x16 pA0,pA1,pB0,pB1;
  int sl_prev=0,sl_cur=0,sl_next=SLOTB;
  #define ROT() do{sl_prev=sl_cur;sl_cur=sl_next;sl_next=(sl_next==(NSLOT-1)*SLOTB)?0:sl_next+SLOTB;}while(0)
  DMA_K(2,2*SLOTB);
  WAIT_BAR(3);
  qkt(pA0,pA1,Kbase,qr,negm,r32,hi);asm volatile("s_nop 15\n\ts_nop 7":"+v"(pA0),"+v"(pA1));CMASK(pA0,pA1,0);
  START(pA0,pA1);
  _Pragma("unroll") for(int r=0;r<16;++r)pA1[r]=__builtin_amdgcn_exp2f(pA1[r]);
  WAIT_BAR(0);
  DMA_K(3,0);DMA_V(1,SLOTB);
  ROT();
  kload8(kf,kp0+sl_cur);
  WAIT_BAR(2);
  s16x4 vlo[8],vhi[8]; u32x4 pw0,pw1,pw2,pw3;
  #define PKW(P,B) cvtpk_s(P[B],P[B+1])
  #define PAF(k) __builtin_bit_cast(bf16x8,pw##k)
  #define VFR(i) (bf16x8){vlo[i][0],vlo[i][1],vlo[i][2],vlo[i][3],vhi[i][0],vhi[i][1],vhi[i][2],vhi[i][3]}
  #define PIN(x) asm volatile("":"+v"(x))
  #define MX3(a,b,c) __builtin_fmaxf(__builtin_fmaxf((a),(b)),(c))
  #define GAPA(MF,A0,A1,A2,A3,W0,W1,PW) do{ MF; sacc+=A0; sacc+=A1; sacc+=A2; sacc+=A3; PIN(sacc); W0; W1; PIN(PW); SBAR(); }while(0)
  #define EX(v) __builtin_amdgcn_exp2f(v)
  #define GAPB(MF,X,B) do{ MF; X[B]=EX(X[B]); X[B+1]=EX(X[B+1]); X[B+2]=EX(X[B+2]); X[B+3]=EX(X[B+3]); PIN(X); SBAR(); }while(0)
  #define VRD(i) do{ vlo[i]=vtr(vp_+(((i)>>2)*4096+((i)&3)*1024)); vhi[i]=vtr(vp_+(((i)>>2)*4096+((i)&3)*1024+512)); }while(0)
  #define KRD(G,j) do{ if(G){ kload2(kf,kp0+sl_next,j); SBAR(); } }while(0)
  #define STEP(C0,C1,P0,P1,t,GK,GV,GL) do{ SBAR(); \
    const lds_cptr vp_=vp0+sl_prev; \
    VRD(0); SBAR(); float sacc=(P0[0]+P0[1]); \
    GAPA(C0=__builtin_amdgcn_mfma_f32_32x32x16_bf16(kf[0],qr[0],negm,0,0,0), P0[2],P0[3],P0[4],P0[5],     pw0[0]=PKW(P0,0), pw0[1]=PKW(P0,2), pw0); \
    VRD(4); SBAR(); GAPA(C1=__builtin_amdgcn_mfma_f32_32x32x16_bf16(kf[1],qr[0],negm,0,0,0), P0[6],P0[7],P0[8],P0[9],     pw0[2]=PKW(P0,4), pw0[3]=PKW(P0,6), pw0); \
    VRD(1); SBAR(); GAPA(C0=__builtin_amdgcn_mfma_f32_32x32x16_bf16(kf[2],qr[1],C0,0,0,0),   P0[10],P0[11],P0[12],P0[13], pw1[0]=PKW(P0,8), pw1[1]=PKW(P0,10), pw1); \
    VRD(5); SBAR(); GAPA(C1=__builtin_amdgcn_mfma_f32_32x32x16_bf16(kf[3],qr[1],C1,0,0,0),   P0[14],P0[15],P1[0],P1[1],   pw1[2]=PKW(P0,12),pw1[3]=PKW(P0,14), pw1); \
    VRD(2); SBAR(); GAPA(C0=__builtin_amdgcn_mfma_f32_32x32x16_bf16(kf[4],qr[2],C0,0,0,0),   P1[2],P1[3],P1[4],P1[5],     pw2[0]=PKW(P1,0), pw2[1]=PKW(P1,2), pw2); \
    VRD(6); SBAR(); GAPA(C1=__builtin_amdgcn_mfma_f32_32x32x16_bf16(kf[5],qr[2],C1,0,0,0),   P1[6],P1[7],P1[8],P1[9],     pw2[2]=PKW(P1,4), pw2[3]=PKW(P1,6), pw2); \
    VRD(3); SBAR(); GAPA(C0=__builtin_amdgcn_mfma_f32_32x32x16_bf16(kf[6],qr[3],C0,0,0,0),   P1[10],P1[11],P1[12],P1[13], pw3[0]=PKW(P1,8), pw3[1]=PKW(P1,10), pw3); \
    VRD(7); SBAR(); GAPA(C1=__builtin_amdgcn_mfma_f32_32x32x16_bf16(kf[7],qr[3],C1,0,0,0),   P1[14],P1[15],0.f,0.f,       pw3[2]=PKW(P1,12),pw3[3]=PKW(P1,14), pw3); \
    l_reg+=sacc; \
    if(GK){DMA_K((t)+3,sl_cur);} if(GV){DMA_V((t)+1,sl_next);} \
    CMASK(C0,C1,t); \
    { float a=MX3(C0[0],C0[1],C1[0]),b=MX3(C0[2],C0[3],C1[1]); a=MX3(a,C1[2],C1[3]); \
      _Pragma("unroll") for(int r=4;r<16;r+=4){a=MX3(a,C0[r],C0[r+1]);b=MX3(b,C0[r+2],C0[r+3]);a=MX3(a,C1[r],C1[r+1]);b=MX3(b,C1[r+2],C1[r+3]);} \
      float rm=__builtin_fmaxf(a,b); { auto rr=__builtin_amdgcn_permlane32_swap(__float_as_uint(rm),__float_as_uint(rm),false,false); rm=__builtin_fmaxf(__uint_as_float(rr[0]),__uint_as_float(rr[1])); } \
      resc=false; \
      if(__builtin_expect(__any(rm>(float)THRL),0)){ const float dl=__builtin_fmaxf(rm,0.f); mhat+=dl; \
        _Pragma("unroll") for(int r=0;r<16;++r){C0[r]-=dl;C1[r]-=dl;} \
        _Pragma("unroll") for(int r=0;r<16;++r)negm[r]=-mhat; asm volatile("":"+v"(negm)); \
        const float f=__builtin_amdgcn_exp2f(-dl); l_reg*=f; if(hi==0)wsf[r32]=f; resc=true; } } \
    SBAR(); \
    GAPB(o[0]=__builtin_amdgcn_mfma_f32_32x32x16_bf16(PAF(0),VFR(0),o[0],0,0,0), C0,0); \
    GAPB(o[1]=__builtin_amdgcn_mfma_f32_32x32x16_bf16(PAF(0),VFR(4),o[1],0,0,0), C0,4); \
    KRD(GL,0); GAPB(o[0]=__builtin_amdgcn_mfma_f32_32x32x16_bf16(PAF(1),VFR(1),o[0],0,0,0), C0,8); \
    KRD(GL,1); GAPB(o[1]=__builtin_amdgcn_mfma_f32_32x32x16_bf16(PAF(1),VFR(5),o[1],0,0,0), C0,12); \
    KRD(GL,2); GAPB(o[0]=__builtin_amdgcn_mfma_f32_32x32x16_bf16(PAF(2),VFR(2),o[0],0,0,0), C1,0); \
    KRD(GL,3); GAPB(o[1]=__builtin_amdgcn_mfma_f32_32x32x16_bf16(PAF(2),VFR(6),o[1],0,0,0), C1,4); \
    GAPB(o[0]=__builtin_amdgcn_mfma_f32_32x32x16_bf16(PAF(3),VFR(3),o[0],0,0,0), C1,8); \
    GAPB(o[1]=__builtin_amdgcn_mfma_f32_32x32x16_bf16(PAF(3),VFR(7),o[1],0,0,0), C1,12); \
    }while(0)
  int t=1;
  #undef CMASK
  #define CMASK(P0,P1,t) do{}while(0)
  for(;t+5<NT;t+=2){
    STEP(pB0,pB1,pA0,pA1,t,true,true,true);     WAIT_BAR(2); RESC(); ROT();
    STEP(pA0,pA1,pB0,pB1,t+1,true,true,true);   WAIT_BAR(2); RESC(); ROT();
  }
  #undef CMASK
  #define CMASK(P0,P1,t) do{}while(0)
  #define ENDW(tt) do{ if((tt)+3<NT){WAIT_BAR(2);} else if((tt)+2<NT){WAIT_BAR(1);} else {WAIT_BAR(0);} }while(0)
  for(;t+1<NT;t+=2){
    STEP(pB0,pB1,pA0,pA1,t,(t+3<NT),(t+1<NT),(t+1<NT));       ENDW(t);   RESC(); ROT();
    STEP(pA0,pA1,pB0,pB1,t+1,(t+4<NT),(t+2<NT),(t+2<NT));     ENDW(t+1); RESC(); ROT();
  }
  STEP(pB0,pB1,pA0,pA1,NT-1,false,false,false); RESC();
  { float sacc=pB0[0]+pB0[1]; _Pragma("unroll") for(int r=2;r<16;++r)sacc+=pB0[r]; _Pragma("unroll") for(int r=0;r<16;++r)sacc+=pB1[r]; l_reg+=sacc;
    pw0=(u32x4){PKW(pB0,0),PKW(pB0,2),PKW(pB0,4),PKW(pB0,6)};pw1=(u32x4){PKW(pB0,8),PKW(pB0,10),PKW(pB0,12),PKW(pB0,14)};pw2=(u32x4){PKW(pB1,0),PKW(pB1,2),PKW(pB1,4),PKW(pB1,6)};pw3=(u32x4){PKW(pB1,8),PKW(pB1,10),PKW(pB1,12),PKW(pB1,14)};
    SBAR(); pv(o,vb0+sl_cur,PAF(0),PAF(1),PAF(2),PAF(3)); }
  #undef PKW
  #undef PAF
  #undef VFR
  #undef PIN
  #undef MX3
  #undef GAPA
  #undef GAPB
  #undef EX
  #undef VRD
  #undef KRD
  #undef STEP
  #undef ENDW
  {auto rr=__builtin_amdgcn_permlane32_swap(__float_as_uint(l_reg),__float_as_uint(l_reg),false,false);l_reg=__uint_as_float(rr[0])+__uint_as_float(rr[1]);}
  if(hi==0)wsf[32+r32]=l_reg;asm volatile("s_waitcnt lgkmcnt(0)":::"memory");
  float rli[16];
  #pragma unroll
  for(int r=0;r<16;++r)rli[r]=__builtin_amdgcn_rcpf(wsf[32+crow(r,hi)]);
  bf16*Ow=O+(rowbase+q0+wid*QBLK)*DM+h*D;
  { bf16*stg=(bf16*)(shm+LDS_OST)+wid*2048;
    #pragma unroll
    for(int r=0;r<16;++r){const int orow=crow(r,hi);
      #pragma unroll
      for(int d0=0;d0<2;++d0)stg[orow*64+d0*32+r32]=__float2bfloat16(o[d0][r]*rli[r]);}
    asm volatile("s_waitcnt lgkmcnt(0)":::"memory");
    #pragma unroll
    for(int i=0;i<4;++i){const int row=i*8+(lane>>3),ch=lane&7; const u32x4 v=*(const u32x4*)(stg+row*64+ch*8); ATTN_STORE16(Ow+(long)row*DM+ch*8,v);} }
  asm volatile("s_waitcnt lgkmcnt(0)\n\ts_barrier":::"memory");
  #undef DMA_K
  #undef DMA_V
  #undef CMASK
  #undef START
  #undef RESC
  #undef ROT
}

constexpr int V_SLOTB=16384;
constexpr int L2_K=0, L2_V=NSLOT*SLOTB, L2_WS=L2_V+NSLOT*V_SLOTB, L2_OST=L2_WS+NW*64*4, L2_BYTES=L2_OST+NW*4096;
__device__ __forceinline__ void pv128(f32x16*o,int vb,bf16x8 pa0,bf16x8 pa1,bf16x8 pa2,bf16x8 pa3){
  #pragma unroll
  for(int d0=0;d0<4;++d0){s16x4 lo[4],hi[4];
    #pragma unroll
    for(int ks=0;ks<4;++ks){
      asm volatile("ds_read_b64_tr_b16 %0,%1 offset:%c2":"=&v"(lo[ks]):"v"(vb),"i"(d0*4096+ks*1024):"memory");
      asm volatile("ds_read_b64_tr_b16 %0,%1 offset:%c2":"=&v"(hi[ks]):"v"(vb),"i"(d0*4096+ks*1024+512):"memory");}
    asm volatile("s_waitcnt lgkmcnt(0)":::"memory");SBAR();
    #define PK(k) (bf16x8){lo[k][0],lo[k][1],lo[k][2],lo[k][3],hi[k][0],hi[k][1],hi[k][2],hi[k][3]}
    o[d0]=__builtin_amdgcn_mfma_f32_32x32x16_bf16(pa0,PK(0),o[d0],0,0,0);
    o[d0]=__builtin_amdgcn_mfma_f32_32x32x16_bf16(pa1,PK(1),o[d0],0,0,0);
    o[d0]=__builtin_amdgcn_mfma_f32_32x32x16_bf16(pa2,PK(2),o[d0],0,0,0);
    o[d0]=__builtin_amdgcn_mfma_f32_32x32x16_bf16(pa3,PK(3),o[d0],0,0,0);
    #undef PK
  }
}
#ifndef A128_NOPIN
#define SB128() SBAR()
#else
#define SB128() do{}while(0)
#endif
#if defined(PROBE_MFMA)
  #define PROBE_HOOK(C0,C1) do{ const bf16x8 zf_=bf16x8{}; _Pragma("unroll") for(int q_=0;q_<8;++q_) o[q_&3]=__builtin_amdgcn_mfma_f32_32x32x16_bf16(__builtin_bit_cast(bf16x8,pw0),zf_,o[q_&3],0,0,0); }while(0)
#elif defined(PROBE_EXP)
  #define PROBE_HOOK(C0,C1) do{ _Pragma("unroll") for(int q_=0;q_<16;++q_){ float j0_=__builtin_amdgcn_exp2f(C0[q_]), j1_=__builtin_amdgcn_exp2f(C1[q_]); asm volatile(""::"v"(j0_),"v"(j1_)); } }while(0)
#elif defined(PROBE_LDS)
  #define PROBE_HOOK(C0,C1) do{ bf16x8 jk_[8]; kload8(jk_,kp0+sl_cur); _Pragma("unroll") for(int q_=0;q_<8;++q_) asm volatile(""::"v"(jk_[q_])); }while(0)
#else
  #define PROBE_HOOK(C0,C1) do{}while(0)
#endif
__device__ __forceinline__ void attn128_unit(int b,int qb,const bf16*Q,const bf16*__restrict__ K,const bf16*__restrict__ V,bf16*O,char*shm){
  const int tid=threadIdx.x,lane=tid&63,r32=lane&31,hi=lane>>5; const int wid=__builtin_amdgcn_readfirstlane(tid>>6);
  const long rowbase=(long)b*SEQ; const int q0=qb*QB;
  const bf16*Qw=Q+(rowbase+q0+wid*QBLK)*DM;
  const bf16*Kh=K+rowbase*DM,*Vh=V+rowbase*DM;
  const unsigned lds0=(unsigned)(uintptr_t)shm;
  float*wsf=(float*)(shm+L2_WS)+wid*64;
  const bf16*ksrc=Kh+(long)lane*DM+wid*8;
  const bf16*vsrc=Vh+(long)(16*(wid&3)+(lane>>2))*DM+(wid>>2)*32+(lane&3)*8;
  const unsigned kdst=lds0+L2_K+wid*1024, vdst=lds0+L2_V+wid*1024;
  #define DMA_K(t,slot) glds16(ksrc+(long)(t)*KVBLK*DM,(unsigned)__builtin_amdgcn_readfirstlane(kdst+(slot)))
  #define DMA_V(t,slot) do{ glds16(vsrc+(long)(t)*KVBLK*DM,(unsigned)__builtin_amdgcn_readfirstlane(vdst+2*(slot))); glds16(vsrc+(long)(t)*KVBLK*DM+64,(unsigned)__builtin_amdgcn_readfirstlane(vdst+2*(slot)+8192)); }while(0)
  const int vb0=(int)(lds0+L2_V)+((lane>>4)&1)*32+(lane&3)*8+(4*hi+((lane&15)>>2))*64;
  const char*Kbase=shm+L2_K; bf16x8 kf[8];
  const lds_cptr shm3=(lds_cptr)shm; const lds_cptr kp0=shm3+L2_K+hi*1024+r32*16; const lds_cptr vp0=shm3+L2_V+((lane>>4)&1)*32+(lane&3)*8+(4*hi+((lane&15)>>2))*64;
  const int NT=SEQ/KVBLK;
  DMA_K(0,0);DMA_V(0,0);DMA_K(1,SLOTB);
  bf16x8 qr[4];
  #pragma unroll
  for(int d0=0;d0<4;++d0)qr[d0]=*reinterpret_cast<const bf16x8*>(&Qw[(long)r32*DM+d0*16+hi*8]);
  float l_reg=0.f;f32x16 o[4];o[0]=f32x16{};o[1]=f32x16{};o[2]=f32x16{};o[3]=f32x16{};
  const f32x16 zero=f32x16{};
  f32x16 pA0,pA1,pB0,pB1;
  int sl_prev=0,sl_cur=0,sl_next=SLOTB;
  #define ROT() do{sl_prev=sl_cur;sl_cur=sl_next;sl_next=(sl_next==(NSLOT-1)*SLOTB)?0:sl_next+SLOTB;}while(0)
  DMA_K(2,2*SLOTB);
  WAIT_BAR(4);
  qkt(pA0,pA1,Kbase,qr,zero,r32,hi);
  _Pragma("unroll") for(int r=0;r<16;++r){pA0[r]=__builtin_amdgcn_exp2f(pA0[r]);pA1[r]=__builtin_amdgcn_exp2f(pA1[r]);}
  WAIT_BAR(0);
  DMA_K(3,0);DMA_V(1,SLOTB);
  ROT();
  kload8(kf,kp0+sl_cur);
  WAIT_BAR(3);
  s16x4 vlo[8],vhi[8],wlo[8],whi[8]; u32x4 pw0,pw1,pw2,pw3;
  #define PKW(P,B) cvtpk_s(P[B],P[B+1])
  #define PAF(k) __builtin_bit_cast(bf16x8,pw##k)
  #define VFR(i) (bf16x8){vlo[i][0],vlo[i][1],vlo[i][2],vlo[i][3],vhi[i][0],vhi[i][1],vhi[i][2],vhi[i][3]}
  #define WFR(i) (bf16x8){wlo[i][0],wlo[i][1],wlo[i][2],wlo[i][3],whi[i][0],whi[i][1],whi[i][2],whi[i][3]}
  #define PIN(x) asm volatile("":"+v"(x))
  #define GAPA(MF,A0,A1,A2,A3,W0,W1,PW) do{ MF; sacc+=A0; sacc+=A1; sacc+=A2; sacc+=A3; PIN(sacc); W0; W1; PIN(PW); SB128(); }while(0)
  #define EX(v) __builtin_amdgcn_exp2f(v)
  #define GAPB2(MF,X,B) do{ MF; X[B]=EX(X[B]); X[B+1]=EX(X[B+1]); PIN(X); SB128(); }while(0)
  #define VRD(i) do{ vlo[i]=vtr(vp_+(((i)>>2)*4096+((i)&3)*1024)); vhi[i]=vtr(vp_+(((i)>>2)*4096+((i)&3)*1024+512)); }while(0)
  #define WRD(i) do{ wlo[i]=vtr(vp_+(8192+((i)>>2)*4096+((i)&3)*1024)); whi[i]=vtr(vp_+(8192+((i)>>2)*4096+((i)&3)*1024+512)); }while(0)
  #define KRD(G,j) do{ if(G){ kload2(kf,kp0+sl_next,j); SB128(); } }while(0)
  #define STEP(C0,C1,P0,P1,t,GK,GV,GL) do{ SB128(); \
    const lds_cptr vp_=vp0+2*sl_prev; \
    VRD(0); SB128(); float sacc=(P0[0]+P0[1]); \
    GAPA(C0=__builtin_amdgcn_mfma_f32_32x32x16_bf16(kf[0],qr[0],zero,0,0,0), P0[2],P0[3],P0[4],P0[5],     pw0[0]=PKW(P0,0), pw0[1]=PKW(P0,2), pw0); \
    VRD(4); SB128(); GAPA(C1=__builtin_amdgcn_mfma_f32_32x32x16_bf16(kf[1],qr[0],zero,0,0,0), P0[6],P0[7],P0[8],P0[9],     pw0[2]=PKW(P0,4), pw0[3]=PKW(P0,6), pw0); \
    VRD(1); SB128(); GAPA(C0=__builtin_amdgcn_mfma_f32_32x32x16_bf16(kf[2],qr[1],C0,0,0,0),   P0[10],P0[11],P0[12],P0[13], pw1[0]=PKW(P0,8), pw1[1]=PKW(P0,10), pw1); \
    VRD(5); SB128(); GAPA(C1=__builtin_amdgcn_mfma_f32_32x32x16_bf16(kf[3],qr[1],C1,0,0,0),   P0[14],P0[15],P1[0],P1[1],   pw1[2]=PKW(P0,12),pw1[3]=PKW(P0,14), pw1); \
    VRD(2); SB128(); GAPA(C0=__builtin_amdgcn_mfma_f32_32x32x16_bf16(kf[4],qr[2],C0,0,0,0),   P1[2],P1[3],P1[4],P1[5],     pw2[0]=PKW(P1,0), pw2[1]=PKW(P1,2), pw2); \
    VRD(6); SB128(); GAPA(C1=__builtin_amdgcn_mfma_f32_32x32x16_bf16(kf[5],qr[2],C1,0,0,0),   P1[6],P1[7],P1[8],P1[9],     pw2[2]=PKW(P1,4), pw2[3]=PKW(P1,6), pw2); \
    VRD(3); SB128(); GAPA(C0=__builtin_amdgcn_mfma_f32_32x32x16_bf16(kf[6],qr[3],C0,0,0,0),   P1[10],P1[11],P1[12],P1[13], pw3[0]=PKW(P1,8), pw3[1]=PKW(P1,10), pw3); \
    VRD(7); SB128(); GAPA(C1=__builtin_amdgcn_mfma_f32_32x32x16_bf16(kf[7],qr[3],C1,0,0,0),   P1[14],P1[15],0.f,0.f,       pw3[2]=PKW(P1,12),pw3[3]=PKW(P1,14), pw3); \
    l_reg+=sacc; \
    if(GK){DMA_K((t)+3,sl_cur);} if(GV){DMA_V((t)+1,sl_next);} \
    SB128(); \
    PROBE_HOOK(C0,C1); \
    WRD(0); GAPB2(o[0]=__builtin_amdgcn_mfma_f32_32x32x16_bf16(PAF(0),VFR(0),o[0],0,0,0), C0,0); \
    WRD(4); GAPB2(o[1]=__builtin_amdgcn_mfma_f32_32x32x16_bf16(PAF(0),VFR(4),o[1],0,0,0), C0,2); \
    WRD(1); KRD(GL,0); GAPB2(o[0]=__builtin_amdgcn_mfma_f32_32x32x16_bf16(PAF(1),VFR(1),o[0],0,0,0), C0,4); \
    WRD(5); KRD(GL,1); GAPB2(o[1]=__builtin_amdgcn_mfma_f32_32x32x16_bf16(PAF(1),VFR(5),o[1],0,0,0), C0,6); \
    WRD(2); KRD(GL,2); GAPB2(o[0]=__builtin_amdgcn_mfma_f32_32x32x16_bf16(PAF(2),VFR(2),o[0],0,0,0), C0,8); \
    WRD(6); KRD(GL,3); GAPB2(o[1]=__builtin_amdgcn_mfma_f32_32x32x16_bf16(PAF(2),VFR(6),o[1],0,0,0), C0,10); \
    WRD(3); GAPB2(o[0]=__builtin_amdgcn_mfma_f32_32x32x16_bf16(PAF(3),VFR(3),o[0],0,0,0), C0,12); \
    WRD(7); GAPB2(o[1]=__builtin_amdgcn_mfma_f32_32x32x16_bf16(PAF(3),VFR(7),o[1],0,0,0), C0,14); \
    GAPB2(o[2]=__builtin_amdgcn_mfma_f32_32x32x16_bf16(PAF(0),WFR(0),o[2],0,0,0), C1,0); \
    GAPB2(o[3]=__builtin_amdgcn_mfma_f32_32x32x16_bf16(PAF(0),WFR(4),o[3],0,0,0), C1,2); \
    GAPB2(o[2]=__builtin_amdgcn_mfma_f32_32x32x16_bf16(PAF(1),WFR(1),o[2],0,0,0), C1,4); \
    GAPB2(o[3]=__builtin_amdgcn_mfma_f32_32x32x16_bf16(PAF(1),WFR(5),o[3],0,0,0), C1,6); \
    GAPB2(o[2]=__builtin_amdgcn_mfma_f32_32x32x16_bf16(PAF(2),WFR(2),o[2],0,0,0), C1,8); \
    GAPB2(o[3]=__builtin_amdgcn_mfma_f32_32x32x16_bf16(PAF(2),WFR(6),o[3],0,0,0), C1,10); \
    GAPB2(o[2]=__builtin_amdgcn_mfma_f32_32x32x16_bf16(PAF(3),WFR(3),o[2],0,0,0), C1,12); \
    GAPB2(o[3]=__builtin_amdgcn_mfma_f32_32x32x16_bf16(PAF(3),WFR(7),o[3],0,0,0), C1,14); \
    }while(0)
  int t=1;
  for(;t+5<NT;t+=2){
    STEP(pB0,pB1,pA0,pA1,t,true,true,true);     WAIT_BAR(3); ROT();
    STEP(pA0,pA1,pB0,pB1,t+1,true,true,true);   WAIT_BAR(3); ROT();
  }
  #define ENDW(tt) do{ if((tt)+3<NT){WAIT_BAR(3);} else if((tt)+2<NT){WAIT_BAR(2);} else {WAIT_BAR(0);} }while(0)
  for(;t+1<NT;t+=2){
    STEP(pB0,pB1,pA0,pA1,t,(t+3<NT),(t+1<NT),(t+1<NT));       ENDW(t);   ROT();
    STEP(pA0,pA1,pB0,pB1,t+1,(t+4<NT),(t+2<NT),(t+2<NT));     ENDW(t+1); ROT();
  }
  STEP(pB0,pB1,pA0,pA1,NT-1,false,false,false);
  { float sacc=pB0[0]+pB0[1]; _Pragma("unroll") for(int r=2;r<16;++r)sacc+=pB0[r]; _Pragma("unroll") for(int r=0;r<16;++r)sacc+=pB1[r]; l_reg+=sacc;
    pw0=(u32x4){PKW(pB0,0),PKW(pB0,2),PKW(pB0,4),PKW(pB0,6)};pw1=(u32x4){PKW(pB0,8),PKW(pB0,10),PKW(pB0,12),PKW(pB0,14)};pw2=(u32x4){PKW(pB1,0),PKW(pB1,2),PKW(pB1,4),PKW(pB1,6)};pw3=(u32x4){PKW(pB1,8),PKW(pB1,10),PKW(pB1,12),PKW(pB1,14)};
    SB128(); pv128(o,vb0+2*sl_cur,PAF(0),PAF(1),PAF(2),PAF(3)); }
  #undef PKW
  #undef PAF
  #undef VFR
  #undef WFR
  #undef PIN
  #undef GAPA
  #undef GAPB2
  #undef EX
  #undef VRD
  #undef WRD
  #undef KRD
  #undef STEP
  #undef ENDW
  {auto rr=__builtin_amdgcn_permlane32_swap(__float_as_uint(l_reg),__float_as_uint(l_reg),false,false);l_reg=__uint_as_float(rr[0])+__uint_as_float(rr[1]);}
  if(hi==0)wsf[32+r32]=l_reg;asm volatile("s_waitcnt lgkmcnt(0)":::"memory");
  float rli[16];
  #pragma unroll
  for(int r=0;r<16;++r)rli[r]=__builtin_amdgcn_rcpf(wsf[32+crow(r,hi)]);
  bf16*Ow=O+(rowbase+q0+wid*QBLK)*DM;
  { bf16*stg=(bf16*)(shm+L2_OST)+wid*2048;
    #pragma unroll
    for(int hh=0;hh<2;++hh){
      #pragma unroll
      for(int r=0;r<16;++r){const int orow=crow(r,hi);
        #pragma unroll
        for(int d0=0;d0<2;++d0)stg[orow*64+d0*32+r32]=__float2bfloat16(o[2*hh+d0][r]*rli[r]);}
      asm volatile("s_waitcnt lgkmcnt(0)":::"memory");
      #pragma unroll
      for(int i=0;i<4;++i){const int row=i*8+(lane>>3),ch=lane&7; const u32x4 v=*(const u32x4*)(stg+row*64+ch*8); ATTN_STORE16(Ow+(long)row*DM+hh*64+ch*8,v);}
      asm volatile("s_waitcnt lgkmcnt(0)":::"memory");
    } }
  asm volatile("s_waitcnt lgkmcnt(0)\n\ts_barrier":::"memory");
  #undef DMA_K
  #undef DMA_V
  #undef ROT
}
struct Diff128Order {
  int vcu,G,blk;
  __device__ __forceinline__ explicit Diff128Order(int grid,int block):vcu((block%8)*(grid/8)+block/8),G(grid),blk(block){}
  __device__ __forceinline__ bool next(int i,int&pair,int&qb)const{
    if(G==256){ if(i>=8)return false; pair=(vcu>>5)*16+2*i+((vcu>>4)&1); qb=vcu&15; return true; }
    const int L=i*G+blk; if(L>=2048)return false; pair=L>>4; qb=L&15; return true; }
};
__device__ __forceinline__ void diff128_phase(char*lds,const bf16*QB,const bf16*KB,const bf16*VB,bf16*O1,bf16*O2,const Diff128Order&S){
  int pair,qb;
  for(int i=0;S.next(i,pair,qb);++i){ const int m=pair&1,h=(pair>>1)&7,b=pair>>4;
    attn128_unit(b,qb,QB+h*128+m*64,KB+h*128+m*64,VB+h*128,(m?O2:O1)+h*128,lds); }
}

__device__ __forceinline__ void dil_unit(int b,int head,int dsh,int r,int chunk,const bf16*QA,const bf16*__restrict__ KA,const bf16*__restrict__ VA,bf16*OG,float*LS,char*shm){
  constexpr int PA=768;
  const int tid=threadIdx.x,lane=tid&63,r32=lane&31,hi=lane>>5; const int wid=__builtin_amdgcn_readfirstlane(tid>>6);
  const int L=SEQ>>dsh, j0=chunk<<8, jb=j0-64;
  const long tok0=(long)b*SEQ+r;
  const unsigned lds0=(unsigned)(uintptr_t)shm;
  float*wsf=(float*)(shm+LDS_WS)+wid*64;
  const bf16*Kc=KA+head*64+wid*8; const bf16*Vc=VA+head*64+(wid>>2)*32+(lane&3)*8;
  const int vrow=16*(wid&3)+(lane>>2);
  const unsigned kdst=lds0+LDS_K+wid*1024, vdst=lds0+LDS_V+wid*1024;
  #define CLAMPJ(x) ((x)<0?0:((x)>L-1?L-1:(x)))
  #define DMA_K(t,slot) do{ const int jj_=CLAMPJ(jb+64*(t)+lane); glds16(Kc+(tok0+((long)jj_<<dsh))*PA,(unsigned)__builtin_amdgcn_readfirstlane(kdst+(slot))); }while(0)
  #define DMA_V(t,slot) do{ const int jj_=CLAMPJ(jb+64*(t)+vrow); glds16(Vc+(tok0+((long)jj_<<dsh))*PA,(unsigned)__builtin_amdgcn_readfirstlane(vdst+(slot))); }while(0)
  const int vb0=(int)(lds0+LDS_V)+((lane>>4)&1)*32+(lane&3)*8+(4*hi+((lane&15)>>2))*64;
  const char*Kbase=shm+LDS_K; bf16x8 kf[8];
  const lds_cptr shm3=(lds_cptr)shm; const lds_cptr kp0=shm3+LDS_K+hi*1024+r32*16; const lds_cptr vp0=shm3+LDS_V+((lane>>4)&1)*32+(lane&3)*8+(4*hi+((lane&15)>>2))*64;
  constexpr int NT=6;
  DMA_K(0,0);DMA_V(0,0);DMA_K(1,SLOTB);
  const int jq=j0+wid*QBLK+r32;
  const bf16*Qw=QA+(tok0+((long)jq<<dsh))*PA+head*64;
  bf16x8 qr[4];
  #pragma unroll
  for(int d0=0;d0<4;++d0)qr[d0]=*reinterpret_cast<const bf16x8*>(&Qw[d0*16+hi*8]);
  float l_reg=0.f;f32x16 o[2];o[0]=f32x16{};o[1]=f32x16{};
  const f32x16 zero=f32x16{};
  #define DMASK(P0,P1,t) do{ const int kb_=jb+64*(t)+4*hi; \
    _Pragma("unroll") for(int r_=0;r_<16;++r_){ const int k0_=kb_+(r_&3)+8*(r_>>2), k1_=k0_+32; \
      const bool v0_=(k0_>=jq-64)&&(k0_<=jq+64)&&(k0_>=0)&&(k0_<L), v1_=(k1_>=jq-64)&&(k1_<=jq+64)&&(k1_>=0)&&(k1_<L); \
      P0[r_]=v0_?P0[r_]:-INFINITY; P1[r_]=v1_?P1[r_]:-INFINITY; } }while(0)
  f32x16 pA0,pA1,pB0,pB1;
  int sl_prev=0,sl_cur=0,sl_next=SLOTB;
  #define ROT() do{sl_prev=sl_cur;sl_cur=sl_next;sl_next=(sl_next==(NSLOT-1)*SLOTB)?0:sl_next+SLOTB;}while(0)
  DMA_K(2,2*SLOTB);
  WAIT_BAR(3);
  qkt(pA0,pA1,Kbase,qr,zero,r32,hi);
  DMASK(pA0,pA1,0);
  _Pragma("unroll") for(int r=0;r<16;++r){pA0[r]=__builtin_amdgcn_exp2f(pA0[r]);pA1[r]=__builtin_amdgcn_exp2f(pA1[r]);}
  WAIT_BAR(0);
  DMA_K(3,0);DMA_V(1,SLOTB);
  ROT();
  kload8(kf,kp0+sl_cur);
  WAIT_BAR(2);
  s16x4 vlo[8],vhi[8]; u32x4 pw0,pw1,pw2,pw3;
  #define PKW(P,B) cvtpk_s(P[B],P[B+1])
  #define PAF(k) __builtin_bit_cast(bf16x8,pw##k)
  #define VFR(i) (bf16x8){vlo[i][0],vlo[i][1],vlo[i][2],vlo[i][3],vhi[i][0],vhi[i][1],vhi[i][2],vhi[i][3]}
  #define PIN(x) asm volatile("":"+v"(x))
  #define GAPA(MF,A0,A1,A2,A3,W0,W1,PW) do{ MF; sacc+=A0; sacc+=A1; sacc+=A2; sacc+=A3; PIN(sacc); W0; W1; PIN(PW); SBAR(); }while(0)
  #define EX(v) __builtin_amdgcn_exp2f(v)
  #define GAPB(MF,X,B) do{ MF; X[B]=EX(X[B]); X[B+1]=EX(X[B+1]); X[B+2]=EX(X[B+2]); X[B+3]=EX(X[B+3]); PIN(X); SBAR(); }while(0)
  #define VRD(i) do{ vlo[i]=vtr(vp_+(((i)>>2)*4096+((i)&3)*1024)); vhi[i]=vtr(vp_+(((i)>>2)*4096+((i)&3)*1024+512)); }while(0)
  #define KRD(G,j) do{ if(G){ kload2(kf,kp0+sl_next,j); SBAR(); } }while(0)
  #define STEP(C0,C1,P0,P1,t,GK,GV,GL) do{ SBAR(); \
    const lds_cptr vp_=vp0+sl_prev; \
    VRD(0); SBAR(); float sacc=(P0[0]+P0[1]); \
    GAPA(C0=__builtin_amdgcn_mfma_f32_32x32x16_bf16(kf[0],qr[0],zero,0,0,0), P0[2],P0[3],P0[4],P0[5],     pw0[0]=PKW(P0,0), pw0[1]=PKW(P0,2), pw0); \
    VRD(4); SBAR(); GAPA(C1=__builtin_amdgcn_mfma_f32_32x32x16_bf16(kf[1],qr[0],zero,0,0,0), P0[6],P0[7],P0[8],P0[9],     pw0[2]=PKW(P0,4), pw0[3]=PKW(P0,6), pw0); \
    VRD(1); SBAR(); GAPA(C0=__builtin_amdgcn_mfma_f32_32x32x16_bf16(kf[2],qr[1],C0,0,0,0),   P0[10],P0[11],P0[12],P0[13], pw1[0]=PKW(P0,8), pw1[1]=PKW(P0,10), pw1); \
    VRD(5); SBAR(); GAPA(C1=__builtin_amdgcn_mfma_f32_32x32x16_bf16(kf[3],qr[1],C1,0,0,0),   P0[14],P0[15],P1[0],P1[1],   pw1[2]=PKW(P0,12),pw1[3]=PKW(P0,14), pw1); \
    VRD(2); SBAR(); GAPA(C0=__builtin_amdgcn_mfma_f32_32x32x16_bf16(kf[4],qr[2],C0,0,0,0),   P1[2],P1[3],P1[4],P1[5],     pw2[0]=PKW(P1,0), pw2[1]=PKW(P1,2), pw2); \
    VRD(6); SBAR(); GAPA(C1=__builtin_amdgcn_mfma_f32_32x32x16_bf16(kf[5],qr[2],C1,0,0,0),   P1[6],P1[7],P1[8],P1[9],     pw2[2]=PKW(P1,4), pw2[3]=PKW(P1,6), pw2); \
    VRD(3); SBAR(); GAPA(C0=__builtin_amdgcn_mfma_f32_32x32x16_bf16(kf[6],qr[3],C0,0,0,0),   P1[10],P1[11],P1[12],P1[13], pw3[0]=PKW(P1,8), pw3[1]=PKW(P1,10), pw3); \
    VRD(7); SBAR(); GAPA(C1=__builtin_amdgcn_mfma_f32_32x32x16_bf16(kf[7],qr[3],C1,0,0,0),   P1[14],P1[15],0.f,0.f,       pw3[2]=PKW(P1,12),pw3[3]=PKW(P1,14), pw3); \
    l_reg+=sacc; \
    if(GK){DMA_K((t)+3,sl_cur);} if(GV){DMA_V((t)+1,sl_next);} \
    DMASK(C0,C1,t); \
    SBAR(); \
    GAPB(o[0]=__builtin_amdgcn_mfma_f32_32x32x16_bf16(PAF(0),VFR(0),o[0],0,0,0), C0,0); \
    GAPB(o[1]=__builtin_amdgcn_mfma_f32_32x32x16_bf16(PAF(0),VFR(4),o[1],0,0,0), C0,4); \
    KRD(GL,0); GAPB(o[0]=__builtin_amdgcn_mfma_f32_32x32x16_bf16(PAF(1),VFR(1),o[0],0,0,0), C0,8); \
    KRD(GL,1); GAPB(o[1]=__builtin_amdgcn_mfma_f32_32x32x16_bf16(PAF(1),VFR(5),o[1],0,0,0), C0,12); \
    KRD(GL,2); GAPB(o[0]=__builtin_amdgcn_mfma_f32_32x32x16_bf16(PAF(2),VFR(2),o[0],0,0,0), C1,0); \
    KRD(GL,3); GAPB(o[1]=__builtin_amdgcn_mfma_f32_32x32x16_bf16(PAF(2),VFR(6),o[1],0,0,0), C1,4); \
    GAPB(o[0]=__builtin_amdgcn_mfma_f32_32x32x16_bf16(PAF(3),VFR(3),o[0],0,0,0), C1,8); \
    GAPB(o[1]=__builtin_amdgcn_mfma_f32_32x32x16_bf16(PAF(3),VFR(7),o[1],0,0,0), C1,12); \
    }while(0)
  #define ENDW(tt) do{ if((tt)+3<NT){WAIT_BAR(2);} else if((tt)+2<NT){WAIT_BAR(1);} else {WAIT_BAR(0);} }while(0)
  STEP(pB0,pB1,pA0,pA1,1,true,true,true);    ENDW(1); ROT();
  STEP(pA0,pA1,pB0,pB1,2,true,true,true);    ENDW(2); ROT();
  STEP(pB0,pB1,pA0,pA1,3,false,true,true);   ENDW(3); ROT();
  STEP(pA0,pA1,pB0,pB1,4,false,true,true);   ENDW(4); ROT();
  STEP(pB0,pB1,pA0,pA1,5,false,false,false);
  { float sacc=pB0[0]+pB0[1]; _Pragma("unroll") for(int r=2;r<16;++r)sacc+=pB0[r]; _Pragma("unroll") for(int r=0;r<16;++r)sacc+=pB1[r]; l_reg+=sacc;
    pw0=(u32x4){PKW(pB0,0),PKW(pB0,2),PKW(pB0,4),PKW(pB0,6)};pw1=(u32x4){PKW(pB0,8),PKW(pB0,10),PKW(pB0,12),PKW(pB0,14)};pw2=(u32x4){PKW(pB1,0),PKW(pB1,2),PKW(pB1,4),PKW(pB1,6)};pw3=(u32x4){PKW(pB1,8),PKW(pB1,10),PKW(pB1,12),PKW(pB1,14)};
    SBAR(); pv(o,vb0+sl_cur,PAF(0),PAF(1),PAF(2),PAF(3)); }
  #undef PKW
  #undef PAF
  #undef VFR
  #undef PIN
  #undef GAPA
  #undef GAPB
  #undef EX
  #undef VRD
  #undef KRD
  #undef STEP
  #undef ENDW
  #undef DMASK
  {auto rr=__builtin_amdgcn_permlane32_swap(__float_as_uint(l_reg),__float_as_uint(l_reg),false,false);l_reg=__uint_as_float(rr[0])+__uint_as_float(rr[1]);}
  if(hi==0)wsf[32+r32]=l_reg;asm volatile("s_waitcnt lgkmcnt(0)":::"memory");
  float rli[16];
  #pragma unroll
  for(int r=0;r<16;++r)rli[r]=__builtin_amdgcn_rcpf(wsf[32+crow(r,hi)]);
  const int gidx=dsh>>1, hslot=head&3;
  { bf16*stg=(bf16*)(shm+LDS_OST)+wid*2048;
    #pragma unroll
    for(int r=0;r<16;++r){const int orow=crow(r,hi);
      #pragma unroll
      for(int d0=0;d0<2;++d0)stg[orow*64+d0*32+r32]=__float2bfloat16(o[d0][r]*rli[r]);}
    asm volatile("s_waitcnt lgkmcnt(0)":::"memory");
    #pragma unroll
    for(int i=0;i<4;++i){const int row=i*8+(lane>>3),ch=lane&7; const u32x4 v=*(const u32x4*)(stg+row*64+ch*8);
      const long tk=tok0+((long)(j0+wid*QBLK+row)<<dsh); ATTN_STORE16(OG+((long)gidx*(BATCH*SEQ)+tk)*256+hslot*64+ch*8,v);} }
  if(hi==0){ const long tk=tok0+((long)jq<<dsh); LS[((long)gidx*(BATCH*SEQ)+tk)*4+hslot]=__builtin_amdgcn_logf(l_reg); }
  asm volatile("s_waitcnt lgkmcnt(0)\n\ts_barrier":::"memory");
  #undef DMA_K
  #undef DMA_V
  #undef CLAMPJ
  #undef ROT
}
__device__ __forceinline__ void dil_phase(char*lds,const bf16*QA,const bf16*KA,const bf16*VA,bf16*OG,float*LS,int vcu,int G){
  for(int u=vcu;u<1536;u+=G){ const int rc=u&15,bh=u>>4,head=bh%12,b=bh/12,g=head>>2; const int dsh=2*g,L=SEQ>>dsh,nchunk=L>>8; const int r=rc/nchunk,chunk=rc%nchunk;
    dil_unit(b,head,dsh,r,chunk,QA,KA,VA,OG,LS,lds); }
}
constexpr float VT8_SCALE=8.0f;
typedef int v8i32a __attribute__((ext_vector_type(8)));
typedef int v4i32a __attribute__((ext_vector_type(4)));
typedef short v2i16a __attribute__((ext_vector_type(2)));
#if defined(PROBE_DMA)
  #define PROBE_DMA_HOOK(t) do{ glds16(ksrc+(long)(t)*KVBLK*DM,(unsigned)__builtin_amdgcn_readfirstlane(lds0+118784+wid*1024)); }while(0)
#else
  #define PROBE_DMA_HOOK(t) do{}while(0)
#endif
#ifndef DMA_POS
#define DMA_POS 1
#endif
#define DMA_AT(pos,GK,GV,t) do{ if((pos)==DMA_POS){ if(GK){DMA_K((t)+3,sl_cur);} if(GV){DMA_V((t)+1,sl_next);} } else if(DMA_POS==3&&(pos)==1){ if(GK){DMA_K((t)+3,sl_cur);} } }while(0)
#ifndef STAMP_TID
#define STAMP_TID 0
#endif
#if defined(PROBE_STAMP)
  #define STAMP(k) do{ __builtin_amdgcn_sched_barrier(0); unsigned long long t_; asm volatile("s_memtime %0\n\ts_waitcnt lgkmcnt(0)":"=s"(t_)::"memory"); __builtin_amdgcn_sched_barrier(0); \
      if((k)==1) segA+=t_-tprev; else if((k)==2) segB+=t_-tprev; else if((k)==3) segW+=t_-tprev; else if((k)==4) segX+=t_-tprev; tprev=t_; }while(0)
  #define WAIT_BAR2(N) do{ asm volatile("s_waitcnt vmcnt(" #N ") lgkmcnt(0)":::"memory"); STAMP(3); asm volatile("s_barrier":::"memory"); STAMP(4); }while(0)
#else
  #define STAMP(k) do{}while(0)
  #define WAIT_BAR2(N) WAIT_BAR(N)
#endif
template<bool FINAL> __device__ __forceinline__ void attn128f8_unit(int b,int qb,const bf16*Q,const bf16*__restrict__ K,const unsigned char*__restrict__ VT,bf16*O,float pscale,char*shm,const bf16*O1=nullptr,float lam=0.f,const float*subg=nullptr,float*stampout=nullptr){
  const int tid=threadIdx.x,lane=tid&63,r32=lane&31,hi=lane>>5; const int wid=__builtin_amdgcn_readfirstlane(tid>>6);
  const long rowbase=(long)b*SEQ; const int q0=qb*QB;
#if defined(PROBE_STAMP)
  unsigned long long segA=0,segB=0,segW=0,segX=0,tprev=0;
#endif
  const bf16*Qw=Q+(rowbase+q0+wid*QBLK)*DM;
  const bf16*Kh=K+rowbase*DM;
  const unsigned lds0=(unsigned)(uintptr_t)shm;
  float*wsf=(float*)(shm+LDS_WS)+wid*64;
  const int krow_=8*wid+(lane>>3);
  const bf16*ksrc=Kh+(long)krow_*DM+(((lane&7)^((krow_>>1)&7))*8);
  const int vrow_=16*wid+(lane>>2);
  const unsigned char*vsrc=VT+(long)vrow_*64+(((lane&3)^((vrow_>>2)&3))*16);
  const unsigned kdst=lds0+LDS_K+wid*1024, vdst=lds0+LDS_V+wid*1024;
  #define DMA_K(t,slot) glds16(ksrc+(long)(t)*KVBLK*DM,(unsigned)__builtin_amdgcn_readfirstlane(kdst+(slot)))
  #define DMA_V(t,slot) glds16(vsrc+(long)(t)*8192,(unsigned)__builtin_amdgcn_readfirstlane(vdst+(slot)))
  bf16x8 kf[8];
  const lds_cptr shm3=(lds_cptr)shm;
  const int kx_=(r32>>1)&7; const lds_cptr kq0=shm3+LDS_K+r32*128+(((0+hi)^kx_)*16),kq1=shm3+LDS_K+r32*128+(((2+hi)^kx_)*16),kq2=shm3+LDS_K+r32*128+(((4+hi)^kx_)*16),kq3=shm3+LDS_K+r32*128+(((6+hi)^kx_)*16);
  #define KLD(j,base,so) do{ kf[2*(j)]=*(const __attribute__((address_space(3))) bf16x8*)((base)+(so)); kf[2*(j)+1]=*(const __attribute__((address_space(3))) bf16x8*)((base)+(so)+4096); }while(0)
  const int vx_=(r32>>2)&3; const lds_cptr vq0=shm3+LDS_V+r32*64+(((2*hi)^vx_)*16), vq1=shm3+LDS_V+r32*64+(((2*hi+1)^vx_)*16);
  const int NT=SEQ/KVBLK;
  DMA_K(0,0);DMA_V(0,0);DMA_K(1,SLOTB);
  bf16x8 qr[4];
  #pragma unroll
  for(int d0=0;d0<4;++d0)qr[d0]=*reinterpret_cast<const bf16x8*>(&Qw[(long)r32*DM+d0*16+hi*8]);
  float l_reg=0.f;f32x16 o[4];o[0]=f32x16{};o[1]=f32x16{};o[2]=f32x16{};o[3]=f32x16{};
  const f32x16 zero=f32x16{};
  f32x16 pA0,pA1,pB0,pB1;
  int sl_prev=0,sl_cur=0,sl_next=SLOTB;
  #define ROT() do{sl_prev=sl_cur;sl_cur=sl_next;sl_next=(sl_next==(NSLOT-1)*SLOTB)?0:sl_next+SLOTB;}while(0)
  DMA_K(2,2*SLOTB);
  WAIT_BAR(3);
  KLD(0,kq0,0);KLD(1,kq1,0);KLD(2,kq2,0);KLD(3,kq3,0);
  pA0=__builtin_amdgcn_mfma_f32_32x32x16_bf16(kf[0],qr[0],zero,0,0,0);pA1=__builtin_amdgcn_mfma_f32_32x32x16_bf16(kf[1],qr[0],zero,0,0,0);
  _Pragma("unroll") for(int d0=1;d0<4;++d0){pA0=__builtin_amdgcn_mfma_f32_32x32x16_bf16(kf[2*d0],qr[d0],pA0,0,0,0);pA1=__builtin_amdgcn_mfma_f32_32x32x16_bf16(kf[2*d0+1],qr[d0],pA1,0,0,0);}
  _Pragma("unroll") for(int r=0;r<16;++r){pA0[r]=__builtin_amdgcn_exp2f(pA0[r]);pA1[r]=__builtin_amdgcn_exp2f(pA1[r]);}
  WAIT_BAR(0);
  DMA_K(3,0);DMA_V(1,SLOTB);
  ROT();
  KLD(0,kq0,sl_cur);KLD(1,kq1,sl_cur);KLD(2,kq2,sl_cur);KLD(3,kq3,sl_cur);
  WAIT_BAR(2);
  v8i32a vf[4]; v8i32a p8; int mxone=0x7F7F7F7F; asm volatile("":"+v"(mxone));
  #define P8CVT(P,B) __builtin_bit_cast(int,__builtin_amdgcn_cvt_scalef32_pk_fp8_f32(__builtin_amdgcn_cvt_scalef32_pk_fp8_f32((v2i16a){0,0},P[B],P[(B)+1],pscale,false),P[(B)+2],P[(B)+3],pscale,true))
  #define PIN(x) asm volatile("":"+v"(x))
  #define GAPA8(MF,A0,A1,A2,A3,W) do{ MF; sacc+=A0; sacc+=A1; sacc+=A2; sacc+=A3; PIN(sacc); W; SB128(); }while(0)
  #define EX(v) __builtin_amdgcn_exp2f(v)
  #define GAPB8(MF,X,B) do{ MF; X[B]=EX(X[B]); X[B+1]=EX(X[B+1]); X[B+2]=EX(X[B+2]); X[B+3]=EX(X[B+3]); X[B+4]=EX(X[B+4]); X[B+5]=EX(X[B+5]); X[B+6]=EX(X[B+6]); X[B+7]=EX(X[B+7]); PIN(X); SB128(); }while(0)
  #define VRDA(i) do{ const v4i32a t_=*(const __attribute__((address_space(3))) v4i32a*)(vq0+sl_prev+(i)*2048); vf[i][0]=t_[0];vf[i][1]=t_[1];vf[i][2]=t_[2];vf[i][3]=t_[3]; }while(0)
  #define VRDB(i) do{ const v4i32a t_=*(const __attribute__((address_space(3))) v4i32a*)(vq1+sl_prev+(i)*2048); vf[i][4]=t_[0];vf[i][5]=t_[1];vf[i][6]=t_[2];vf[i][7]=t_[3]; }while(0)
  #define VF8(i) vf[i]
  #define P8V() p8
  #define PVMF(i) asm volatile("s_nop 3\n\tv_mfma_scale_f32_32x32x64_f8f6f4 %0, %1, %2, %0, %3, %3 op_sel_hi:[0,0,0]":"+v"(o[i]):"v"(P8V()),"v"(VF8(i)),"v"(mxone))
  #define KRD(G,j) do{ if(G){ KLD(j,kq##j,sl_next); SB128(); } }while(0)
#if defined(A128_COARSE)
  #define STEP(C0,C1,P0,P1,t,GK,GV,GL) do{ SB128(); STAMP(0); \
    C0=__builtin_amdgcn_mfma_f32_32x32x16_bf16(kf[0],qr[0],zero,0,0,0); C1=__builtin_amdgcn_mfma_f32_32x32x16_bf16(kf[1],qr[0],zero,0,0,0); \
    C0=__builtin_amdgcn_mfma_f32_32x32x16_bf16(kf[2],qr[1],C0,0,0,0);   C1=__builtin_amdgcn_mfma_f32_32x32x16_bf16(kf[3],qr[1],C1,0,0,0); \
    C0=__builtin_amdgcn_mfma_f32_32x32x16_bf16(kf[4],qr[2],C0,0,0,0);   C1=__builtin_amdgcn_mfma_f32_32x32x16_bf16(kf[5],qr[2],C1,0,0,0); \
    C0=__builtin_amdgcn_mfma_f32_32x32x16_bf16(kf[6],qr[3],C0,0,0,0);   C1=__builtin_amdgcn_mfma_f32_32x32x16_bf16(kf[7],qr[3],C1,0,0,0); \
    SB128(); \
    VRDA(0);VRDB(0);VRDA(1);VRDB(1);VRDA(2);VRDB(2);VRDA(3);VRDB(3); \
    { float sacc=(P0[0]+P0[1]),sacd=(P1[0]+P1[1]); \
      _Pragma("unroll") for(int r_=2;r_<16;++r_){ sacc+=P0[r_]; sacd+=P1[r_]; } \
      l_reg+=sacc+sacd; } \
    p8[0]=P8CVT(P0,0);p8[1]=P8CVT(P0,4);p8[2]=P8CVT(P0,8);p8[3]=P8CVT(P0,12);p8[4]=P8CVT(P1,0);p8[5]=P8CVT(P1,4);p8[6]=P8CVT(P1,8);p8[7]=P8CVT(P1,12); \
    STAMP(1); SB128(); \
    PVMF(0);PVMF(1);PVMF(2);PVMF(3); \
    SB128(); \
    _Pragma("unroll") for(int r_=0;r_<16;++r_){ C0[r_]=EX(C0[r_]); C1[r_]=EX(C1[r_]); } \
    if(GL){ KLD(0,kq0,sl_next);KLD(1,kq1,sl_next);KLD(2,kq2,sl_next);KLD(3,kq3,sl_next); } \
    if(GK){DMA_K((t)+3,sl_cur);} if(GV){DMA_V((t)+1,sl_next);} \
    STAMP(2); SB128(); \
    }while(0)
#else
  #define STEP(C0,C1,P0,P1,t,GK,GV,GL) do{ SB128(); STAMP(0); \
    if(DMA_POS==3){ if(GV){DMA_V((t)+1,sl_next);} } \
    VRDA(0); SB128(); float sacc=(P0[0]+P0[1]); \
    GAPA8(C0=__builtin_amdgcn_mfma_f32_32x32x16_bf16(kf[0],qr[0],zero,0,0,0), P0[2],P0[3],P0[4],P0[5],     p8[0]=P8CVT(P0,0)); \
    VRDB(0); SB128(); GAPA8(C1=__builtin_amdgcn_mfma_f32_32x32x16_bf16(kf[1],qr[0],zero,0,0,0), P0[6],P0[7],P0[8],P0[9],     p8[1]=P8CVT(P0,4)); \
    VRDA(1); SB128(); GAPA8(C0=__builtin_amdgcn_mfma_f32_32x32x16_bf16(kf[2],qr[1],C0,0,0,0),   P0[10],P0[11],P0[12],P0[13], p8[2]=P8CVT(P0,8)); \
    VRDB(1); SB128(); GAPA8(C1=__builtin_amdgcn_mfma_f32_32x32x16_bf16(kf[3],qr[1],C1,0,0,0),   P0[14],P0[15],P1[0],P1[1],   p8[3]=P8CVT(P0,12)); \
    VRDA(2); SB128(); GAPA8(C0=__builtin_amdgcn_mfma_f32_32x32x16_bf16(kf[4],qr[2],C0,0,0,0),   P1[2],P1[3],P1[4],P1[5],     p8[4]=P8CVT(P1,0)); \
    VRDB(2); SB128(); GAPA8(C1=__builtin_amdgcn_mfma_f32_32x32x16_bf16(kf[5],qr[2],C1,0,0,0),   P1[6],P1[7],P1[8],P1[9],     p8[5]=P8CVT(P1,4)); \
    VRDA(3); SB128(); GAPA8(C0=__builtin_amdgcn_mfma_f32_32x32x16_bf16(kf[6],qr[3],C0,0,0,0),   P1[10],P1[11],P1[12],P1[13], p8[6]=P8CVT(P1,8)); \
    VRDB(3); SB128(); GAPA8(C1=__builtin_amdgcn_mfma_f32_32x32x16_bf16(kf[7],qr[3],C1,0,0,0),   P1[14],P1[15],0.f,0.f,       p8[7]=P8CVT(P1,12)); \
    l_reg+=sacc; STAMP(1); \
    PROBE_DMA_HOOK(t); DMA_AT(0,GK,GV,t); \
    SB128(); \
    GAPB8(PVMF(0), C0,0); \
    KRD(GL,0); KRD(GL,1); GAPB8(PVMF(1), C0,8); \
    KRD(GL,2); KRD(GL,3); GAPB8(PVMF(2), C1,0); DMA_AT(1,GK,GV,t); \
    GAPB8(PVMF(3), C1,8); DMA_AT(2,GK,GV,t); STAMP(2); \
    }while(0)
#endif
#if defined(A128_PRIO)
  if(wid>=4) __builtin_amdgcn_s_setprio(A128_PRIO);
#endif
  int t=1;
  for(;t+5<NT;t+=2){
    STEP(pB0,pB1,pA0,pA1,t,true,true,true);     WAIT_BAR2(2); ROT();
    STEP(pA0,pA1,pB0,pB1,t+1,true,true,true);   WAIT_BAR2(2); ROT();
  }
  #define ENDW(tt) do{ if((tt)+3<NT){WAIT_BAR(2);} else if((tt)+2<NT){WAIT_BAR(1);} else {WAIT_BAR(0);} }while(0)
  for(;t+1<NT;t+=2){
    STEP(pB0,pB1,pA0,pA1,t,(t+3<NT),(t+1<NT),(t+1<NT));       ENDW(t);   ROT();
    STEP(pA0,pA1,pB0,pB1,t+1,(t+4<NT),(t+2<NT),(t+2<NT));     ENDW(t+1); ROT();
  }
  STEP(pB0,pB1,pA0,pA1,NT-1,false,false,false);
  { float sacc=pB0[0]+pB0[1]; _Pragma("unroll") for(int r=2;r<16;++r)sacc+=pB0[r]; _Pragma("unroll") for(int r=0;r<16;++r)sacc+=pB1[r]; l_reg+=sacc;
    p8[0]=P8CVT(pB0,0);p8[1]=P8CVT(pB0,4);p8[2]=P8CVT(pB0,8);p8[3]=P8CVT(pB0,12);p8[4]=P8CVT(pB1,0);p8[5]=P8CVT(pB1,4);p8[6]=P8CVT(pB1,8);p8[7]=P8CVT(pB1,12);
    sl_prev=sl_cur;
    VRDA(0);VRDB(0);VRDA(1);VRDB(1);VRDA(2);VRDB(2);VRDA(3);VRDB(3);
    PVMF(0);PVMF(1);PVMF(2);PVMF(3); asm volatile("s_nop 15\n\ts_nop 15":"+v"(o[0]),"+v"(o[1]),"+v"(o[2]),"+v"(o[3])); }
  #undef P8CVT
  #undef PIN
  #undef GAPA8
  #undef GAPB8
  #undef EX
  #undef VRDA
  #undef VRDB
  #undef VF8
  #undef P8V
  #undef PVMF
  #undef KRD
  #undef KLD
  #undef STEP
  #undef ENDW
#if defined(A128_PRIO)
  __builtin_amdgcn_s_setprio(0);
#endif
  {auto rr=__builtin_amdgcn_permlane32_swap(__float_as_uint(l_reg),__float_as_uint(l_reg),false,false);l_reg=__uint_as_float(rr[0])+__uint_as_float(rr[1]);}
  if(hi==0)wsf[32+r32]=l_reg*(VT8_SCALE/pscale);asm volatile("s_waitcnt lgkmcnt(0)":::"memory");
  float rli[16];
  #pragma unroll
  for(int r=0;r<16;++r)rli[r]=__builtin_amdgcn_rcpf(wsf[32+crow(r,hi)]);
  bf16*Ow=O+(rowbase+q0+wid*QBLK)*DM;
  if constexpr(!FINAL){
  { bf16*stg=(bf16*)(shm+LDS_OST)+wid*4096;
    #pragma unroll
    for(int hh=0;hh<2;++hh){
      #pragma unroll
      for(int r=0;r<16;++r){const int orow=crow(r,hi);
        #pragma unroll
        for(int d0=0;d0<2;++d0)stg[orow*64+d0*32+r32]=__float2bfloat16(o[2*hh+d0][r]*rli[r]);}
      asm volatile("s_waitcnt lgkmcnt(0)":::"memory");
      #pragma unroll
      for(int i=0;i<4;++i){const int row=i*8+(lane>>3),ch=lane&7; const u32x4 v=*(const u32x4*)(stg+row*64+ch*8); ATTN_STORE16(Ow+(long)row*DM+hh*64+ch*8,v);}
      asm volatile("s_waitcnt lgkmcnt(0)":::"memory");
    } }
  } else {
  { bf16*stg=(bf16*)(shm+LDS_OST)+wid*4096;
    #pragma unroll
    for(int r=0;r<16;++r){const int orow=crow(r,hi);
      #pragma unroll
      for(int d0=0;d0<4;++d0)stg[orow*128+d0*32+r32]=__float2bfloat16(o[d0][r]*rli[r]);}
    asm volatile("s_waitcnt lgkmcnt(0)":::"memory");
    const float*subg2=subg; const bf16*O1b=O1; float lam2=lam; asm volatile("":"+s"(subg2),"+s"(O1b),"+v"(lam2));
    const int ch=lane&15; float sg[8];
    #pragma unroll
    for(int e=0;e<8;++e)sg[e]=subg2[ch*8+e]*0.8f;
    const bf16*O1w=O1b+(rowbase+q0+wid*QBLK)*DM;
    #pragma unroll 1
    for(int i=0;i<8;++i){const int row=i*4+(lane>>4);
      const u32x4 a2=*(const u32x4*)(stg+row*128+ch*8); const u32x4 a1=*(const u32x4*)(O1w+(long)row*DM+ch*8);
      float v[8]; const unsigned w1[4]={a1.x,a1.y,a1.z,a1.w},w2[4]={a2.x,a2.y,a2.z,a2.w};
      #pragma unroll
      for(int e=0;e<4;++e){ v[2*e]=__uint_as_float(w1[e]<<16)-lam2*__uint_as_float(w2[e]<<16); v[2*e+1]=__uint_as_float(w1[e]&0xffff0000u)-lam2*__uint_as_float(w2[e]&0xffff0000u); }
      float ss=0.f;
      #pragma unroll
      for(int e=0;e<8;++e)ss+=v[e]*v[e];
      ss+=__shfl_xor(ss,1);ss+=__shfl_xor(ss,2);ss+=__shfl_xor(ss,4);ss+=__shfl_xor(ss,8);
      const float rstd=1.f/sqrtf(ss*(1.f/128.f)+1e-6f);
      u32x4 wo; wo.x=cvtpk_s(v[0]*rstd*sg[0],v[1]*rstd*sg[1]); wo.y=cvtpk_s(v[2]*rstd*sg[2],v[3]*rstd*sg[3]); wo.z=cvtpk_s(v[4]*rstd*sg[4],v[5]*rstd*sg[5]); wo.w=cvtpk_s(v[6]*rstd*sg[6],v[7]*rstd*sg[7]);
      ATTN_STORE16(Ow+(long)row*DM+ch*8,wo); if(i&1) asm volatile("":::"memory"); }
    asm volatile("s_waitcnt lgkmcnt(0)":::"memory");
  }
  }
#if defined(PROBE_STAMP)
  if(blockIdx.x==0&&tid==STAMP_TID&&stampout){ stampout[0]+=(float)segA; stampout[1]+=(float)segB; stampout[2]+=(float)segW; stampout[3]+=(float)segX; }
#endif
  asm volatile("s_waitcnt lgkmcnt(0)\n\ts_barrier":::"memory");
  #undef DMA_K
  #undef DMA_V
  #undef ROT
}
#ifndef Q8_OLDDMA
#define Q8_OLDDMA 0
#endif
__device__ __forceinline__ void glds16_old(const void*gsrc,unsigned lds_dst,int wid){unsigned keep;
  asm volatile("s_cmp_lt_u32 %3, 4\n\ts_cbranch_scc0 1f\n\ts_mov_b32 %0, m0\n\ts_mov_b32 m0, %2\n\ts_nop 0\n\tglobal_load_lds_dwordx4 %1, off\n\ts_mov_b32 m0, %0\n1:":"=&s"(keep):"v"(gsrc),"s"(lds_dst),"s"(wid):"memory","scc");}
constexpr int Q8_KSLOT=8192  , Q8_LDS_K=0, Q8_LDS_V=3*Q8_KSLOT, Q8_LDS_WS=Q8_LDS_V+3*8192, Q8_LDS_OST=Q8_LDS_WS+NW*64*4;
template<bool FINAL> __device__ __forceinline__ void attn128q8_unit(int b,int qb,const unsigned char*Q8,const unsigned char*__restrict__ K8,const unsigned char*__restrict__ VT,bf16*O,float pscale,char*shm,const bf16*O1=nullptr,float lam=0.f,const float*subg=nullptr){
  const int tid=threadIdx.x,lane=tid&63,r32=lane&31,hi=lane>>5; const int wid=__builtin_amdgcn_readfirstlane(tid>>6);
  const long rowbase=(long)b*SEQ; const int q0=qb*QB;
  const unsigned lds0=(unsigned)(uintptr_t)shm;
  float*wsf=(float*)(shm+Q8_LDS_WS)+wid*64;
#if Q8_OLDDMA
  const int krow_=16*(wid&3)+(lane>>2);
  const unsigned char*ksrc=K8+(rowbase+krow_)*DM+(((lane&3)^((krow_>>2)&3))*16);
  const int vrow_=16*(wid&3)+(lane>>2);
#else
  const int krow_=16*(wid&3)+(lane>>2);
  const unsigned char*ksrc=K8+(rowbase+(wid>>2)*64+krow_)*DM+(((lane&3)^((krow_>>2)&3))*16);
  const int vrow_=16*wid+(lane>>2);
#endif
  const unsigned char*vsrc=VT+(long)vrow_*64+(((lane&3)^((vrow_>>2)&3))*16);
#if Q8_OLDDMA
  const unsigned kdst=lds0+Q8_LDS_K+(wid&3)*1024, vdst=lds0+Q8_LDS_V+(wid&3)*1024;
#else
  const unsigned kdst=lds0+Q8_LDS_K+wid*1024, vdst=lds0+Q8_LDS_V+wid*1024;
#endif
#if Q8_OLDDMA
  #define DMA_KD(dbl,slot) do{ glds16_old(ksrc+(long)(dbl)*(2*KVBLK)*DM,(unsigned)__builtin_amdgcn_readfirstlane(kdst+(slot)),wid); glds16_old(ksrc+(long)(dbl)*(2*KVBLK)*DM+(long)KVBLK*DM,(unsigned)__builtin_amdgcn_readfirstlane(kdst+(slot)+4096),wid); }while(0)
  #define DMA_V(t,slot) do{ glds16_old(vsrc+(long)(t)*8192,(unsigned)__builtin_amdgcn_readfirstlane(vdst+(slot)),wid); glds16_old(vsrc+(long)(t)*8192+4096,(unsigned)__builtin_amdgcn_readfirstlane(vdst+(slot)+4096),wid); }while(0)
  #define WB_(a,b) WAIT_BAR(b)
#else
  #define DMA_KD(dbl,slot) glds16(ksrc+(long)(dbl)*(2*KVBLK)*DM,(unsigned)__builtin_amdgcn_readfirstlane(kdst+(slot)))
  #define DMA_V(t,slot) glds16(vsrc+(long)(t)*8192,(unsigned)__builtin_amdgcn_readfirstlane(vdst+(slot)))
  #define WB_(a,b) WAIT_BAR(a)
#endif
  const lds_cptr shm3=(lds_cptr)shm;
  const int vx_=(r32>>2)&3;
  const lds_cptr kq0=shm3+Q8_LDS_K+r32*64+(((2*hi)^vx_)*16), kq1=shm3+Q8_LDS_K+r32*64+(((2*hi+1)^vx_)*16);
  const lds_cptr vq0=shm3+Q8_LDS_V+r32*64+(((2*hi)^vx_)*16), vq1=shm3+Q8_LDS_V+r32*64+(((2*hi+1)^vx_)*16);
  constexpr int NT=SEQ/KVBLK;
  DMA_KD(0,0);DMA_V(0,0);DMA_KD(1,SLOTB);
  v8i32a qf;
  { const unsigned char*qp=Q8+(rowbase+q0+wid*QBLK+r32)*DM+hi*32; const v4i32a a_=*(const v4i32a*)qp, b_=*(const v4i32a*)(qp+16);
    qf[0]=a_[0];qf[1]=a_[1];qf[2]=a_[2];qf[3]=a_[3];qf[4]=b_[0];qf[5]=b_[1];qf[6]=b_[2];qf[7]=b_[3]; }
  float l_reg=0.f;f32x16 o[4];o[0]=f32x16{};o[1]=f32x16{};o[2]=f32x16{};o[3]=f32x16{};
  f32x16 pA0,pA1,pB0,pB1;
  int sl_prev=0,sl_cur=0,sl_next=SLOTB;
  #define ROT() do{sl_prev=sl_cur;sl_cur=sl_next;sl_next=(sl_next==(NSLOT-1)*SLOTB)?0:sl_next+SLOTB;}while(0)
  v8i32a kfa,kfb,vf[4],p8; int mxone=0x7F7F7F7F,mxk=0x7B7B7B7B,mxq=0x79797979; asm volatile("":"+v"(mxone),"+v"(mxk),"+v"(mxq));
  #define KLD8(so) do{ const v4i32a a_=*(const __attribute__((address_space(3))) v4i32a*)(kq0+(so)), b_=*(const __attribute__((address_space(3))) v4i32a*)(kq1+(so)), \
      c_=*(const __attribute__((address_space(3))) v4i32a*)(kq0+(so)+2048), d_=*(const __attribute__((address_space(3))) v4i32a*)(kq1+(so)+2048); \
      kfa[0]=a_[0];kfa[1]=a_[1];kfa[2]=a_[2];kfa[3]=a_[3];kfa[4]=b_[0];kfa[5]=b_[1];kfa[6]=b_[2];kfa[7]=b_[3]; kfb[0]=c_[0];kfb[1]=c_[1];kfb[2]=c_[2];kfb[3]=c_[3];kfb[4]=d_[0];kfb[5]=d_[1];kfb[6]=d_[2];kfb[7]=d_[3]; }while(0)
#if defined(Q8_PRIO)
  #define QKMF(C,KF) asm volatile("s_setprio 1\n\ts_nop 1\n\tv_mfma_scale_f32_32x32x64_f8f6f4 %0, %1, %2, 0, %3, %4 op_sel_hi:[0,0,0]\n\ts_setprio 0":"=&v"(C):"v"(KF),"v"(qf),"v"(mxk),"v"(mxq))
#else
  #define QKMF(C,KF) asm volatile("s_nop 1\n\tv_mfma_scale_f32_32x32x64_f8f6f4 %0, %1, %2, 0, %3, %4 op_sel_hi:[0,0,0]":"=&v"(C):"v"(KF),"v"(qf),"v"(mxk),"v"(mxq))
#endif
  WAIT_BAR(0);
  KLD8(0);
  QKMF(pA0,kfa);QKMF(pA1,kfb);
  asm volatile("s_nop 15\n\ts_nop 15":"+v"(pA0),"+v"(pA1));
  _Pragma("unroll") for(int r=0;r<16;++r){pA0[r]=__builtin_amdgcn_exp2f(pA0[r]);pA1[r]=__builtin_amdgcn_exp2f(pA1[r]);}
  DMA_KD(2,2*SLOTB);DMA_V(1,SLOTB);
  ROT();
  KLD8(4096);
  WB_(2,4);
  int kcur=SLOTB,kprev=0,knext=2*SLOTB;
  #define P8CVT(P,B) __builtin_bit_cast(int,__builtin_amdgcn_cvt_scalef32_pk_fp8_f32(__builtin_amdgcn_cvt_scalef32_pk_fp8_f32((v2i16a){0,0},P[B],P[(B)+1],pscale,false),P[(B)+2],P[(B)+3],pscale,true))
  #define EX(v) __builtin_amdgcn_exp2f(v)
  #define VRDA(i) do{ const v4i32a t_=*(const __attribute__((address_space(3))) v4i32a*)(vq0+sl_prev+(i)*2048); vf[i][0]=t_[0];vf[i][1]=t_[1];vf[i][2]=t_[2];vf[i][3]=t_[3]; }while(0)
  #define VRDB(i) do{ const v4i32a t_=*(const __attribute__((address_space(3))) v4i32a*)(vq1+sl_prev+(i)*2048); vf[i][4]=t_[0];vf[i][5]=t_[1];vf[i][6]=t_[2];vf[i][7]=t_[3]; }while(0)
#if defined(Q8_PRIO)
  #define PVMF(i) asm volatile("s_setprio 1\n\ts_nop 3\n\tv_mfma_scale_f32_32x32x64_f8f6f4 %0, %1, %2, %0, %3, %3 op_sel_hi:[0,0,0]\n\ts_setprio 0":"+v"(o[i]):"v"(p8),"v"(vf[i]),"v"(mxone))
#else
  #define PVMF(i) asm volatile("s_nop 3\n\tv_mfma_scale_f32_32x32x64_f8f6f4 %0, %1, %2, %0, %3, %3 op_sel_hi:[0,0,0]":"+v"(o[i]):"v"(p8),"v"(vf[i]),"v"(mxone))
#endif
  #define EX8(X,B) do{ X[B]=EX(X[B]); X[B+1]=EX(X[B+1]); X[B+2]=EX(X[B+2]); X[B+3]=EX(X[B+3]); X[B+4]=EX(X[B+4]); X[B+5]=EX(X[B+5]); X[B+6]=EX(X[B+6]); X[B+7]=EX(X[B+7]); }while(0)
  #define STEP(C0,C1,P0,P1,t,KOFF,GK,KD,GV,GL) do{ SB128(); \
    QKMF(C0,kfa); \
    VRDA(0);VRDB(0);VRDA(1);VRDB(1); \
    { float sacc=(P0[0]+P0[1]); _Pragma("unroll") for(int r_=2;r_<16;++r_) sacc+=P0[r_]; l_reg+=sacc; } \
    p8[0]=P8CVT(P0,0);p8[1]=P8CVT(P0,4);p8[2]=P8CVT(P0,8);p8[3]=P8CVT(P0,12); SB128(); \
    QKMF(C1,kfb); \
    VRDA(2);VRDB(2);VRDA(3);VRDB(3); \
    { float sacc=(P1[0]+P1[1]); _Pragma("unroll") for(int r_=2;r_<16;++r_) sacc+=P1[r_]; l_reg+=sacc; } \
    p8[4]=P8CVT(P1,0);p8[5]=P8CVT(P1,4);p8[6]=P8CVT(P1,8);p8[7]=P8CVT(P1,12); SB128(); \
    PVMF(0); asm volatile("s_nop 7":"+v"(C0),"+v"(C1)); EX8(C0,0); SB128(); \
    PVMF(1); EX8(C0,8); if(GL){ KLD8(KOFF); } SB128(); \
    PVMF(2); EX8(C1,0); if(GK){DMA_KD(KD,kprev);} if(GV){DMA_V((t)+1,sl_next);} SB128(); \
    PVMF(3); EX8(C1,8); SB128(); \
    }while(0)
  #define KROT() do{ const int o_=kprev; kprev=kcur; kcur=knext; knext=o_; }while(0)
  int t=1;
  for(;t+5<NT;t+=2){
    STEP(pB0,pB1,pA0,pA1,t,  kcur,     false,0,          true,true);   WB_(1,2); ROT();
    STEP(pA0,pA1,pB0,pB1,t+1,kcur+4096,true,((t+1)>>1)+2,true,true);   WB_(2,4); ROT(); KROT();
  }
  STEP(pB0,pB1,pA0,pA1,t,  kcur,     false,0,true,true);   WB_(1,2); ROT();
  STEP(pA0,pA1,pB0,pB1,t+1,kcur+4096,false,0,true,true);   WB_(1,2); ROT(); KROT();
  STEP(pB0,pB1,pA0,pA1,t+2,kcur,     false,0,true,true);   WB_(1,2); ROT();
  STEP(pA0,pA1,pB0,pB1,t+3,kcur+4096,false,0,true,true);   WAIT_BAR(0); ROT(); KROT();
  STEP(pB0,pB1,pA0,pA1,NT-1,0,false,0,false,false);
  { float sacc=pB0[0]+pB0[1]; _Pragma("unroll") for(int r=2;r<16;++r)sacc+=pB0[r]; _Pragma("unroll") for(int r=0;r<16;++r)sacc+=pB1[r]; l_reg+=sacc;
    p8[0]=P8CVT(pB0,0);p8[1]=P8CVT(pB0,4);p8[2]=P8CVT(pB0,8);p8[3]=P8CVT(pB0,12);p8[4]=P8CVT(pB1,0);p8[5]=P8CVT(pB1,4);p8[6]=P8CVT(pB1,8);p8[7]=P8CVT(pB1,12);
    sl_prev=sl_cur;
    VRDA(0);VRDB(0);VRDA(1);VRDB(1);VRDA(2);VRDB(2);VRDA(3);VRDB(3);
    PVMF(0);PVMF(1);PVMF(2);PVMF(3); asm volatile("s_nop 15\n\ts_nop 15":"+v"(o[0]),"+v"(o[1]),"+v"(o[2]),"+v"(o[3])); }
  #undef P8CVT
  #undef EX
  #undef EX8
  #undef VRDA
  #undef VRDB
  #undef PVMF
  #undef QKMF
  #undef KLD8
  #undef STEP
  #undef KROT
  {auto rr=__builtin_amdgcn_permlane32_swap(__float_as_uint(l_reg),__float_as_uint(l_reg),false,false);l_reg=__uint_as_float(rr[0])+__uint_as_float(rr[1]);}
  if(hi==0)wsf[32+r32]=l_reg*(VT8_SCALE/pscale);asm volatile("s_waitcnt lgkmcnt(0)":::"memory");
  float rli[16];
  #pragma unroll
  for(int r=0;r<16;++r)rli[r]=__builtin_amdgcn_rcpf(wsf[32+crow(r,hi)]);
  bf16*Ow=O+(rowbase+q0+wid*QBLK)*DM;
  if constexpr(!FINAL){
  { bf16*stg=(bf16*)(shm+Q8_LDS_OST)+wid*4096;
    #pragma unroll
    for(int hh=0;hh<2;++hh){
      #pragma unroll
      for(int r=0;r<16;++r){const int orow=crow(r,hi);
        #pragma unroll
        for(int d0=0;d0<2;++d0)stg[orow*64+d0*32+r32]=__float2bfloat16(o[2*hh+d0][r]*rli[r]);}
      asm volatile("s_waitcnt lgkmcnt(0)":::"memory");
      #pragma unroll
      for(int i=0;i<4;++i){const int row=i*8+(lane>>3),ch=lane&7; const u32x4 v=*(const u32x4*)(stg+row*64+ch*8); ATTN_STORE16(Ow+(long)row*DM+hh*64+ch*8,v);}
      asm volatile("s_waitcnt lgkmcnt(0)":::"memory");
    } }
  } else {
  { bf16*stg=(bf16*)(shm+Q8_LDS_OST)+wid*4096;
    #pragma unroll
    for(int r=0;r<16;++r){const int orow=crow(r,hi);
      #pragma unroll
      for(int d0=0;d0<4;++d0)stg[orow*128+d0*32+r32]=__float2bfloat16(o[d0][r]*rli[r]);}
    asm volatile("s_waitcnt lgkmcnt(0)":::"memory");
    const float*subg2=subg; const bf16*O1b=O1; float lam2=lam; asm volatile("":"+s"(subg2),"+s"(O1b),"+v"(lam2));
    const int ch=lane&15; float sg[8];
    #pragma unroll
    for(int e=0;e<8;++e)sg[e]=subg2[ch*8+e]*0.8f;
    const bf16*O1w=O1b+(rowbase+q0+wid*QBLK)*DM;
    #pragma unroll 1
    for(int i=0;i<8;++i){const int row=i*4+(lane>>4);
      const u32x4 a2=*(const u32x4*)(stg+row*128+ch*8); const u32x4 a1=*(const u32x4*)(O1w+(long)row*DM+ch*8);
      float v[8]; const unsigned w1[4]={a1.x,a1.y,a1.z,a1.w},w2[4]={a2.x,a2.y,a2.z,a2.w};
      #pragma unroll
      for(int e=0;e<4;++e){ v[2*e]=__uint_as_float(w1[e]<<16)-lam2*__uint_as_float(w2[e]<<16); v[2*e+1]=__uint_as_float(w1[e]&0xffff0000u)-lam2*__uint_as_float(w2[e]&0xffff0000u); }
      float ss=0.f;
      #pragma unroll
      for(int e=0;e<8;++e)ss+=v[e]*v[e];
      ss+=__shfl_xor(ss,1);ss+=__shfl_xor(ss,2);ss+=__shfl_xor(ss,4);ss+=__shfl_xor(ss,8);
      const float rstd=1.f/sqrtf(ss*(1.f/128.f)+1e-6f);
      u32x4 wo; wo.x=cvtpk_s(v[0]*rstd*sg[0],v[1]*rstd*sg[1]); wo.y=cvtpk_s(v[2]*rstd*sg[2],v[3]*rstd*sg[3]); wo.z=cvtpk_s(v[4]*rstd*sg[4],v[5]*rstd*sg[5]); wo.w=cvtpk_s(v[6]*rstd*sg[6],v[7]*rstd*sg[7]);
      ATTN_STORE16(Ow+(long)row*DM+ch*8,wo); }
    asm volatile("s_waitcnt lgkmcnt(0)":::"memory");
  }
  }
  asm volatile("s_waitcnt lgkmcnt(0)\n\ts_barrier":::"memory");
  #undef DMA_KD
  #undef DMA_V
  #undef WB_
  #undef ROT
}
struct DiffFusedOrder {
  int vcu,G,blk;
  __device__ __forceinline__ explicit DiffFusedOrder(int grid,int block):vcu((block%8)*(grid/8)+block/8),G(grid),blk(block){}
  __device__ __forceinline__ bool next(int i,int&bh,int&qb)const{
    if(G==256){ if(i>=4)return false; bh=(vcu>>5)*8+2*i+((vcu>>4)&1); qb=vcu&15; return true; }
    const int L=i*G+blk; if(L>=1024)return false; bh=L>>4; qb=L&15; return true; }
};
__device__ __forceinline__ void diff128f8_phase(char*lds,const bf16*QB,const bf16*KB,const unsigned char*VT8,bf16*O1,bf16*OB,float pscale,float lam,const float*subg,const DiffFusedOrder&S,float*stampout=nullptr){
  int bh,qb;
  for(int i=0;S.next(i,bh,qb);++i){ const int h=bh&7,b=bh>>3;
    attn128f8_unit<false>(b,qb,QB+h*128,KB+h*128,VT8+(size_t)bh*(64*8192),O1+h*128,pscale,lds,nullptr,0.f,nullptr,stampout); }
  asm volatile("s_waitcnt vmcnt(0)":::"memory");
  for(int i=0;S.next(i,bh,qb);++i){ const int h=bh&7,b=bh>>3;
    attn128f8_unit<true>(b,qb,QB+h*128+64,KB+h*128+64,VT8+(size_t)bh*(64*8192),OB+h*128,pscale,lds,O1+h*128,lam,subg); }
}
__device__ __forceinline__ void diff128q8_phase(char*lds,const unsigned char*Q8,const unsigned char*K8,const unsigned char*VT8,bf16*O1,bf16*OB,float pscale,float lam,const float*subg,const DiffFusedOrder&S){
  int bh,qb;
  for(int i=0;S.next(i,bh,qb);++i){ const int h=bh&7,b=bh>>3;
    attn128q8_unit<false>(b,qb,Q8+h*128,K8+h*128,VT8+(size_t)bh*(64*8192),O1+h*128,pscale,lds); }
  asm volatile("s_waitcnt vmcnt(0)":::"memory");
  for(int i=0;S.next(i,bh,qb);++i){ const int h=bh&7,b=bh>>3;
    attn128q8_unit<true>(b,qb,Q8+h*128+64,K8+h*128+64,VT8+(size_t)bh*(64*8192),OB+h*128,pscale,lds,O1+h*128,lam,subg); }
}
constexpr int ATTN_LDS_BYTES=LDS_BYTES;
struct AttnUnit { int pair; int qb; };
struct DiffOrder {
  int vcu,G,blk;
  __device__ __forceinline__ explicit DiffOrder(int grid,int block):vcu((block%8)*(grid/8)+block/8),G(grid),blk(block){}
  __device__ __forceinline__ bool next(int i,AttnUnit&u)const{
    if(G==256){ if(i>=16)return false; u.pair=(vcu&~31)+2*i+((vcu>>4)&1); u.qb=vcu&15; return true; }
    const int L=i*G+blk; if(L>=4096)return false; u.pair=L>>4; u.qb=L&15; return true; }
};
template<int THRL=8> __device__ __forceinline__ void diff_attn_phase(char*lds,const bf16*QB,const bf16*KB,const bf16*VB,bf16*O1,bf16*O2,const DiffOrder&S){
  AttnUnit u;
  for(int i=0;S.next(i,u);++i){ const int b=u.pair>>5,vh=u.pair&31,h=vh>>2,m=(vh>>1)&1,c=vh&1;
    attn_unit<THRL>(b,0,u.qb,QB+h*128+m*64,KB+h*128+m*64,VB+h*128+c*64,(m?O2:O1)+h*128+c*64,lds); }
}
#undef SBAR
#undef WAIT_BAR
}

constexpr int NWAVES = 8;
constexpr size_t MiB = 1u << 20;
constexpr size_t WS_CTL = 0, CTL_ZERO_BYTES = 1 * MiB;
constexpr size_t WS_MOD = 1 * MiB;
constexpr int MOD_LAM = 8 * 6144;
constexpr size_t WS_WIN = 2 * MiB, WS_WPA = 17 * MiB, WS_WPB = 18 * MiB, WS_WOUT = 20 * MiB, WS_WQ = 22 * MiB, WS_SK = 26 * MiB;
constexpr size_t WS_R1 = 32 * MiB;
constexpr size_t WS_QA = 96 * MiB, WS_KA = 144 * MiB, WS_VA = 192 * MiB;
constexpr size_t WS_O1 = 96 * MiB;
constexpr size_t WS_OB = 160 * MiB, WS_OA = 368 * MiB;
constexpr size_t WS_VT8 = 64 * MiB;
constexpr size_t WS_EU = 96 * MiB, WS_EV = 112 * MiB, WS_ESC = 128 * MiB;
constexpr size_t WS_QB = 240 * MiB, WS_KB = 304 * MiB, WS_VB = 368 * MiB;
constexpr size_t WS_MIX = 240 * MiB, WS_TMP = 304 * MiB;
constexpr size_t WS_QP = 240 * MiB;
constexpr size_t WS_OUTG = 432 * MiB, WS_LSE = 480 * MiB;
constexpr size_t WS_IDX = 432 * MiB, WS_GATE = 448 * MiB;
constexpr size_t WS_CS = 432 * MiB;
constexpr size_t WS_DELTA = 368 * MiB;
constexpr size_t WS_END = 512 * MiB;
constexpr int CW_TMO = 0, CW_BAR = 4096, CW_AMAX = 32768;
constexpr size_t WS_SA = 1 * MiB + 256 * 1024, WS_SW = 1 * MiB + 512 * 1024;
constexpr int RING_OFF = 0, RING_BYTES = 131072;
constexpr int LDSCTL_OFF = RING_BYTES, MISC_OFF = LDSCTL_OFF + 320;
constexpr int LDS_BYTES = 147456;
constexpr int N_PHASES = 13;

#define GAS __attribute__((address_space(1)))
#define LAS __attribute__((address_space(3)))
typedef unsigned short bf16;
typedef unsigned v4u __attribute__((ext_vector_type(4)));
typedef float f32x4 __attribute__((ext_vector_type(4)));
typedef short bf16x8 __attribute__((ext_vector_type(8)));
typedef GAS unsigned gu32;
typedef GAS unsigned long long gu64;
#define RLX_AGENT __ATOMIC_RELAXED, __HIP_MEMORY_SCOPE_AGENT
#define LDS_WAIT() asm volatile("s_waitcnt lgkmcnt(0)" ::: "memory")
#define VM_WAIT() asm volatile("s_waitcnt vmcnt(0)" ::: "memory")
__device__ __forceinline__ unsigned long long rt() { return __builtin_amdgcn_s_memrealtime(); }
__device__ __forceinline__ unsigned f2bf(float f) { unsigned u = __builtin_bit_cast(unsigned, f); return (u + 0x7fffu + ((u >> 16) & 1u)) >> 16; }
__device__ __forceinline__ unsigned pk2(float lo, float hi) { return f2bf(lo) | (f2bf(hi) << 16); }

#define XB_TMO      128
#define XB_XCNT(j)  (256  + 64 * (j))
#define XB_XSUB(j)  (1280 + 64 * (j))
#define XB_XGEN(j)  (2304 + 64 * (j))
#define XB_TOP      3328
#define XB_TOPGEN   3392
#define XCD_BAR_WORDS 3456
#define XB_SPIN_CAP (1u << 18)

__device__ __forceinline__ unsigned xb_ld(unsigned* p)              { return __hip_atomic_load(p, __ATOMIC_RELAXED, __HIP_MEMORY_SCOPE_AGENT); }
__device__ __forceinline__ unsigned xb_add(unsigned* p, unsigned v) { return __hip_atomic_fetch_add(p, v, __ATOMIC_RELAXED, __HIP_MEMORY_SCOPE_AGENT); }
__device__ __forceinline__ unsigned xb_xcc_id() { return (unsigned)__builtin_amdgcn_s_getreg((3 << 11) | 20) & 0xFu; }
#define XB_SPIN(cond, bar) do { unsigned _sp = 0; while (cond) { __builtin_amdgcn_s_sleep(1); \
    if ((++_sp & 255u) == 0u) { if (xb_ld(&(bar)[XB_TMO])) break; if (_sp > XB_SPIN_CAP) { atomicAdd(&(bar)[XB_TMO], 1u); break; } } } } while (0)

struct XcdBarrier {
    unsigned* bar; unsigned x;
    volatile LAS unsigned* st;
};

__device__ __forceinline__ XcdBarrier xcd_barrier_post(unsigned* bar, volatile LAS unsigned* st) {
    XcdBarrier b; b.bar = bar; b.x = xb_xcc_id(); b.st = st;
    if (threadIdx.x == 0) (void)xb_add(&bar[XB_XCNT(b.x)], 1u);
    return b;
}
__device__ __forceinline__ void xcd_barrier_complete(unsigned* bar, unsigned x, unsigned& nloc, unsigned& nx) {
    const unsigned G = gridDim.x * gridDim.y * gridDim.z;
    unsigned sum, cnt, mine, sp = 0u;
    for (;;) {
        sum = 0u; cnt = 0u; mine = 0u;
#pragma unroll
        for (unsigned j = 0; j < 16; ++j) { const unsigned c = xb_ld(&bar[XB_XCNT(j)]); sum += c; cnt += (c > 0u) ? 1u : 0u; mine = (j == x) ? c : mine; }
        if (sum == G) break;
        __builtin_amdgcn_s_sleep(1);
        if ((++sp & 255u) == 0u) { if (xb_ld(&bar[XB_TMO])) break; if (sp > XB_SPIN_CAP) { atomicAdd(&bar[XB_TMO], 1u); break; } }
    }
    nloc = mine > 0u ? mine : 1u; nx = cnt > 0u ? cnt : 1u;
}

__device__ __forceinline__ void xcd_barrier(const XcdBarrier& b) {
    asm volatile("s_waitcnt vmcnt(0)" ::: "memory");
    __syncthreads();
    if (threadIdx.x == 0) {
        unsigned* bar = b.bar;
        __builtin_amdgcn_s_waitcnt(0);
        unsigned nloc = b.st[0], nx = b.st[1];
        if (nloc == 0u) { xcd_barrier_complete(bar, b.x, nloc, nx); b.st[0] = nloc; b.st[1] = nx; }
        const unsigned old = xb_add(&bar[XB_XSUB(b.x)], 1u);
        const unsigned gen = old / nloc;
        if (old + 1u == (gen + 1u) * nloc) {
            __builtin_amdgcn_fence(__ATOMIC_RELEASE, "agent");
            asm volatile("s_waitcnt vmcnt(0)" ::: "memory");
            const unsigned og = xb_add(&bar[XB_TOP], 1u);
            const unsigned tg = og / nx;
            if (og + 1u == (tg + 1u) * nx) xb_add(&bar[XB_TOPGEN], 1u);
            else XB_SPIN(xb_ld(&bar[XB_TOPGEN]) == tg, bar);
            __builtin_amdgcn_fence(__ATOMIC_ACQUIRE, "agent");
            xb_add(&bar[XB_XGEN(b.x)], 1u);
            asm volatile("s_waitcnt vmcnt(0)" ::: "memory");
        } else {
            XB_SPIN(xb_ld(&bar[XB_XGEN(b.x)]) == gen, bar);
            __builtin_amdgcn_fence(__ATOMIC_ACQUIRE, "agent");
            asm volatile("s_waitcnt vmcnt(0)" ::: "memory");
        }
    }
    __syncthreads();
}
__device__ __forceinline__ float wave_sum(float v) {
#pragma unroll
    for (int o = 1; o < 64; o <<= 1) v += __shfl_xor(v, o);
    return v;
}
__device__ __forceinline__ void p0_transpose_item(const float* W, int K, int N, bf16* WT, int row_off, LAS float* scr, int item, int lane) {
    const int nblk = N / 32, kb = item / nblk, nb = item % nblk, k0 = 64 * kb, n0 = 32 * nb;
#pragma unroll 8
    for (int i = 0; i < 32; ++i) { const int kk = 2 * i + (lane >> 5); scr[kk * 33 + (lane & 31)] = W[(size_t)(k0 + kk) * N + n0 + (lane & 31)]; }
    LDS_WAIT(); asm volatile("" ::: "memory");
    const int c = lane & 7;
#pragma unroll
    for (int j = 0; j < 4; ++j) { const int n = (lane >> 3) + 8 * j; const LAS float* s = scr + (8 * c) * 33 + n;
        v4u o; o.x = pk2(s[0 * 33], s[1 * 33]); o.y = pk2(s[2 * 33], s[3 * 33]); o.z = pk2(s[4 * 33], s[5 * 33]); o.w = pk2(s[6 * 33], s[7 * 33]);
        *(GAS v4u*)(WT + (size_t)(row_off + n0 + n) * K + k0 + 8 * c) = o; }
    LDS_WAIT(); asm volatile("" ::: "memory");
}

typedef float f32x16 __attribute__((ext_vector_type(16)));
typedef unsigned u32x2 __attribute__((ext_vector_type(2)));
typedef __bf16 bf16x2v __attribute__((ext_vector_type(2)));
struct Frame {
    LAS unsigned char* lds;
    volatile LAS unsigned* MISC;
    gu32* ctl;
    int tid, lane, wave;
    int vcu, G;
};
struct Args { const void* in[25]; float* out; unsigned char* ws; int ph_lo, ph_hi, bar_region, pad; };

__device__ __forceinline__ float bflo(unsigned w) { return __uint_as_float(w << 16); }
__device__ __forceinline__ float bfhi(unsigned w) { return __uint_as_float(w & 0xffff0000u); }
__device__ __forceinline__ float dot2bf(unsigned a, unsigned b, float acc) { return __builtin_amdgcn_fdot2_f32_bf16(__builtin_bit_cast(bf16x2v, a), __builtin_bit_cast(bf16x2v, b), acc, false); }

__device__ __forceinline__ int win_slot(int col) {
    const int pn = col >> 8;
    if (pn < 6 || (pn >= 9 && pn < 17)) { const int within = col & 255; return pn * 256 + 128 * ((within >> 5) & 1) + 32 * (within >> 6) + (within & 31); }
    return col;
}
__device__ __forceinline__ void win_fp8_item(const float* W, const unsigned* amax, unsigned char* WT8, float* sW, LAS float* scr, int item, int lane) {
    constexpr int nblk = IN_W / 32; const int kb = item / nblk, nb = item % nblk, k0 = 64 * kb, n0 = 32 * nb;
#pragma unroll 8
    for (int i = 0; i < 32; ++i) { const int kk = 2 * i + (lane >> 5); scr[kk * 33 + (lane & 31)] = W[(size_t)(k0 + kk) * IN_W + n0 + (lane & 31)]; }
    LDS_WAIT(); asm volatile("" ::: "memory");
    const int n = lane >> 1, hf = lane & 1, slot = win_slot(n0 + n);
    const float am = __uint_as_float(amax[slot]); const float sc = am > 0.f ? 240.0f / am : 1.0f;
    const LAS float* sp = scr + (hf * 32) * 33 + n;
    unsigned w[8];
#pragma unroll
    for (int j = 0; j < 8; ++j) { int t = __builtin_amdgcn_cvt_pk_fp8_f32(sp[(4 * j) * 33] * sc, sp[(4 * j + 1) * 33] * sc, 0, false); t = __builtin_amdgcn_cvt_pk_fp8_f32(sp[(4 * j + 2) * 33] * sc, sp[(4 * j + 3) * 33] * sc, t, true); w[j] = (unsigned)t; }
    unsigned char* dp = WT8 + (size_t)slot * 1024 + k0 + hf * 32;
    *(GAS v4u*)dp = (v4u){w[0], w[1], w[2], w[3]}; *(GAS v4u*)(dp + 16) = (v4u){w[4], w[5], w[6], w[7]};
    if (kb == 0 && hf == 0) sW[slot] = am > 0.f ? am * (1.0f / 240.0f) : 1.0f;
    LDS_WAIT(); asm volatile("" ::: "memory");
}

__device__ __forceinline__ void p0_prologue(Frame& F, const Args& a) {
    float* modp = (float*)(a.ws + WS_MOD);
    {
        LAS float* sc = (LAS float*)F.lds;
        LAS float* red = (LAS float*)(F.lds + 32768);
        const float* c = (const float*)a.in[1]; const float* w_ada = (const float*)a.in[3]; const float* b_ada = (const float*)a.in[4];
        bool did = false;
        for (int u = F.vcu; u < 192; u += F.G) {
            if (!did) { for (int i = F.tid; i < 8192; i += NWAVES * 64) { const float v = c[i]; sc[i] = v / (1.f + __expf(-v)); } __syncthreads(); did = true; }
            const int cc = F.tid & 31, kg = F.tid >> 5, col = u * 32 + cc;
            float acc[8];
#pragma unroll
            for (int b = 0; b < 8; ++b) acc[b] = 0.f;
#pragma unroll 8
            for (int k = kg * 64; k < kg * 64 + 64; ++k) { const float w = w_ada[(size_t)k * 6144 + col];
#pragma unroll
                for (int b = 0; b < 8; ++b) acc[b] += sc[b * 1024 + k] * w; }
#pragma unroll
            for (int b = 0; b < 8; ++b) red[(kg * 8 + b) * 32 + cc] = acc[b];
            __syncthreads();
            if (F.tid < 256) { const int b = F.tid >> 5; float s = b_ada[col];
#pragma unroll
                for (int g = 0; g < 16; ++g) s += red[(g * 8 + b) * 32 + cc];
                modp[b * 6144 + col] = s; }
            __syncthreads();
        }
        if (F.vcu == F.G - 1 && F.wave == 0) {
            const float p1 = ((const float*)a.in[13])[F.lane] * ((const float*)a.in[14])[F.lane];
            const float p2 = ((const float*)a.in[15])[F.lane] * ((const float*)a.in[16])[F.lane];
            const float s1 = wave_sum(p1), s2 = wave_sum(p2);
            if (F.lane == 0) { modp[MOD_LAM] = expf(s1) - expf(s2) + LAM_INIT; modp[MOD_LAM + 16] = 0.f; modp[MOD_LAM + 17] = 0.f; modp[MOD_LAM + 18] = 0.f; modp[MOD_LAM + 19] = 0.f; modp[MOD_LAM + 24] = 0.f; modp[MOD_LAM + 25] = 0.f; }
        }
        __syncthreads();
    }
    { const float* w_in = (const float*)a.in[6]; unsigned* amax = (unsigned*)(a.ws + WS_CTL) + CW_AMAX;
      for (int u = F.vcu; u < 4 * (IN_W / 128); u += F.G) { const int cu = u % (IN_W / 128), kq = u / (IN_W / 128);
          const int col = cu * 128 + (F.tid & 127), kb = kq * 256 + (F.tid >> 7) * 64; float m = 0.f;
#pragma unroll 8
          for (int k = kb; k < kb + 64; ++k) m = fmaxf(m, fabsf(w_in[(size_t)k * IN_W + col]));
          atomicMax(amax + win_slot(col), __float_as_uint(m)); } }
    LAS float* scr = (LAS float*)(F.lds + RING_OFF + F.wave * 16384);
    const int gw = F.vcu * NWAVES + F.wave, NGW = F.G * NWAVES;
    constexpr int I_PA = (DIL_OUT / 64) * (D / 32), I_PB = (D / 64) * (D / 32), I_OUT = I_PB, I_Q = (D / 64) * (PEER_QW / 32);
    constexpr int NITEMS = I_PA + I_PB + I_OUT + I_Q;
    for (int it = gw; it < NITEMS; it += NGW) {
        int r = it;
        if (r < I_PA) { p0_transpose_item((const float*)a.in[10], DIL_OUT, D, (bf16*)(a.ws + WS_WPA), 0, scr, r, F.lane); continue; } r -= I_PA;
        if (r < I_PB) { p0_transpose_item((const float*)a.in[18], D, D, (bf16*)(a.ws + WS_WPB), 0, scr, r, F.lane); continue; } r -= I_PB;
        if (r < I_OUT) { p0_transpose_item((const float*)a.in[19], D, D, (bf16*)(a.ws + WS_WOUT), 0, scr, r, F.lane); continue; } r -= I_OUT;
        p0_transpose_item((const float*)a.in[21], D, PEER_QW, (bf16*)(a.ws + WS_WQ), 0, scr, r, F.lane);
    }
    { const float* sk = (const float*)a.in[22]; bf16* o = (bf16*)(a.ws + WS_SK);
      for (int i = (F.vcu * NWAVES * 64 + F.tid); i < 8 * 2 * 128 * 128 / 8; i += F.G * NWAVES * 64) {
          const f32x4 v0 = *(const GAS f32x4*)(sk + (size_t)i * 8), v1 = *(const GAS f32x4*)(sk + (size_t)i * 8 + 4);
          v4u w; w.x = pk2(v0.x, v0.y); w.y = pk2(v0.z, v0.w); w.z = pk2(v1.x, v1.y); w.w = pk2(v1.z, v1.w);
          const int row = i >> 4, grp = i & 15, hh = row >> 7, n = row & 127;
          const size_t dst = ((((size_t)hh * 4 + (n >> 5)) * 8 + (grp >> 1)) * 64 + (grp & 1) * 32 + (n & 31)) * 8;
          *(GAS v4u*)(o + dst) = w; } }
}

__device__ __forceinline__ void convert_bf16(Frame& F, const float* src, bf16* dst, size_t n8) {
    for (size_t i = (size_t)F.vcu * NWAVES * 64 + F.tid; i < n8; i += (size_t)F.G * NWAVES * 64) {
        const f32x4 v0 = *(const GAS f32x4*)(src + i * 8), v1 = *(const GAS f32x4*)(src + i * 8 + 4);
        v4u w; w.x = pk2(v0.x, v0.y); w.y = pk2(v0.z, v0.w); w.z = pk2(v1.x, v1.y); w.w = pk2(v1.z, v1.w);
        *(GAS v4u*)(dst + i * 8) = w; }
}

typedef float f32x2v __attribute__((ext_vector_type(2)));
__device__ __forceinline__ void convert_fp8_slices(Frame& F, const float* src, unsigned char* dst, float* scale) {
    const int gw = F.vcu * NWAVES + F.wave, NGW = F.G * NWAVES, l = F.lane;
    for (int e = gw; e < NEXP; e += NGW) {
        const GAS f32x4* rp = (const GAS f32x4*)(src + (size_t)e * 1024 + l * 16);
        const f32x4 v0 = rp[0], v1 = rp[1], v2 = rp[2], v3 = rp[3];
        float am = fmaxf(fmaxf(fmaxf(fabsf(v0.x), fabsf(v0.y)), fmaxf(fabsf(v0.z), fabsf(v0.w))), fmaxf(fmaxf(fabsf(v1.x), fabsf(v1.y)), fmaxf(fabsf(v1.z), fabsf(v1.w))));
        am = fmaxf(am, fmaxf(fmaxf(fmaxf(fabsf(v2.x), fabsf(v2.y)), fmaxf(fabsf(v2.z), fabsf(v2.w))), fmaxf(fmaxf(fabsf(v3.x), fabsf(v3.y)), fmaxf(fabsf(v3.z), fabsf(v3.w)))));
#pragma unroll
        for (int o = 1; o < 64; o <<= 1) am = fmaxf(am, __shfl_xor(am, o));
        const float sc = am > 0.f ? 256.0f / am : 1.0f;
        v4u w;
        { int t = __builtin_amdgcn_cvt_pk_fp8_f32(v0.x * sc, v0.y * sc, 0, false); t = __builtin_amdgcn_cvt_pk_fp8_f32(v0.z * sc, v0.w * sc, t, true); w.x = (unsigned)t; }
        { int t = __builtin_amdgcn_cvt_pk_fp8_f32(v1.x * sc, v1.y * sc, 0, false); t = __builtin_amdgcn_cvt_pk_fp8_f32(v1.z * sc, v1.w * sc, t, true); w.y = (unsigned)t; }
        { int t = __builtin_amdgcn_cvt_pk_fp8_f32(v2.x * sc, v2.y * sc, 0, false); t = __builtin_amdgcn_cvt_pk_fp8_f32(v2.z * sc, v2.w * sc, t, true); w.z = (unsigned)t; }
        { int t = __builtin_amdgcn_cvt_pk_fp8_f32(v3.x * sc, v3.y * sc, 0, false); t = __builtin_amdgcn_cvt_pk_fp8_f32(v3.z * sc, v3.w * sc, t, true); w.w = (unsigned)t; }
        *(GAS v4u*)(dst + ((size_t)(l >> 3) * NEXP + e) * 128 + (l & 7) * 16) = w;
        if (l == 0) scale[e] = am > 0.f ? am * (1.0f / 256.0f) : 1.0f;
    }
}

template <bool FP8OUT>
__device__ __forceinline__ void norm_mod_rows(Frame& F, const float* xin, const float* g, const float* modp, int sh_off, int sc_off, bf16* out, const int* positions = nullptr, float* CS = nullptr, float* sA = nullptr, const bf16* delta = nullptr) {
    const int gw = F.vcu * NWAVES + F.wave, NGW = F.G * NWAVES;
    f32x4 gg[4];
#pragma unroll
    for (int j = 0; j < 4; ++j) gg[j] = ((const GAS f32x4*)g)[F.lane + 64 * j];
    for (int m = gw; m < T; m += NGW) {
        const int b = m >> 12;
        const GAS f32x4* xr = (const GAS f32x4*)(xin + (size_t)m * D) + F.lane;
        f32x4 v[4]; float s = 0.f;
#pragma unroll
        for (int j = 0; j < 4; ++j) { v[j] = xr[64 * j];
            if (delta) { const u32x2 dl = *((const GAS u32x2*)(delta + (size_t)m * D) + F.lane + 64 * j); v[j].x += bflo(dl.x); v[j].y += bfhi(dl.x); v[j].z += bflo(dl.y); v[j].w += bfhi(dl.y); }
            s += (v[j].x * v[j].x + v[j].y * v[j].y) + (v[j].z * v[j].z + v[j].w * v[j].w); }
        const float rstd = 1.f / sqrtf(wave_sum(s) * (1.f / D) + EPS);
        const GAS f32x4* shp = (const GAS f32x4*)(modp + (size_t)b * 6144 + sh_off) + F.lane;
        const GAS f32x4* scp = (const GAS f32x4*)(modp + (size_t)b * 6144 + sc_off) + F.lane;
        GAS unsigned long long* o8 = (GAS unsigned long long*)(out + (size_t)m * D) + F.lane;
        if constexpr (FP8OUT) {
            f32x4 y[4]; float am = 0.f;
#pragma unroll
            for (int j = 0; j < 4; ++j) { const f32x4 sc = scp[64 * j], sh = shp[64 * j]; y[j] = v[j] * rstd * gg[j] * (sc + 1.0f) + sh;
                am = fmaxf(am, fmaxf(fmaxf(fabsf(y[j].x), fabsf(y[j].y)), fmaxf(fabsf(y[j].z), fabsf(y[j].w)))); }
#pragma unroll
            for (int o = 1; o < 64; o <<= 1) am = fmaxf(am, __shfl_xor(am, o));
            const float qs = am > 0.f ? 240.0f / am : 1.0f;
            GAS unsigned* o4 = (GAS unsigned*)((unsigned char*)out + (size_t)m * D) + F.lane;
#pragma unroll
            for (int j = 0; j < 4; ++j) { int t = __builtin_amdgcn_cvt_pk_fp8_f32(y[j].x * qs, y[j].y * qs, 0, false); t = __builtin_amdgcn_cvt_pk_fp8_f32(y[j].z * qs, y[j].w * qs, t, true); o4[64 * j] = (unsigned)t; }
            if (F.lane == 0) sA[m] = am > 0.f ? am * (1.0f / 240.0f) : 1.0f;
        } else {
#pragma unroll
        for (int j = 0; j < 4; ++j) { const f32x4 sc = scp[64 * j], sh = shp[64 * j];
            const f32x4 y = v[j] * rstd * gg[j] * (sc + 1.0f) + sh;
            o8[64 * j] = (unsigned long long)pk2(y.x, y.y) | ((unsigned long long)pk2(y.z, y.w) << 32); }
        }
        if (CS) {
            constexpr float L2T = 13.287712379549449f / 32.f;
            const int i = F.lane & 31; const float ang = (float)positions[m] * exp2f(-(float)i * L2T);
            float sn, cs; sincosf(ang, &sn, &cs);
            CS[(size_t)m * 64 + F.lane] = (F.lane < 32) ? cs : sn; }
    }
}

template <int NIT>
__device__ __forceinline__ void normrope_buf(bf16* base, int hq, int dd, const float (&g)[4], float c0, float s0, float c1, float s1, float qs) {
    unsigned lo[NIT], hi[NIT];
#pragma unroll
    for (int it = 0; it < NIT; ++it) { const bf16* p = base + (it * 4 + hq) * 64 + dd; lo[it] = *(const GAS unsigned*)p; hi[it] = *(const GAS unsigned*)(p + 32); }
#pragma unroll
    for (int it = 0; it < NIT; ++it) {
        const float x1a = bflo(lo[it]), x1b = bfhi(lo[it]), x2a = bflo(hi[it]), x2b = bfhi(hi[it]);
        float ss = (x1a * x1a + x1b * x1b) + (x2a * x2a + x2b * x2b);
        ss += __shfl_xor(ss, 1); ss += __shfl_xor(ss, 2); ss += __shfl_xor(ss, 4); ss += __shfl_xor(ss, 8);
        const float rstd = 1.f / sqrtf(ss * (1.f / 64.f) + EPS);
        const float y1a = x1a * rstd * g[0], y1b = x1b * rstd * g[1], y2a = x2a * rstd * g[2], y2b = x2b * rstd * g[3];
        const float o1a = (y1a * c0 - y2a * s0) * qs, o2a = (y2a * c0 + y1a * s0) * qs;
        const float o1b = (y1b * c1 - y2b * s1) * qs, o2b = (y2b * c1 + y1b * s1) * qs;
        bf16* p = base + (it * 4 + hq) * 64 + dd;
        *(GAS unsigned*)p = pk2(o1a, o1b); *(GAS unsigned*)(p + 32) = pk2(o2a, o2b);
    }
}
__device__ __forceinline__ void p3_normrope(Frame& F, const Args& a) {
    const int gw = F.vcu * NWAVES + F.wave, NGW = F.G * NWAVES;
    const int sub = F.lane & 15, hq = F.lane >> 4, dd = 2 * sub;
    bf16* QA = (bf16*)(a.ws + WS_QA); bf16* KA = (bf16*)(a.ws + WS_KA); bf16* QB = (bf16*)(a.ws + WS_QB); bf16* KB = (bf16*)(a.ws + WS_KB);
    const int* positions = (const int*)a.in[2];
    float g[4][4];
    { const float* gp[4] = {(const float*)a.in[8], (const float*)a.in[9], (const float*)a.in[11], (const float*)a.in[12]};
#pragma unroll
      for (int i = 0; i < 4; ++i) { g[i][0] = gp[i][dd]; g[i][1] = gp[i][dd + 1]; g[i][2] = gp[i][dd + 32]; g[i][3] = gp[i][dd + 33]; } }
    constexpr float L2T = 13.287712379549449f / 32.f;
    const float f0 = exp2f(-(float)dd * L2T), f1 = exp2f(-(float)(dd + 1) * L2T);
    for (int t = gw; t < T; t += NGW) {
        const float pos = (float)positions[t];
        float s0, c0, s1, c1; sincosf(pos * f0, &s0, &c0); sincosf(pos * f1, &s1, &c1);
        normrope_buf<3>(QA + (size_t)t * 768, hq, dd, g[0], c0, s0, c1, s1, QSCALE);
        normrope_buf<3>(KA + (size_t)t * 768, hq, dd, g[1], c0, s0, c1, s1, 1.0f);
        normrope_buf<4>(QB + (size_t)t * 1024, hq, dd, g[2], c0, s0, c1, s1, QSCALE);
        normrope_buf<4>(KB + (size_t)t * 1024, hq, dd, g[3], c0, s0, c1, s1, 1.0f);
    }
}

__device__ __forceinline__ void p4_dilated(Frame& F, const Args& a) {
    constexpr int ROWB = 144;
    const bf16* QA = (const bf16*)(a.ws + WS_QA); const bf16* KA = (const bf16*)(a.ws + WS_KA); const bf16* VA = (const bf16*)(a.ws + WS_VA);
    bf16* OUTG = (bf16*)(a.ws + WS_OUTG); float* LSE = (float*)(a.ws + WS_LSE);
    LAS unsigned char* Ks = F.lds; LAS unsigned char* Vs = F.lds + 384 * ROWB;
    const int tid = F.tid, l = F.lane, qi = F.wave * 32 + (l & 31), hf = l >> 5;
    for (int u = F.vcu; u < 1536; u += F.G) {
        const int rc = u & 15, bh = u >> 4, head = bh % 12, b = bh / 12, g = head >> 2, hslot = head & 3;
        const int dsh = 2 * g, L = SEQ >> dsh, nchunk = L >> 8;
        const int r = rc / nchunk, chunk = rc % nchunk, j0 = chunk << 8;
#pragma unroll
        for (int p = 0; p < 6; ++p) { const int row = p * 64 + (tid >> 3), ch = tid & 7, jj = j0 - 64 + row;
            v4u kv = (v4u){0u, 0u, 0u, 0u}, vv = (v4u){0u, 0u, 0u, 0u};
            if ((unsigned)jj < (unsigned)L) { const size_t tok = (size_t)b * SEQ + r + ((size_t)jj << dsh);
                kv = *(const GAS v4u*)(KA + tok * 768 + head * 64 + ch * 8); vv = *(const GAS v4u*)(VA + tok * 768 + head * 64 + ch * 8); }
            *(LAS v4u*)(Ks + row * ROWB + ch * 16) = kv; *(LAS v4u*)(Vs + row * ROWB + ch * 16) = vv; }
        const int j = j0 + qi; const size_t qtok = (size_t)b * SEQ + r + ((size_t)j << dsh);
        unsigned q[32];
#pragma unroll
        for (int c = 0; c < 8; ++c) { const v4u t4 = *(const GAS v4u*)(QA + qtok * 768 + head * 64 + c * 8); q[4 * c] = t4.x; q[4 * c + 1] = t4.y; q[4 * c + 2] = t4.z; q[4 * c + 3] = t4.w; }
        __syncthreads();
        float m = -INFINITY, lsum = 0.f; float o[64];
#pragma unroll
        for (int i = 0; i < 64; ++i) o[i] = 0.f;
        const int rowbase = qi + hf * 64, nk = 64 + hf;
        for (int kk = 0; kk < nk; ++kk) {
            const int row = rowbase + kk, jj = j0 - 64 + row;
            if ((unsigned)jj < (unsigned)L) {
                const LAS v4u* kp = (const LAS v4u*)(Ks + row * ROWB);
                float s0 = 0.f, s1 = 0.f, s2 = 0.f, s3 = 0.f;
#pragma unroll
                for (int c = 0; c < 8; ++c) { const v4u kv = kp[c]; s0 = dot2bf(kv.x, q[4 * c], s0); s1 = dot2bf(kv.y, q[4 * c + 1], s1); s2 = dot2bf(kv.z, q[4 * c + 2], s2); s3 = dot2bf(kv.w, q[4 * c + 3], s3); }
                const float s = (s0 + s1) + (s2 + s3);
                if (s > m + 8.f) { const float f = exp2f(m - s); lsum *= f;
#pragma unroll
                    for (int i = 0; i < 64; ++i) o[i] *= f;
                    m = s; }
                const float p = exp2f(s - m); lsum += p;
                const LAS v4u* vp = (const LAS v4u*)(Vs + row * ROWB);
#pragma unroll
                for (int c = 0; c < 8; ++c) { const v4u vv = vp[c];
                    o[8 * c + 0] += p * bflo(vv.x); o[8 * c + 1] += p * bfhi(vv.x); o[8 * c + 2] += p * bflo(vv.y); o[8 * c + 3] += p * bfhi(vv.y);
                    o[8 * c + 4] += p * bflo(vv.z); o[8 * c + 5] += p * bfhi(vv.z); o[8 * c + 6] += p * bflo(vv.w); o[8 * c + 7] += p * bfhi(vv.w); }
            }
        }
        const float mo = __shfl_xor(m, 32), M = fmaxf(m, mo);
        const float f = exp2f(m - M);
        float lt = lsum * f; lt += __shfl_xor(lt, 32);
        const float inv = 1.f / lt;
        unsigned pk[16];
#pragma unroll
        for (int i = 0; i < 32; i += 2) {
            float a0 = o[i] * f, a1 = o[i + 1] * f, b0 = o[32 + i] * f, b1 = o[33 + i] * f;
            a0 += __shfl_xor(a0, 32); a1 += __shfl_xor(a1, 32); b0 += __shfl_xor(b0, 32); b1 += __shfl_xor(b1, 32);
            pk[i >> 1] = hf ? pk2(b0 * inv, b1 * inv) : pk2(a0 * inv, a1 * inv);
        }
        bf16* op = OUTG + ((size_t)g * T + qtok) * 256 + hslot * 64 + hf * 32;
#pragma unroll
        for (int c = 0; c < 4; ++c) *(GAS v4u*)(op + c * 8) = (v4u){pk[4 * c], pk[4 * c + 1], pk[4 * c + 2], pk[4 * c + 3]};
        if (hf == 0) LSE[((size_t)g * T + qtok) * 4 + hslot] = M + log2f(lt);
        __syncthreads();
    }
}

__device__ __forceinline__ void p3_vt8(Frame& F, const Args& a) {
    const unsigned char* VB8 = (const unsigned char*)(a.ws + WS_VB); unsigned char* VT8 = (unsigned char*)(a.ws + WS_VT8);
    LAS unsigned char* img = F.lds + F.wave * 8192;
    const int l = F.lane;
    for (int u = F.vcu * NWAVES + F.wave; u < BATCH * 8 * 64; u += F.G * NWAVES) {
        const int tile = u & 63, bh = u >> 6, h = bh & 7, b = bh >> 3;
        const unsigned char* src = VB8 + ((size_t)b * SEQ + tile * 64) * 1024 + h * 128;
#pragma unroll
        for (int i = 0; i < 8; ++i) { const int key = i * 8 + (l >> 3), ch = l & 7;
            *(LAS v4u*)(img + key * 128 + ch * 16) = *(const GAS v4u*)(src + (size_t)key * 1024 + ch * 16); }
        LDS_WAIT(); asm volatile("" ::: "memory");
#pragma unroll
        for (int dd = 0; dd < 2; ++dd) { const int d = l + 64 * dd;
            unsigned w[16];
#pragma unroll
            for (int j = 0; j < 16; ++j) { unsigned x = 0;
#pragma unroll
                for (int e = 0; e < 4; ++e) { const int pp = 4 * j + e; const int key = 32 * ((pp >> 4) & 1) + 8 * ((pp & 15) >> 2) + 4 * (pp >> 5) + (pp & 3);
                    x |= (unsigned)img[key * 128 + d] << (8 * e); }
                w[j] = x; }
            unsigned char* dst = VT8 + ((size_t)bh * 64 + tile) * 8192 + d * 64;
#pragma unroll
            for (int c = 0; c < 4; ++c) *(GAS v4u*)(dst + c * 16) = (v4u){w[4 * c], w[4 * c + 1], w[4 * c + 2], w[4 * c + 3]}; }
        LDS_WAIT(); asm volatile("" ::: "memory");
    }
}

__device__ __forceinline__ void p6_combine(Frame& F, const Args& a) {
    const int gw = F.vcu * NWAVES + F.wave, NGW = F.G * NWAVES, l = F.lane;
    const bf16* OUTG = (const bf16*)(a.ws + WS_OUTG); const float* LSE = (const float*)(a.ws + WS_LSE);
    bf16* OA = (bf16*)(a.ws + WS_OA);
    for (int t = gw; t < T; t += NGW) {
        const int hslot = l >> 4, d4 = (l & 15) * 4;
        float ls[3];
#pragma unroll
        for (int g = 0; g < 3; ++g) ls[g] = LSE[((size_t)g * T + t) * 4 + hslot];
        const float M = fmaxf(fmaxf(ls[0], ls[1]), ls[2]);
        float acc0 = 0.f, acc1 = 0.f, acc2 = 0.f, acc3 = 0.f, wsum = 0.f;
#pragma unroll
        for (int g = 0; g < 3; ++g) { const float w = exp2f(ls[g] - M); wsum += w;
            const u32x2 v = *(const GAS u32x2*)(OUTG + ((size_t)g * T + t) * 256 + hslot * 64 + d4);
            acc0 += w * bflo(v.x); acc1 += w * bfhi(v.x); acc2 += w * bflo(v.y); acc3 += w * bfhi(v.y); }
        const float iw = 1.f / wsum;
        u32x2 w2; w2.x = pk2(acc0 * iw, acc1 * iw); w2.y = pk2(acc2 * iw, acc3 * iw);
        *(GAS u32x2*)(OA + (size_t)t * 256 + hslot * 64 + d4) = w2;
    }
}

#define CE_DESC(a, b) do { const float hi_ = fmaxf(a, b), lo_ = fminf(a, b); a = hi_; b = lo_; } while (0)
#define CE_ASC(a, b)  do { const float hi_ = fmaxf(a, b), lo_ = fminf(a, b); a = lo_; b = hi_; } while (0)
template <int N> __device__ __forceinline__ void bitonic_sort_desc(float (&v)[N]) {
#pragma unroll
    for (int k = 2; k <= N; k <<= 1)
#pragma unroll
        for (int j = k >> 1; j > 0; j >>= 1)
#pragma unroll
            for (int i = 0; i < N; ++i) { const int l = i ^ j; if (l > i) { if ((i & k) == 0) CE_DESC(v[i], v[l]); else CE_ASC(v[i], v[l]); } }
}
template <int X> __device__ __forceinline__ void merge_top16(float (&a)[16]) {
    float c[16];
#pragma unroll
    for (int i = 0; i < 16; ++i) c[i] = fmaxf(a[i], __shfl_xor(a[15 - i], X));
#pragma unroll
    for (int j = 8; j > 0; j >>= 1)
#pragma unroll
        for (int i = 0; i < 16; ++i) { const int l = i ^ j; if (l > i) CE_DESC(c[i], c[l]); }
#pragma unroll
    for (int i = 0; i < 16; ++i) a[i] = c[i];
}
template <int X> __device__ __forceinline__ void merge_8_8(const float (&a)[8], float (&c)[16]) {
#pragma unroll
    for (int i = 0; i < 8; ++i) { c[i] = a[i]; c[8 + i] = __shfl_xor(a[7 - i], X); }
#pragma unroll
    for (int j = 8; j > 0; j >>= 1)
#pragma unroll
        for (int i = 0; i < 16; ++i) { const int l = i ^ j; if (l > i) CE_DESC(c[i], c[l]); }
}
struct P11Frags { bf16x8 a0[8], a1[8], b[8]; };
__device__ __forceinline__ void p11_load_a(P11Frags& R, const bf16* QF, int u, int w, int l) {
    const int h = u & 7, rb = (u >> 3) * 2, half = w >> 2;
    const bf16* ap0 = QF + ((((size_t)(rb * 8 + h) * 2 + half) * 8) * 64 + l) * 8;
    const bf16* ap1 = QF + ((((size_t)((rb + 1) * 8 + h) * 2 + half) * 8) * 64 + l) * 8;
#pragma unroll
    for (int s = 0; s < 8; ++s) { R.a0[s] = *(const GAS bf16x8*)(ap0 + s * 512); R.a1[s] = *(const GAS bf16x8*)(ap1 + s * 512); }
}
__device__ __forceinline__ void p11_load_b(P11Frags& R, const bf16* SKF, int h, int w, int l) {
    const int half = w >> 2, kt = w & 3;
    const bf16* bp = SKF + ((((size_t)(h * 2 + half) * 4 + kt) * 8) * 64 + l) * 8;
#pragma unroll
    for (int s = 0; s < 8; ++s) R.b[s] = *(const GAS bf16x8*)(bp + s * 512);
}
__device__ __forceinline__ void p11_peer_topk(Frame& F, const Args& a) {
    constexpr int RS = 132;
    const bf16* QF = (const bf16*)(a.ws + WS_QP); const bf16* SKF = (const bf16*)(a.ws + WS_SK);
    int* IDX = (int*)(a.ws + WS_IDX); float* GATE = (float*)(a.ws + WS_GATE);
    LAS float* sc = (LAS float*)F.lds;
    LAS float* tv = (LAS float*)(F.lds + 67584);
    LAS unsigned char* tab = (LAS unsigned char*)(F.lds + 67584 + 8192);
    const int tid = F.tid, l = F.lane, w = F.wave;
    if (tid < 64) {
        int q = tid, ci = 255, n = 0;
        for (int i = 0; i < 16; ++i) for (int j = 0; j < 16; ++j) if ((i + 1) * (j + 1) <= 16) { if (n == q) ci = i * 16 + j; ++n; }
        tab[tid] = (unsigned char)ci;
    }
    __syncthreads();
#define LDS_BAR() do { asm volatile("s_waitcnt lgkmcnt(0)" ::: "memory"); __builtin_amdgcn_s_barrier(); asm volatile("" ::: "memory"); } while (0)
#ifdef PROBE11
    const int pm_ = a.pad;
#else
    constexpr int pm_ = 0;
#endif
    P11Frags R;
    int hcur = F.vcu & 7;
    if (F.vcu < 4096) { p11_load_b(R, SKF, hcur, w, l); p11_load_a(R, QF, F.vcu, w, l); }
    for (int u = F.vcu; u < 4096; u += F.G) {
        const int h = u & 7, t0 = (u >> 3) * 64;
        if (h != hcur) { hcur = h; p11_load_b(R, SKF, h, w, l); }
        if (!(pm_ & 4)) {   const int half = w >> 2, kt = w & 3, r32 = l & 31, hi = l >> 5;
            f32x16 acc0, acc1;
#pragma unroll
            for (int i = 0; i < 16; ++i) { acc0[i] = 0.f; acc1[i] = 0.f; }
#pragma unroll
            for (int s = 0; s < 8; ++s) {
                acc0 = __builtin_amdgcn_mfma_f32_32x32x16_bf16(R.a0[s], R.b[s], acc0, 0, 0, 0);
                acc1 = __builtin_amdgcn_mfma_f32_32x32x16_bf16(R.a1[s], R.b[s], acc1, 0, 0, 0);
            }
#pragma unroll
            for (int r = 0; r < 16; ++r) { const int row = (r & 3) + 8 * (r >> 2) + 4 * hi;
                sc[(half * 64 + row) * RS + kt * 32 + r32] = acc0[r]; sc[(half * 64 + 32 + row) * RS + kt * 32 + r32] = acc1[r]; }
        }
        if (u + F.G < 4096) p11_load_a(R, QF, u + F.G, w, l);
        LDS_BAR();
        if (!(pm_ & 1)) {
            const int row = tid >> 2, part = tid & 3;
            float v[32];
#pragma unroll
            for (int k = 0; k < 32; ++k) v[k] = __uint_as_float((__float_as_uint(sc[row * RS + 4 * k + part]) & ~0x7Fu) | (unsigned)(127 - (4 * k + part)));
            bitonic_sort_desc<32>(v);
            float t16[16];
#pragma unroll
            for (int i = 0; i < 16; ++i) t16[i] = v[i];
            merge_top16<1>(t16); merge_top16<2>(t16);
            if (part == 0) {
#pragma unroll
                for (int i = 0; i < 4; ++i) *(LAS f32x4*)(tv + row * 16 + 4 * i) = (f32x4){t16[4 * i], t16[4 * i + 1], t16[4 * i + 2], t16[4 * i + 3]}; }
        }
        LDS_BAR();
        if (!(pm_ & 2)) {
            const int tok = tid >> 3, part = tid & 7;
            float c8[8];
#pragma unroll
            for (int k = 0; k < 8; ++k) { const int ci = tab[part * 8 + k]; const int ii = (ci >> 4) & 15, jj = ci & 15;
                const float sum = tv[tok * 16 + ii] + tv[(64 + tok) * 16 + jj];
                c8[k] = (ci == 255) ? -INFINITY : __uint_as_float((__float_as_uint(sum) & ~0xFFu) | (unsigned)(255 - ci)); }
            bitonic_sort_desc<8>(c8);
            float c[16];
            merge_8_8<1>(c8, c); merge_top16<2>(c); merge_top16<4>(c);
            const float mx = c[0]; float den = 0.f;
#pragma unroll
            for (int k = 0; k < 16; ++k) den += __expf(c[k] - mx);
            const float iden = 1.f / den;
            int ev[2]; float gv[2];
#pragma unroll
            for (int kk = 0; kk < 2; ++kk) {
                float val = c[0];
#pragma unroll
                for (int k = 0; k < 16; ++k) val = (k == part * 2 + kk) ? c[k] : val;
                const int ci = 255 - (int)(__float_as_uint(val) & 0xFFu);
                const int e1 = 127 - (int)(__float_as_uint(tv[tok * 16 + (ci >> 4)]) & 0x7Fu), e2 = 127 - (int)(__float_as_uint(tv[(64 + tok) * 16 + (ci & 15)]) & 0x7Fu);
                ev[kk] = e1 * 128 + e2; gv[kk] = __expf(val - mx) * iden; }
            if (pm_ == 0) {
                const size_t o = ((size_t)h * T + t0 + tok) * 16 + 2 * part;
                *(GAS u32x2*)(IDX + o) = (u32x2){(unsigned)ev[0], (unsigned)ev[1]}; *(GAS f32x2v*)(GATE + o) = (f32x2v){gv[0], gv[1]}; }
            else if (pm_ & 8) { if (ev[0] == 12345 && gv[1] == 7.f) IDX[0] = ev[1]; }
        }
        LDS_BAR();
    }
}

#undef LDS_BAR
typedef int v4i __attribute__((ext_vector_type(4)));
__device__ __forceinline__ float gelu_erf(float x) { return 0.5f * x * (1.0f + erff(x * 0.70710678118654752f)); }
struct GBuf { v4u r[16]; v4u h0, h1; };
template <bool WITH_H> __device__ __forceinline__ void peer_issue(GBuf& B, const unsigned char* tab, const bf16* H2, const LAS int* il, int tbase, int it, int g, int c) {
    const int s = it >> 4, tt = it & 15;
    const LAS v4i* ip = (const LAS v4i*)(il + tt * 128 + g * 16);
    const v4i i0 = ip[0], i1 = ip[1], i2 = ip[2], i3 = ip[3];
    const int e[16] = {i0.x, i0.y, i0.z, i0.w, i1.x, i1.y, i1.z, i1.w, i2.x, i2.y, i2.z, i2.w, i3.x, i3.y, i3.z, i3.w};
    const unsigned char* ts = tab + (size_t)s * NEXP * 128 + c * 16;
#pragma unroll
    for (int i = 0; i < 16; ++i) B.r[i] = *(const GAS v4u*)(ts + (size_t)e[i] * 128);
    if (WITH_H) { const bf16* hp = H2 + (size_t)(tbase + tt) * 1024 + s * 128 + c * 16; B.h0 = *(const GAS v4u*)hp; B.h1 = *(const GAS v4u*)(hp + 8); }
}
__device__ __forceinline__ void peer_u_compute(const GBuf& B, LAS float* wl, int it, int g, int c) {
    const int tt = it & 15;
    const unsigned hw[8] = {B.h0.x, B.h0.y, B.h0.z, B.h0.w, B.h1.x, B.h1.y, B.h1.z, B.h1.w};
    float d[16];
#pragma unroll
    for (int i = 0; i < 16; ++i) {
        const unsigned uw[4] = {B.r[i].x, B.r[i].y, B.r[i].z, B.r[i].w};
        float a0 = 0.f, a1 = 0.f;
#pragma unroll
        for (int j = 0; j < 4; ++j) {
            a0 = __builtin_amdgcn_fdot2_f32_bf16(__builtin_amdgcn_cvt_scalef32_pk_bf16_fp8(uw[j], 1.0f, false), __builtin_bit_cast(bf16x2v, hw[2 * j]), a0, false);
            a1 = __builtin_amdgcn_fdot2_f32_bf16(__builtin_amdgcn_cvt_scalef32_pk_bf16_fp8(uw[j], 1.0f, true), __builtin_bit_cast(bf16x2v, hw[2 * j + 1]), a1, false); }
        d[i] = a0 + a1;
    }
    const bool u4 = (c & 4) != 0, u2 = (c & 2) != 0, u1 = (c & 1) != 0;
    float r8[8], r4[4], r2[2];
#pragma unroll
    for (int j = 0; j < 8; ++j) { const float keep = u4 ? d[8 + j] : d[j], send = u4 ? d[j] : d[8 + j]; r8[j] = keep + __shfl_xor(send, 4); }
#pragma unroll
    for (int j = 0; j < 4; ++j) { const float keep = u2 ? r8[4 + j] : r8[j], send = u2 ? r8[j] : r8[4 + j]; r4[j] = keep + __shfl_xor(send, 2); }
#pragma unroll
    for (int j = 0; j < 2; ++j) { const float keep = u1 ? r4[2 + j] : r4[j], send = u1 ? r4[j] : r4[2 + j]; r2[j] = keep + __shfl_xor(send, 1); }
    LAS f32x2v* wp = (LAS f32x2v*)(wl + tt * 128 + g * 16 + 2 * c);
    f32x2v cur = *wp; cur.x += r2[0]; cur.y += r2[1]; *wp = cur;
}
__device__ __forceinline__ void peer_v_compute(const GBuf& B, const LAS float* wl, float* out, const float* modp, const float* xin, const bf16* delta, int tbase, int it, int g, int c) {
    const int s = it >> 4, tt = it & 15, t = tbase + tt;
    const LAS f32x4* wp = (const LAS f32x4*)(wl + tt * 128 + g * 16);
    const f32x4 w0 = wp[0], w1 = wp[1], w2 = wp[2], w3 = wp[3];
    const float w[16] = {w0.x, w0.y, w0.z, w0.w, w1.x, w1.y, w1.z, w1.w, w2.x, w2.y, w2.z, w2.w, w3.x, w3.y, w3.z, w3.w};
    f32x2v o2[8];
#pragma unroll
    for (int j = 0; j < 8; ++j) o2[j] = (f32x2v){0.f, 0.f};
#pragma unroll
    for (int i = 0; i < 16; ++i) {
        const unsigned vw[4] = {B.r[i].x, B.r[i].y, B.r[i].z, B.r[i].w}; const f32x2v ww = (f32x2v){w[i], w[i]};
#pragma unroll
        for (int j = 0; j < 4; ++j) {
            o2[2 * j] = __builtin_elementwise_fma(__builtin_amdgcn_cvt_pk_f32_fp8((int)vw[j], false), ww, o2[2 * j]);
            o2[2 * j + 1] = __builtin_elementwise_fma(__builtin_amdgcn_cvt_pk_f32_fp8((int)vw[j], true), ww, o2[2 * j + 1]); }
    }
    float o[16];
#pragma unroll
    for (int j = 0; j < 8; ++j) { o[2 * j] = o2[j].x; o[2 * j + 1] = o2[j].y; }
    const bool u4 = (g & 4) != 0, u2 = (g & 2) != 0, u1 = (g & 1) != 0;
    float r8[8], r4[4], r2[2];
#pragma unroll
    for (int j = 0; j < 8; ++j) { const float keep = u4 ? o[8 + j] : o[j], send = u4 ? o[j] : o[8 + j]; r8[j] = keep + __shfl_xor(send, 32); }
#pragma unroll
    for (int j = 0; j < 4; ++j) { const float keep = u2 ? r8[4 + j] : r8[j], send = u2 ? r8[j] : r8[4 + j]; r4[j] = keep + __shfl_xor(send, 16); }
#pragma unroll
    for (int j = 0; j < 2; ++j) { const float keep = u1 ? r4[2 + j] : r4[j], send = u1 ? r4[j] : r4[2 + j]; r2[j] = keep + __shfl_xor(send, 8); }
    const int b = t >> 12; const int col = s * 128 + c * 16 + 2 * g;
    GAS f32x2v* op = (GAS f32x2v*)(out + (size_t)t * 1024 + col); const f32x2v gv = *(const GAS f32x2v*)(modp + (size_t)b * 6144 + 5120 + col);
    f32x2v xv = *(const GAS f32x2v*)(xin + (size_t)t * 1024 + col); const unsigned dl = *(const GAS unsigned*)(delta + (size_t)t * 1024 + col);
    xv.x += bflo(dl) + gv.x * r2[0]; xv.y += bfhi(dl) + gv.y * r2[1]; *op = xv;
}
__device__ __forceinline__ void p12_gather(Frame& F, const Args& a) {
    const int l = F.lane, g = l >> 3, c = l & 7;
    const bf16* H2 = (const bf16*)(a.ws + WS_R1); const int* IDX = (const int*)(a.ws + WS_IDX); const float* GATE = (const float*)(a.ws + WS_GATE);
    const unsigned char* EU = (const unsigned char*)(a.ws + WS_EU); const unsigned char* EV = (const unsigned char*)(a.ws + WS_EV);
    const float* SU = (const float*)(a.ws + WS_ESC); const float* SV = SU + NEXP;
    const float* modp = (const float*)(a.ws + WS_MOD); float* out = a.out; const float* xin = (const float*)a.in[0]; const bf16* delta = (const bf16*)(a.ws + WS_DELTA);
    LAS float* wl = (LAS float*)(F.lds + F.wave * 8192);
    LAS int* il = (LAS int*)(F.lds + 65536 + F.wave * 8192);
    for (int tbase = (F.vcu * NWAVES + F.wave) * 16; tbase < T; tbase += F.G * NWAVES * 16) {
#pragma unroll
        for (int tt = 0; tt < 16; ++tt) { il[tt * 128 + l] = IDX[((size_t)(l >> 4) * T + tbase + tt) * 16 + (l & 15)]; il[tt * 128 + 64 + l] = IDX[((size_t)(4 + (l >> 4)) * T + tbase + tt) * 16 + (l & 15)];
            wl[tt * 128 + l] = 0.f; wl[tt * 128 + 64 + l] = 0.f; }
        {   GBuf b0, b1;
            peer_issue<true>(b0, EU, H2, il, tbase, 0, g, c);
            for (int it = 0; it < 128; it += 2) {
                peer_issue<true>(b1, EU, H2, il, tbase, it + 1, g, c);
                peer_u_compute(b0, wl, it, g, c);
                if (it + 2 < 128) peer_issue<true>(b0, EU, H2, il, tbase, it + 2, g, c);
                peer_u_compute(b1, wl, it + 1, g, c);
            }
        }
#pragma unroll 4
        for (int tt = 0; tt < 16; ++tt) { const int t = tbase + tt;
#pragma unroll
            for (int j = 0; j < 2; ++j) { const int k = 2 * c + j; const int e = il[tt * 128 + g * 16 + k];
                wl[tt * 128 + g * 16 + k] = GATE[((size_t)g * T + t) * 16 + k] * gelu_erf(wl[tt * 128 + g * 16 + k] * SU[e]) * SV[e]; } }
        {   GBuf b0, b1;
            peer_issue<false>(b0, EV, H2, il, tbase, 0, g, c);
            for (int it = 0; it < 128; it += 2) {
                peer_issue<false>(b1, EV, H2, il, tbase, it + 1, g, c);
                peer_v_compute(b0, wl, out, modp, xin, delta, tbase, it, g, c);
                if (it + 2 < 128) peer_issue<false>(b0, EV, H2, il, tbase, it + 2, g, c);
                peer_v_compute(b1, wl, out, modp, xin, delta, tbase, it + 1, g, c);
            }
        }
    }
}


__global__ void __launch_bounds__(NWAVES * 64, 2) fwd_kernel(Args args) {
    extern __shared__ __attribute__((aligned(16))) unsigned char lds[];
    Frame F;
    F.lds = (LAS unsigned char*)lds;
    F.MISC = (volatile LAS unsigned*)(F.lds + MISC_OFF);
    F.tid = threadIdx.x; F.lane = F.tid & 63; F.wave = __builtin_amdgcn_readfirstlane(F.tid >> 6);
    F.G = gridDim.x; { const int bx = blockIdx.x; F.vcu = (F.G % 8 == 0) ? (bx % 8) * (F.G / 8) + bx / 8 : bx; }
    unsigned char* ws = args.ws;
    F.ctl = (gu32*)(ws + WS_CTL);
    for (int u = F.tid; u < (LDS_BYTES - LDSCTL_OFF) / 4; u += NWAVES * 64) ((LAS unsigned*)(F.lds + LDSCTL_OFF))[u] = 0u;
    __syncthreads();
    const int lo = args.ph_lo, hi = args.ph_hi;
    const bool fused = (hi - lo) > 1;
    XcdBarrier bar; bar.bar = (unsigned*)(F.ctl + CW_BAR) + args.bar_region * XCD_BAR_WORDS; bar.x = 0; bar.st = nullptr;
    if (fused) bar = xcd_barrier_post((unsigned*)(F.ctl + CW_BAR) + args.bar_region * XCD_BAR_WORDS, F.MISC + 8);
#ifndef PHASE_MASK
#define PHASE_MASK 0xFFFF
#endif
#define IN(k) (((PHASE_MASK >> (k)) & 1) && lo <= (k) && (k) < hi)
#ifdef PROBE_BAR2
#define SEAM(k) do { if (IN(k) && IN((k) + 1)) { xcd_barrier(bar); xcd_barrier(bar); } } while (0)
#else
#define SEAM(k) do { if (IN(k) && IN((k) + 1)) xcd_barrier(bar); } while (0)
#endif
#ifdef PROBE_DOUBLE
    int two_ = 2; asm volatile("" : "+s"(two_));
#define REP(k) for (int rep_ = 0; rep_ < ((k) == PROBE_DOUBLE ? two_ : 1); ++rep_, ((k) == PROBE_DOUBLE && rep_ == 1 && fused ? xcd_barrier(bar) : (void)0))
#else
#define REP(k)
#endif

    bf16* XN = (bf16*)(ws + WS_R1);
    float* modp = (float*)(ws + WS_MOD);

    REP(0) if (IN(0)) { p0_prologue(F, args); } SEAM(0);
    REP(1) if (IN(1)) {
        norm_mod_rows<true>(F, (const float*)args.in[0], (const float*)args.in[5], modp, 0, 1024, XN, (const int*)args.in[2], (float*)(ws + WS_CS), (float*)(ws + WS_SA));
        {
            LAS float* scr = (LAS float*)(F.lds + RING_OFF + F.wave * 16384);
            for (int it = F.vcu * NWAVES + F.wave; it < (D / 64) * (IN_W / 32); it += F.G * NWAVES)
                win_fp8_item((const float*)args.in[6], (const unsigned*)(ws + WS_CTL) + CW_AMAX, (unsigned char*)(ws + WS_WIN), (float*)(ws + WS_SW), scr, it, F.lane); }
    } SEAM(1);
    REP(2) if (IN(2)) {
#if defined(P2_STAGGER)
        {
            const unsigned long long t0_ = __builtin_amdgcn_s_memrealtime(); const unsigned long long wait_ = (unsigned long long)((F.vcu & 3) * P2_STAGGER) * 100ull;
            while (__builtin_amdgcn_s_memrealtime() - t0_ < wait_) __builtin_amdgcn_s_sleep(32);
        }
#endif
        int kdim = D / 2; asm volatile("" : "+s"(kdim));
        pg8::Gemm g{XN, (const bf16*)(ws + WS_WIN), T, IN_W, kdim}; pg8::StaticOrder S; S.init(T, IN_W, F.G, (int)blockIdx.x);
        pg8::EpiInProj E{(bf16*)(ws + WS_QA), (bf16*)(ws + WS_KA), (bf16*)(ws + WS_VA), (bf16*)(ws + WS_QB), (bf16*)(ws + WS_KB), (bf16*)(ws + WS_VB), (bf16*)args.out, (const float*)args.in[7],
                          (const float*)args.in[8], (const float*)args.in[9], (const float*)args.in[11], (const float*)args.in[12], (const float*)(ws + WS_CS), QSCALE, (const float*)(ws + WS_SA), (const float*)(ws + WS_SW)};
        pg8::gemm_phase<pg8::EpiInProj, pg8::StaticOrder, true, true, true>(F.lds + RING_OFF, g, S, E
#ifdef PROBE_GSTAMP
            , modp + MOD_LAM + 24
#endif
            );
    } SEAM(2);
    REP(4) if (IN(4)) {
        p3_vt8(F, args); __syncthreads();
        attn_body::dil_phase((char*)lds + RING_OFF, (const attn_body::bf16*)(ws + WS_QA), (const attn_body::bf16*)(ws + WS_KA), (const attn_body::bf16*)(ws + WS_VA),
                             (attn_body::bf16*)(ws + WS_OUTG), (float*)(ws + WS_LSE), F.vcu, F.G);
    } SEAM(4);
    REP(5) if (IN(5)) {
        p6_combine(F, args);
        const attn_body::DiffFusedOrder S((int)F.G, (int)blockIdx.x);
        float pscale;
        { const float gq = fabsf(((const float*)args.in[11])[F.lane]), gk = fabsf(((const float*)args.in[12])[F.lane]);
          float mq = gq, mk = gk;
#pragma unroll
          for (int o = 1; o < 64; o <<= 1) { mq = fmaxf(mq, __shfl_xor(mq, o)); mk = fmaxf(mk, __shfl_xor(mk, o)); }
          const float smax = 64.0f * QSCALE * mq * mk * 1.02f;
          pscale = exp2f(fmaxf(0.0f, ceilf(smax - 8.5f))); }
#if QK_FP8
        attn_body::diff128q8_phase((char*)lds + RING_OFF, (const unsigned char*)(ws + WS_QB), (const unsigned char*)(ws + WS_KB), (const unsigned char*)(ws + WS_VT8),
                                   (attn_body::bf16*)(ws + WS_O1), (attn_body::bf16*)(ws + WS_OB), pscale, modp[MOD_LAM], (const float*)args.in[17], S);
#else
        attn_body::diff128f8_phase((char*)lds + RING_OFF, (const attn_body::bf16*)(ws + WS_QB), (const attn_body::bf16*)(ws + WS_KB), (const unsigned char*)(ws + WS_VT8),
                                   (attn_body::bf16*)(ws + WS_O1), (attn_body::bf16*)(ws + WS_OB), pscale, modp[MOD_LAM], (const float*)args.in[17], S
#ifdef PROBE_STAMP
                                   , modp + MOD_LAM + 16
#endif
                                   );
#endif
    } SEAM(5);
    REP(7) if (IN(7)) {
#ifdef PROBE7
        if (!(args.pad & 1))
#endif
        { int kdim = DIL_OUT; asm volatile("" : "+s"(kdim));
          pg8::Gemm g{(const bf16*)(ws + WS_OA), (const bf16*)(ws + WS_WPA), T, D, kdim}; pg8::StaticOrder S; S.init(T, D, F.G, (int)blockIdx.x);
          pg8::EpiBf16 E{(bf16*)(ws + WS_TMP), D};
          pg8::gemm_phase<pg8::EpiBf16, pg8::StaticOrder, true, true>(F.lds + RING_OFF, g, S, E); }
#ifdef PROBE7
        if (!(args.pad & 2))
#endif
        { pg8::Gemm g{(const bf16*)(ws + WS_OB), (const bf16*)(ws + WS_WPB), T, D, D}; pg8::StaticOrder S; S.init(T, D, F.G, (int)blockIdx.x);
          pg8::EpiBranchB E{(const bf16*)(ws + WS_TMP), (const unsigned char*)args.out, (bf16*)(ws + WS_MIX)};
          pg8::gemm_phase<pg8::EpiBranchB, pg8::StaticOrder, true, true>(F.lds + RING_OFF, g, S, E); }
    } SEAM(7);
    REP(8) if (IN(8)) {
        pg8::Gemm g{(const bf16*)(ws + WS_MIX), (const bf16*)(ws + WS_WOUT), T, D, D}; pg8::StaticOrder S; S.init(T, D, F.G, (int)blockIdx.x);
        pg8::EpiOut E{modp, (bf16*)(ws + WS_DELTA)};
        pg8::gemm_phase<pg8::EpiOut, pg8::StaticOrder, true, true>(F.lds + RING_OFF, g, S, E);
    } SEAM(8);
    REP(9) if (IN(9)) {
        norm_mod_rows<false>(F, (const float*)args.in[0], (const float*)args.in[20], modp, 3072, 4096, XN, nullptr, nullptr, nullptr, (const bf16*)(ws + WS_DELTA));
        convert_fp8_slices(F, (const float*)args.in[23], (unsigned char*)(ws + WS_EU), (float*)(ws + WS_ESC));
        convert_fp8_slices(F, (const float*)args.in[24], (unsigned char*)(ws + WS_EV), (float*)(ws + WS_ESC) + NEXP);
    } SEAM(9);
    REP(10) if (IN(10)) {
        pg8::Gemm g{XN, (const bf16*)(ws + WS_WQ), T, PEER_QW, D}; pg8::StaticOrder S; S.init(T, PEER_QW, F.G, (int)blockIdx.x);
        pg8::EpiQF E{(bf16*)(ws + WS_QP)};
        pg8::gemm_phase<pg8::EpiQF, pg8::StaticOrder, true, true>(F.lds + RING_OFF, g, S, E);
    } SEAM(10);
    REP(11) if (IN(11)) { p11_peer_topk(F, args); } SEAM(11);
    REP(12) if (IN(12)) { p12_gather(F, args); }
#ifdef PROBE_GSTAMP
    if (fused) { xcd_barrier(bar);
        if (blockIdx.x == 0 && F.tid == 0) { const float e_ = modp[MOD_LAM + 24], u_ = modp[MOD_LAM + 25];
            args.out[0] = (PROBE_GSTAMP == 0) ? 10.0f + 89.0f * e_ / u_ : 10.0f + u_ * (1.0f / (15.0f * 1000.0f)); } }
#endif
#ifdef PROBE_STAMP
    if (fused) { xcd_barrier(bar);
        if (blockIdx.x == 0 && F.tid == 0) { const float a_ = modp[MOD_LAM + 16], b_ = modp[MOD_LAM + 17], w_ = (PROBE_STAMP == 4) ? modp[MOD_LAM + 19] : modp[MOD_LAM + 18]; const float tot = a_ + b_ + modp[MOD_LAM + 18] + modp[MOD_LAM + 19];
            const float v = (PROBE_STAMP == 0) ? a_ / tot : (PROBE_STAMP == 1) ? b_ / tot : (PROBE_STAMP == 2 || PROBE_STAMP == 4) ? w_ / tot : tot * (1.0f / (4.0f * 60.0f * 100.0f));
            args.out[0] = 10.0f + 89.0f * (PROBE_STAMP != 3 ? v : 0.f) + (PROBE_STAMP == 3 ? v : 0.f); } }
#endif
#undef IN
#undef SEAM
}

extern "C" void kernel_launch(void* const* d_in, const int* in_sizes, int n_in, void* d_out, int out_size, void* d_ws, size_t ws_size, hipStream_t stream) {
    static int grid = 0;
    if (grid == 0) {
        if (n_in != 25 || in_sizes[0] != T * D || out_size != T * D || ws_size < WS_END) {
            fprintf(stderr, "kernel_launch: built for 25 inputs, x and out of %d floats, >= %zu bytes of workspace; got n_in %d, in0 %d, out %d, ws %zu; nothing launched\n", T * D, (size_t)WS_END, n_in, n_in > 0 ? in_sizes[0] : -1, out_size, ws_size); grid = -1; return; }
        int dev = 0, cus = 0, per_cu = 0;
        if (hipGetDevice(&dev) != hipSuccess || hipDeviceGetAttribute(&cus, hipDeviceAttributeMultiprocessorCount, dev) != hipSuccess) { fprintf(stderr, "kernel_launch: hipGetDevice / hipDeviceGetAttribute failed\n"); grid = -1; return; }
        if (hipFuncSetAttribute((const void*)fwd_kernel, hipFuncAttributeMaxDynamicSharedMemorySize, LDS_BYTES) != hipSuccess) { fprintf(stderr, "kernel_launch: hipFuncSetAttribute failed\n"); grid = -1; return; }
        if (hipOccupancyMaxActiveBlocksPerMultiprocessor(&per_cu, (const void*)fwd_kernel, NWAVES * 64, LDS_BYTES) != hipSuccess || per_cu < 1)
            fprintf(stderr, "kernel_launch: note: occupancy query reports %d workgroups per CU\n", per_cu);
        (void)hipGetLastError();
        grid = cus;
    }
    if (grid < 0) return;
    if (hipMemsetAsync((char*)d_ws + WS_CTL, 0, CTL_ZERO_BYTES, stream) != hipSuccess) { fprintf(stderr, "kernel_launch: hipMemsetAsync failed\n"); return; }
    Args a{};
    for (int i = 0; i < 25; ++i) a.in[i] = d_in[i];
    a.out = (float*)d_out; a.ws = (unsigned char*)d_ws;
#if defined(PROBE_RELAUNCH)
    a.ph_lo = 0; a.ph_hi = PROBE_RELAUNCH + 1; hipLaunchKernelGGL(fwd_kernel, dim3(grid), dim3(NWAVES * 64), LDS_BYTES, stream, a);
    a.bar_region = 1; a.ph_lo = PROBE_RELAUNCH; a.ph_hi = PROBE_RELAUNCH + 1;
#ifdef PROBE11
    a.pad = PROBE11;
#endif
#ifdef PROBE7
    a.pad = PROBE7;
#endif
    hipLaunchKernelGGL(fwd_kernel, dim3(grid), dim3(NWAVES * 64), LDS_BYTES, stream, a);
    a.pad = 0;
    if (PROBE_RELAUNCH + 1 < N_PHASES) { a.bar_region = 2; a.ph_lo = PROBE_RELAUNCH + 1; a.ph_hi = N_PHASES; hipLaunchKernelGGL(fwd_kernel, dim3(grid), dim3(NWAVES * 64), LDS_BYTES, stream, a); }
#elif MK_N_LAUNCHES == 1
    a.ph_lo = 0; a.ph_hi = N_PHASES;
    hipLaunchKernelGGL(fwd_kernel, dim3(grid), dim3(NWAVES * 64), LDS_BYTES, stream, a);
#else
    for (int p = 0; p < N_PHASES; ++p) { a.ph_lo = p; a.ph_hi = p + 1;
        hipLaunchKernelGGL(fwd_kernel, dim3(grid), dim3(NWAVES * 64), LDS_BYTES, stream, a); }
#endif
    const hipError_t le = hipPeekAtLastError();
    if (le != hipSuccess) fprintf(stderr, "kernel_launch: launch failed: %s\n", hipGetErrorName(le));
}
```

```cpp
#include <hip/hip_runtime.h>
#include <hip/hip_bf16.h>
#include <cstdio>
#include <cstdint>
#include <cmath>

#ifndef MK_N_LAUNCHES
#define MK_N_LAUNCHES 1
#endif

constexpr int BATCH = 8, SEQ = 4096, D = 1024, T = BATCH * SEQ;
constexpr int DIL_W = 768, DIL_HEADS = 12, DIL_OUT = 256;
constexpr int DIFF_W = 1024, DIFF_HEADS = 8;
constexpr int IN_W = 7424, GATE_W = 2048;
constexpr int PEER_H = 8, PEER_NK = 128, PEER_QW = 2048, NEXP = 16384;
constexpr float EPS = 1e-6f;
constexpr float LAM_INIT = 0.2f;
constexpr float QSCALE = 0.125f * 1.4426950408889634f;

namespace pg8 {
#define PG8_LAS __attribute__((address_space(3)))
typedef unsigned short bf16_t;
typedef short bf16x8 __attribute__((ext_vector_type(8)));
typedef float f32x4 __attribute__((ext_vector_type(4)));
typedef unsigned u32x4 __attribute__((ext_vector_type(4)));
typedef int v4i32_t __attribute__((ext_vector_type(4)));
typedef int v8i32_t __attribute__((ext_vector_type(8)));
constexpr int BM = 256, BK = 64, HALF = 128, HTB = HALF * BK * 2  , STAGE_BYTES = 8 * HTB, NXCD = 8, WGM = 8;

__host__ __device__ __forceinline__ int lds_byte(int r, int c) { const int st = (r >> 4) * 2 + (c >> 5), rr = r & 15, cc = c & 31, ob = rr * 64 + cc * 2; return st * 1024 + (ob ^ (((ob >> 9) & 1) << 5)); }
__host__ __device__ __forceinline__ void stage_rc(int b, int& R, int& C) { const int st = b / 1024, sb = b % 1024, swz = sb ^ (((sb >> 9) & 1) << 5); R = (st >> 1) * 16 + swz / 64; C = (st & 1) * 32 + (swz % 64) / 2; }
__host__ __device__ __forceinline__ int perm32(int rho) { const int n = rho >> 4, i = rho & 15; return 8 * (i >> 2) + 4 * n + (i & 3); }

struct Unit { int pm, pn; };
struct Gemm { const bf16_t* A; const bf16_t* Bt; int M, N, K; };

struct StaticOrder {
    int nM, nN, nwg, G, c;
    __host__ __device__ void init(int M, int N, int G_, int c_) { nM = M / BM; nN = N / BM; nwg = nM * nN; G = G_; c = c_; }
    __host__ __device__ bool next(int i, Unit& u) const {
        const long L = (long)i * G + c; if (L >= nwg) return false;
        int wgid = (int)L; { const int q = nwg / NXCD, r = nwg % NXCD, xcd = wgid % NXCD, off = wgid / NXCD; wgid = (xcd < r ? xcd * (q + 1) : r * (q + 1) + (xcd - r) * q) + off; }
        const int nig = WGM * nN, gid = wgid / nig, fm = gid * WGM, gsz = (nM - fm) < WGM ? (nM - fm) : WGM;
        u.pm = fm + ((wgid % nig) % gsz); u.pn = (wgid % nig) / gsz; return true;
    }
    __device__ __forceinline__ void a_ready(const Unit&) const {}
    __device__ __forceinline__ void done(const Unit&) const {}
};

__device__ __forceinline__ unsigned cvt_pk_bf16(float lo, float hi) { unsigned r; asm volatile("v_cvt_pk_bf16_f32 %0, %1, %2" : "=v"(r) : "v"(lo), "v"(hi)); return r; }
typedef float f32x2 __attribute__((ext_vector_type(2)));
typedef unsigned u32x2 __attribute__((ext_vector_type(2)));
#ifndef QK_FP8
#define QK_FP8 1
#endif
#ifndef G_U8
#define G_U8 1
#endif
__device__ __forceinline__ float bf_lo(unsigned w) { return __uint_as_float(w << 16); }
__device__ __forceinline__ float bf_hi(unsigned w) { return __uint_as_float(w & 0xffff0000u); }

struct EpiBf16 {
    static constexpr bool PERM = true, AFTER_DRAIN = false;
    bf16_t* O; int ldc;
    __device__ __forceinline__ void operator()(const f32x4 (&acc)[2][2][4][2], const Unit& u, int wr, int wc, int fr, int fq) const {
        const int row0 = u.pm * BM + wr * 64 + fr; const int col0 = u.pn * BM + wc * 32 + 8 * fq;
#pragma unroll
        for (int ai = 0; ai < 2; ++ai)
#pragma unroll
            for (int m = 0; m < 4; ++m) { bf16_t* rowp = O + (size_t)(row0 + ai * HALF + m * 16) * ldc + col0;
#pragma unroll
                for (int bj = 0; bj < 2; ++bj) { const f32x4 v0 = acc[ai][bj][m][0], v1 = acc[ai][bj][m][1];
                    u32x4 w; w.x = cvt_pk_bf16(v0[0], v0[1]); w.y = cvt_pk_bf16(v0[2], v0[3]); w.z = cvt_pk_bf16(v1[0], v1[1]); w.w = cvt_pk_bf16(v1[2], v1[3]);
                    *(u32x4*)(rowp + bj * HALF) = w; } }
    }
};

struct EpiQF {
    static constexpr bool PERM = true, AFTER_DRAIN = false;
    bf16_t* O;
    __device__ __forceinline__ void operator()(const f32x4 (&acc)[2][2][4][2], const Unit& u, int wr, int wc, int fr, int fq) const {
#pragma unroll
        for (int ai = 0; ai < 2; ++ai)
#pragma unroll
            for (int m = 0; m < 4; ++m) { const int rb = u.pm * 8 + ai * 4 + wr * 2 + (m >> 1), r32 = (m & 1) * 16 + fr;
#pragma unroll
                for (int bj = 0; bj < 2; ++bj) { const f32x4 v0 = acc[ai][bj][m][0], v1 = acc[ai][bj][m][1];
                    u32x4 w; w.x = cvt_pk_bf16(v0[0], v0[1]); w.y = cvt_pk_bf16(v0[2], v0[3]); w.z = cvt_pk_bf16(v1[0], v1[1]); w.w = cvt_pk_bf16(v1[2], v1[3]);
                    const size_t off = ((((size_t)(rb * 8 + u.pn) * 2 + bj) * 8 + 2 * wc + (fq >> 1)) * 64 + (fq & 1) * 32 + r32) * 8;
                    *(u32x4*)(O + off) = w; } }
    }
};

struct EpiInProj {
    static constexpr bool PERM = true, AFTER_DRAIN = false;
    bf16_t *QA, *KA, *VA, *QB, *KB, *VB, *G; const float* b_gate; const float *qn_a, *kn_a, *qn_b, *kn_b; const float* CS; float qscale;
    const float* sA; const float* sW;
    __device__ __forceinline__ void operator()(const f32x4 (&acc)[2][2][4][2], const Unit& u, int wr, int wc, int fr, int fq) const {
        const int pn = u.pn; bf16_t* base; int ldc, colt; int mode = 0; const float* gn = nullptr; float qs = 1.f;
        bool f8 = false;
        if (pn < 3)       { base = QA; ldc = 768;  colt = pn * BM; mode = 2; gn = qn_a; qs = qscale; }
        else if (pn < 6)  { base = KA; ldc = 768;  colt = (pn - 3) * BM; mode = 2; gn = kn_a; }
        else if (pn < 9)  { base = VA; ldc = 768;  colt = (pn - 6) * BM; }
        else if (pn < 13) { base = QB; ldc = 1024; colt = (pn - 9) * BM; mode = 2; gn = qn_b; qs = qscale * (QK_FP8 ? 64.f : 1.f); f8 = QK_FP8; }
        else if (pn < 17) { base = KB; ldc = 1024; colt = (pn - 13) * BM; mode = 2; gn = kn_b; qs = QK_FP8 ? 16.f : 1.f; f8 = QK_FP8; }
        else if (pn < 21) { base = VB; ldc = 1024; colt = (pn - 17) * BM; mode = 3; }
        else              { base = G;  ldc = 2048; colt = (pn - 21) * BM; mode = 1; }
        const int row0 = u.pm * BM + wr * 64 + fr;
        if (mode == 2) {
            const f32x4 g1a = *(const f32x4*)(gn + 8 * fq), g1b = *(const f32x4*)(gn + 8 * fq + 4), g2a = *(const f32x4*)(gn + 32 + 8 * fq), g2b = *(const f32x4*)(gn + 32 + 8 * fq + 4);
            const int col0 = colt + wc * 64 + 8 * fq;
            float rav[2][4];
#pragma unroll
            for (int ai = 0; ai < 2; ++ai)
#pragma unroll
                for (int m = 0; m < 4; ++m) rav[ai][m] = sA[row0 + ai * HALF + m * 16];
            const float* swp = sW + pn * BM + wc * 32 + 8 * fq;
            const f32x4 w1a = *(const f32x4*)swp, w1b = *(const f32x4*)(swp + 4), w2a = *(const f32x4*)(swp + HALF), w2b = *(const f32x4*)(swp + HALF + 4);
#pragma unroll
            for (int ai = 0; ai < 2; ++ai)
#pragma unroll
                for (int m = 0; m < 4; ++m) { const size_t row = (size_t)(row0 + ai * HALF + m * 16);
                    const float ra = rav[ai][m];
                    const f32x4 x1a = acc[ai][0][m][0] * w1a * ra, x1b = acc[ai][0][m][1] * w1b * ra, x2a = acc[ai][1][m][0] * w2a * ra, x2b = acc[ai][1][m][1] * w2b * ra;
                    const float* cp = CS + row * 64 + 8 * fq;
                    const f32x4 ca = *(const f32x4*)cp, cb = *(const f32x4*)(cp + 4), sa = *(const f32x4*)(cp + 32), sb = *(const f32x4*)(cp + 36);
                    float ss = 0.f;
#pragma unroll
                    for (int e = 0; e < 4; ++e) ss += (x1a[e] * x1a[e] + x1b[e] * x1b[e]) + (x2a[e] * x2a[e] + x2b[e] * x2b[e]);
                    ss += __shfl_xor(ss, 16); ss += __shfl_xor(ss, 32);
                    const float rs = qs / sqrtf(ss * (1.f / 64.f) + 1e-6f);
                    const f32x4 y1a = x1a * g1a * rs, y1b = x1b * g1b * rs, y2a = x2a * g2a * rs, y2b = x2b * g2b * rs;
                    const f32x4 o1a = y1a * ca - y2a * sa, o1b = y1b * cb - y2b * sb, o2a = y2a * ca + y1a * sa, o2b = y2b * cb + y1b * sb;
                    if (f8) {
                        int t0 = __builtin_amdgcn_cvt_pk_fp8_f32(o1a[0], o1a[1], 0, false); t0 = __builtin_amdgcn_cvt_pk_fp8_f32(o1a[2], o1a[3], t0, true);
                        int t1 = __builtin_amdgcn_cvt_pk_fp8_f32(o1b[0], o1b[1], 0, false); t1 = __builtin_amdgcn_cvt_pk_fp8_f32(o1b[2], o1b[3], t1, true);
                        int t2 = __builtin_amdgcn_cvt_pk_fp8_f32(o2a[0], o2a[1], 0, false); t2 = __builtin_amdgcn_cvt_pk_fp8_f32(o2a[2], o2a[3], t2, true);
                        int t3 = __builtin_amdgcn_cvt_pk_fp8_f32(o2b[0], o2b[1], 0, false); t3 = __builtin_amdgcn_cvt_pk_fp8_f32(o2b[2], o2b[3], t3, true);
                        unsigned char* rp8 = (unsigned char*)base + row * 1024 + col0;
                        *(u32x2*)rp8 = (u32x2){(unsigned)t0, (unsigned)t1}; *(u32x2*)(rp8 + 32) = (u32x2){(unsigned)t2, (unsigned)t3};
                        if (m == 3) asm volatile("" ::: "memory");
                        continue; }
                    u32x4 w1, w2;
                    w1.x = cvt_pk_bf16(o1a[0], o1a[1]); w1.y = cvt_pk_bf16(o1a[2], o1a[3]); w1.z = cvt_pk_bf16(o1b[0], o1b[1]); w1.w = cvt_pk_bf16(o1b[2], o1b[3]);
                    w2.x = cvt_pk_bf16(o2a[0], o2a[1]); w2.y = cvt_pk_bf16(o2a[2], o2a[3]); w2.z = cvt_pk_bf16(o2b[0], o2b[1]); w2.w = cvt_pk_bf16(o2b[2], o2b[3]);
                    bf16_t* rowp = base + row * ldc + col0;
                    *(u32x4*)rowp = w1; *(u32x4*)(rowp + 32) = w2;
                    if (m == 3) asm volatile("" ::: "memory"); }
            return;
        }
        const bool gate = mode == 1;
        const int col0 = colt + wc * 32 + 8 * fq;
        f32x4 bv[2][2], sw[2][2];
#pragma unroll
        for (int bj = 0; bj < 2; ++bj)
#pragma unroll
            for (int n = 0; n < 2; ++n) { bv[bj][n] = gate ? *(const f32x4*)(b_gate + col0 + bj * HALF + 4 * n) : (f32x4){0.f, 0.f, 0.f, 0.f}; sw[bj][n] = *(const f32x4*)(sW + pn * BM + wc * 32 + 8 * fq + bj * HALF + 4 * n); }
#pragma unroll
        for (int ai = 0; ai < 2; ++ai)
#pragma unroll
            for (int m = 0; m < 4; ++m) { bf16_t* rowp = base + (size_t)(row0 + ai * HALF + m * 16) * ldc + col0; const float ra = sA[row0 + ai * HALF + m * 16];
#pragma unroll
                for (int bj = 0; bj < 2; ++bj) { f32x4 v0 = acc[ai][bj][m][0] * sw[bj][0] * ra, v1 = acc[ai][bj][m][1] * sw[bj][1] * ra;
                    if (gate) {
                        v0 = v0 + bv[bj][0]; v1 = v1 + bv[bj][1];
#pragma unroll
                        for (int e = 0; e < 4; ++e) { v0[e] = 1.0f / (1.0f + __expf(-v0[e])); v1[e] = 1.0f / (1.0f + __expf(-v1[e])); }
                    }
                    if (mode == 3) {
#define V8C(x) __builtin_amdgcn_fmed3f((x) * 8.f, -448.f, 448.f)
                        int t0 = __builtin_amdgcn_cvt_pk_fp8_f32(V8C(v0[0]), V8C(v0[1]), 0, false); t0 = __builtin_amdgcn_cvt_pk_fp8_f32(V8C(v0[2]), V8C(v0[3]), t0, true);
                        int t1 = __builtin_amdgcn_cvt_pk_fp8_f32(V8C(v1[0]), V8C(v1[1]), 0, false); t1 = __builtin_amdgcn_cvt_pk_fp8_f32(V8C(v1[2]), V8C(v1[3]), t1, true);
#undef V8C
                        *(u32x2*)((unsigned char*)base + (size_t)(row0 + ai * HALF + m * 16) * 1024 + col0 + bj * HALF) = (u32x2){(unsigned)t0, (unsigned)t1};
                    } else if (G_U8 && gate) {
                        unsigned t0 = 0, t1 = 0;
#pragma unroll
                        for (int e = 0; e < 4; ++e) { t0 = __builtin_amdgcn_cvt_pk_u8_f32(__builtin_rintf(v0[e] * 255.f), e, t0); t1 = __builtin_amdgcn_cvt_pk_u8_f32(__builtin_rintf(v1[e] * 255.f), e, t1); }
                        *(u32x2*)((unsigned char*)base + (size_t)(row0 + ai * HALF + m * 16) * 2048 + col0 + bj * HALF) = (u32x2){(unsigned)t0, (unsigned)t1};
                    } else {
                    u32x4 w; w.x = cvt_pk_bf16(v0[0], v0[1]); w.y = cvt_pk_bf16(v0[2], v0[3]); w.z = cvt_pk_bf16(v1[0], v1[1]); w.w = cvt_pk_bf16(v1[2], v1[3]);
                    *(u32x4*)(rowp + bj * HALF) = w; } } }
    }
};

struct EpiBranchB {
    static constexpr bool PERM = true, AFTER_DRAIN = false;
    const bf16_t* ta; const unsigned char* G; bf16_t* mixed;
    __device__ __forceinline__ void operator()(const f32x4 (&acc)[2][2][4][2], const Unit& u, int wr, int wc, int fr, int fq) const {
        const int row0 = u.pm * BM + wr * 64 + fr; const int col0 = u.pn * BM + wc * 32 + 8 * fq;
#pragma unroll
        for (int ai = 0; ai < 2; ++ai)
#pragma unroll
            for (int m = 0; m < 4; ++m) { const size_t row = (size_t)(row0 + ai * HALF + m * 16);
                const bf16_t* tp = ta + row * 1024 + col0; bf16_t* mp = mixed + row * 1024 + col0;
#pragma unroll
                for (int bj = 0; bj < 2; ++bj) { const int c = bj * HALF;
                    const u32x4 t = *(const u32x4*)(tp + c); const f32x4 a0 = acc[ai][bj][m][0], a1 = acc[ai][bj][m][1];
                    float g0[8], g1[8];
                    if (G_U8) { const unsigned char* gp = G + row * 2048 + col0 + c; const u32x2 q0 = *(const u32x2*)gp, q1 = *(const u32x2*)(gp + 1024);
#pragma unroll
                        for (int e = 0; e < 4; ++e) { g0[e] = (float)((q0.x >> (8 * e)) & 255u) * (1.f / 255.f); g0[4 + e] = (float)((q0.y >> (8 * e)) & 255u) * (1.f / 255.f);
                                                      g1[e] = (float)((q1.x >> (8 * e)) & 255u) * (1.f / 255.f); g1[4 + e] = (float)((q1.y >> (8 * e)) & 255u) * (1.f / 255.f); } }
                    else { const bf16_t* gp = (const bf16_t*)G + row * 2048 + col0 + c; const u32x4 q0 = *(const u32x4*)gp, q1 = *(const u32x4*)(gp + 1024);
                        g0[0] = bf_lo(q0.x); g0[1] = bf_hi(q0.x); g0[2] = bf_lo(q0.y); g0[3] = bf_hi(q0.y); g0[4] = bf_lo(q0.z); g0[5] = bf_hi(q0.z); g0[6] = bf_lo(q0.w); g0[7] = bf_hi(q0.w);
                        g1[0] = bf_lo(q1.x); g1[1] = bf_hi(q1.x); g1[2] = bf_lo(q1.y); g1[3] = bf_hi(q1.y); g1[4] = bf_lo(q1.z); g1[5] = bf_hi(q1.z); g1[6] = bf_lo(q1.w); g1[7] = bf_hi(q1.w); }
                    u32x4 w;
                    w.x = cvt_pk_bf16(bf_lo(t.x) * g0[0] + a0[0] * g1[0], bf_hi(t.x) * g0[1] + a0[1] * g1[1]);
                    w.y = cvt_pk_bf16(bf_lo(t.y) * g0[2] + a0[2] * g1[2], bf_hi(t.y) * g0[3] + a0[3] * g1[3]);
                    w.z = cvt_pk_bf16(bf_lo(t.z) * g0[4] + a1[0] * g1[4], bf_hi(t.z) * g0[5] + a1[1] * g1[5]);
                    w.w = cvt_pk_bf16(bf_lo(t.w) * g0[6] + a1[2] * g1[6], bf_hi(t.w) * g0[7] + a1[3] * g1[7]);
                    *(u32x4*)(mp + c) = w; }
                asm volatile("" ::: "memory"); }
    }
};
struct EpiOut {
    static constexpr bool PERM = true, AFTER_DRAIN = false;
    const float* mod; bf16_t* delta;
    __device__ __forceinline__ void operator()(const f32x4 (&acc)[2][2][4][2], const Unit& u, int wr, int wc, int fr, int fq) const {
        const int row0 = u.pm * BM + wr * 64 + fr; const int col0 = u.pn * BM + wc * 32 + 8 * fq;
        const int b = (u.pm * BM) >> 12;
        f32x4 gv[2][2];
#pragma unroll
        for (int bj = 0; bj < 2; ++bj)
#pragma unroll
            for (int n = 0; n < 2; ++n) gv[bj][n] = *(const f32x4*)(mod + (size_t)b * 6144 + 2048 + col0 + bj * HALF + 4 * n);
#pragma unroll
        for (int ai = 0; ai < 2; ++ai)
#pragma unroll
            for (int m = 0; m < 4; ++m) { bf16_t* rowp = delta + (size_t)(row0 + ai * HALF + m * 16) * 1024 + col0;
#pragma unroll
                for (int bj = 0; bj < 2; ++bj) { const f32x4 v0 = gv[bj][0] * acc[ai][bj][m][0], v1 = gv[bj][1] * acc[ai][bj][m][1];
                    u32x4 w; w.x = cvt_pk_bf16(v0[0], v0[1]); w.y = cvt_pk_bf16(v0[2], v0[3]); w.z = cvt_pk_bf16(v1[0], v1[1]); w.w = cvt_pk_bf16(v1[2], v1[3]);
                    *(u32x4*)(rowp + bj * HALF) = w; } }
    }
};


template <class Epi, class Sched, bool ALIGN_EPI = false, bool SP2 = false, bool FP8 = false>
__device__ __forceinline__ void gemm_phase(PG8_LAS unsigned char* lds, const Gemm g, const Sched& S, const Epi& E, float* gstamp = nullptr) {
    const int tid = threadIdx.x, wid = __builtin_amdgcn_readfirstlane(tid >> 6), lane = tid & 63, wr = wid >> 2, wc = wid & 3, fr = lane & 15, fq = lane >> 4;
    const int K = g.K, nt = K / BK;
    unsigned voffA[2], voffB[2];
#pragma unroll
    for (int i = 0; i < 2; ++i) { int R, C; stage_rc(tid * 16 + i * 8192, R, C); const int Rb = Epi::PERM ? ((R & ~31) + perm32(R & 31)) : R;
        voffA[i] = (unsigned)(R * K + C) * 2u; voffB[i] = (unsigned)(Rb * K + C) * 2u; }
    const size_t kstep = (size_t)(BK * 2);
    const size_t hstep = (size_t)HALF * K * 2;
    const size_t tstep = 2 * hstep;
    const unsigned ldsw = (unsigned)wid * 1024u;
    const int aoff = FP8 ? lds_byte(wr * 64 + fr, fq * 16) : lds_byte(wr * 64 + fr, fq * 8), boff = FP8 ? lds_byte(wc * 32 + fr, fq * 16) : lds_byte(wc * 32 + fr, fq * 8);
#define PG8_SA(b, h) (((b) * 2 + (h)) * HTB)
#define PG8_SB(b, h) ((4 + (b) * 2 + (h)) * HTB)
#define PG8_STAGE(bufoff, gbase, voff) do { _Pragma("unroll") for (int _i = 0; _i < 2; ++_i) \
        __builtin_amdgcn_global_load_lds((const unsigned*)((const char*)(gbase) + (voff)[_i]), (PG8_LAS unsigned*)(lds + (bufoff) + ldsw + _i * 8192), 16, 0, 0); } while (0)
#define PG8_LD32(p) __builtin_shufflevector(*(const PG8_LAS v4i32_t*)(p), *(const PG8_LAS v4i32_t*)((p) + 16), 0, 1, 2, 3, 4, 5, 6, 7)
#define PG8_LDA(dst, b, h) do { if constexpr (FP8) { _Pragma("unroll") for (int m = 0; m < 4; ++m) dst##8[m] = PG8_LD32(lds + PG8_SA(b, h) + aoff + m * 2048); } \
        else { _Pragma("unroll") for (int m = 0; m < 4; ++m) _Pragma("unroll") for (int k = 0; k < 2; ++k) dst[m][k] = *(const PG8_LAS bf16x8*)(lds + PG8_SA(b, h) + aoff + m * 2048 + k * 1024); } } while (0)
#define PG8_LDB(dst, b, h) do { if constexpr (FP8) { _Pragma("unroll") for (int n = 0; n < 2; ++n) dst##8[n] = PG8_LD32(lds + PG8_SB(b, h) + boff + n * 2048); } \
        else { _Pragma("unroll") for (int n = 0; n < 2; ++n) _Pragma("unroll") for (int k = 0; k < 2; ++k) dst[n][k] = *(const PG8_LAS bf16x8*)(lds + PG8_SB(b, h) + boff + n * 2048 + k * 1024); } } while (0)
#define PG8_MMA(ai, bj, At, Bt) do { __builtin_amdgcn_s_setprio(1); \
        if constexpr (FP8) { _Pragma("unroll") for (int m = 0; m < 4; ++m) _Pragma("unroll") for (int n = 0; n < 2; ++n) \
            asm volatile("v_mfma_scale_f32_16x16x128_f8f6f4 %0, %1, %2, %0, %3, %3 op_sel_hi:[0,0,0]" : "+v"(acc[ai][bj][m][n]) : "v"(Bt##8[n]), "v"(At##8[m]), "v"(mxone)); } \
        else { _Pragma("unroll") for (int m = 0; m < 4; ++m) _Pragma("unroll") for (int n = 0; n < 2; ++n) _Pragma("unroll") for (int k = 0; k < 2; ++k) \
            acc[ai][bj][m][n] = __builtin_amdgcn_mfma_f32_16x16x32_bf16(Bt[n][k], At[m][k], acc[ai][bj][m][n], 0, 0, 0); } \
        __builtin_amdgcn_s_setprio(0); } while (0)
#define PG8_WAIT_V(n) asm volatile("s_waitcnt vmcnt(" #n ")" ::: "memory")
#define PG8_WAIT_L(n) asm volatile("s_waitcnt lgkmcnt(" #n ")" ::: "memory")
#define PG8_BAR __builtin_amdgcn_s_barrier()
#define PG8_SCHED __builtin_amdgcn_sched_barrier(0)
    Unit cur, nxt; int ui = 0;
    if (!S.next(0, cur)) return;
    f32x4 acc[2][2][4][2];
#pragma unroll
    for (int a = 0; a < 2; ++a)
#pragma unroll
        for (int b = 0; b < 2; ++b)
#pragma unroll
            for (int m = 0; m < 4; ++m)
#pragma unroll
                for (int n = 0; n < 2; ++n) acc[a][b][m][n] = (f32x4){0.f, 0.f, 0.f, 0.f};
    bf16x8 At[4][2], B0[2][2], B1[2][2]; v8i32_t At8[4], B08[2], B18[2];
    int mxone = 0x7F7F7F7F; asm volatile("" : "+v"(mxone));
    const char* cA = (const char*)g.A + (size_t)cur.pm * tstep; const char* cB = (const char*)g.Bt + (size_t)cur.pn * tstep;
    S.a_ready(cur);
    if constexpr (SP2) {
        PG8_STAGE(PG8_SB(0, 0), cB, voffB); PG8_STAGE(PG8_SB(0, 1), cB + hstep, voffB); PG8_STAGE(PG8_SA(0, 0), cA, voffA); PG8_STAGE(PG8_SA(0, 1), cA + hstep, voffA);
        if (wr == 1) PG8_BAR;
        PG8_WAIT_V(2); PG8_BAR;
        PG8_STAGE(PG8_SB(1, 0), cB + kstep, voffB); PG8_STAGE(PG8_SA(1, 0), cA + kstep, voffA); PG8_STAGE(PG8_SB(1, 1), cB + hstep + kstep, voffB);
        PG8_WAIT_V(6); PG8_BAR;
    } else {
        PG8_STAGE(PG8_SB(0, 0), cB, voffB); PG8_STAGE(PG8_SA(0, 0), cA, voffA); PG8_STAGE(PG8_SB(0, 1), cB + hstep, voffB); PG8_STAGE(PG8_SA(0, 1), cA + hstep, voffA);
        if (wr == 1) PG8_BAR;
        PG8_WAIT_V(4); PG8_BAR;
        PG8_STAGE(PG8_SB(1, 0), cB + kstep, voffB); PG8_STAGE(PG8_SA(1, 0), cA + kstep, voffA); PG8_STAGE(PG8_SB(1, 1), cB + hstep + kstep, voffB);
        PG8_WAIT_V(6); PG8_BAR;
    }
#if defined(PROBE_GSTAMP)
    unsigned long long tu0_; asm volatile("s_memtime %0\n\ts_waitcnt lgkmcnt(0)" : "=s"(tu0_) :: "memory");
#endif
    for (;;) {
        const bool has_next = S.next(ui + 1, nxt);
        const char* nA = has_next ? (const char*)g.A + (size_t)nxt.pm * tstep : cA; const char* nB = has_next ? (const char*)g.Bt + (size_t)nxt.pn * tstep : cB;
        for (int t = 0; t < nt; t += 2) {
            const bool last = (t == nt - 2);
            const char* a1 = cA + (size_t)(t + 1) * kstep;
            const char* a2 = last ? nA : cA + (size_t)(t + 2) * kstep; const char* b2 = last ? nB : cB + (size_t)(t + 2) * kstep;
            const char* a3 = a2 + kstep; const char* b3 = b2 + kstep;
            if (last && has_next) S.a_ready(nxt);
            if constexpr (SP2) {
            PG8_LDB(B0, 0, 0); PG8_LDB(B1, 0, 1); PG8_SCHED; PG8_LDA(At, 0, 0); PG8_STAGE(PG8_SA(1, 1), a1 + hstep, voffA);
            PG8_WAIT_V(8); PG8_WAIT_L(0); PG8_BAR; PG8_MMA(0, 0, At, B0); PG8_MMA(0, 1, At, B1); PG8_BAR; PG8_SCHED;
            PG8_LDA(At, 0, 1); PG8_STAGE(PG8_SB(0, 0), b2, voffB); PG8_STAGE(PG8_SB(0, 1), b2 + hstep, voffB); PG8_STAGE(PG8_SA(0, 0), a2, voffA);
            PG8_WAIT_V(8); PG8_WAIT_L(0); PG8_BAR; PG8_MMA(1, 0, At, B0); PG8_MMA(1, 1, At, B1); PG8_BAR; PG8_SCHED;
            PG8_LDB(B0, 1, 0); PG8_LDB(B1, 1, 1); PG8_SCHED; PG8_LDA(At, 1, 0); PG8_STAGE(PG8_SA(0, 1), a2 + hstep, voffA);
            PG8_WAIT_V(8); PG8_WAIT_L(0); PG8_BAR; PG8_MMA(0, 0, At, B0); PG8_MMA(0, 1, At, B1); PG8_BAR; PG8_SCHED;
            PG8_LDA(At, 1, 1); PG8_STAGE(PG8_SB(1, 0), b3, voffB); PG8_STAGE(PG8_SB(1, 1), b3 + hstep, voffB); PG8_STAGE(PG8_SA(1, 0), a3, voffA);
            PG8_WAIT_V(8); PG8_WAIT_L(0); PG8_BAR; PG8_MMA(1, 0, At, B0); PG8_MMA(1, 1, At, B1); PG8_BAR; PG8_SCHED;
            } else {
            PG8_LDB(B0, 0, 0); PG8_SCHED; PG8_LDA(At, 0, 0); PG8_STAGE(PG8_SA(1, 1), a1 + hstep, voffA);
            PG8_WAIT_L(8); PG8_BAR; PG8_WAIT_L(0); PG8_MMA(0, 0, At, B0); PG8_BAR; PG8_SCHED;
            PG8_LDB(B1, 0, 1); PG8_STAGE(PG8_SB(0, 0), b2, voffB);
            PG8_BAR; PG8_WAIT_L(0); PG8_MMA(0, 1, At, B1); PG8_BAR;
            PG8_LDA(At, 0, 1); PG8_STAGE(PG8_SA(0, 0), a2, voffA);
            PG8_BAR; PG8_WAIT_L(0); PG8_MMA(1, 0, At, B0); PG8_BAR; PG8_SCHED;
            PG8_STAGE(PG8_SB(0, 1), b2 + hstep, voffB);
            PG8_WAIT_V(6); PG8_BAR; PG8_MMA(1, 1, At, B1); PG8_BAR;
            PG8_LDB(B0, 1, 0); PG8_SCHED; PG8_LDA(At, 1, 0); PG8_STAGE(PG8_SA(0, 1), a2 + hstep, voffA);
            PG8_WAIT_L(8); PG8_BAR; PG8_WAIT_L(0); PG8_MMA(0, 0, At, B0); PG8_BAR; PG8_SCHED;
            PG8_LDB(B1, 1, 1); PG8_STAGE(PG8_SB(1, 0), b3, voffB);
            PG8_BAR; PG8_WAIT_L(0); PG8_MMA(0, 1, At, B1); PG8_BAR;
            PG8_LDA(At, 1, 1); PG8_STAGE(PG8_SA(1, 0), a3, voffA);
            PG8_BAR; PG8_WAIT_L(0); PG8_MMA(1, 0, At, B0); PG8_BAR; PG8_SCHED;
            PG8_STAGE(PG8_SB(1, 1), b3 + hstep, voffB);
            PG8_WAIT_V(6); PG8_BAR; PG8_MMA(1, 1, At, B1); PG8_BAR;
            }
        }
        if constexpr (FP8) asm volatile("s_nop 15\n\ts_nop 15" ::: "memory");
        if constexpr (ALIGN_EPI) { if (wr == 0) PG8_BAR; }
#if defined(PROBE_GSTAMP)
        unsigned long long te0_; asm volatile("s_memtime %0\n\ts_waitcnt lgkmcnt(0)" : "=s"(te0_) :: "memory");
#endif
        if constexpr (!Epi::AFTER_DRAIN) { E(acc, cur, wr, wc, fr, fq); S.done(cur); }
#if defined(PROBE_GSTAMP)
        if (gstamp) { asm volatile("s_waitcnt vmcnt(0)" ::: "memory"); unsigned long long te1_; asm volatile("s_memtime %0\n\ts_waitcnt lgkmcnt(0)" : "=s"(te1_) :: "memory");
            if (blockIdx.x == 0 && threadIdx.x == 0) { gstamp[0] += (float)(te1_ - te0_); gstamp[1] += (float)(te1_ - tu0_); } tu0_ = te1_; }
#endif
        if (!has_next) break;
#pragma unroll
        for (int a = 0; a < 2; ++a)
#pragma unroll
            for (int b = 0; b < 2; ++b)
#pragma unroll
                for (int m = 0; m < 4; ++m)
#pragma unroll
                    for (int n = 0; n < 2; ++n) acc[a][b][m][n] = (f32x4){0.f, 0.f, 0.f, 0.f};
        cur = nxt; cA = nA; cB = nB; ++ui;
        if constexpr (ALIGN_EPI) { if (wr == 1) PG8_BAR; }
    }
    PG8_WAIT_V(0);
    if constexpr (!ALIGN_EPI) { if (wr == 0) PG8_BAR; }
    PG8_BAR;
    if constexpr (Epi::AFTER_DRAIN) { E.fused(acc, cur, wr, wc, fr, fq, lds, wid, lane); S.done(cur); }
#undef PG8_SA
#undef PG8_SB
#undef PG8_STAGE
#undef PG8_LDA
#undef PG8_LDB
#undef PG8_MMA
#undef PG8_LD32
#undef PG8_WAIT_V
#undef PG8_WAIT_L
#undef PG8_BAR
#undef PG8_SCHED
}
}
#include <hip/hip_bf16.h>
#include <cmath>
namespace attn_body {
using bf16=__hip_bfloat16;
using bf16x8=__attribute__((ext_vector_type(8)))short;
using s16x4=__attribute__((ext_vector_type(4)))short;
using f32x16=__attribute__((ext_vector_type(16)))float;
using u32x4=__attribute__((ext_vector_type(4)))unsigned;
constexpr int BATCH=8,NHEAD=16,SEQ=4096,D=64,DM=NHEAD*D;
constexpr int NW=8,QBLK=32,QB=QBLK*NW,KVBLK=64,NQB=SEQ/QB;
constexpr int ATTN_PITCH=DM, ATTN_UNIT_ROWS=QB;
__device__ __forceinline__ int crow(int r,int hi){return (r&3)+8*(r>>2)+4*hi;}
#define SBAR() __builtin_amdgcn_sched_barrier(0)
__device__ __forceinline__ void cmask(f32x16&p0,f32x16&p1,int jb,int qrel,int hi){
  const float NEG=-INFINITY; int kb=64*jb+4*hi;
  #pragma unroll
  for(int r=0;r<16;++r){int kv=kb+(r&3)+8*(r>>2); if(kv>qrel)p0[r]=NEG; if(kv+32>qrel)p1[r]=NEG;}
}

constexpr int NSLOT=3, SLOTB=8192;
constexpr int LDS_K=0, LDS_V=NSLOT*SLOTB, LDS_WS=2*NSLOT*SLOTB, LDS_OST=LDS_WS+NW*64*4, LDS_BYTES=LDS_OST+NW*4096;
constexpr float C2=0.125f*1.4426950408889634f;
__device__ __forceinline__ void glds16(const void*gsrc,unsigned lds_dst){unsigned keep;
  asm volatile("s_mov_b32 %0, m0\n\ts_mov_b32 m0, %2\n\ts_nop 0\n\tglobal_load_lds_dwordx4 %1, off\n\ts_mov_b32 m0, %0":"=&s"(keep):"v"(gsrc),"s"(lds_dst):"memory");}
__device__ __forceinline__ float max3f(float a,float b,float c){float r;asm("v_max3_f32 %0, %1, %2, %3":"=v"(r):"v"(a),"v"(b),"v"(c));return r;}
__device__ __forceinline__ float max2f(float a,float b){float r;asm("v_max_f32_e32 %0, %1, %2":"=v"(r):"v"(a),"v"(b));return r;}
__device__ __forceinline__ float fadd_s(float a,float b){float r;asm("v_add_f32_e32 %0, %1, %2":"=v"(r):"v"(a),"v"(b));return r;}
__device__ __forceinline__ float fsub_s(float a,float b){float r;asm("v_sub_f32_e32 %0, %1, %2":"=v"(r):"v"(a),"v"(b));return r;}
typedef float f32x2_t __attribute__((ext_vector_type(2))); typedef __bf16 bf16x2_t __attribute__((ext_vector_type(2)));
__device__ __forceinline__ unsigned cvtpk_s(float lo,float hi){f32x2_t v={lo,hi};bf16x2_t b=__builtin_convertvector(v,bf16x2_t);return __builtin_bit_cast(unsigned,b);}
#define WAIT_BAR(N) asm volatile("s_waitcnt vmcnt(" #N ") lgkmcnt(0)\n\ts_barrier":::"memory")

__device__ __forceinline__ void qkt(f32x16&p0,f32x16&p1,const char*Kslot,const bf16x8*qr,const f32x16&negm,int r32,int hi){
  const char*kb=Kslot+hi*1024+r32*16;
  #pragma unroll
  for(int d0=0;d0<4;++d0){
    const bf16x8 b0=*reinterpret_cast<const bf16x8*>(kb+d0*2048);
    const bf16x8 b1=*reinterpret_cast<const bf16x8*>(kb+d0*2048+512);
    if(d0==0){p0=__builtin_amdgcn_mfma_f32_32x32x16_bf16(b0,qr[0],negm,0,0,0);p1=__builtin_amdgcn_mfma_f32_32x32x16_bf16(b1,qr[0],negm,0,0,0);}
    else{p0=__builtin_amdgcn_mfma_f32_32x32x16_bf16(b0,qr[d0],p0,0,0,0);p1=__builtin_amdgcn_mfma_f32_32x32x16_bf16(b1,qr[d0],p1,0,0,0);}}
}
typedef __attribute__((address_space(3))) const char* lds_cptr;
typedef short v4i16_t __attribute__((ext_vector_type(4)));
__device__ __forceinline__ void kload8(bf16x8*kf,lds_cptr kp){
  kf[0]=*(const __attribute__((address_space(3))) bf16x8*)(kp);      kf[1]=*(const __attribute__((address_space(3))) bf16x8*)(kp+512);
  kf[2]=*(const __attribute__((address_space(3))) bf16x8*)(kp+2048); kf[3]=*(const __attribute__((address_space(3))) bf16x8*)(kp+2560);
  kf[4]=*(const __attribute__((address_space(3))) bf16x8*)(kp+4096); kf[5]=*(const __attribute__((address_space(3))) bf16x8*)(kp+4608);
  kf[6]=*(const __attribute__((address_space(3))) bf16x8*)(kp+6144); kf[7]=*(const __attribute__((address_space(3))) bf16x8*)(kp+6656);
}
__device__ __forceinline__ void kload2(bf16x8*kf,lds_cptr kp,int j){ kf[2*j]=*(const __attribute__((address_space(3))) bf16x8*)(kp+j*2048); kf[2*j+1]=*(const __attribute__((address_space(3))) bf16x8*)(kp+j*2048+512); }
__device__ __forceinline__ s16x4 vtr(lds_cptr p){ return __builtin_bit_cast(s16x4,__builtin_amdgcn_ds_read_tr16_b64_v4i16((__attribute__((address_space(3))) v4i16_t*)p)); }
__device__ __forceinline__ float rowmax(const f32x16&p0,const f32x16&p1){
  float a=max3f(p0[0],p0[1],p1[0]),b=max3f(p0[2],p0[3],p1[1]);a=max3f(a,p1[2],p1[3]);
  #pragma unroll
  for(int r=4;r<16;r+=4){a=max3f(a,p0[r],p0[r+1]);b=max3f(b,p0[r+2],p0[r+3]);a=max3f(a,p1[r],p1[r+1]);b=max3f(b,p1[r+2],p1[r+3]);}
  const float m=max2f(a,b);
  auto rr=__builtin_amdgcn_permlane32_swap(__float_as_uint(m),__float_as_uint(m),false,false);
  return max2f(__uint_as_float(rr[0]),__uint_as_float(rr[1]));
}
__device__ __forceinline__ void pv(f32x16*o,int vb,bf16x8 pa0,bf16x8 pa1,bf16x8 pa2,bf16x8 pa3){
  #pragma unroll
  for(int d0=0;d0<2;++d0){s16x4 lo[4],hi[4];
    #pragma unroll
    for(int ks=0;ks<4;++ks){
      asm volatile("ds_read_b64_tr_b16 %0,%1 offset:%c2":"=&v"(lo[ks]):"v"(vb),"i"(d0*4096+ks*1024):"memory");
      asm volatile("ds_read_b64_tr_b16 %0,%1 offset:%c2":"=&v"(hi[ks]):"v"(vb),"i"(d0*4096+ks*1024+512):"memory");}
    asm volatile("s_waitcnt lgkmcnt(0)":::"memory");SBAR();
    #define PK(k) (bf16x8){lo[k][0],lo[k][1],lo[k][2],lo[k][3],hi[k][0],hi[k][1],hi[k][2],hi[k][3]}
    o[d0]=__builtin_amdgcn_mfma_f32_32x32x16_bf16(pa0,PK(0),o[d0],0,0,0);
    o[d0]=__builtin_amdgcn_mfma_f32_32x32x16_bf16(pa1,PK(1),o[d0],0,0,0);
    o[d0]=__builtin_amdgcn_mfma_f32_32x32x16_bf16(pa2,PK(2),o[d0],0,0,0);
    o[d0]=__builtin_amdgcn_mfma_f32_32x32x16_bf16(pa3,PK(3),o[d0],0,0,0);
    #undef PK
  }
}

#ifndef ATTN_STORE16
#define ATTN_STORE16(p,v) (*(u32x4*)(p)=(v))
#endif
template<int THRL> __device__ __forceinline__ void attn_unit(int b,int h,int qb,const bf16*Q,const bf16*__restrict__ K,const bf16*__restrict__ V,bf16*O,char*shm){
  const int tid=threadIdx.x,lane=tid&63,r32=lane&31,hi=lane>>5; const int wid=__builtin_amdgcn_readfirstlane(tid>>6);
  const long rowbase=(long)b*SEQ; const int q0=qb*QB;
  const bf16*Qw=Q+(rowbase+q0+wid*QBLK)*DM+h*D;
  const bf16*Kh=K+rowbase*DM+h*D,*Vh=V+rowbase*DM+h*D;
  const unsigned lds0=(unsigned)(uintptr_t)shm;
  float*wsf=(float*)(shm+LDS_WS)+wid*64;
  const bf16*ksrc=Kh+(long)lane*DM+wid*8;
  const bf16*vsrc=Vh+(long)(16*(wid&3)+(lane>>2))*DM+(wid>>2)*32+(lane&3)*8;
  const unsigned kdst=lds0+LDS_K+wid*1024, vdst=lds0+LDS_V+wid*1024;
  #define DMA_K(t,slot) glds16(ksrc+(long)(t)*KVBLK*DM,(unsigned)__builtin_amdgcn_readfirstlane(kdst+(slot)))
  #define DMA_V(t,slot) glds16(vsrc+(long)(t)*KVBLK*DM,(unsigned)__builtin_amdgcn_readfirstlane(vdst+(slot)))
  const int vb0=(int)(lds0+LDS_V)+((lane>>4)&1)*32+(lane&3)*8+(4*hi+((lane&15)>>2))*64;
  const char*Kbase=shm+LDS_K; bf16x8 kf[8];
  const lds_cptr shm3=(lds_cptr)shm; const lds_cptr kp0=shm3+LDS_K+hi*1024+r32*16; const lds_cptr vp0=shm3+LDS_V+((lane>>4)&1)*32+(lane&3)*8+(4*hi+((lane&15)>>2))*64;
  const int NT=SEQ/KVBLK;
  DMA_K(0,0);DMA_V(0,0);DMA_K(1,SLOTB);
  bf16x8 qr[4];
  #pragma unroll
  for(int d0=0;d0<4;++d0)qr[d0]=*reinterpret_cast<const bf16x8*>(&Qw[(long)r32*DM+d0*16+hi*8]);
  float mhat=0.f,l_reg=0.f;f32x16 o[2];o[0]=f32x16{};o[1]=f32x16{};f32x16 negm=f32x16{};asm volatile("":"+v"(negm));
  const int qrel=wid*QBLK+r32;
  #define CMASK(P0,P1,t) do{}while(0)
  bool resc=false;
  #define START(P0,P1) do{ const float rm=rowmax(P0,P1); resc=false; \
    { const float dl=rm; mhat=fadd_s(mhat,dl); \
      _Pragma("unroll") for(int r=0;r<16;++r){P0[r]=fsub_s(P0[r],dl);P1[r]=fsub_s(P1[r],dl);} \
      _Pragma("unroll") for(int r=0;r<16;++r)negm[r]=-mhat; asm volatile("":"+v"(negm)); } \
    _Pragma("unroll") for(int r=0;r<16;++r)P0[r]=__builtin_amdgcn_exp2f(P0[r]); }while(0)
  #define RESC() do{ if(resc){ asm volatile("s_waitcnt lgkmcnt(0)":::"memory"); \
      _Pragma("unroll") for(int d_=0;d_<2;++d_) _Pragma("unroll") for(int r=0;r<16;++r)o[d_][r]*=wsf[crow(r,hi)]; } }while(0)
  f32x16 pA0,pA1,pB0,pB1;
  int sl_prev=0,sl_cur=0,sl_next=SLOTB;
  #define ROT() do{sl_prev=sl_cur;sl_cur=sl_next;sl_next=(sl_next==(NSLOT-1)*SLOTB)?0:sl_next+SLOTB;}while(0)
  DMA_K(2,2*SLOTB);
  WAIT_BAR(3);
  qkt(pA0,pA1,Kbase,qr,negm,r32,hi);asm volatile("s_nop 15\n\ts_nop 7":"+v"(pA0),"+v"(pA1));CMASK(pA0,pA1,0);
  START(pA0,pA1);
  _Pragma("unroll") for(int r=0;r<16;++r)pA1[r]=__builtin_amdgcn_exp2f(pA1[r]);
  WAIT_BAR(0);
  DMA_K(3,0);DMA_V(1,SLOTB);
  ROT();
  kload8(kf,kp0+sl_cur);
  WAIT_BAR(2);
  s16x4 vlo[8],vhi[8]; u32x4 pw0,pw1,pw2,pw3;
  #define PKW(P,B) cvtpk_s(P[B],P[B+1])
  #define PAF(k) __builtin_bit_cast(bf16x8,pw##k)
  #define VFR(i) (bf16x8){vlo[i][0],vlo[i][1],vlo[i][2],vlo[i][3],vhi[i][0],vhi[i][1],vhi[i][2],vhi[i][3]}
  #define PIN(x) asm volatile("":"+v"(x))
  #define MX3(a,b,c) __builtin_fmaxf(__builtin_fmaxf((a),(b)),(c))
  #define GAPA(MF,A0,A1,A2,A3,W0,W1,PW) do{ MF; sacc+=A0; sacc+=A1; sacc+=A2; sacc+=A3; PIN(sacc); W0; W1; PIN(PW); SBAR(); }while(0)
  #define EX(v) __builtin_amdgcn_exp2f(v)
  #define GAPB(MF,X,B) do{ MF; X[B]=EX(X[B]); X[B+1]=EX(X[B+1]); X[B+2]=EX(X[B+2]); X[B+3]=EX(X[B+3]); PIN(X); SBAR(); }while(0)
  #define VRD(i) do{ vlo[i]=vtr(vp_+(((i)>>2)*4096+((i)&3)*1024)); vhi[i]=vtr(vp_+(((i)>>2)*4096+((i)&3)*1024+512)); }while(0)
  #define KRD(G,j) do{ if(G){ kload2(kf,kp0+sl_next,j); SBAR(); } }while(0)
  #define STEP(C0,C1,P0,P1,t,GK,GV,GL) do{ SBAR(); \
    const lds_cptr vp_=vp0+sl_prev; \
    VRD(0); SBAR(); float sacc=(P0[0]+P0[1]); \
    GAPA(C0=__builtin_amdgcn_mfma_f32_32x32x16_bf16(kf[0],qr[0],negm,0,0,0), P0[2],P0[3],P0[4],P0[5],     pw0[0]=PKW(P0,0), pw0[1]=PKW(P0,2), pw0); \
    VRD(4); SBAR(); GAPA(C1=__builtin_amdgcn_mfma_f32_32x32x16_bf16(kf[1],qr[0],negm,0,0,0), P0[6],P0[7],P0[8],P0[9],     pw0[2]=PKW(P0,4), pw0[3]=PKW(P0,6), pw0); \
    VRD(1); SBAR(); GAPA(C0=__builtin_amdgcn_mfma_f32_32x32x16_bf16(kf[2],qr[1],C0,0,0,0),   P0[10],P0[11],P0[12],P0[13], pw1[0]=PKW(P0,8), pw1[1]=PKW(P0,10), pw1); \
    VRD(5); SBAR(); GAPA(C1=__builtin_amdgcn_mfma_f32_32x32x16_bf16(kf[3],qr[1],C1,0,0,0),   P0[14],P0[15],P1[0],P1[1],   pw1[2]=PKW(P0,12),pw1[3]=PKW(P0,14), pw1); \
    VRD(2); SBAR(); GAPA(C0=__builtin_amdgcn_mfma_f32_32x32x16_bf16(kf[4],qr[2],C0,0,0,0),   P1[2],P1[3],P1[4],P1[5],     pw2[0]=PKW(P1,0), pw2[1]=PKW(P1,2), pw2); \
    VRD(6); SBAR(); GAPA(C1=__builtin_amdgcn_mfma_f32_32x32x16_bf16(kf[5],qr[2],C1,0,0,0),   P1[6],P1[7],P1[8],P1[9],     pw2[2]=PKW(P1,4), pw2[3]=PKW(P1,6), pw2); \
    VRD(3); SBAR(); GAPA(C0=__builtin_amdgcn_mfma_f32_32x32x16_bf16(kf[6],qr[3],C0,0,0,0),   P1[10],P1[11],P1[12],P1[13], pw3[0]=PKW(P1,8), pw3[1]=PKW(P1,10), pw3); \
    VRD(7); SBAR(); GAPA(C1=__builtin_amdgcn_mfma_f32_32x32x16_bf16(kf[7],qr[3],C1,0,0,0),   P1[14],P1[15],0.f,0.f,       pw3[2]=PKW(P1,12),pw3[3]=PKW(P1,14), pw3); \
    l_reg+=sacc; \
    if(GK){DMA_K((t)+3,sl_cur);} if(GV){DMA_V((t)+1,sl_next);} \
    CMASK(C0,C1,t); \
    { float a=MX3(C0[0],C0[1],C1[0]),b=MX3(C0[2],C0[3],C1[1]); a=MX3(a,C1[2],C1[3]); \
      _Pragma("unroll") for(int r=4;r<16;r+=4){a=MX3(a,C0[r],C0[r+1]);b=MX3(b,C0[r+2],C0[r+3]);a=MX3(a,C1[r],C1[r+1]);b=MX3(b,C1[r+2],C1[r+3]);} \
      float rm=__builtin_fmaxf(a,b); { auto rr=__builtin_amdgcn_permlane32_swap(__float_as_uint(rm),__float_as_uint(rm),false,false); rm=__builtin_fmaxf(__uint_as_float(rr[0]),__uint_as_float(rr[1])); } \
      resc=false; \
      if(__builtin_expect(__any(rm>(float)THRL),0)){ const float dl=__builtin_fmaxf(rm,0.f); mhat+=dl; \
        _Pragma("unroll") for(int r=0;r<16;++r){C0[r]-=dl;C1[r]-=dl;} \
        _Pragma("unroll") for(int r=0;r<16;++r)negm[r]=-mhat; asm volatile("":"+v"(negm)); \
        const float f=__builtin_amdgcn_exp2f(-dl); l_reg*=f; if(hi==0)wsf[r32]=f; resc=true; } } \
    SBAR(); \
    GAPB(o[0]=__builtin_amdgcn_mfma_f32_32x32x16_bf16(PAF(0),VFR(0),o[0],0,0,0), C0,0); \
    GAPB(o[1]=__builtin_amdgcn_mfma_f32_32x32x16_bf16(PAF(0),VFR(4),o[1],0,0,0), C0,4); \
    KRD(GL,0); GAPB(o[0]=__builtin_amdgcn_mfma_f32_32x32x16_bf16(PAF(1),VFR(1),o[0],0,0,0), C0,8); \
    KRD(GL,1); GAPB(o[1]=__builtin_amdgcn_mfma_f32_32x32x16_bf16(PAF(1),VFR(5),o[1],0,0,0), C0,12); \
    KRD(GL,2); GAPB(o[0]=__builtin_amdgcn_mfma_f32_32x32x16_bf16(PAF(2),VFR(2),o[0],0,0,0), C1,0); \
    KRD(GL,3); GAPB(o[1]=__builtin_amdgcn_mfma_f32_32x32x16_bf16(PAF(2),VFR(6),o[1],0,0,0), C1,4); \
    GAPB(o[0]=__builtin_amdgcn_mfma_f32_32x32x16_bf16(PAF(3),VFR(3),o[0],0,0,0), C1,8); \
    GAPB(o[1]=__builtin_amdgcn_mfma_f32_32x32x16_bf16(PAF(3),VFR(7),o[1],0,0,0), C1,12); \
    }while(0)
  int t=1;
  #undef CMASK
  #define CMASK(P0,P1,t) do{}while(0)
  for(;t+5<NT;t+=2){
    STEP(pB0,pB1,pA0,pA1,t,true,true,true);     WAIT_BAR(2); RESC(); ROT();
    STEP(pA0,pA1,pB0,pB1,t+1,true,true,true);   WAIT_BAR(2); RESC(); ROT();
  }
  #undef CMASK
  #define CMASK(P0,P1,t) do{}while(0)
  #define ENDW(tt) do{ if((tt)+3<NT){WAIT_BAR(2);} else if((tt)+2<NT){WAIT_BAR(1);} else {WAIT_BAR(0);} }while(0)
  for(;t+1<NT;t+=2){
    STEP(pB0,pB1,pA0,pA1,t,(t+3<NT),(t+1<NT),(t+1<NT));       ENDW(t);   RESC(); ROT();
    STEP(pA0,pA1,pB0,pB1,t+1,(t+4<NT),(t+2<NT),(t+2<NT));     ENDW(t+1); RESC(); ROT();
  }
  STEP(pB0,pB1,pA0,pA1,NT-1,false,false,false); RESC();
  { float sacc=pB0[0]+pB0[1]; _Pragma("unroll") for(int r=2;r<16;++r)sacc+=pB0[r]; _Pragma("unroll") for(int r=0;r<16;++r)sacc+=pB1[r]; l_reg+=sacc;
    pw0=(u32x4){PKW(pB0,0),PKW(pB0,2),PKW(pB0,4),PKW(pB0,6)};pw1=(u32x4){PKW(pB0,8),PKW(pB0,10),PKW(pB0,12),PKW(pB0,14)};pw2=(u32x4){PKW(pB1,0),PKW(pB1,2),PKW(pB1,4),PKW(pB1,6)};pw3=(u32x4){PKW(pB1,8),PKW(pB1,10),PKW(pB1,12),PKW(pB1,14)};
    SBAR(); pv(o,vb0+sl_cur,PAF(0),PAF(1),PAF(2),PAF(3)); }
  #undef PKW
  #undef PAF
  #undef VFR
  #undef PIN
  #undef MX3
  #undef GAPA
  #undef GAPB
  #undef EX
  #undef VRD
  #undef KRD
  #undef STEP
  #undef ENDW
  {auto rr=__builtin_amdgcn_permlane32_swap(__float_as_uint(l_reg),__float_as_uint(l_reg),false,false);l_reg=__uint_as_float(rr[0])+__uint_as_float(rr[1]);}
  if(hi==0)wsf[32+r32]=l_reg;asm volatile("s_waitcnt lgkmcnt(0)":::"memory");
  float rli[16];
  #pragma unroll
  for(int r=0;r<16;++r)rli[r]=__builtin_amdgcn_rcpf(wsf[32+crow(r,hi)]);
  bf16*Ow=O+(rowbase+q0+wid*QBLK)*DM+h*D;
  { bf16*stg=(bf16*)(shm+LDS_OST)+wid*2048;
    #pragma unroll
    for(int r=0;r<16;++r){const int orow=crow(r,hi);
      #pragma unroll
      for(int d0=0;d0<2;++d0)stg[orow*64+d0*32+r32]=__float2bfloat16(o[d0][r]*rli[r]);}
    asm volatile("s_waitcnt lgkmcnt(0)":::"memory");
    #pragma unroll
    for(int i=0;i<4;++i){const int row=i*8+(lane>>3),ch=lane&7; const u32x4 v=*(const u32x4*)(stg+row*64+ch*8); ATTN_STORE16(Ow+(long)row*DM+ch*8,v);} }
  asm volatile("s_waitcnt lgkmcnt(0)\n\ts_barrier":::"memory");
  #undef DMA_K
  #undef DMA_V
  #undef CMASK
  #undef START
  #undef RESC
  #undef ROT
}

constexpr int V_SLOTB=16384;
constexpr int L2_K=0, L2_V=NSLOT*SLOTB, L2_WS=L2_V+NSLOT*V_SLOTB, L2_OST=L2_WS+NW*64*4, L2_BYTES=L2_OST+NW*4096;
__device__ __forceinline__ void pv128(f32x16*o,int vb,bf16x8 pa0,bf16x8 pa1,bf16x8 pa2,bf16x8 pa3){
  #pragma unroll
  for(int d0=0;d0<4;++d0){s16x4 lo[4],hi[4];
    #pragma unroll
    for(int ks=0;ks<4;++ks){
      asm volatile("ds_read_b64_tr_b16 %0,%1 offset:%c2":"=&v"(lo[ks]):"v"(vb),"i"(d0*4096+ks*1024):"memory");
      asm volatile("ds_read_b64_tr_b16 %0,%1 offset:%c2":"=&v"(hi[ks]):"v"(vb),"i"(d0*4096+ks*1024+512):"memory");}
    asm volatile("s_waitcnt lgkmcnt(0)":::"memory");SBAR();
    #define PK(k) (bf16x8){lo[k][0],lo[k][1],lo[k][2],lo[k][3],hi[k][0],hi[k][1],hi[k][2],hi[k][3]}
    o[d0]=__builtin_amdgcn_mfma_f32_32x32x16_bf16(pa0,PK(0),o[d0],0,0,0);
    o[d0]=__builtin_amdgcn_mfma_f32_32x32x16_bf16(pa1,PK(1),o[d0],0,0,0);
    o[d0]=__builtin_amdgcn_mfma_f32_32x32x16_bf16(pa2,PK(2),o[d0],0,0,0);
    o[d0]=__builtin_amdgcn_mfma_f32_32x32x16_bf16(pa3,PK(3),o[d0],0,0,0);
    #undef PK
  }
}
#ifndef A128_NOPIN
#define SB128() SBAR()
#else
#define SB128() do{}while(0)
#endif
#if defined(PROBE_MFMA)
  #define PROBE_HOOK(C0,C1) do{ const bf16x8 zf_=bf16x8{}; _Pragma("unroll") for(int q_=0;q_<8;++q_) o[q_&3]=__builtin_amdgcn_mfma_f32_32x32x16_bf16(__builtin_bit_cast(bf16x8,pw0),zf_,o[q_&3],0,0,0); }while(0)
#elif defined(PROBE_EXP)
  #define PROBE_HOOK(C0,C1) do{ _Pragma("unroll") for(int q_=0;q_<16;++q_){ float j0_=__builtin_amdgcn_exp2f(C0[q_]), j1_=__builtin_amdgcn_exp2f(C1[q_]); asm volatile(""::"v"(j0_),"v"(j1_)); } }while(0)
#elif defined(PROBE_LDS)
  #define PROBE_HOOK(C0,C1) do{ bf16x8 jk_[8]; kload8(jk_,kp0+sl_cur); _Pragma("unroll") for(int q_=0;q_<8;++q_) asm volatile(""::"v"(jk_[q_])); }while(0)
#else
  #define PROBE_HOOK(C0,C1) do{}while(0)
#endif
__device__ __forceinline__ void attn128_unit(int b,int qb,const bf16*Q,const bf16*__restrict__ K,const bf16*__restrict__ V,bf16*O,char*shm){
  const int tid=threadIdx.x,lane=tid&63,r32=lane&31,hi=lane>>5; const int wid=__builtin_amdgcn_readfirstlane(tid>>6);
  const long rowbase=(long)b*SEQ; const int q0=qb*QB;
  const bf16*Qw=Q+(rowbase+q0+wid*QBLK)*DM;
  const bf16*Kh=K+rowbase*DM,*Vh=V+rowbase*DM;
  const unsigned lds0=(unsigned)(uintptr_t)shm;
  float*wsf=(float*)(shm+L2_WS)+wid*64;
  const bf16*ksrc=Kh+(long)lane*DM+wid*8;
  const bf16*vsrc=Vh+(long)(16*(wid&3)+(lane>>2))*DM+(wid>>2)*32+(lane&3)*8;
  const unsigned kdst=lds0+L2_K+wid*1024, vdst=lds0+L2_V+wid*1024;
  #define DMA_K(t,slot) glds16(ksrc+(long)(t)*KVBLK*DM,(unsigned)__builtin_amdgcn_readfirstlane(kdst+(slot)))
  #define DMA_V(t,slot) do{ glds16(vsrc+(long)(t)*KVBLK*DM,(unsigned)__builtin_amdgcn_readfirstlane(vdst+2*(slot))); glds16(vsrc+(long)(t)*KVBLK*DM+64,(unsigned)__builtin_amdgcn_readfirstlane(vdst+2*(slot)+8192)); }while(0)
  const int vb0=(int)(lds0+L2_V)+((lane>>4)&1)*32+(lane&3)*8+(4*hi+((lane&15)>>2))*64;
  const char*Kbase=shm+L2_K; bf16x8 kf[8];
  const lds_cptr shm3=(lds_cptr)shm; const lds_cptr kp0=shm3+L2_K+hi*1024+r32*16; const lds_cptr vp0=shm3+L2_V+((lane>>4)&1)*32+(lane&3)*8+(4*hi+((lane&15)>>2))*64;
  const int NT=SEQ/KVBLK;
  DMA_K(0,0);DMA_V(0,0);DMA_K(1,SLOTB);
  bf16x8 qr[4];
  #pragma unroll
  for(int d0=0;d0<4;++d0)qr[d0]=*reinterpret_cast<const bf16x8*>(&Qw[(long)r32*DM+d0*16+hi*8]);
  float l_reg=0.f;f32x16 o[4];o[0]=f32x16{};o[1]=f32x16{};o[2]=f32x16{};o[3]=f32x16{};
  const f32x16 zero=f32x16{};
  f32x16 pA0,pA1,pB0,pB1;
  int sl_prev=0,sl_cur=0,sl_next=SLOTB;
  #define ROT() do{sl_prev=sl_cur;sl_cur=sl_next;sl_next=(sl_next==(NSLOT-1)*SLOTB)?0:sl_next+SLOTB;}while(0)
  DMA_K(2,2*SLOTB);
  WAIT_BAR(4);
  qkt(pA0,pA1,Kbase,qr,zero,r32,hi);
  _Pragma("unroll") for(int r=0;r<16;++r){pA0[r]=__builtin_amdgcn_exp2f(pA0[r]);pA1[r]=__builtin_amdgcn_exp2f(pA1[r]);}
  WAIT_BAR(0);
  DMA_K(3,0);DMA_V(1,SLOTB);
  ROT();
  kload8(kf,kp0+sl_cur);
  WAIT_BAR(3);
  s16x4 vlo[8],vhi[8],wlo[8],whi[8]; u32x4 pw0,pw1,pw2,pw3;
  #define PKW(P,B) cvtpk_s(P[B],P[B+1])
  #define PAF(k) __builtin_bit_cast(bf16x8,pw##k)
  #define VFR(i) (bf16x8){vlo[i][0],vlo[i][1],vlo[i][2],vlo[i][3],vhi[i][0],vhi[i][1],vhi[i][2],vhi[i][3]}
  #define WFR(i) (bf16x8){wlo[i][0],wlo[i][1],wlo[i][2],wlo[i][3],whi[i][0],whi[i][1],whi[i][2],whi[i][3]}
  #define PIN(x) asm volatile("":"+v"(x))
  #define GAPA(MF,A0,A1,A2,A3,W0,W1,PW) do{ MF; sacc+=A0; sacc+=A1; sacc+=A2; sacc+=A3; PIN(sacc); W0; W1; PIN(PW); SB128(); }while(0)
  #define EX(v) __builtin_amdgcn_exp2f(v)
  #define GAPB2(MF,X,B) do{ MF; X[B]=EX(X[B]); X[B+1]=EX(X[B+1]); PIN(X); SB128(); }while(0)
  #define VRD(i) do{ vlo[i]=vtr(vp_+(((i)>>2)*4096+((i)&3)*1024)); vhi[i]=vtr(vp_+(((i)>>2)*4096+((i)&3)*1024+512)); }while(0)
  #define WRD(i) do{ wlo[i]=vtr(vp_+(8192+((i)>>2)*4096+((i)&3)*1024)); whi[i]=vtr(vp_+(8192+((i)>>2)*4096+((i)&3)*1024+512)); }while(0)
  #define KRD(G,j) do{ if(G){ kload2(kf,kp0+sl_next,j); SB128(); } }while(0)
  #define STEP(C0,C1,P0,P1,t,GK,GV,GL) do{ SB128(); \
    const lds_cptr vp_=vp0+2*sl_prev; \
    VRD(0); SB128(); float sacc=(P0[0]+P0[1]); \
    GAPA(C0=__builtin_amdgcn_mfma_f32_32x32x16_bf16(kf[0],qr[0],zero,0,0,0), P0[2],P0[3],P0[4],P0[5],     pw0[0]=PKW(P0,0), pw0[1]=PKW(P0,2), pw0); \
    VRD(4); SB128(); GAPA(C1=__builtin_amdgcn_mfma_f32_32x32x16_bf16(kf[1],qr[0],zero,0,0,0), P0[6],P0[7],P0[8],P0[9],     pw0[2]=PKW(P0,4), pw0[3]=PKW(P0,6), pw0); \
    VRD(1); SB128(); GAPA(C0=__builtin_amdgcn_mfma_f32_32x32x16_bf16(kf[2],qr[1],C0,0,0,0),   P0[10],P0[11],P0[12],P0[13], pw1[0]=PKW(P0,8), pw1[1]=PKW(P0,10), pw1); \
    VRD(5); SB128(); GAPA(C1=__builtin_amdgcn_mfma_f32_32x32x16_bf16(kf[3],qr[1],C1,0,0,0),   P0[14],P0[15],P1[0],P1[1],   pw1[2]=PKW(P0,12),pw1[3]=PKW(P0,14), pw1); \
    VRD(2); SB128(); GAPA(C0=__builtin_amdgcn_mfma_f32_32x32x16_bf16(kf[4],qr[2],C0,0,0,0),   P1[2],P1[3],P1[4],P1[5],     pw2[0]=PKW(P1,0), pw2[1]=PKW(P1,2), pw2); \
    VRD(6); SB128(); GAPA(C1=__builtin_amdgcn_mfma_f32_32x32x16_bf16(kf[5],qr[2],C1,0,0,0),   P1[6],P1[7],P1[8],P1[9],     pw2[2]=PKW(P1,4), pw2[3]=PKW(P1,6), pw2); \
    VRD(3); SB128(); GAPA(C0=__builtin_amdgcn_mfma_f32_32x32x16_bf16(kf[6],qr[3],C0,0,0,0),   P1[10],P1[11],P1[12],P1[13], pw3[0]=PKW(P1,8), pw3[1]=PKW(P1,10), pw3); \
    VRD(7); SB128(); GAPA(C1=__builtin_amdgcn_mfma_f32_32x32x16_bf16(kf[7],qr[3],C1,0,0,0),   P1[14],P1[15],0.f,0.f,       pw3[2]=PKW(P1,12),pw3[3]=PKW(P1,14), pw3); \
    l_reg+=sacc; \
    if(GK){DMA_K((t)+3,sl_cur);} if(GV){DMA_V((t)+1,sl_next);} \
    SB128(); \
    PROBE_HOOK(C0,C1); \
    WRD(0); GAPB2(o[0]=__builtin_amdgcn_mfma_f32_32x32x16_bf16(PAF(0),VFR(0),o[0],0,0,0), C0,0); \
    WRD(4); GAPB2(o[1]=__builtin_amdgcn_mfma_f32_32x32x16_bf16(PAF(0),VFR(4),o[1],0,0,0), C0,2); \
    WRD(1); KRD(GL,0); GAPB2(o[0]=__builtin_amdgcn_mfma_f32_32x32x16_bf16(PAF(1),VFR(1),o[0],0,0,0), C0,4); \
    WRD(5); KRD(GL,1); GAPB2(o[1]=__builtin_amdgcn_mfma_f32_32x32x16_bf16(PAF(1),VFR(5),o[1],0,0,0), C0,6); \
    WRD(2); KRD(GL,2); GAPB2(o[0]=__builtin_amdgcn_mfma_f32_32x32x16_bf16(PAF(2),VFR(2),o[0],0,0,0), C0,8); \
    WRD(6); KRD(GL,3); GAPB2(o[1]=__builtin_amdgcn_mfma_f32_32x32x16_bf16(PAF(2),VFR(6),o[1],0,0,0), C0,10); \
    WRD(3); GAPB2(o[0]=__builtin_amdgcn_mfma_f32_32x32x16_bf16(PAF(3),VFR(3),o[0],0,0,0), C0,12); \
    WRD(7); GAPB2(o[1]=__builtin_amdgcn_mfma_f32_32x32x16_bf16(PAF(3),VFR(7),o[1],0,0,0), C0,14); \
    GAPB2(o[2]=__builtin_amdgcn_mfma_f32_32x32x16_bf16(PAF(0),WFR(0),o[2],0,0,0), C1,0); \
    GAPB2(o[3]=__builtin_amdgcn_mfma_f32_32x32x16_bf16(PAF(0),WFR(4),o[3],0,0,0), C1,2); \
    GAPB2(o[2]=__builtin_amdgcn_mfma_f32_32x32x16_bf16(PAF(1),WFR(1),o[2],0,0,0), C1,4); \
    GAPB2(o[3]=__builtin_amdgcn_mfma_f32_32x32x16_bf16(PAF(1),WFR(5),o[3],0,0,0), C1,6); \
    GAPB2(o[2]=__builtin_amdgcn_mfma_f32_32x32x16_bf16(PAF(2),WFR(2),o[2],0,0,0), C1,8); \
    GAPB2(o[3]=__builtin_amdgcn_mfma_f32_32x32x16_bf16(PAF(2),WFR(6),o[3],0,0,0), C1,10); \
    GAPB2(o[2]=__builtin_amdgcn_mfma_f32_32x32x16_bf16(PAF(3),WFR(3),o[2],0,0,0), C1,12); \
    GAPB2(o[3]=__builtin_amdgcn_mfma_f32_32x32x16_bf16(PAF(3),WFR(7),o[3],0,0,0), C1,14); \
    }while(0)
  int t=1;
  for(;t+5<NT;t+=2){
    STEP(pB0,pB1,pA0,pA1,t,true,true,true);     WAIT_BAR(3); ROT();
    STEP(pA0,pA1,pB0,pB1,t+1,true,true,true);   WAIT_BAR(3); ROT();
  }
  #define ENDW(tt) do{ if((tt)+3<NT){WAIT_BAR(3);} else if((tt)+2<NT){WAIT_BAR(2);} else {WAIT_BAR(0);} }while(0)
  for(;t+1<NT;t+=2){
    STEP(pB0,pB1,pA0,pA1,t,(t+3<NT),(t+1<NT),(t+1<NT));       ENDW(t);   ROT();
    STEP(pA0,pA1,pB0,pB1,t+1,(t+4<NT),(t+2<NT),(t+2<NT));     ENDW(t+1); ROT();
  }
  STEP(pB0,pB1,pA0,pA1,NT-1,false,false,false);
  { float sacc=pB0[0]+pB0[1]; _Pragma("unroll") for(int r=2;r<16;++r)sacc+=pB0[r]; _Pragma("unroll") for(int r=0;r<16;++r)sacc+=pB1[r]; l_reg+=sacc;
    pw0=(u32x4){PKW(pB0,0),PKW(pB0,2),PKW(pB0,4),PKW(pB0,6)};pw1=(u32x4){PKW(pB0,8),PKW(pB0,10),PKW(pB0,12),PKW(pB0,14)};pw2=(u32x4){PKW(pB1,0),PKW(pB1,2),PKW(pB1,4),PKW(pB1,6)};pw3=(u32x4){PKW(pB1,8),PKW(pB1,10),PKW(pB1,12),PKW(pB1,14)};
    SB128(); pv128(o,vb0+2*sl_cur,PAF(0),PAF(1),PAF(2),PAF(3)); }
  #undef PKW
  #undef PAF
  #undef VFR
  #undef WFR
  #undef PIN
  #undef GAPA
  #undef GAPB2
  #undef EX
  #undef VRD
  #undef WRD
  #undef KRD
  #undef STEP
  #undef ENDW
  {auto rr=__builtin_amdgcn_permlane32_swap(__float_as_uint(l_reg),__float_as_uint(l_reg),false,false);l_reg=__uint_as_float(rr[0])+__uint_as_float(rr[1]);}
  if(hi==0)wsf[32+r32]=l_reg;asm volatile("s_waitcnt lgkmcnt(0)":::"memory");
  float rli[16];
  #pragma unroll
  for(int r=0;r<16;++r)rli[r]=__builtin_amdgcn_rcpf(wsf[32+crow(r,hi)]);
  bf16*Ow=O+(rowbase+q0+wid*QBLK)*DM;
  { bf16*stg=(bf16*)(shm+L2_OST)+wid*2048;
    #pragma unroll
    for(int hh=0;hh<2;++hh){
      #pragma unroll
      for(int r=0;r<16;++r){const int orow=crow(r,hi);
        #pragma unroll
        for(int d0=0;d0<2;++d0)stg[orow*64+d0*32+r32]=__float2bfloat16(o[2*hh+d0][r]*rli[r]);}
      asm volatile("s_waitcnt lgkmcnt(0)":::"memory");
      #pragma unroll
      for(int i=0;i<4;++i){const int row=i*8+(lane>>3),ch=lane&7; const u32x4 v=*(const u32x4*)(stg+row*64+ch*8); ATTN_STORE16(Ow+(long)row*DM+hh*64+ch*8,v);}
      asm volatile("s_waitcnt lgkmcnt(0)":::"memory");
    } }
  asm volatile("s_waitcnt lgkmcnt(0)\n\ts_barrier":::"memory");
  #undef DMA_K
  #undef DMA_V
  #undef ROT
}
struct Diff128Order {
  int vcu,G,blk;
  __device__ __forceinline__ explicit Diff128Order(int grid,int block):vcu((block%8)*(grid/8)+block/8),G(grid),blk(block){}
  __device__ __forceinline__ bool next(int i,int&pair,int&qb)const{
    if(G==256){ if(i>=8)return false; pair=(vcu>>5)*16+2*i+((vcu>>4)&1); qb=vcu&15; return true; }
    const int L=i*G+blk; if(L>=2048)return false; pair=L>>4; qb=L&15; return true; }
};
__device__ __forceinline__ void diff128_phase(char*lds,const bf16*QB,const bf16*KB,const bf16*VB,bf16*O1,bf16*O2,const Diff128Order&S){
  int pair,qb;
  for(int i=0;S.next(i,pair,qb);++i){ const int m=pair&1,h=(pair>>1)&7,b=pair>>4;
    attn128_unit(b,qb,QB+h*128+m*64,KB+h*128+m*64,VB+h*128,(m?O2:O1)+h*128,lds); }
}

__device__ __forceinline__ void dil_unit(int b,int head,int dsh,int r,int chunk,const bf16*QA,const bf16*__restrict__ KA,const bf16*__restrict__ VA,bf16*OG,float*LS,char*shm){
  constexpr int PA=768;
  const int tid=threadIdx.x,lane=tid&63,r32=lane&31,hi=lane>>5; const int wid=__builtin_amdgcn_readfirstlane(tid>>6);
  const int L=SEQ>>dsh, j0=chunk<<8, jb=j0-64;
  const long tok0=(long)b*SEQ+r;
  const unsigned lds0=(unsigned)(uintptr_t)shm;
  float*wsf=(float*)(shm+LDS_WS)+wid*64;
  const bf16*Kc=KA+head*64+wid*8; const bf16*Vc=VA+head*64+(wid>>2)*32+(lane&3)*8;
  const int vrow=16*(wid&3)+(lane>>2);
  const unsigned kdst=lds0+LDS_K+wid*1024, vdst=lds0+LDS_V+wid*1024;
  #define CLAMPJ(x) ((x)<0?0:((x)>L-1?L-1:(x)))
  #define DMA_K(t,slot) do{ const int jj_=CLAMPJ(jb+64*(t)+lane); glds16(Kc+(tok0+((long)jj_<<dsh))*PA,(unsigned)__builtin_amdgcn_readfirstlane(kdst+(slot))); }while(0)
  #define DMA_V(t,slot) do{ const int jj_=CLAMPJ(jb+64*(t)+vrow); glds16(Vc+(tok0+((long)jj_<<dsh))*PA,(unsigned)__builtin_amdgcn_readfirstlane(vdst+(slot))); }while(0)
  const int vb0=(int)(lds0+LDS_V)+((lane>>4)&1)*32+(lane&3)*8+(4*hi+((lane&15)>>2))*64;
  const char*Kbase=shm+LDS_K; bf16x8 kf[8];
  const lds_cptr shm3=(lds_cptr)shm; const lds_cptr kp0=shm3+LDS_K+hi*1024+r32*16; const lds_cptr vp0=shm3+LDS_V+((lane>>4)&1)*32+(lane&3)*8+(4*hi+((lane&15)>>2))*64;
  constexpr int NT=6;
  DMA_K(0,0);DMA_V(0,0);DMA_K(1,SLOTB);
  const int jq=j0+wid*QBLK+r32;
  const bf16*Qw=QA+(tok0+((long)jq<<dsh))*PA+head*64;
  bf16x8 qr[4];
  #pragma unroll
  for(int d0=0;d0<4;++d0)qr[d0]=*reinterpret_cast<const bf16x8*>(&Qw[d0*16+hi*8]);
  float l_reg=0.f;f32x16 o[2];o[0]=f32x16{};o[1]=f32x16{};
  const f32x16 zero=f32x16{};
  #define DMASK(P0,P1,t) do{ const int kb_=jb+64*(t)+4*hi; \
    _Pragma("unroll") for(int r_=0;r_<16;++r_){ const int k0_=kb_+(r_&3)+8*(r_>>2), k1_=k0_+32; \
      const bool v0_=(k0_>=jq-64)&&(k0_<=jq+64)&&(k0_>=0)&&(k0_<L), v1_=(k1_>=jq-64)&&(k1_<=jq+64)&&(k1_>=0)&&(k1_<L); \
      P0[r_]=v0_?P0[r_]:-INFINITY; P1[r_]=v1_?P1[r_]:-INFINITY; } }while(0)
  f32x16 pA0,pA1,pB0,pB1;
  int sl_prev=0,sl_cur=0,sl_next=SLOTB;
  #define ROT() do{sl_prev=sl_cur;sl_cur=sl_next;sl_next=(sl_next==(NSLOT-1)*SLOTB)?0:sl_next+SLOTB;}while(0)
  DMA_K(2,2*SLOTB);
  WAIT_BAR(3);
  qkt(pA0,pA1,Kbase,qr,zero,r32,hi);
  DMASK(pA0,pA1,0);
  _Pragma("unroll") for(int r=0;r<16;++r){pA0[r]=__builtin_amdgcn_exp2f(pA0[r]);pA1[r]=__builtin_amdgcn_exp2f(pA1[r]);}
  WAIT_BAR(0);
  DMA_K(3,0);DMA_V(1,SLOTB);
  ROT();
  kload8(kf,kp0+sl_cur);
  WAIT_BAR(2);
  s16x4 vlo[8],vhi[8]; u32x4 pw0,pw1,pw2,pw3;
  #define PKW(P,B) cvtpk_s(P[B],P[B+1])
  #define PAF(k) __builtin_bit_cast(bf16x8,pw##k)
  #define VFR(i) (bf16x8){vlo[i][0],vlo[i][1],vlo[i][2],vlo[i][3],vhi[i][0],vhi[i][1],vhi[i][2],vhi[i][3]}
  #define PIN(x) asm volatile("":"+v"(x))
  #define GAPA(MF,A0,A1,A2,A3,W0,W1,PW) do{ MF; sacc+=A0; sacc+=A1; sacc+=A2; sacc+=A3; PIN(sacc); W0; W1; PIN(PW); SBAR(); }while(0)
  #define EX(v) __builtin_amdgcn_exp2f(v)
  #define GAPB(MF,X,B) do{ MF; X[B]=EX(X[B]); X[B+1]=EX(X[B+1]); X[B+2]=EX(X[B+2]); X[B+3]=EX(X[B+3]); PIN(X); SBAR(); }while(0)
  #define VRD(i) do{ vlo[i]=vtr(vp_+(((i)>>2)*4096+((i)&3)*1024)); vhi[i]=vtr(vp_+(((i)>>2)*4096+((i)&3)*1024+512)); }while(0)
  #define KRD(G,j) do{ if(G){ kload2(kf,kp0+sl_next,j); SBAR(); } }while(0)
  #define STEP(C0,C1,P0,P1,t,GK,GV,GL) do{ SBAR(); \
    const lds_cptr vp_=vp0+sl_prev; \
    VRD(0); SBAR(); float sacc=(P0[0]+P0[1]); \
    GAPA(C0=__builtin_amdgcn_mfma_f32_32x32x16_bf16(kf[0],qr[0],zero,0,0,0), P0[2],P0[3],P0[4],P0[5],     pw0[0]=PKW(P0,0), pw0[1]=PKW(P0,2), pw0); \
    VRD(4); SBAR(); GAPA(C1=__builtin_amdgcn_mfma_f32_32x32x16_bf16(kf[1],qr[0],zero,0,0,0), P0[6],P0[7],P0[8],P0[9],     pw0[2]=PKW(P0,4), pw0[3]=PKW(P0,6), pw0); \
    VRD(1); SBAR(); GAPA(C0=__builtin_amdgcn_mfma_f32_32x32x16_bf16(kf[2],qr[1],C0,0,0,0),   P0[10],P0[11],P0[12],P0[13], pw1[0]=PKW(P0,8), pw1[1]=PKW(P0,10), pw1); \
    VRD(5); SBAR(); GAPA(C1=__builtin_amdgcn_mfma_f32_32x32x16_bf16(kf[3],qr[1],C1,0,0,0),   P0[14],P0[15],P1[0],P1[1],   pw1[2]=PKW(P0,12),pw1[3]=PKW(P0,14), pw1); \
    VRD(2); SBAR(); GAPA(C0=__builtin_amdgcn_mfma_f32_32x32x16_bf16(kf[4],qr[2],C0,0,0,0),   P1[2],P1[3],P1[4],P1[5],     pw2[0]=PKW(P1,0), pw2[1]=PKW(P1,2), pw2); \
    VRD(6); SBAR(); GAPA(C1=__builtin_amdgcn_mfma_f32_32x32x16_bf16(kf[5],qr[2],C1,0,0,0),   P1[6],P1[7],P1[8],P1[9],     pw2[2]=PKW(P1,4), pw2[3]=PKW(P1,6), pw2); \
    VRD(3); SBAR(); GAPA(C0=__builtin_amdgcn_mfma_f32_32x32x16_bf16(kf[6],qr[3],C0,0,0,0),   P1[10],P1[11],P1[12],P1[13], pw3[0]=PKW(P1,8), pw3[1]=PKW(P1,10), pw3); \
    VRD(7); SBAR(); GAPA(C1=__builtin_amdgcn_mfma_f32_32x32x16_bf16(kf[7],qr[3],C1,0,0,0),   P1[14],P1[15],0.f,0.f,       pw3[2]=PKW(P1,12),pw3[3]=PKW(P1,14), pw3); \
    l_reg+=sacc; \
    if(GK){DMA_K((t)+3,sl_cur);} if(GV){DMA_V((t)+1,sl_next);} \
    DMASK(C0,C1,t); \
    SBAR(); \
    GAPB(o[0]=__builtin_amdgcn_mfma_f32_32x32x16_bf16(PAF(0),VFR(0),o[0],0,0,0), C0,0); \
    GAPB(o[1]=__builtin_amdgcn_mfma_f32_32x32x16_bf16(PAF(0),VFR(4),o[1],0,0,0), C0,4); \
    KRD(GL,0); GAPB(o[0]=__builtin_amdgcn_mfma_f32_32x32x16_bf16(PAF(1),VFR(1),o[0],0,0,0), C0,8); \
    KRD(GL,1); GAPB(o[1]=__builtin_amdgcn_mfma_f32_32x32x16_bf16(PAF(1),VFR(5),o[1],0,0,0), C0,12); \
    KRD(GL,2); GAPB(o[0]=__builtin_amdgcn_mfma_f32_32x32x16_bf16(PAF(2),VFR(2),o[0],0,0,0), C1,0); \
    KRD(GL,3); GAPB(o[1]=__builtin_amdgcn_mfma_f32_32x32x16_bf16(PAF(2),VFR(6),o[1],0,0,0), C1,4); \
    GAPB(o[0]=__builtin_amdgcn_mfma_f32_32x32x16_bf16(PAF(3),VFR(3),o[0],0,0,0), C1,8); \
    GAPB(o[1]=__builtin_amdgcn_mfma_f32_32x32x16_bf16(PAF(3),VFR(7),o[1],0,0,0), C1,12); \
    }while(0)
  #define ENDW(tt) do{ if((tt)+3<NT){WAIT_BAR(2);} else if((tt)+2<NT){WAIT_BAR(1);} else {WAIT_BAR(0);} }while(0)
  STEP(pB0,pB1,pA0,pA1,1,true,true,true);    ENDW(1); ROT();
  STEP(pA0,pA1,pB0,pB1,2,true,true,true);    ENDW(2); ROT();
  STEP(pB0,pB1,pA0,pA1,3,false,true,true);   ENDW(3); ROT();
  STEP(pA0,pA1,pB0,pB1,4,false,true,true);   ENDW(4); ROT();
  STEP(pB0,pB1,pA0,pA1,5,false,false,false);
  { float sacc=pB0[0]+pB0[1]; _Pragma("unroll") for(int r=2;r<16;++r)sacc+=pB0[r]; _Pragma("unroll") for(int r=0;r<16;++r)sacc+=pB1[r]; l_reg+=sacc;
    pw0=(u32x4){PKW(pB0,0),PKW(pB0,2),PKW(pB0,4),PKW(pB0,6)};pw1=(u32x4){PKW(pB0,8),PKW(pB0,10),PKW(pB0,12),PKW(pB0,14)};pw2=(u32x4){PKW(pB1,0),PKW(pB1,2),PKW(pB1,4),PKW(pB1,6)};pw3=(u32x4){PKW(pB1,8),PKW(pB1,10),PKW(pB1,12),PKW(pB1,14)};
    SBAR(); pv(o,vb0+sl_cur,PAF(0),PAF(1),PAF(2),PAF(3)); }
  #undef PKW
  #undef PAF
  #undef VFR
  #undef PIN
  #undef GAPA
  #undef GAPB
  #undef EX
  #undef VRD
  #undef KRD
  #undef STEP
  #undef ENDW
  #undef DMASK
  {auto rr=__builtin_amdgcn_permlane32_swap(__float_as_uint(l_reg),__float_as_uint(l_reg),false,false);l_reg=__uint_as_float(rr[0])+__uint_as_float(rr[1]);}
  if(hi==0)wsf[32+r32]=l_reg;asm volatile("s_waitcnt lgkmcnt(0)":::"memory");
  float rli[16];
  #pragma unroll
  for(int r=0;r<16;++r)rli[r]=__builtin_amdgcn_rcpf(wsf[32+crow(r,hi)]);
  const int gidx=dsh>>1, hslot=head&3;
  { bf16*stg=(bf16*)(shm+LDS_OST)+wid*2048;
    #pragma unroll
    for(int r=0;r<16;++r){const int orow=crow(r,hi);
      #pragma unroll
      for(int d0=0;d0<2;++d0)stg[orow*64+d0*32+r32]=__float2bfloat16(o[d0][r]*rli[r]);}
    asm volatile("s_waitcnt lgkmcnt(0)":::"memory");
    #pragma unroll
    for(int i=0;i<4;++i){const int row=i*8+(lane>>3),ch=lane&7; const u32x4 v=*(const u32x4*)(stg+row*64+ch*8);
      const long tk=tok0+((long)(j0+wid*QBLK+row)<<dsh); ATTN_STORE16(OG+((long)gidx*(BATCH*SEQ)+tk)*256+hslot*64+ch*8,v);} }
  if(hi==0){ const long tk=tok0+((long)jq<<dsh); LS[((long)gidx*(BATCH*SEQ)+tk)*4+hslot]=__builtin_amdgcn_logf(l_reg); }
  asm volatile("s_waitcnt lgkmcnt(0)\n\ts_barrier":::"memory");
  #undef DMA_K
  #undef DMA_V
  #undef CLAMPJ
  #undef ROT
}
__device__ __forceinline__ void dil_phase(char*lds,const bf16*QA,const bf16*KA,const bf16*VA,bf16*OG,float*LS,int vcu,int G){
  for(int u=vcu;u<1536;u+=G){ const int rc=u&15,bh=u>>4,head=bh%12,b=bh/12,g=head>>2; const int dsh=2*g,L=SEQ>>dsh,nchunk=L>>8; const int r=rc/nchunk,chunk=rc%nchunk;
    dil_unit(b,head,dsh,r,chunk,QA,KA,VA,OG,LS,lds); }
}
constexpr float VT8_SCALE=8.0f;
typedef int v8i32a __attribute__((ext_vector_type(8)));
typedef int v4i32a __attribute__((ext_vector_type(4)));
typedef short v2i16a __attribute__((ext_vector_type(2)));
#if defined(PROBE_DMA)
  #define PROBE_DMA_HOOK(t) do{ glds16(ksrc+(long)(t)*KVBLK*DM,(unsigned)__builtin_amdgcn_readfirstlane(lds0+118784+wid*1024)); }while(0)
#else
  #define PROBE_DMA_HOOK(t) do{}while(0)
#endif
#ifndef DMA_POS
#define DMA_POS 1
#endif
#define DMA_AT(pos,GK,GV,t) do{ if((pos)==DMA_POS){ if(GK){DMA_K((t)+3,sl_cur);} if(GV){DMA_V((t)+1,sl_next);} } else if(DMA_POS==3&&(pos)==1){ if(GK){DMA_K((t)+3,sl_cur);} } }while(0)
#ifndef STAMP_TID
#define STAMP_TID 0
#endif
#if defined(PROBE_STAMP)
  #define STAMP(k) do{ __builtin_amdgcn_sched_barrier(0); unsigned long long t_; asm volatile("s_memtime %0\n\ts_waitcnt lgkmcnt(0)":"=s"(t_)::"memory"); __builtin_amdgcn_sched_barrier(0); \
      if((k)==1) segA+=t_-tprev; else if((k)==2) segB+=t_-tprev; else if((k)==3) segW+=t_-tprev; else if((k)==4) segX+=t_-tprev; tprev=t_; }while(0)
  #define WAIT_BAR2(N) do{ asm volatile("s_waitcnt vmcnt(" #N ") lgkmcnt(0)":::"memory"); STAMP(3); asm volatile("s_barrier":::"memory"); STAMP(4); }while(0)
#else
  #define STAMP(k) do{}while(0)
  #define WAIT_BAR2(N) WAIT_BAR(N)
#endif
template<bool FINAL> __device__ __forceinline__ void attn128f8_unit(int b,int qb,const bf16*Q,const bf16*__restrict__ K,const unsigned char*__restrict__ VT,bf16*O,float pscale,char*shm,const bf16*O1=nullptr,float lam=0.f,const float*subg=nullptr,float*stampout=nullptr){
  const int tid=threadIdx.x,lane=tid&63,r32=lane&31,hi=lane>>5; const int wid=__builtin_amdgcn_readfirstlane(tid>>6);
  const long rowbase=(long)b*SEQ; const int q0=qb*QB;
#if defined(PROBE_STAMP)
  unsigned long long segA=0,segB=0,segW=0,segX=0,tprev=0;
#endif
  const bf16*Qw=Q+(rowbase+q0+wid*QBLK)*DM;
  const bf16*Kh=K+rowbase*DM;
  const unsigned lds0=(unsigned)(uintptr_t)shm;
  float*wsf=(float*)(shm+LDS_WS)+wid*64;
  const int krow_=8*wid+(lane>>3);
  const bf16*ksrc=Kh+(long)krow_*DM+(((lane&7)^((krow_>>1)&7))*8);
  const int vrow_=16*wid+(lane>>2);
  const unsigned char*vsrc=VT+(long)vrow_*64+(((lane&3)^((vrow_>>2)&3))*16);
  const unsigned kdst=lds0+LDS_K+wid*1024, vdst=lds0+LDS_V+wid*1024;
  #define DMA_K(t,slot) glds16(ksrc+(long)(t)*KVBLK*DM,(unsigned)__builtin_amdgcn_readfirstlane(kdst+(slot)))
  #define DMA_V(t,slot) glds16(vsrc+(long)(t)*8192,(unsigned)__builtin_amdgcn_readfirstlane(vdst+(slot)))
  bf16x8 kf[8];
  const lds_cptr shm3=(lds_cptr)shm;
  const int kx_=(r32>>1)&7; const lds_cptr kq0=shm3+LDS_K+r32*128+(((0+hi)^kx_)*16),kq1=shm3+LDS_K+r32*128+(((2+hi)^kx_)*16),kq2=shm3+LDS_K+r32*128+(((4+hi)^kx_)*16),kq3=shm3+LDS_K+r32*128+(((6+hi)^kx_)*16);
  #define KLD(j,base,so) do{ kf[2*(j)]=*(const __attribute__((address_space(3))) bf16x8*)((base)+(so)); kf[2*(j)+1]=*(const __attribute__((address_space(3))) bf16x8*)((base)+(so)+4096); }while(0)
  const int vx_=(r32>>2)&3; const lds_cptr vq0=shm3+LDS_V+r32*64+(((2*hi)^vx_)*16), vq1=shm3+LDS_V+r32*64+(((2*hi+1)^vx_)*16);
  const int NT=SEQ/KVBLK;
  DMA_K(0,0);DMA_V(0,0);DMA_K(1,SLOTB);
  bf16x8 qr[4];
  #pragma unroll
  for(int d0=0;d0<4;++d0)qr[d0]=*reinterpret_cast<const bf16x8*>(&Qw[(long)r32*DM+d0*16+hi*8]);
  float l_reg=0.f;f32x16 o[4];o[0]=f32x16{};o[1]=f32x16{};o[2]=f32x16{};o[3]=f32x16{};
  const f32x16 zero=f32x16{};
  f32x16 pA0,pA1,pB0,pB1;
  int sl_prev=0,sl_cur=0,sl_next=SLOTB;
  #define ROT() do{sl_prev=sl_cur;sl_cur=sl_next;sl_next=(sl_next==(NSLOT-1)*SLOTB)?0:sl_next+SLOTB;}while(0)
  DMA_K(2,2*SLOTB);
  WAIT_BAR(3);
  KLD(0,kq0,0);KLD(1,kq1,0);KLD(2,kq2,0);KLD(3,kq3,0);
  pA0=__builtin_amdgcn_mfma_f32_32x32x16_bf16(kf[0],qr[0],zero,0,0,0);pA1=__builtin_amdgcn_mfma_f32_32x32x16_bf16(kf[1],qr[0],zero,0,0,0);
  _Pragma("unroll") for(int d0=1;d0<4;++d0){pA0=__builtin_amdgcn_mfma_f32_32x32x16_bf16(kf[2*d0],qr[d0],pA0,0,0,0);pA1=__builtin_amdgcn_mfma_f32_32x32x16_bf16(kf[2*d0+1],qr[d0],pA1,0,0,0);}
  _Pragma("unroll") for(int r=0;r<16;++r){pA0[r]=__builtin_amdgcn_exp2f(pA0[r]);pA1[r]=__builtin_amdgcn_exp2f(pA1[r]);}
  WAIT_BAR(0);
  DMA_K(3,0);DMA_V(1,SLOTB);
  ROT();
  KLD(0,kq0,sl_cur);KLD(1,kq1,sl_cur);KLD(2,kq2,sl_cur);KLD(3,kq3,sl_cur);
  WAIT_BAR(2);
  v8i32a vf[4]; v8i32a p8; int mxone=0x7F7F7F7F; asm volatile("":"+v"(mxone));
  #define P8CVT(P,B) __builtin_bit_cast(int,__builtin_amdgcn_cvt_scalef32_pk_fp8_f32(__builtin_amdgcn_cvt_scalef32_pk_fp8_f32((v2i16a){0,0},P[B],P[(B)+1],pscale,false),P[(B)+2],P[(B)+3],pscale,true))
  #define PIN(x) asm volatile("":"+v"(x))
  #define GAPA8(MF,A0,A1,A2,A3,W) do{ MF; sacc+=A0; sacc+=A1; sacc+=A2; sacc+=A3; PIN(sacc); W; SB128(); }while(0)
  #define EX(v) __builtin_amdgcn_exp2f(v)
  #define GAPB8(MF,X,B) do{ MF; X[B]=EX(X[B]); X[B+1]=EX(X[B+1]); X[B+2]=EX(X[B+2]); X[B+3]=EX(X[B+3]); X[B+4]=EX(X[B+4]); X[B+5]=EX(X[B+5]); X[B+6]=EX(X[B+6]); X[B+7]=EX(X[B+7]); PIN(X); SB128(); }while(0)
  #define VRDA(i) do{ const v4i32a t_=*(const __attribute__((address_space(3))) v4i32a*)(vq0+sl_prev+(i)*2048); vf[i][0]=t_[0];vf[i][1]=t_[1];vf[i][2]=t_[2];vf[i][3]=t_[3]; }while(0)
  #define VRDB(i) do{ const v4i32a t_=*(const __attribute__((address_space(3))) v4i32a*)(vq1+sl_prev+(i)*2048); vf[i][4]=t_[0];vf[i][5]=t_[1];vf[i][6]=t_[2];vf[i][7]=t_[3]; }while(0)
  #define VF8(i) vf[i]
  #define P8V() p8
  #define PVMF(i) asm volatile("s_nop 3\n\tv_mfma_scale_f32_32x32x64_f8f6f4 %0, %1, %2, %0, %3, %3 op_sel_hi:[0,0,0]":"+v"(o[i]):"v"(P8V()),"v"(VF8(i)),"v"(mxone))
  #define KRD(G,j) do{ if(G){ KLD(j,kq##j,sl_next); SB128(); } }while(0)
#if defined(A128_COARSE)
  #define STEP(C0,C1,P0,P1,t,GK,GV,GL) do{ SB128(); STAMP(0); \
    C0=__builtin_amdgcn_mfma_f32_32x32x16_bf16(kf[0],qr[0],zero,0,0,0); C1=__builtin_amdgcn_mfma_f32_32x32x16_bf16(kf[1],qr[0],zero,0,0,0); \
    C0=__builtin_amdgcn_mfma_f32_32x32x16_bf16(kf[2],qr[1],C0,0,0,0);   C1=__builtin_amdgcn_mfma_f32_32x32x16_bf16(kf[3],qr[1],C1,0,0,0); \
    C0=__builtin_amdgcn_mfma_f32_32x32x16_bf16(kf[4],qr[2],C0,0,0,0);   C1=__builtin_amdgcn_mfma_f32_32x32x16_bf16(kf[5],qr[2],C1,0,0,0); \
    C0=__builtin_amdgcn_mfma_f32_32x32x16_bf16(kf[6],qr[3],C0,0,0,0);   C1=__builtin_amdgcn_mfma_f32_32x32x16_bf16(kf[7],qr[3],C1,0,0,0); \
    SB128(); \
    VRDA(0);VRDB(0);VRDA(1);VRDB(1);VRDA(2);VRDB(2);VRDA(3);VRDB(3); \
    { float sacc=(P0[0]+P0[1]),sacd=(P1[0]+P1[1]); \
      _Pragma("unroll") for(int r_=2;r_<16;++r_){ sacc+=P0[r_]; sacd+=P1[r_]; } \
      l_reg+=sacc+sacd; } \
    p8[0]=P8CVT(P0,0);p8[1]=P8CVT(P0,4);p8[2]=P8CVT(P0,8);p8[3]=P8CVT(P0,12);p8[4]=P8CVT(P1,0);p8[5]=P8CVT(P1,4);p8[6]=P8CVT(P1,8);p8[7]=P8CVT(P1,12); \
    STAMP(1); SB128(); \
    PVMF(0);PVMF(1);PVMF(2);PVMF(3); \
    SB128(); \
    _Pragma("unroll") for(int r_=0;r_<16;++r_){ C0[r_]=EX(C0[r_]); C1[r_]=EX(C1[r_]); } \
    if(GL){ KLD(0,kq0,sl_next);KLD(1,kq1,sl_next);KLD(2,kq2,sl_next);KLD(3,kq3,sl_next); } \
    if(GK){DMA_K((t)+3,sl_cur);} if(GV){DMA_V((t)+1,sl_next);} \
    STAMP(2); SB128(); \
    }while(0)
#else
  #define STEP(C0,C1,P0,P1,t,GK,GV,GL) do{ SB128(); STAMP(0); \
    if(DMA_POS==3){ if(GV){DMA_V((t)+1,sl_next);} } \
    VRDA(0); SB128(); float sacc=(P0[0]+P0[1]); \
    GAPA8(C0=__builtin_amdgcn_mfma_f32_32x32x16_bf16(kf[0],qr[0],zero,0,0,0), P0[2],P0[3],P0[4],P0[5],     p8[0]=P8CVT(P0,0)); \
    VRDB(0); SB128(); GAPA8(C1=__builtin_amdgcn_mfma_f32_32x32x16_bf16(kf[1],qr[0],zero,0,0,0), P0[6],P0[7],P0[8],P0[9],     p8[1]=P8CVT(P0,4)); \
    VRDA(1); SB128(); GAPA8(C0=__builtin_amdgcn_mfma_f32_32x32x16_bf16(kf[2],qr[1],C0,0,0,0),   P0[10],P0[11],P0[12],P0[13], p8[2]=P8CVT(P0,8)); \
    VRDB(1); SB128(); GAPA8(C1=__builtin_amdgcn_mfma_f32_32x32x16_bf16(kf[3],qr[1],C1,0,0,0),   P0[14],P0[15],P1[0],P1[1],   p8[3]=P8CVT(P0,12)); \
    VRDA(2); SB128(); GAPA8(C0=__builtin_amdgcn_mfma_f32_32x32x16_bf16(kf[4],qr[2],C0,0,0,0),   P1[2],P1[3],P1[4],P1[5],     p8[4]=P8CVT(P1,0)); \
    VRDB(2); SB128(); GAPA8(C1=__builtin_amdgcn_mfma_f32_32x32x16_bf16(kf[5],qr[2],C1,0,0,0),   P1[6],P1[7],P1[8],P1[9],     p8[5]=P8CVT(P1,4)); \
    VRDA(3); SB128(); GAPA8(C0=__builtin_amdgcn_mfma_f32_32x32x16_bf16(kf[6],qr[3],C0,0,0,0),   P1[10],P1[11],P1[12],P1[13], p8[6]=P8CVT(P1,8)); \
    VRDB(3); SB128(); GAPA8(C1=__builtin_amdgcn_mfma_f32_32x32x16_bf16(kf[7],qr[3],C1,0,0,0),   P1[14],P1[15],0.f,0.f,       p8[7]=P8CVT(P1,12)); \
    l_reg+=sacc; STAMP(1); \
    PROBE_DMA_HOOK(t); DMA_AT(0,GK,GV,t); \
    SB128(); \
    GAPB8(PVMF(0), C0,0); \
    KRD(GL,0); KRD(GL,1); GAPB8(PVMF(1), C0,8); \
    KRD(GL,2); KRD(GL,3); GAPB8(PVMF(2), C1,0); DMA_AT(1,GK,GV,t); \
    GAPB8(PVMF(3), C1,8); DMA_AT(2,GK,GV,t); STAMP(2); \
    }while(0)
#endif
#if defined(A128_PRIO)
  if(wid>=4) __builtin_amdgcn_s_setprio(A128_PRIO);
#endif
  int t=1;
  for(;t+5<NT;t+=2){
    STEP(pB0,pB1,pA0,pA1,t,true,true,true);     WAIT_BAR2(2); ROT();
    STEP(pA0,pA1,pB0,pB1,t+1,true,true,true);   WAIT_BAR2(2); ROT();
  }
  #define ENDW(tt) do{ if((tt)+3<NT){WAIT_BAR(2);} else if((tt)+2<NT){WAIT_BAR(1);} else {WAIT_BAR(0);} }while(0)
  for(;t+1<NT;t+=2){
    STEP(pB0,pB1,pA0,pA1,t,(t+3<NT),(t+1<NT),(t+1<NT));       ENDW(t);   ROT();
    STEP(pA0,pA1,pB0,pB1,t+1,(t+4<NT),(t+2<NT),(t+2<NT));     ENDW(t+1); ROT();
  }
  STEP(pB0,pB1,pA0,pA1,NT-1,false,false,false);
  { float sacc=pB0[0]+pB0[1]; _Pragma("unroll") for(int r=2;r<16;++r)sacc+=pB0[r]; _Pragma("unroll") for(int r=0;r<16;++r)sacc+=pB1[r]; l_reg+=sacc;
    p8[0]=P8CVT(pB0,0);p8[1]=P8CVT(pB0,4);p8[2]=P8CVT(pB0,8);p8[3]=P8CVT(pB0,12);p8[4]=P8CVT(pB1,0);p8[5]=P8CVT(pB1,4);p8[6]=P8CVT(pB1,8);p8[7]=P8CVT(pB1,12);
    sl_prev=sl_cur;
    VRDA(0);VRDB(0);VRDA(1);VRDB(1);VRDA(2);VRDB(2);VRDA(3);VRDB(3);
    PVMF(0);PVMF(1);PVMF(2);PVMF(3); asm volatile("s_nop 15\n\ts_nop 15":"+v"(o[0]),"+v"(o[1]),"+v"(o[2]),"+v"(o[3])); }
  #undef P8CVT
  #undef PIN
  #undef GAPA8
  #undef GAPB8
  #undef EX
  #undef VRDA
  #undef VRDB
  #undef VF8
  #undef P8V
  #undef PVMF
  #undef KRD
  #undef KLD
  #undef STEP
  #undef ENDW
#if defined(A128_PRIO)
  __builtin_amdgcn_s_setprio(0);
#endif
  {auto rr=__builtin_amdgcn_permlane32_swap(__float_as_uint(l_reg),__float_as_uint(l_reg),false,false);l_reg=__uint_as_float(rr[0])+__uint_as_float(rr[1]);}
  if(hi==0)wsf[32+r32]=l_reg*(VT8_SCALE/pscale);asm volatile("s_waitcnt lgkmcnt(0)":::"memory");
  float rli[16];
  #pragma unroll
  for(int r=0;r<16;++r)rli[r]=__builtin_amdgcn_rcpf(wsf[32+crow(r,hi)]);
  bf16*Ow=O+(rowbase+q0+wid*QBLK)*DM;
  if constexpr(!FINAL){
  { bf16*stg=(bf16*)(shm+LDS_OST)+wid*4096;
    #pragma unroll
    for(int hh=0;hh<2;++hh){
      #pragma unroll
      for(int r=0;r<16;++r){const int orow=crow(r,hi);
        #pragma unroll
        for(int d0=0;d0<2;++d0)stg[orow*64+d0*32+r32]=__float2bfloat16(o[2*hh+d0][r]*rli[r]);}
      asm volatile("s_waitcnt lgkmcnt(0)":::"memory");
      #pragma unroll
      for(int i=0;i<4;++i){const int row=i*8+(lane>>3),ch=lane&7; const u32x4 v=*(const u32x4*)(stg+row*64+ch*8); ATTN_STORE16(Ow+(long)row*DM+hh*64+ch*8,v);}
      asm volatile("s_waitcnt lgkmcnt(0)":::"memory");
    } }
  } else {
  { bf16*stg=(bf16*)(shm+LDS_OST)+wid*4096;
    #pragma unroll
    for(int r=0;r<16;++r){const int orow=crow(r,hi);
      #pragma unroll
      for(int d0=0;d0<4;++d0)stg[orow*128+d0*32+r32]=__float2bfloat16(o[d0][r]*rli[r]);}
    asm volatile("s_waitcnt lgkmcnt(0)":::"memory");
    const float*subg2=subg; const bf16*O1b=O1; float lam2=lam; asm volatile("":"+s"(subg2),"+s"(O1b),"+v"(lam2));
    const int ch=lane&15; float sg[8];
    #pragma unroll
    for(int e=0;e<8;++e)sg[e]=subg2[ch*8+e]*0.8f;
    const bf16*O1w=O1b+(rowbase+q0+wid*QBLK)*DM;
    #pragma unroll 1
    for(int i=0;i<8;++i){const int row=i*4+(lane>>4);
      const u32x4 a2=*(const u32x4*)(stg+row*128+ch*8); const u32x4 a1=*(const u32x4*)(O1w+(long)row*DM+ch*8);
      float v[8]; const unsigned w1[4]={a1.x,a1.y,a1.z,a1.w},w2[4]={a2.x,a2.y,a2.z,a2.w};
      #pragma unroll
      for(int e=0;e<4;++e){ v[2*e]=__uint_as_float(w1[e]<<16)-lam2*__uint_as_float(w2[e]<<16); v[2*e+1]=__uint_as_float(w1[e]&0xffff0000u)-lam2*__uint_as_float(w2[e]&0xffff0000u); }
      float ss=0.f;
      #pragma unroll
      for(int e=0;e<8;++e)ss+=v[e]*v[e];
      ss+=__shfl_xor(ss,1);ss+=__shfl_xor(ss,2);ss+=__shfl_xor(ss,4);ss+=__shfl_xor(ss,8);
      const float rstd=1.f/sqrtf(ss*(1.f/128.f)+1e-6f);
      u32x4 wo; wo.x=cvtpk_s(v[0]*rstd*sg[0],v[1]*rstd*sg[1]); wo.y=cvtpk_s(v[2]*rstd*sg[2],v[3]*rstd*sg[3]); wo.z=cvtpk_s(v[4]*rstd*sg[4],v[5]*rstd*sg[5]); wo.w=cvtpk_s(v[6]*rstd*sg[6],v[7]*rstd*sg[7]);
      ATTN_STORE16(Ow+(long)row*DM+ch*8,wo); if(i&1) asm volatile("":::"memory"); }
    asm volatile("s_waitcnt lgkmcnt(0)":::"memory");
  }
  }
#if defined(PROBE_STAMP)
  if(blockIdx.x==0&&tid==STAMP_TID&&stampout){ stampout[0]+=(float)segA; stampout[1]+=(float)segB; stampout[2]+=(float)segW; stampout[3]+=(float)segX; }
#endif
  asm volatile("s_waitcnt lgkmcnt(0)\n\ts_barrier":::"memory");
  #undef DMA_K
  #undef DMA_V
  #undef ROT
}
#ifndef Q8_OLDDMA
#define Q8_OLDDMA 0
#endif
__device__ __forceinline__ void glds16_old(const void*gsrc,unsigned lds_dst,int wid){unsigned keep;
  asm volatile("s_cmp_lt_u32 %3, 4\n\ts_cbranch_scc0 1f\n\ts_mov_b32 %0, m0\n\ts_mov_b32 m0, %2\n\ts_nop 0\n\tglobal_load_lds_dwordx4 %1, off\n\ts_mov_b32 m0, %0\n1:":"=&s"(keep):"v"(gsrc),"s"(lds_dst),"s"(wid):"memory","scc");}
constexpr int Q8_KSLOT=8192  , Q8_LDS_K=0, Q8_LDS_V=3*Q8_KSLOT, Q8_LDS_WS=Q8_LDS_V+3*8192, Q8_LDS_OST=Q8_LDS_WS+NW*64*4;
template<bool FINAL> __device__ __forceinline__ void attn128q8_unit(int b,int qb,const unsigned char*Q8,const unsigned char*__restrict__ K8,const unsigned char*__restrict__ VT,bf16*O,float pscale,char*shm,const bf16*O1=nullptr,float lam=0.f,const float*subg=nullptr){
  const int tid=threadIdx.x,lane=tid&63,r32=lane&31,hi=lane>>5; const int wid=__builtin_amdgcn_readfirstlane(tid>>6);
  const long rowbase=(long)b*SEQ; const int q0=qb*QB;
  const unsigned lds0=(unsigned)(uintptr_t)shm;
  float*wsf=(float*)(shm+Q8_LDS_WS)+wid*64;
#if Q8_OLDDMA
  const int krow_=16*(wid&3)+(lane>>2);
  const unsigned char*ksrc=K8+(rowbase+krow_)*DM+(((lane&3)^((krow_>>2)&3))*16);
  const int vrow_=16*(wid&3)+(lane>>2);
#else
  const int krow_=16*(wid&3)+(lane>>2);
  const unsigned char*ksrc=K8+(rowbase+(wid>>2)*64+krow_)*DM+(((lane&3)^((krow_>>2)&3))*16);
  const int vrow_=16*wid+(lane>>2);
#endif
  const unsigned char*vsrc=VT+(long)vrow_*64+(((lane&3)^((vrow_>>2)&3))*16);
#if Q8_OLDDMA
  const unsigned kdst=lds0+Q8_LDS_K+(wid&3)*1024, vdst=lds0+Q8_LDS_V+(wid&3)*1024;
#else
  const unsigned kdst=lds0+Q8_LDS_K+wid*1024, vdst=lds0+Q8_LDS_V+wid*1024;
#endif
#if Q8_OLDDMA
  #define DMA_KD(dbl,slot) do{ glds16_old(ksrc+(long)(dbl)*(2*KVBLK)*DM,(unsigned)__builtin_amdgcn_readfirstlane(kdst+(slot)),wid); glds16_old(ksrc+(long)(dbl)*(2*KVBLK)*DM+(long)KVBLK*DM,(unsigned)__builtin_amdgcn_readfirstlane(kdst+(slot)+4096),wid); }while(0)
  #define DMA_V(t,slot) do{ glds16_old(vsrc+(long)(t)*8192,(unsigned)__builtin_amdgcn_readfirstlane(vdst+(slot)),wid); glds16_old(vsrc+(long)(t)*8192+4096,(unsigned)__builtin_amdgcn_readfirstlane(vdst+(slot)+4096),wid); }while(0)
  #define WB_(a,b) WAIT_BAR(b)
#else
  #define DMA_KD(dbl,slot) glds16(ksrc+(long)(dbl)*(2*KVBLK)*DM,(unsigned)__builtin_amdgcn_readfirstlane(kdst+(slot)))
  #define DMA_V(t,slot) glds16(vsrc+(long)(t)*8192,(unsigned)__builtin_amdgcn_readfirstlane(vdst+(slot)))
  #define WB_(a,b) WAIT_BAR(a)
#endif
  const lds_cptr shm3=(lds_cptr)shm;
  const int vx_=(r32>>2)&3;
  const lds_cptr kq0=shm3+Q8_LDS_K+r32*64+(((2*hi)^vx_)*16), kq1=shm3+Q8_LDS_K+r32*64+(((2*hi+1)^vx_)*16);
  const lds_cptr vq0=shm3+Q8_LDS_V+r32*64+(((2*hi)^vx_)*16), vq1=shm3+Q8_LDS_V+r32*64+(((2*hi+1)^vx_)*16);
  constexpr int NT=SEQ/KVBLK;
  DMA_KD(0,0);DMA_V(0,0);DMA_KD(1,SLOTB);
  v8i32a qf;
  { const unsigned char*qp=Q8+(rowbase+q0+wid*QBLK+r32)*DM+hi*32; const v4i32a a_=*(const v4i32a*)qp, b_=*(const v4i32a*)(qp+16);
    qf[0]=a_[0];qf[1]=a_[1];qf[2]=a_[2];qf[3]=a_[3];qf[4]=b_[0];qf[5]=b_[1];qf[6]=b_[2];qf[7]=b_[3]; }
  float l_reg=0.f;f32x16 o[4];o[0]=f32x16{};o[1]=f32x16{};o[2]=f32x16{};o[3]=f32x16{};
  f32x16 pA0,pA1,pB0,pB1;
  int sl_prev=0,sl_cur=0,sl_next=SLOTB;
  #define ROT() do{sl_prev=sl_cur;sl_cur=sl_next;sl_next=(sl_next==(NSLOT-1)*SLOTB)?0:sl_next+SLOTB;}while(0)
  v8i32a kfa,kfb,vf[4],p8; int mxone=0x7F7F7F7F,mxk=0x7B7B7B7B,mxq=0x79797979; asm volatile("":"+v"(mxone),"+v"(mxk),"+v"(mxq));
  #define KLD8(so) do{ const v4i32a a_=*(const __attribute__((address_space(3))) v4i32a*)(kq0+(so)), b_=*(const __attribute__((address_space(3))) v4i32a*)(kq1+(so)), \
      c_=*(const __attribute__((address_space(3))) v4i32a*)(kq0+(so)+2048), d_=*(const __attribute__((address_space(3))) v4i32a*)(kq1+(so)+2048); \
      kfa[0]=a_[0];kfa[1]=a_[1];kfa[2]=a_[2];kfa[3]=a_[3];kfa[4]=b_[0];kfa[5]=b_[1];kfa[6]=b_[2];kfa[7]=b_[3]; kfb[0]=c_[0];kfb[1]=c_[1];kfb[2]=c_[2];kfb[3]=c_[3];kfb[4]=d_[0];kfb[5]=d_[1];kfb[6]=d_[2];kfb[7]=d_[3]; }while(0)
#if defined(Q8_PRIO)
  #define QKMF(C,KF) asm volatile("s_setprio 1\n\ts_nop 1\n\tv_mfma_scale_f32_32x32x64_f8f6f4 %0, %1, %2, 0, %3, %4 op_sel_hi:[0,0,0]\n\ts_setprio 0":"=&v"(C):"v"(KF),"v"(qf),"v"(mxk),"v"(mxq))
#else
  #define QKMF(C,KF) asm volatile("s_nop 1\n\tv_mfma_scale_f32_32x32x64_f8f6f4 %0, %1, %2, 0, %3, %4 op_sel_hi:[0,0,0]":"=&v"(C):"v"(KF),"v"(qf),"v"(mxk),"v"(mxq))
#endif
  WAIT_BAR(0);
  KLD8(0);
  QKMF(pA0,kfa);QKMF(pA1,kfb);
  asm volatile("s_nop 15\n\ts_nop 15":"+v"(pA0),"+v"(pA1));
  _Pragma("unroll") for(int r=0;r<16;++r){pA0[r]=__builtin_amdgcn_exp2f(pA0[r]);pA1[r]=__builtin_amdgcn_exp2f(pA1[r]);}
  DMA_KD(2,2*SLOTB);DMA_V(1,SLOTB);
  ROT();
  KLD8(4096);
  WB_(2,4);
  int kcur=SLOTB,kprev=0,knext=2*SLOTB;
  v2i16a p8undef_;
  #define P8CVT(P,B) __builtin_bit_cast(int,__builtin_amdgcn_cvt_scalef32_pk_fp8_f32(__builtin_amdgcn_cvt_scalef32_pk_fp8_f32(p8undef_,P[B],P[(B)+1],pscale,false),P[(B)+2],P[(B)+3],pscale,true))
  #define EX(v) __builtin_amdgcn_exp2f(v)
  #define VRDA(i) do{ const v4i32a t_=*(const __attribute__((address_space(3))) v4i32a*)(vq0+sl_prev+(i)*2048); vf[i][0]=t_[0];vf[i][1]=t_[1];vf[i][2]=t_[2];vf[i][3]=t_[3]; }while(0)
  #define VRDB(i) do{ const v4i32a t_=*(const __attribute__((address_space(3))) v4i32a*)(vq1+sl_prev+(i)*2048); vf[i][4]=t_[0];vf[i][5]=t_[1];vf[i][6]=t_[2];vf[i][7]=t_[3]; }while(0)
#if defined(Q8_PRIO)
  #define PVMF(i) asm volatile("s_setprio 1\n\ts_nop 3\n\tv_mfma_scale_f32_32x32x64_f8f6f4 %0, %1, %2, %0, %3, %3 op_sel_hi:[0,0,0]\n\ts_setprio 0":"+v"(o[i]):"v"(p8),"v"(vf[i]),"v"(mxone))
#else
  #define PVMF(i) asm volatile("s_nop 3\n\tv_mfma_scale_f32_32x32x64_f8f6f4 %0, %1, %2, %0, %3, %3 op_sel_hi:[0,0,0]":"+v"(o[i]):"v"(p8),"v"(vf[i]),"v"(mxone))
#endif
  #define EX8(X,B) do{ X[B]=EX(X[B]); X[B+1]=EX(X[B+1]); X[B+2]=EX(X[B+2]); X[B+3]=EX(X[B+3]); X[B+4]=EX(X[B+4]); X[B+5]=EX(X[B+5]); X[B+6]=EX(X[B+6]); X[B+7]=EX(X[B+7]); }while(0)
  #define STEP(C0,C1,P0,P1,t,KOFF,GK,KD,GV,GL) do{ SB128(); \
    QKMF(C0,kfa); \
    VRDA(0);VRDB(0);VRDA(1);VRDB(1); \
    { float sacc=(P0[0]+P0[1]); _Pragma("unroll") for(int r_=2;r_<16;++r_) sacc+=P0[r_]; l_reg+=sacc; } \
    p8[0]=P8CVT(P0,0);p8[1]=P8CVT(P0,4);p8[2]=P8CVT(P0,8);p8[3]=P8CVT(P0,12); SB128(); \
    QKMF(C1,kfb); \
    VRDA(2);VRDB(2);VRDA(3);VRDB(3); \
    { float sacc=(P1[0]+P1[1]); _Pragma("unroll") for(int r_=2;r_<16;++r_) sacc+=P1[r_]; l_reg+=sacc; } \
    p8[4]=P8CVT(P1,0);p8[5]=P8CVT(P1,4);p8[6]=P8CVT(P1,8);p8[7]=P8CVT(P1,12); SB128(); \
    PVMF(0); asm volatile("s_nop 7":"+v"(C0),"+v"(C1)); EX8(C0,0); SB128(); \
    PVMF(1); EX8(C0,8); if(GL){ KLD8(KOFF); } SB128(); \
    PVMF(2); EX8(C1,0); if(GK){DMA_KD(KD,kprev);} if(GV){DMA_V((t)+1,sl_next);} SB128(); \
    PVMF(3); EX8(C1,8); SB128(); \
    }while(0)
  #define KROT() do{ const int o_=kprev; kprev=kcur; kcur=knext; knext=o_; }while(0)
  int t=1;
  for(;t+5<NT;t+=2){
    STEP(pB0,pB1,pA0,pA1,t,  kcur,     false,0,          true,true);   WB_(1,2); ROT();
    STEP(pA0,pA1,pB0,pB1,t+1,kcur+4096,true,((t+1)>>1)+2,true,true);   WB_(2,4); ROT(); KROT();
  }
  STEP(pB0,pB1,pA0,pA1,t,  kcur,     false,0,true,true);   WB_(1,2); ROT();
  STEP(pA0,pA1,pB0,pB1,t+1,kcur+4096,false,0,true,true);   WB_(1,2); ROT(); KROT();
  STEP(pB0,pB1,pA0,pA1,t+2,kcur,     false,0,true,true);   WB_(1,2); ROT();
  STEP(pA0,pA1,pB0,pB1,t+3,kcur+4096,false,0,true,true);   WAIT_BAR(0); ROT(); KROT();
  STEP(pB0,pB1,pA0,pA1,NT-1,0,false,0,false,false);
  { float sacc=pB0[0]+pB0[1]; _Pragma("unroll") for(int r=2;r<16;++r)sacc+=pB0[r]; _Pragma("unroll") for(int r=0;r<16;++r)sacc+=pB1[r]; l_reg+=sacc;
    p8[0]=P8CVT(pB0,0);p8[1]=P8CVT(pB0,4);p8[2]=P8CVT(pB0,8);p8[3]=P8CVT(pB0,12);p8[4]=P8CVT(pB1,0);p8[5]=P8CVT(pB1,4);p8[6]=P8CVT(pB1,8);p8[7]=P8CVT(pB1,12);
    sl_prev=sl_cur;
    VRDA(0);VRDB(0);VRDA(1);VRDB(1);VRDA(2);VRDB(2);VRDA(3);VRDB(3);
    PVMF(0);PVMF(1);PVMF(2);PVMF(3); asm volatile("s_nop 15\n\ts_nop 15":"+v"(o[0]),"+v"(o[1]),"+v"(o[2]),"+v"(o[3])); }
  #undef P8CVT
  #undef EX
  #undef EX8
  #undef VRDA
  #undef VRDB
  #undef PVMF
  #undef QKMF
  #undef KLD8
  #undef STEP
  #undef KROT
  {auto rr=__builtin_amdgcn_permlane32_swap(__float_as_uint(l_reg),__float_as_uint(l_reg),false,false);l_reg=__uint_as_float(rr[0])+__uint_as_float(rr[1]);}
  if(hi==0)wsf[32+r32]=l_reg*(VT8_SCALE/pscale);asm volatile("s_waitcnt lgkmcnt(0)":::"memory");
  float rli[16];
  #pragma unroll
  for(int r=0;r<16;++r)rli[r]=__builtin_amdgcn_rcpf(wsf[32+crow(r,hi)]);
  bf16*Ow=O+(rowbase+q0+wid*QBLK)*DM;
  if constexpr(!FINAL){
  { bf16*stg=(bf16*)(shm+Q8_LDS_OST)+wid*4096;
    #pragma unroll
    for(int hh=0;hh<2;++hh){
      #pragma unroll
      for(int r=0;r<16;++r){const int orow=crow(r,hi);
        #pragma unroll
        for(int d0=0;d0<2;++d0)stg[orow*64+d0*32+r32]=__float2bfloat16(o[2*hh+d0][r]*rli[r]);}
      asm volatile("s_waitcnt lgkmcnt(0)":::"memory");
      #pragma unroll
      for(int i=0;i<4;++i){const int row=i*8+(lane>>3),ch=lane&7; const u32x4 v=*(const u32x4*)(stg+row*64+ch*8); ATTN_STORE16(Ow+(long)row*DM+hh*64+ch*8,v);}
      asm volatile("s_waitcnt lgkmcnt(0)":::"memory");
    } }
  } else {
  { bf16*stg=(bf16*)(shm+Q8_LDS_OST)+wid*4096;
    #pragma unroll
    for(int r=0;r<16;++r){const int orow=crow(r,hi);
      #pragma unroll
      for(int d0=0;d0<4;++d0)stg[orow*128+d0*32+r32]=__float2bfloat16(o[d0][r]*rli[r]);}
    asm volatile("s_waitcnt lgkmcnt(0)":::"memory");
    const float*subg2=subg; const bf16*O1b=O1; float lam2=lam; asm volatile("":"+s"(subg2),"+s"(O1b),"+v"(lam2));
    const int ch=lane&15; float sg[8];
    #pragma unroll
    for(int e=0;e<8;++e)sg[e]=subg2[ch*8+e]*0.8f;
    const bf16*O1w=O1b+(rowbase+q0+wid*QBLK)*DM;
    #pragma unroll 1
    for(int i=0;i<8;++i){const int row=i*4+(lane>>4);
      const u32x4 a2=*(const u32x4*)(stg+row*128+ch*8); const u32x4 a1=*(const u32x4*)(O1w+(long)row*DM+ch*8);
      float v[8]; const unsigned w1[4]={a1.x,a1.y,a1.z,a1.w},w2[4]={a2.x,a2.y,a2.z,a2.w};
      #pragma unroll
      for(int e=0;e<4;++e){ v[2*e]=__uint_as_float(w1[e]<<16)-lam2*__uint_as_float(w2[e]<<16); v[2*e+1]=__uint_as_float(w1[e]&0xffff0000u)-lam2*__uint_as_float(w2[e]&0xffff0000u); }
      float ss=0.f;
      #pragma unroll
      for(int e=0;e<8;++e)ss+=v[e]*v[e];
      ss+=__shfl_xor(ss,1);ss+=__shfl_xor(ss,2);ss+=__shfl_xor(ss,4);ss+=__shfl_xor(ss,8);
      const float rstd=1.f/sqrtf(ss*(1.f/128.f)+1e-6f);
      u32x4 wo; wo.x=cvtpk_s(v[0]*rstd*sg[0],v[1]*rstd*sg[1]); wo.y=cvtpk_s(v[2]*rstd*sg[2],v[3]*rstd*sg[3]); wo.z=cvtpk_s(v[4]*rstd*sg[4],v[5]*rstd*sg[5]); wo.w=cvtpk_s(v[6]*rstd*sg[6],v[7]*rstd*sg[7]);
      ATTN_STORE16(Ow+(long)row*DM+ch*8,wo); }
    asm volatile("s_waitcnt lgkmcnt(0)":::"memory");
  }
  }
  asm volatile("s_waitcnt lgkmcnt(0)\n\ts_barrier":::"memory");
  #undef DMA_KD
  #undef DMA_V
  #undef WB_
  #undef ROT
}
struct DiffFusedOrder {
  int vcu,G,blk;
  __device__ __forceinline__ explicit DiffFusedOrder(int grid,int block):vcu((block%8)*(grid/8)+block/8),G(grid),blk(block){}
  __device__ __forceinline__ bool next(int i,int&bh,int&qb)const{
    if(G==256){ if(i>=4)return false; bh=(vcu>>5)*8+2*i+((vcu>>4)&1); qb=vcu&15; return true; }
    const int L=i*G+blk; if(L>=1024)return false; bh=L>>4; qb=L&15; return true; }
};
__device__ __forceinline__ void diff128f8_phase(char*lds,const bf16*QB,const bf16*KB,const unsigned char*VT8,bf16*O1,bf16*OB,float pscale,float lam,const float*subg,const DiffFusedOrder&S,float*stampout=nullptr){
  int bh,qb;
  for(int i=0;S.next(i,bh,qb);++i){ const int h=bh&7,b=bh>>3;
    attn128f8_unit<false>(b,qb,QB+h*128,KB+h*128,VT8+(size_t)bh*(64*8192),O1+h*128,pscale,lds,nullptr,0.f,nullptr,stampout); }
  asm volatile("s_waitcnt vmcnt(0)":::"memory");
  for(int i=0;S.next(i,bh,qb);++i){ const int h=bh&7,b=bh>>3;
    attn128f8_unit<true>(b,qb,QB+h*128+64,KB+h*128+64,VT8+(size_t)bh*(64*8192),OB+h*128,pscale,lds,O1+h*128,lam,subg); }
}
__device__ __forceinline__ void diff128q8_phase(char*lds,const unsigned char*Q8,const unsigned char*K8,const unsigned char*VT8,bf16*O1,bf16*OB,float pscale,float lam,const float*subg,const DiffFusedOrder&S){
  int bh,qb;
  for(int i=0;S.next(i,bh,qb);++i){ const int h=bh&7,b=bh>>3;
    attn128q8_unit<false>(b,qb,Q8+h*128,K8+h*128,VT8+(size_t)bh*(64*8192),O1+h*128,pscale,lds); }
  asm volatile("s_waitcnt vmcnt(0)":::"memory");
  for(int i=0;S.next(i,bh,qb);++i){ const int h=bh&7,b=bh>>3;
    attn128q8_unit<true>(b,qb,Q8+h*128+64,K8+h*128+64,VT8+(size_t)bh*(64*8192),OB+h*128,pscale,lds,O1+h*128,lam,subg); }
}
constexpr int ATTN_LDS_BYTES=LDS_BYTES;
struct AttnUnit { int pair; int qb; };
struct DiffOrder {
  int vcu,G,blk;
  __device__ __forceinline__ explicit DiffOrder(int grid,int block):vcu((block%8)*(grid/8)+block/8),G(grid),blk(block){}
  __device__ __forceinline__ bool next(int i,AttnUnit&u)const{
    if(G==256){ if(i>=16)return false; u.pair=(vcu&~31)+2*i+((vcu>>4)&1); u.qb=vcu&15; return true; }
    const int L=i*G+blk; if(L>=4096)return false; u.pair=L>>4; u.qb=L&15; return true; }
};
template<int THRL=8> __device__ __forceinline__ void diff_attn_phase(char*lds,const bf16*QB,const bf16*KB,const bf16*VB,bf16*O1,bf16*O2,const DiffOrder&S){
  AttnUnit u;
  for(int i=0;S.next(i,u);++i){ const int b=u.pair>>5,vh=u.pair&31,h=vh>>2,m=(vh>>1)&1,c=vh&1;
    attn_unit<THRL>(b,0,u.qb,QB+h*128+m*64,KB+h*128+m*64,VB+h*128+c*64,(m?O2:O1)+h*128+c*64,lds); }
}
#undef SBAR
#undef WAIT_BAR
}

constexpr int NWAVES = 8;
constexpr size_t MiB = 1u << 20;
constexpr size_t WS_CTL = 0, CTL_ZERO_BYTES = 1 * MiB;
constexpr size_t WS_MOD = 1 * MiB;
constexpr int MOD_LAM = 8 * 6144;
constexpr size_t WS_WIN = 2 * MiB, WS_WPA = 17 * MiB, WS_WPB = 18 * MiB, WS_WOUT = 20 * MiB, WS_WQ = 22 * MiB, WS_SK = 26 * MiB;
constexpr size_t WS_R1 = 32 * MiB;
constexpr size_t WS_QA = 96 * MiB, WS_KA = 144 * MiB, WS_VA = 192 * MiB;
constexpr size_t WS_O1 = 96 * MiB;
constexpr size_t WS_OB = 160 * MiB, WS_OA = 368 * MiB;
constexpr size_t WS_VT8 = 64 * MiB;
constexpr size_t WS_EU = 96 * MiB, WS_EV = 112 * MiB, WS_ESC = 128 * MiB;
constexpr size_t WS_QB = 240 * MiB, WS_KB = 304 * MiB, WS_VB = 368 * MiB;
constexpr size_t WS_MIX = 240 * MiB, WS_TMP = 304 * MiB;
constexpr size_t WS_QP = 240 * MiB;
constexpr size_t WS_OUTG = 432 * MiB, WS_LSE = 480 * MiB;
constexpr size_t WS_IDX = 432 * MiB, WS_GATE = 448 * MiB;
constexpr size_t WS_CS = 432 * MiB;
constexpr size_t WS_DELTA = 368 * MiB;
constexpr size_t WS_END = 512 * MiB;
constexpr int CW_TMO = 0, CW_BAR = 4096, CW_AMAX = 32768;
constexpr size_t WS_SA = 1 * MiB + 256 * 1024, WS_SW = 1 * MiB + 512 * 1024;
constexpr int RING_OFF = 0, RING_BYTES = 131072;
constexpr int LDSCTL_OFF = RING_BYTES, MISC_OFF = LDSCTL_OFF + 320;
constexpr int LDS_BYTES = 147456;
constexpr int N_PHASES = 13;

#define GAS __attribute__((address_space(1)))
#define LAS __attribute__((address_space(3)))
typedef unsigned short bf16;
typedef unsigned v4u __attribute__((ext_vector_type(4)));
typedef float f32x4 __attribute__((ext_vector_type(4)));
typedef short bf16x8 __attribute__((ext_vector_type(8)));
typedef GAS unsigned gu32;
typedef GAS unsigned long long gu64;
#define RLX_AGENT __ATOMIC_RELAXED, __HIP_MEMORY_SCOPE_AGENT
#define LDS_WAIT() asm volatile("s_waitcnt lgkmcnt(0)" ::: "memory")
#define VM_WAIT() asm volatile("s_waitcnt vmcnt(0)" ::: "memory")
__device__ __forceinline__ unsigned long long rt() { return __builtin_amdgcn_s_memrealtime(); }
__device__ __forceinline__ unsigned f2bf(float f) { unsigned u = __builtin_bit_cast(unsigned, f); return (u + 0x7fffu + ((u >> 16) & 1u)) >> 16; }
__device__ __forceinline__ unsigned pk2(float lo, float hi) { return f2bf(lo) | (f2bf(hi) << 16); }

#define XB_TMO      128
#define XB_XCNT(j)  (256  + 64 * (j))
#define XB_XSUB(j)  (1280 + 64 * (j))
#define XB_XGEN(j)  (2304 + 64 * (j))
#define XB_TOP      3328
#define XB_TOPGEN   3392
#define XCD_BAR_WORDS 3456
#define XB_SPIN_CAP (1u << 18)

__device__ __forceinline__ unsigned xb_ld(unsigned* p)              { return __hip_atomic_load(p, __ATOMIC_RELAXED, __HIP_MEMORY_SCOPE_AGENT); }
__device__ __forceinline__ unsigned xb_add(unsigned* p, unsigned v) { return __hip_atomic_fetch_add(p, v, __ATOMIC_RELAXED, __HIP_MEMORY_SCOPE_AGENT); }
__device__ __forceinline__ unsigned xb_xcc_id() { return (unsigned)__builtin_amdgcn_s_getreg((3 << 11) | 20) & 0xFu; }
#define XB_SPIN(cond, bar) do { unsigned _sp = 0; while (cond) { __builtin_amdgcn_s_sleep(1); \
    if ((++_sp & 255u) == 0u) { if (xb_ld(&(bar)[XB_TMO])) break; if (_sp > XB_SPIN_CAP) { atomicAdd(&(bar)[XB_TMO], 1u); break; } } } } while (0)

struct XcdBarrier {
    unsigned* bar; unsigned x;
    volatile LAS unsigned* st;
};

__device__ __forceinline__ XcdBarrier xcd_barrier_post(unsigned* bar, volatile LAS unsigned* st) {
    XcdBarrier b; b.bar = bar; b.x = xb_xcc_id(); b.st = st;
    if (threadIdx.x == 0) (void)xb_add(&bar[XB_XCNT(b.x)], 1u);
    return b;
}
__device__ __forceinline__ void xcd_barrier_complete(unsigned* bar, unsigned x, unsigned& nloc, unsigned& nx) {
    const unsigned G = gridDim.x * gridDim.y * gridDim.z;
    unsigned sum, cnt, mine, sp = 0u;
    for (;;) {
        sum = 0u; cnt = 0u; mine = 0u;
#pragma unroll
        for (unsigned j = 0; j < 16; ++j) { const unsigned c = xb_ld(&bar[XB_XCNT(j)]); sum += c; cnt += (c > 0u) ? 1u : 0u; mine = (j == x) ? c : mine; }
        if (sum == G) break;
        __builtin_amdgcn_s_sleep(1);
        if ((++sp & 255u) == 0u) { if (xb_ld(&bar[XB_TMO])) break; if (sp > XB_SPIN_CAP) { atomicAdd(&bar[XB_TMO], 1u); break; } }
    }
    nloc = mine > 0u ? mine : 1u; nx = cnt > 0u ? cnt : 1u;
}

__device__ __forceinline__ void xcd_barrier(const XcdBarrier& b) {
    asm volatile("s_waitcnt vmcnt(0)" ::: "memory");
    __syncthreads();
    if (threadIdx.x == 0) {
        unsigned* bar = b.bar;
        __builtin_amdgcn_s_waitcnt(0);
        unsigned nloc = b.st[0], nx = b.st[1];
        if (nloc == 0u) { xcd_barrier_complete(bar, b.x, nloc, nx); b.st[0] = nloc; b.st[1] = nx; }
        const unsigned old = xb_add(&bar[XB_XSUB(b.x)], 1u);
        const unsigned gen = old / nloc;
        if (old + 1u == (gen + 1u) * nloc) {
            __builtin_amdgcn_fence(__ATOMIC_RELEASE, "agent");
            asm volatile("s_waitcnt vmcnt(0)" ::: "memory");
            const unsigned og = xb_add(&bar[XB_TOP], 1u);
            const unsigned tg = og / nx;
            if (og + 1u == (tg + 1u) * nx) xb_add(&bar[XB_TOPGEN], 1u);
            else XB_SPIN(xb_ld(&bar[XB_TOPGEN]) == tg, bar);
            __builtin_amdgcn_fence(__ATOMIC_ACQUIRE, "agent");
            xb_add(&bar[XB_XGEN(b.x)], 1u);
            asm volatile("s_waitcnt vmcnt(0)" ::: "memory");
        } else {
            XB_SPIN(xb_ld(&bar[XB_XGEN(b.x)]) == gen, bar);
            __builtin_amdgcn_fence(__ATOMIC_ACQUIRE, "agent");
            asm volatile("s_waitcnt vmcnt(0)" ::: "memory");
        }
    }
    __syncthreads();
}
__device__ __forceinline__ float wave_sum(float v) {
#pragma unroll
    for (int o = 1; o < 64; o <<= 1) v += __shfl_xor(v, o);
    return v;
}
__device__ __forceinline__ void p0_transpose_item(const float* W, int K, int N, bf16* WT, int row_off, LAS float* scr, int item, int lane) {
    const int nblk = N / 32, kb = item / nblk, nb = item % nblk, k0 = 64 * kb, n0 = 32 * nb;
#pragma unroll 8
    for (int i = 0; i < 32; ++i) { const int kk = 2 * i + (lane >> 5); scr[kk * 33 + (lane & 31)] = W[(size_t)(k0 + kk) * N + n0 + (lane & 31)]; }
    LDS_WAIT(); asm volatile("" ::: "memory");
    const int c = lane & 7;
#pragma unroll
    for (int j = 0; j < 4; ++j) { const int n = (lane >> 3) + 8 * j; const LAS float* s = scr + (8 * c) * 33 + n;
        v4u o; o.x = pk2(s[0 * 33], s[1 * 33]); o.y = pk2(s[2 * 33], s[3 * 33]); o.z = pk2(s[4 * 33], s[5 * 33]); o.w = pk2(s[6 * 33], s[7 * 33]);
        *(GAS v4u*)(WT + (size_t)(row_off + n0 + n) * K + k0 + 8 * c) = o; }
    LDS_WAIT(); asm volatile("" ::: "memory");
}

typedef float f32x16 __attribute__((ext_vector_type(16)));
typedef unsigned u32x2 __attribute__((ext_vector_type(2)));
typedef __bf16 bf16x2v __attribute__((ext_vector_type(2)));
struct Frame {
    LAS unsigned char* lds;
    volatile LAS unsigned* MISC;
    gu32* ctl;
    int tid, lane, wave;
    int vcu, G;
};
struct Args { const void* in[25]; float* out; unsigned char* ws; int ph_lo, ph_hi, bar_region, pad; };

__device__ __forceinline__ float bflo(unsigned w) { return __uint_as_float(w << 16); }
__device__ __forceinline__ float bfhi(unsigned w) { return __uint_as_float(w & 0xffff0000u); }
__device__ __forceinline__ float dot2bf(unsigned a, unsigned b, float acc) { return __builtin_amdgcn_fdot2_f32_bf16(__builtin_bit_cast(bf16x2v, a), __builtin_bit_cast(bf16x2v, b), acc, false); }

__device__ __forceinline__ int win_slot(int col) {
    const int pn = col >> 8;
    if (pn < 6 || (pn >= 9 && pn < 17)) { const int within = col & 255; return pn * 256 + 128 * ((within >> 5) & 1) + 32 * (within >> 6) + (within & 31); }
    return col;
}
__device__ __forceinline__ void win_fp8_item(const float* W, const unsigned* amax, unsigned char* WT8, float* sW, LAS float* scr, int item, int lane) {
    constexpr int nblk = IN_W / 32; const int kb = item / nblk, nb = item % nblk, k0 = 64 * kb, n0 = 32 * nb;
#pragma unroll 8
    for (int i = 0; i < 32; ++i) { const int kk = 2 * i + (lane >> 5); scr[kk * 33 + (lane & 31)] = W[(size_t)(k0 + kk) * IN_W + n0 + (lane & 31)]; }
    LDS_WAIT(); asm volatile("" ::: "memory");
    const int n = lane >> 1, hf = lane & 1, slot = win_slot(n0 + n);
    const float am = __uint_as_float(amax[slot]); const float sc = am > 0.f ? 240.0f / am : 1.0f;
    const LAS float* sp = scr + (hf * 32) * 33 + n;
    unsigned w[8];
#pragma unroll
    for (int j = 0; j < 8; ++j) { int t = __builtin_amdgcn_cvt_pk_fp8_f32(sp[(4 * j) * 33] * sc, sp[(4 * j + 1) * 33] * sc, 0, false); t = __builtin_amdgcn_cvt_pk_fp8_f32(sp[(4 * j + 2) * 33] * sc, sp[(4 * j + 3) * 33] * sc, t, true); w[j] = (unsigned)t; }
    unsigned char* dp = WT8 + (size_t)slot * 1024 + k0 + hf * 32;
    *(GAS v4u*)dp = (v4u){w[0], w[1], w[2], w[3]}; *(GAS v4u*)(dp + 16) = (v4u){w[4], w[5], w[6], w[7]};
    if (kb == 0 && hf == 0) sW[slot] = am > 0.f ? am * (1.0f / 240.0f) : 1.0f;
    LDS_WAIT(); asm volatile("" ::: "memory");
}

__device__ __forceinline__ void p0_prologue(Frame& F, const Args& a) {
    float* modp = (float*)(a.ws + WS_MOD);
    {
        LAS float* sc = (LAS float*)F.lds;
        LAS float* red = (LAS float*)(F.lds + 32768);
        const float* c = (const float*)a.in[1]; const float* w_ada = (const float*)a.in[3]; const float* b_ada = (const float*)a.in[4];
        bool did = false;
        for (int u = F.vcu; u < 192; u += F.G) {
            if (!did) { for (int i = F.tid; i < 8192; i += NWAVES * 64) { const float v = c[i]; sc[i] = v / (1.f + __expf(-v)); } __syncthreads(); did = true; }
            const int cc = F.tid & 31, kg = F.tid >> 5, col = u * 32 + cc;
            float acc[8];
#pragma unroll
            for (int b = 0; b < 8; ++b) acc[b] = 0.f;
#pragma unroll 8
            for (int k = kg * 64; k < kg * 64 + 64; ++k) { const float w = w_ada[(size_t)k * 6144 + col];
#pragma unroll
                for (int b = 0; b < 8; ++b) acc[b] += sc[b * 1024 + k] * w; }
#pragma unroll
            for (int b = 0; b < 8; ++b) red[(kg * 8 + b) * 32 + cc] = acc[b];
            __syncthreads();
            if (F.tid < 256) { const int b = F.tid >> 5; float s = b_ada[col];
#pragma unroll
                for (int g = 0; g < 16; ++g) s += red[(g * 8 + b) * 32 + cc];
                modp[b * 6144 + col] = s; }
            __syncthreads();
        }
        if (F.vcu == F.G - 1 && F.wave == 0) {
            const float p1 = ((const float*)a.in[13])[F.lane] * ((const float*)a.in[14])[F.lane];
            const float p2 = ((const float*)a.in[15])[F.lane] * ((const float*)a.in[16])[F.lane];
            const float s1 = wave_sum(p1), s2 = wave_sum(p2);
            if (F.lane == 0) { modp[MOD_LAM] = expf(s1) - expf(s2) + LAM_INIT; modp[MOD_LAM + 16] = 0.f; modp[MOD_LAM + 17] = 0.f; modp[MOD_LAM + 18] = 0.f; modp[MOD_LAM + 19] = 0.f; modp[MOD_LAM + 24] = 0.f; modp[MOD_LAM + 25] = 0.f; }
        }
        __syncthreads();
    }
    { const float* w_in = (const float*)a.in[6]; unsigned* amax = (unsigned*)(a.ws + WS_CTL) + CW_AMAX;
      for (int u = F.vcu; u < 4 * (IN_W / 128); u += F.G) { const int cu = u % (IN_W / 128), kq = u / (IN_W / 128);
          const int col = cu * 128 + (F.tid & 127), kb = kq * 256 + (F.tid >> 7) * 64; float m = 0.f;
#pragma unroll 8
          for (int k = kb; k < kb + 64; ++k) m = fmaxf(m, fabsf(w_in[(size_t)k * IN_W + col]));
          atomicMax(amax + win_slot(col), __float_as_uint(m)); } }
    LAS float* scr = (LAS float*)(F.lds + RING_OFF + F.wave * 16384);
    const int gw = F.vcu * NWAVES + F.wave, NGW = F.G * NWAVES;
    constexpr int I_PA = (DIL_OUT / 64) * (D / 32), I_PB = (D / 64) * (D / 32), I_OUT = I_PB, I_Q = (D / 64) * (PEER_QW / 32);
    constexpr int NITEMS = I_PA + I_PB + I_OUT + I_Q;
    for (int it = gw; it < NITEMS; it += NGW) {
        int r = it;
        if (r < I_PA) { p0_transpose_item((const float*)a.in[10], DIL_OUT, D, (bf16*)(a.ws + WS_WPA), 0, scr, r, F.lane); continue; } r -= I_PA;
        if (r < I_PB) { p0_transpose_item((const float*)a.in[18], D, D, (bf16*)(a.ws + WS_WPB), 0, scr, r, F.lane); continue; } r -= I_PB;
        if (r < I_OUT) { p0_transpose_item((const float*)a.in[19], D, D, (bf16*)(a.ws + WS_WOUT), 0, scr, r, F.lane); continue; } r -= I_OUT;
        p0_transpose_item((const float*)a.in[21], D, PEER_QW, (bf16*)(a.ws + WS_WQ), 0, scr, r, F.lane);
    }
    { const float* sk = (const float*)a.in[22]; bf16* o = (bf16*)(a.ws + WS_SK);
      for (int i = (F.vcu * NWAVES * 64 + F.tid); i < 8 * 2 * 128 * 128 / 8; i += F.G * NWAVES * 64) {
          const f32x4 v0 = *(const GAS f32x4*)(sk + (size_t)i * 8), v1 = *(const GAS f32x4*)(sk + (size_t)i * 8 + 4);
          v4u w; w.x = pk2(v0.x, v0.y); w.y = pk2(v0.z, v0.w); w.z = pk2(v1.x, v1.y); w.w = pk2(v1.z, v1.w);
          const int row = i >> 4, grp = i & 15, hh = row >> 7, n = row & 127;
          const size_t dst = ((((size_t)hh * 4 + (n >> 5)) * 8 + (grp >> 1)) * 64 + (grp & 1) * 32 + (n & 31)) * 8;
          *(GAS v4u*)(o + dst) = w; } }
}

__device__ __forceinline__ void convert_bf16(Frame& F, const float* src, bf16* dst, size_t n8) {
    for (size_t i = (size_t)F.vcu * NWAVES * 64 + F.tid; i < n8; i += (size_t)F.G * NWAVES * 64) {
        const f32x4 v0 = *(const GAS f32x4*)(src + i * 8), v1 = *(const GAS f32x4*)(src + i * 8 + 4);
        v4u w; w.x = pk2(v0.x, v0.y); w.y = pk2(v0.z, v0.w); w.z = pk2(v1.x, v1.y); w.w = pk2(v1.z, v1.w);
        *(GAS v4u*)(dst + i * 8) = w; }
}

typedef float f32x2v __attribute__((ext_vector_type(2)));
__device__ __forceinline__ void convert_fp8_slices(Frame& F, const float* src, unsigned char* dst, float* scale) {
    const int gw = F.vcu * NWAVES + F.wave, NGW = F.G * NWAVES, l = F.lane;
    for (int e = gw; e < NEXP; e += NGW) {
        const GAS f32x4* rp = (const GAS f32x4*)(src + (size_t)e * 1024 + l * 16);
        const f32x4 v0 = rp[0], v1 = rp[1], v2 = rp[2], v3 = rp[3];
        float am = fmaxf(fmaxf(fmaxf(fabsf(v0.x), fabsf(v0.y)), fmaxf(fabsf(v0.z), fabsf(v0.w))), fmaxf(fmaxf(fabsf(v1.x), fabsf(v1.y)), fmaxf(fabsf(v1.z), fabsf(v1.w))));
        am = fmaxf(am, fmaxf(fmaxf(fmaxf(fabsf(v2.x), fabsf(v2.y)), fmaxf(fabsf(v2.z), fabsf(v2.w))), fmaxf(fmaxf(fabsf(v3.x), fabsf(v3.y)), fmaxf(fabsf(v3.z), fabsf(v3.w)))));
#pragma unroll
        for (int o = 1; o < 64; o <<= 1) am = fmaxf(am, __shfl_xor(am, o));
        const float sc = am > 0.f ? 256.0f / am : 1.0f;
        v4u w;
        { int t = __builtin_amdgcn_cvt_pk_fp8_f32(v0.x * sc, v0.y * sc, 0, false); t = __builtin_amdgcn_cvt_pk_fp8_f32(v0.z * sc, v0.w * sc, t, true); w.x = (unsigned)t; }
        { int t = __builtin_amdgcn_cvt_pk_fp8_f32(v1.x * sc, v1.y * sc, 0, false); t = __builtin_amdgcn_cvt_pk_fp8_f32(v1.z * sc, v1.w * sc, t, true); w.y = (unsigned)t; }
        { int t = __builtin_amdgcn_cvt_pk_fp8_f32(v2.x * sc, v2.y * sc, 0, false); t = __builtin_amdgcn_cvt_pk_fp8_f32(v2.z * sc, v2.w * sc, t, true); w.z = (unsigned)t; }
        { int t = __builtin_amdgcn_cvt_pk_fp8_f32(v3.x * sc, v3.y * sc, 0, false); t = __builtin_amdgcn_cvt_pk_fp8_f32(v3.z * sc, v3.w * sc, t, true); w.w = (unsigned)t; }
        *(GAS v4u*)(dst + ((size_t)(l >> 3) * NEXP + e) * 128 + (l & 7) * 16) = w;
        if (l == 0) scale[e] = am > 0.f ? am * (1.0f / 256.0f) : 1.0f;
    }
}

template <bool FP8OUT>
__device__ __forceinline__ void norm_mod_rows(Frame& F, const float* xin, const float* g, const float* modp, int sh_off, int sc_off, bf16* out, const int* positions = nullptr, float* CS = nullptr, float* sA = nullptr, const bf16* delta = nullptr) {
    const int gw = F.vcu * NWAVES + F.wave, NGW = F.G * NWAVES;
    f32x4 gg[4];
#pragma unroll
    for (int j = 0; j < 4; ++j) gg[j] = ((const GAS f32x4*)g)[F.lane + 64 * j];
    for (int m = gw; m < T; m += NGW) {
        const int b = m >> 12;
        const GAS f32x4* xr = (const GAS f32x4*)(xin + (size_t)m * D) + F.lane;
        f32x4 v[4]; float s = 0.f;
#pragma unroll
        for (int j = 0; j < 4; ++j) { v[j] = xr[64 * j];
            if (delta) { const u32x2 dl = *((const GAS u32x2*)(delta + (size_t)m * D) + F.lane + 64 * j); v[j].x += bflo(dl.x); v[j].y += bfhi(dl.x); v[j].z += bflo(dl.y); v[j].w += bfhi(dl.y); }
            s += (v[j].x * v[j].x + v[j].y * v[j].y) + (v[j].z * v[j].z + v[j].w * v[j].w); }
        const float rstd = 1.f / sqrtf(wave_sum(s) * (1.f / D) + EPS);
        const GAS f32x4* shp = (const GAS f32x4*)(modp + (size_t)b * 6144 + sh_off) + F.lane;
        const GAS f32x4* scp = (const GAS f32x4*)(modp + (size_t)b * 6144 + sc_off) + F.lane;
        GAS unsigned long long* o8 = (GAS unsigned long long*)(out + (size_t)m * D) + F.lane;
        if constexpr (FP8OUT) {
            f32x4 y[4]; float am = 0.f;
#pragma unroll
            for (int j = 0; j < 4; ++j) { const f32x4 sc = scp[64 * j], sh = shp[64 * j]; y[j] = v[j] * rstd * gg[j] * (sc + 1.0f) + sh;
                am = fmaxf(am, fmaxf(fmaxf(fabsf(y[j].x), fabsf(y[j].y)), fmaxf(fabsf(y[j].z), fabsf(y[j].w)))); }
#pragma unroll
            for (int o = 1; o < 64; o <<= 1) am = fmaxf(am, __shfl_xor(am, o));
            const float qs = am > 0.f ? 240.0f / am : 1.0f;
            GAS unsigned* o4 = (GAS unsigned*)((unsigned char*)out + (size_t)m * D) + F.lane;
#pragma unroll
            for (int j = 0; j < 4; ++j) { int t = __builtin_amdgcn_cvt_pk_fp8_f32(y[j].x * qs, y[j].y * qs, 0, false); t = __builtin_amdgcn_cvt_pk_fp8_f32(y[j].z * qs, y[j].w * qs, t, true); o4[64 * j] = (unsigned)t; }
            if (F.lane == 0) sA[m] = am > 0.f ? am * (1.0f / 240.0f) : 1.0f;
        } else {
#pragma unroll
        for (int j = 0; j < 4; ++j) { const f32x4 sc = scp[64 * j], sh = shp[64 * j];
            const f32x4 y = v[j] * rstd * gg[j] * (sc + 1.0f) + sh;
            o8[64 * j] = (unsigned long long)pk2(y.x, y.y) | ((unsigned long long)pk2(y.z, y.w) << 32); }
        }
        if (CS) {
            constexpr float L2T = 13.287712379549449f / 32.f;
            const int i = F.lane & 31; const float ang = (float)positions[m] * exp2f(-(float)i * L2T);
            float sn, cs; sincosf(ang, &sn, &cs);
            CS[(size_t)m * 64 + F.lane] = (F.lane < 32) ? cs : sn; }
    }
}

template <int NIT>
__device__ __forceinline__ void normrope_buf(bf16* base, int hq, int dd, const float (&g)[4], float c0, float s0, float c1, float s1, float qs) {
    unsigned lo[NIT], hi[NIT];
#pragma unroll
    for (int it = 0; it < NIT; ++it) { const bf16* p = base + (it * 4 + hq) * 64 + dd; lo[it] = *(const GAS unsigned*)p; hi[it] = *(const GAS unsigned*)(p + 32); }
#pragma unroll
    for (int it = 0; it < NIT; ++it) {
        const float x1a = bflo(lo[it]), x1b = bfhi(lo[it]), x2a = bflo(hi[it]), x2b = bfhi(hi[it]);
        float ss = (x1a * x1a + x1b * x1b) + (x2a * x2a + x2b * x2b);
        ss += __shfl_xor(ss, 1); ss += __shfl_xor(ss, 2); ss += __shfl_xor(ss, 4); ss += __shfl_xor(ss, 8);
        const float rstd = 1.f / sqrtf(ss * (1.f / 64.f) + EPS);
        const float y1a = x1a * rstd * g[0], y1b = x1b * rstd * g[1], y2a = x2a * rstd * g[2], y2b = x2b * rstd * g[3];
        const float o1a = (y1a * c0 - y2a * s0) * qs, o2a = (y2a * c0 + y1a * s0) * qs;
        const float o1b = (y1b * c1 - y2b * s1) * qs, o2b = (y2b * c1 + y1b * s1) * qs;
        bf16* p = base + (it * 4 + hq) * 64 + dd;
        *(GAS unsigned*)p = pk2(o1a, o1b); *(GAS unsigned*)(p + 32) = pk2(o2a, o2b);
    }
}
__device__ __forceinline__ void p3_normrope(Frame& F, const Args& a) {
    const int gw = F.vcu * NWAVES + F.wave, NGW = F.G * NWAVES;
    const int sub = F.lane & 15, hq = F.lane >> 4, dd = 2 * sub;
    bf16* QA = (bf16*)(a.ws + WS_QA); bf16* KA = (bf16*)(a.ws + WS_KA); bf16* QB = (bf16*)(a.ws + WS_QB); bf16* KB = (bf16*)(a.ws + WS_KB);
    const int* positions = (const int*)a.in[2];
    float g[4][4];
    { const float* gp[4] = {(const float*)a.in[8], (const float*)a.in[9], (const float*)a.in[11], (const float*)a.in[12]};
#pragma unroll
      for (int i = 0; i < 4; ++i) { g[i][0] = gp[i][dd]; g[i][1] = gp[i][dd + 1]; g[i][2] = gp[i][dd + 32]; g[i][3] = gp[i][dd + 33]; } }
    constexpr float L2T = 13.287712379549449f / 32.f;
    const float f0 = exp2f(-(float)dd * L2T), f1 = exp2f(-(float)(dd + 1) * L2T);
    for (int t = gw; t < T; t += NGW) {
        const float pos = (float)positions[t];
        float s0, c0, s1, c1; sincosf(pos * f0, &s0, &c0); sincosf(pos * f1, &s1, &c1);
        normrope_buf<3>(QA + (size_t)t * 768, hq, dd, g[0], c0, s0, c1, s1, QSCALE);
        normrope_buf<3>(KA + (size_t)t * 768, hq, dd, g[1], c0, s0, c1, s1, 1.0f);
        normrope_buf<4>(QB + (size_t)t * 1024, hq, dd, g[2], c0, s0, c1, s1, QSCALE);
        normrope_buf<4>(KB + (size_t)t * 1024, hq, dd, g[3], c0, s0, c1, s1, 1.0f);
    }
}

__device__ __forceinline__ void p4_dilated(Frame& F, const Args& a) {
    constexpr int ROWB = 144;
    const bf16* QA = (const bf16*)(a.ws + WS_QA); const bf16* KA = (const bf16*)(a.ws + WS_KA); const bf16* VA = (const bf16*)(a.ws + WS_VA);
    bf16* OUTG = (bf16*)(a.ws + WS_OUTG); float* LSE = (float*)(a.ws + WS_LSE);
    LAS unsigned char* Ks = F.lds; LAS unsigned char* Vs = F.lds + 384 * ROWB;
    const int tid = F.tid, l = F.lane, qi = F.wave * 32 + (l & 31), hf = l >> 5;
    for (int u = F.vcu; u < 1536; u += F.G) {
        const int rc = u & 15, bh = u >> 4, head = bh % 12, b = bh / 12, g = head >> 2, hslot = head & 3;
        const int dsh = 2 * g, L = SEQ >> dsh, nchunk = L >> 8;
        const int r = rc / nchunk, chunk = rc % nchunk, j0 = chunk << 8;
#pragma unroll
        for (int p = 0; p < 6; ++p) { const int row = p * 64 + (tid >> 3), ch = tid & 7, jj = j0 - 64 + row;
            v4u kv = (v4u){0u, 0u, 0u, 0u}, vv = (v4u){0u, 0u, 0u, 0u};
            if ((unsigned)jj < (unsigned)L) { const size_t tok = (size_t)b * SEQ + r + ((size_t)jj << dsh);
                kv = *(const GAS v4u*)(KA + tok * 768 + head * 64 + ch * 8); vv = *(const GAS v4u*)(VA + tok * 768 + head * 64 + ch * 8); }
            *(LAS v4u*)(Ks + row * ROWB + ch * 16) = kv; *(LAS v4u*)(Vs + row * ROWB + ch * 16) = vv; }
        const int j = j0 + qi; const size_t qtok = (size_t)b * SEQ + r + ((size_t)j << dsh);
        unsigned q[32];
#pragma unroll
        for (int c = 0; c < 8; ++c) { const v4u t4 = *(const GAS v4u*)(QA + qtok * 768 + head * 64 + c * 8); q[4 * c] = t4.x; q[4 * c + 1] = t4.y; q[4 * c + 2] = t4.z; q[4 * c + 3] = t4.w; }
        __syncthreads();
        float m = -INFINITY, lsum = 0.f; float o[64];
#pragma unroll
        for (int i = 0; i < 64; ++i) o[i] = 0.f;
        const int rowbase = qi + hf * 64, nk = 64 + hf;
        for (int kk = 0; kk < nk; ++kk) {
            const int row = rowbase + kk, jj = j0 - 64 + row;
            if ((unsigned)jj < (unsigned)L) {
                const LAS v4u* kp = (const LAS v4u*)(Ks + row * ROWB);
                float s0 = 0.f, s1 = 0.f, s2 = 0.f, s3 = 0.f;
#pragma unroll
                for (int c = 0; c < 8; ++c) { const v4u kv = kp[c]; s0 = dot2bf(kv.x, q[4 * c], s0); s1 = dot2bf(kv.y, q[4 * c + 1], s1); s2 = dot2bf(kv.z, q[4 * c + 2], s2); s3 = dot2bf(kv.w, q[4 * c + 3], s3); }
                const float s = (s0 + s1) + (s2 + s3);
                if (s > m + 8.f) { const float f = exp2f(m - s); lsum *= f;
#pragma unroll
                    for (int i = 0; i < 64; ++i) o[i] *= f;
                    m = s; }
                const float p = exp2f(s - m); lsum += p;
                const LAS v4u* vp = (const LAS v4u*)(Vs + row * ROWB);
#pragma unroll
                for (int c = 0; c < 8; ++c) { const v4u vv = vp[c];
                    o[8 * c + 0] += p * bflo(vv.x); o[8 * c + 1] += p * bfhi(vv.x); o[8 * c + 2] += p * bflo(vv.y); o[8 * c + 3] += p * bfhi(vv.y);
                    o[8 * c + 4] += p * bflo(vv.z); o[8 * c + 5] += p * bfhi(vv.z); o[8 * c + 6] += p * bflo(vv.w); o[8 * c + 7] += p * bfhi(vv.w); }
            }
        }
        const float mo = __shfl_xor(m, 32), M = fmaxf(m, mo);
        const float f = exp2f(m - M);
        float lt = lsum * f; lt += __shfl_xor(lt, 32);
        const float inv = 1.f / lt;
        unsigned pk[16];
#pragma unroll
        for (int i = 0; i < 32; i += 2) {
            float a0 = o[i] * f, a1 = o[i + 1] * f, b0 = o[32 + i] * f, b1 = o[33 + i] * f;
            a0 += __shfl_xor(a0, 32); a1 += __shfl_xor(a1, 32); b0 += __shfl_xor(b0, 32); b1 += __shfl_xor(b1, 32);
            pk[i >> 1] = hf ? pk2(b0 * inv, b1 * inv) : pk2(a0 * inv, a1 * inv);
        }
        bf16* op = OUTG + ((size_t)g * T + qtok) * 256 + hslot * 64 + hf * 32;
#pragma unroll
        for (int c = 0; c < 4; ++c) *(GAS v4u*)(op + c * 8) = (v4u){pk[4 * c], pk[4 * c + 1], pk[4 * c + 2], pk[4 * c + 3]};
        if (hf == 0) LSE[((size_t)g * T + qtok) * 4 + hslot] = M + log2f(lt);
        __syncthreads();
    }
}

__device__ __forceinline__ void p3_vt8(Frame& F, const Args& a) {
    const unsigned char* VB8 = (const unsigned char*)(a.ws + WS_VB); unsigned char* VT8 = (unsigned char*)(a.ws + WS_VT8);
    LAS unsigned char* img = F.lds + F.wave * 8192;
    const int l = F.lane;
    for (int u = F.vcu * NWAVES + F.wave; u < BATCH * 8 * 64; u += F.G * NWAVES) {
        const int tile = u & 63, bh = u >> 6, h = bh & 7, b = bh >> 3;
        const unsigned char* src = VB8 + ((size_t)b * SEQ + tile * 64) * 1024 + h * 128;
#pragma unroll
        for (int i = 0; i < 8; ++i) { const int key = i * 8 + (l >> 3), ch = l & 7;
            *(LAS v4u*)(img + key * 128 + ch * 16) = *(const GAS v4u*)(src + (size_t)key * 1024 + ch * 16); }
        LDS_WAIT(); asm volatile("" ::: "memory");
#pragma unroll
        for (int dd = 0; dd < 2; ++dd) { const int d = l + 64 * dd;
            unsigned w[16];
#pragma unroll
            for (int j = 0; j < 16; ++j) { unsigned x = 0;
#pragma unroll
                for (int e = 0; e < 4; ++e) { const int pp = 4 * j + e; const int key = 32 * ((pp >> 4) & 1) + 8 * ((pp & 15) >> 2) + 4 * (pp >> 5) + (pp & 3);
                    x |= (unsigned)img[key * 128 + d] << (8 * e); }
                w[j] = x; }
            unsigned char* dst = VT8 + ((size_t)bh * 64 + tile) * 8192 + d * 64;
#pragma unroll
            for (int c = 0; c < 4; ++c) *(GAS v4u*)(dst + c * 16) = (v4u){w[4 * c], w[4 * c + 1], w[4 * c + 2], w[4 * c + 3]}; }
        LDS_WAIT(); asm volatile("" ::: "memory");
    }
}

__device__ __forceinline__ void p6_combine(Frame& F, const Args& a) {
    const int gw = F.vcu * NWAVES + F.wave, NGW = F.G * NWAVES, l = F.lane;
    const bf16* OUTG = (const bf16*)(a.ws + WS_OUTG); const float* LSE = (const float*)(a.ws + WS_LSE);
    bf16* OA = (bf16*)(a.ws + WS_OA);
    for (int t = gw; t < T; t += NGW) {
        const int hslot = l >> 4, d4 = (l & 15) * 4;
        float ls[3];
#pragma unroll
        for (int g = 0; g < 3; ++g) ls[g] = LSE[((size_t)g * T + t) * 4 + hslot];
        const float M = fmaxf(fmaxf(ls[0], ls[1]), ls[2]);
        float acc0 = 0.f, acc1 = 0.f, acc2 = 0.f, acc3 = 0.f, wsum = 0.f;
#pragma unroll
        for (int g = 0; g < 3; ++g) { const float w = exp2f(ls[g] - M); wsum += w;
            const u32x2 v = *(const GAS u32x2*)(OUTG + ((size_t)g * T + t) * 256 + hslot * 64 + d4);
            acc0 += w * bflo(v.x); acc1 += w * bfhi(v.x); acc2 += w * bflo(v.y); acc3 += w * bfhi(v.y); }
        const float iw = 1.f / wsum;
        u32x2 w2; w2.x = pk2(acc0 * iw, acc1 * iw); w2.y = pk2(acc2 * iw, acc3 * iw);
        *(GAS u32x2*)(OA + (size_t)t * 256 + hslot * 64 + d4) = w2;
    }
}

#define CE_DESC(a, b) do { const float hi_ = fmaxf(a, b), lo_ = fminf(a, b); a = hi_; b = lo_; } while (0)
#define CE_ASC(a, b)  do { const float hi_ = fmaxf(a, b), lo_ = fminf(a, b); a = lo_; b = hi_; } while (0)
template <int N> __device__ __forceinline__ void bitonic_sort_desc(float (&v)[N]) {
#pragma unroll
    for (int k = 2; k <= N; k <<= 1)
#pragma unroll
        for (int j = k >> 1; j > 0; j >>= 1)
#pragma unroll
            for (int i = 0; i < N; ++i) { const int l = i ^ j; if (l > i) { if ((i & k) == 0) CE_DESC(v[i], v[l]); else CE_ASC(v[i], v[l]); } }
}
template <int X> __device__ __forceinline__ void merge_top16(float (&a)[16]) {
    float c[16];
#pragma unroll
    for (int i = 0; i < 16; ++i) c[i] = fmaxf(a[i], __shfl_xor(a[15 - i], X));
#pragma unroll
    for (int j = 8; j > 0; j >>= 1)
#pragma unroll
        for (int i = 0; i < 16; ++i) { const int l = i ^ j; if (l > i) CE_DESC(c[i], c[l]); }
#pragma unroll
    for (int i = 0; i < 16; ++i) a[i] = c[i];
}
template <int X> __device__ __forceinline__ void merge_8_8(const float (&a)[8], float (&c)[16]) {
#pragma unroll
    for (int i = 0; i < 8; ++i) { c[i] = a[i]; c[8 + i] = __shfl_xor(a[7 - i], X); }
#pragma unroll
    for (int j = 8; j > 0; j >>= 1)
#pragma unroll
        for (int i = 0; i < 16; ++i) { const int l = i ^ j; if (l > i) CE_DESC(c[i], c[l]); }
}
struct P11Frags { bf16x8 a0[8], a1[8], b[8]; };
__device__ __forceinline__ void p11_load_a(P11Frags& R, const bf16* QF, int u, int w, int l) {
    const int h = u & 7, rb = (u >> 3) * 2, half = w >> 2;
    const bf16* ap0 = QF + ((((size_t)(rb * 8 + h) * 2 + half) * 8) * 64 + l) * 8;
    const bf16* ap1 = QF + ((((size_t)((rb + 1) * 8 + h) * 2 + half) * 8) * 64 + l) * 8;
#pragma unroll
    for (int s = 0; s < 8; ++s) { R.a0[s] = *(const GAS bf16x8*)(ap0 + s * 512); R.a1[s] = *(const GAS bf16x8*)(ap1 + s * 512); }
}
__device__ __forceinline__ void p11_load_b(P11Frags& R, const bf16* SKF, int h, int w, int l) {
    const int half = w >> 2, kt = w & 3;
    const bf16* bp = SKF + ((((size_t)(h * 2 + half) * 4 + kt) * 8) * 64 + l) * 8;
#pragma unroll
    for (int s = 0; s < 8; ++s) R.b[s] = *(const GAS bf16x8*)(bp + s * 512);
}
__device__ __forceinline__ void p11_peer_topk(Frame& F, const Args& a) {
    constexpr int RS = 132;
    const bf16* QF = (const bf16*)(a.ws + WS_QP); const bf16* SKF = (const bf16*)(a.ws + WS_SK);
    int* IDX = (int*)(a.ws + WS_IDX); float* GATE = (float*)(a.ws + WS_GATE);
    LAS float* sc = (LAS float*)F.lds;
    LAS float* tv = (LAS float*)(F.lds + 67584);
    LAS unsigned char* tab = (LAS unsigned char*)(F.lds + 67584 + 8192);
    const int tid = F.tid, l = F.lane, w = F.wave;
    if (tid < 64) {
        int q = tid, ci = 255, n = 0;
        for (int i = 0; i < 16; ++i) for (int j = 0; j < 16; ++j) if ((i + 1) * (j + 1) <= 16) { if (n == q) ci = i * 16 + j; ++n; }
        tab[tid] = (unsigned char)ci;
    }
    __syncthreads();
#define LDS_BAR() do { asm volatile("s_waitcnt lgkmcnt(0)" ::: "memory"); __builtin_amdgcn_s_barrier(); asm volatile("" ::: "memory"); } while (0)
#ifdef PROBE11
    const int pm_ = a.pad;
#else
    constexpr int pm_ = 0;
#endif
    P11Frags R;
    int hcur = F.vcu & 7;
    if (F.vcu < 4096) { p11_load_b(R, SKF, hcur, w, l); p11_load_a(R, QF, F.vcu, w, l); }
    for (int u = F.vcu; u < 4096; u += F.G) {
        const int h = u & 7, t0 = (u >> 3) * 64;
        if (h != hcur) { hcur = h; p11_load_b(R, SKF, h, w, l); }
        if (!(pm_ & 4)) {   const int half = w >> 2, kt = w & 3, r32 = l & 31, hi = l >> 5;
            f32x16 acc0, acc1;
#pragma unroll
            for (int i = 0; i < 16; ++i) { acc0[i] = 0.f; acc1[i] = 0.f; }
#pragma unroll
            for (int s = 0; s < 8; ++s) {
                acc0 = __builtin_amdgcn_mfma_f32_32x32x16_bf16(R.a0[s], R.b[s], acc0, 0, 0, 0);
                acc1 = __builtin_amdgcn_mfma_f32_32x32x16_bf16(R.a1[s], R.b[s], acc1, 0, 0, 0);
            }
#pragma unroll
            for (int r = 0; r < 16; ++r) { const int row = (r & 3) + 8 * (r >> 2) + 4 * hi;
                sc[(half * 64 + row) * RS + kt * 32 + r32] = acc0[r]; sc[(half * 64 + 32 + row) * RS + kt * 32 + r32] = acc1[r]; }
        }
        if (u + F.G < 4096) p11_load_a(R, QF, u + F.G, w, l);
        LDS_BAR();
        if (!(pm_ & 1)) {
            const int row = tid >> 2, part = tid & 3;
            float v[32];
#pragma unroll
            for (int k = 0; k < 32; ++k) v[k] = __uint_as_float((__float_as_uint(sc[row * RS + 4 * k + part]) & ~0x7Fu) | (unsigned)(127 - (4 * k + part)));
            bitonic_sort_desc<32>(v);
            float t16[16];
#pragma unroll
            for (int i = 0; i < 16; ++i) t16[i] = v[i];
            merge_top16<1>(t16); merge_top16<2>(t16);
            if (part == 0) {
#pragma unroll
                for (int i = 0; i < 4; ++i) *(LAS f32x4*)(tv + row * 16 + 4 * i) = (f32x4){t16[4 * i], t16[4 * i + 1], t16[4 * i + 2], t16[4 * i + 3]}; }
        }
        LDS_BAR();
        if (!(pm_ & 2)) {
            const int tok = tid >> 3, part = tid & 7;
            float c8[8];
#pragma unroll
            for (int k = 0; k < 8; ++k) { const int ci = tab[part * 8 + k]; const int ii = (ci >> 4) & 15, jj = ci & 15;
                const float sum = tv[tok * 16 + ii] + tv[(64 + tok) * 16 + jj];
                c8[k] = (ci == 255) ? -INFINITY : __uint_as_float((__float_as_uint(sum) & ~0xFFu) | (unsigned)(255 - ci)); }
            bitonic_sort_desc<8>(c8);
            float c[16];
            merge_8_8<1>(c8, c); merge_top16<2>(c); merge_top16<4>(c);
            const float mx = c[0]; float den = 0.f;
#pragma unroll
            for (int k = 0; k < 16; ++k) den += __expf(c[k] - mx);
            const float iden = 1.f / den;
            int ev[2]; float gv[2];
#pragma unroll
            for (int kk = 0; kk < 2; ++kk) {
                float val = c[0];
#pragma unroll
                for (int k = 0; k < 16; ++k) val = (k == part * 2 + kk) ? c[k] : val;
                const int ci = 255 - (int)(__float_as_uint(val) & 0xFFu);
                const int e1 = 127 - (int)(__float_as_uint(tv[tok * 16 + (ci >> 4)]) & 0x7Fu), e2 = 127 - (int)(__float_as_uint(tv[(64 + tok) * 16 + (ci & 15)]) & 0x7Fu);
                ev[kk] = e1 * 128 + e2; gv[kk] = __expf(val - mx) * iden; }
            if (pm_ == 0) {
                const size_t o = ((size_t)h * T + t0 + tok) * 16 + 2 * part;
                *(GAS u32x2*)(IDX + o) = (u32x2){(unsigned)ev[0], (unsigned)ev[1]}; *(GAS f32x2v*)(GATE + o) = (f32x2v){gv[0], gv[1]}; }
            else if (pm_ & 8) { if (ev[0] == 12345 && gv[1] == 7.f) IDX[0] = ev[1]; }
        }
        LDS_BAR();
    }
}

#undef LDS_BAR
typedef int v4i __attribute__((ext_vector_type(4)));
__device__ __forceinline__ float gelu_erf(float x) { return 0.5f * x * (1.0f + erff(x * 0.70710678118654752f)); }
struct GBuf { v4u r[16]; v4u h0, h1; };
template <bool WITH_H> __device__ __forceinline__ void peer_issue(GBuf& B, const unsigned char* tab, const bf16* H2, const LAS int* il, int tbase, int it, int g, int c) {
    const int s = it >> 4, tt = it & 15;
    const LAS v4i* ip = (const LAS v4i*)(il + tt * 128 + g * 16);
    const v4i i0 = ip[0], i1 = ip[1], i2 = ip[2], i3 = ip[3];
    const int e[16] = {i0.x, i0.y, i0.z, i0.w, i1.x, i1.y, i1.z, i1.w, i2.x, i2.y, i2.z, i2.w, i3.x, i3.y, i3.z, i3.w};
    const unsigned char* ts = tab + (size_t)s * NEXP * 128 + c * 16;
#pragma unroll
    for (int i = 0; i < 16; ++i) B.r[i] = *(const GAS v4u*)(ts + (size_t)e[i] * 128);
    if (WITH_H) { const bf16* hp = H2 + (size_t)(tbase + tt) * 1024 + s * 128 + c * 16; B.h0 = *(const GAS v4u*)hp; B.h1 = *(const GAS v4u*)(hp + 8); }
}
__device__ __forceinline__ void peer_u_compute(const GBuf& B, LAS float* wl, int it, int g, int c) {
    const int tt = it & 15;
    const unsigned hw[8] = {B.h0.x, B.h0.y, B.h0.z, B.h0.w, B.h1.x, B.h1.y, B.h1.z, B.h1.w};
    float d[16];
#pragma unroll
    for (int i = 0; i < 16; ++i) {
        const unsigned uw[4] = {B.r[i].x, B.r[i].y, B.r[i].z, B.r[i].w};
        float a0 = 0.f, a1 = 0.f;
#pragma unroll
        for (int j = 0; j < 4; ++j) {
            a0 = __builtin_amdgcn_fdot2_f32_bf16(__builtin_amdgcn_cvt_scalef32_pk_bf16_fp8(uw[j], 1.0f, false), __builtin_bit_cast(bf16x2v, hw[2 * j]), a0, false);
            a1 = __builtin_amdgcn_fdot2_f32_bf16(__builtin_amdgcn_cvt_scalef32_pk_bf16_fp8(uw[j], 1.0f, true), __builtin_bit_cast(bf16x2v, hw[2 * j + 1]), a1, false); }
        d[i] = a0 + a1;
    }
    const bool u4 = (c & 4) != 0, u2 = (c & 2) != 0, u1 = (c & 1) != 0;
    float r8[8], r4[4], r2[2];
#pragma unroll
    for (int j = 0; j < 8; ++j) { const float keep = u4 ? d[8 + j] : d[j], send = u4 ? d[j] : d[8 + j]; r8[j] = keep + __shfl_xor(send, 4); }
#pragma unroll
    for (int j = 0; j < 4; ++j) { const float keep = u2 ? r8[4 + j] : r8[j], send = u2 ? r8[j] : r8[4 + j]; r4[j] = keep + __shfl_xor(send, 2); }
#pragma unroll
    for (int j = 0; j < 2; ++j) { const float keep = u1 ? r4[2 + j] : r4[j], send = u1 ? r4[j] : r4[2 + j]; r2[j] = keep + __shfl_xor(send, 1); }
    LAS f32x2v* wp = (LAS f32x2v*)(wl + tt * 128 + g * 16 + 2 * c);
    f32x2v cur = *wp; cur.x += r2[0]; cur.y += r2[1]; *wp = cur;
}
__device__ __forceinline__ void peer_v_compute(const GBuf& B, const LAS float* wl, float* out, const float* modp, const float* xin, const bf16* delta, int tbase, int it, int g, int c) {
    const int s = it >> 4, tt = it & 15, t = tbase + tt;
    const LAS f32x4* wp = (const LAS f32x4*)(wl + tt * 128 + g * 16);
    const f32x4 w0 = wp[0], w1 = wp[1], w2 = wp[2], w3 = wp[3];
    const float w[16] = {w0.x, w0.y, w0.z, w0.w, w1.x, w1.y, w1.z, w1.w, w2.x, w2.y, w2.z, w2.w, w3.x, w3.y, w3.z, w3.w};
    f32x2v o2[8];
#pragma unroll
    for (int j = 0; j < 8; ++j) o2[j] = (f32x2v){0.f, 0.f};
#pragma unroll
    for (int i = 0; i < 16; ++i) {
        const unsigned vw[4] = {B.r[i].x, B.r[i].y, B.r[i].z, B.r[i].w}; const f32x2v ww = (f32x2v){w[i], w[i]};
#pragma unroll
        for (int j = 0; j < 4; ++j) {
            o2[2 * j] = __builtin_elementwise_fma(__builtin_amdgcn_cvt_pk_f32_fp8((int)vw[j], false), ww, o2[2 * j]);
            o2[2 * j + 1] = __builtin_elementwise_fma(__builtin_amdgcn_cvt_pk_f32_fp8((int)vw[j], true), ww, o2[2 * j + 1]); }
    }
    float o[16];
#pragma unroll
    for (int j = 0; j < 8; ++j) { o[2 * j] = o2[j].x; o[2 * j + 1] = o2[j].y; }
    const bool u4 = (g & 4) != 0, u2 = (g & 2) != 0, u1 = (g & 1) != 0;
    float r8[8], r4[4], r2[2];
#pragma unroll
    for (int j = 0; j < 8; ++j) { const float keep = u4 ? o[8 + j] : o[j], send = u4 ? o[j] : o[8 + j]; r8[j] = keep + __shfl_xor(send, 32); }
#pragma unroll
    for (int j = 0; j < 4; ++j) { const float keep = u2 ? r8[4 + j] : r8[j], send = u2 ? r8[j] : r8[4 + j]; r4[j] = keep + __shfl_xor(send, 16); }
#pragma unroll
    for (int j = 0; j < 2; ++j) { const float keep = u1 ? r4[2 + j] : r4[j], send = u1 ? r4[j] : r4[2 + j]; r2[j] = keep + __shfl_xor(send, 8); }
    const int b = t >> 12; const int col = s * 128 + c * 16 + 2 * g;
    GAS f32x2v* op = (GAS f32x2v*)(out + (size_t)t * 1024 + col); const f32x2v gv = *(const GAS f32x2v*)(modp + (size_t)b * 6144 + 5120 + col);
    f32x2v xv = *(const GAS f32x2v*)(xin + (size_t)t * 1024 + col); const unsigned dl = *(const GAS unsigned*)(delta + (size_t)t * 1024 + col);
    xv.x += bflo(dl) + gv.x * r2[0]; xv.y += bfhi(dl) + gv.y * r2[1]; *op = xv;
}
__device__ __forceinline__ void p12_gather(Frame& F, const Args& a) {
    const int l = F.lane, g = l >> 3, c = l & 7;
    const bf16* H2 = (const bf16*)(a.ws + WS_R1); const int* IDX = (const int*)(a.ws + WS_IDX); const float* GATE = (const float*)(a.ws + WS_GATE);
    const unsigned char* EU = (const unsigned char*)(a.ws + WS_EU); const unsigned char* EV = (const unsigned char*)(a.ws + WS_EV);
    const float* SU = (const float*)(a.ws + WS_ESC); const float* SV = SU + NEXP;
    const float* modp = (const float*)(a.ws + WS_MOD); float* out = a.out; const float* xin = (const float*)a.in[0]; const bf16* delta = (const bf16*)(a.ws + WS_DELTA);
    LAS float* wl = (LAS float*)(F.lds + F.wave * 8192);
    LAS int* il = (LAS int*)(F.lds + 65536 + F.wave * 8192);
    for (int tbase = (F.vcu * NWAVES + F.wave) * 16; tbase < T; tbase += F.G * NWAVES * 16) {
#pragma unroll
        for (int tt = 0; tt < 16; ++tt) { il[tt * 128 + l] = IDX[((size_t)(l >> 4) * T + tbase + tt) * 16 + (l & 15)]; il[tt * 128 + 64 + l] = IDX[((size_t)(4 + (l >> 4)) * T + tbase + tt) * 16 + (l & 15)];
            wl[tt * 128 + l] = 0.f; wl[tt * 128 + 64 + l] = 0.f; }
        {   GBuf b0, b1;
            peer_issue<true>(b0, EU, H2, il, tbase, 0, g, c);
            for (int it = 0; it < 128; it += 2) {
                peer_issue<true>(b1, EU, H2, il, tbase, it + 1, g, c);
                peer_u_compute(b0, wl, it, g, c);
                if (it + 2 < 128) peer_issue<true>(b0, EU, H2, il, tbase, it + 2, g, c);
                peer_u_compute(b1, wl, it + 1, g, c);
            }
        }
#pragma unroll 4
        for (int tt = 0; tt < 16; ++tt) { const int t = tbase + tt;
#pragma unroll
            for (int j = 0; j < 2; ++j) { const int k = 2 * c + j; const int e = il[tt * 128 + g * 16 + k];
                wl[tt * 128 + g * 16 + k] = GATE[((size_t)g * T + t) * 16 + k] * gelu_erf(wl[tt * 128 + g * 16 + k] * SU[e]) * SV[e]; } }
        {   GBuf b0, b1;
            peer_issue<false>(b0, EV, H2, il, tbase, 0, g, c);
            for (int it = 0; it < 128; it += 2) {
                peer_issue<false>(b1, EV, H2, il, tbase, it + 1, g, c);
                peer_v_compute(b0, wl, out, modp, xin, delta, tbase, it, g, c);
                if (it + 2 < 128) peer_issue<false>(b0, EV, H2, il, tbase, it + 2, g, c);
                peer_v_compute(b1, wl, out, modp, xin, delta, tbase, it + 1, g, c);
            }
        }
    }
}


__global__ void __launch_bounds__(NWAVES * 64, 2) fwd_kernel(Args args) {
    extern __shared__ __attribute__((aligned(16))) unsigned char lds[];
    Frame F;
    F.lds = (LAS unsigned char*)lds;
    F.MISC = (volatile LAS unsigned*)(F.lds + MISC_OFF);
    F.tid = threadIdx.x; F.lane = F.tid & 63; F.wave = __builtin_amdgcn_readfirstlane(F.tid >> 6);
    F.G = gridDim.x; { const int bx = blockIdx.x; F.vcu = (F.G % 8 == 0) ? (bx % 8) * (F.G / 8) + bx / 8 : bx; }
    unsigned char* ws = args.ws;
    F.ctl = (gu32*)(ws + WS_CTL);
    for (int u = F.tid; u < (LDS_BYTES - LDSCTL_OFF) / 4; u += NWAVES * 64) ((LAS unsigned*)(F.lds + LDSCTL_OFF))[u] = 0u;
    __syncthreads();
    const int lo = args.ph_lo, hi = args.ph_hi;
    const bool fused = (hi - lo) > 1;
    XcdBarrier bar; bar.bar = (unsigned*)(F.ctl + CW_BAR) + args.bar_region * XCD_BAR_WORDS; bar.x = 0; bar.st = nullptr;
    if (fused) bar = xcd_barrier_post((unsigned*)(F.ctl + CW_BAR) + args.bar_region * XCD_BAR_WORDS, F.MISC + 8);
#ifndef PHASE_MASK
#define PHASE_MASK 0xFFFF
#endif
#define IN(k) (((PHASE_MASK >> (k)) & 1) && lo <= (k) && (k) < hi)
#ifdef PROBE_BAR2
#define SEAM(k) do { if (IN(k) && IN((k) + 1)) { xcd_barrier(bar); xcd_barrier(bar); } } while (0)
#else
#define SEAM(k) do { if (IN(k) && IN((k) + 1)) xcd_barrier(bar); } while (0)
#endif
#ifdef PROBE_DOUBLE
    int two_ = 2; asm volatile("" : "+s"(two_));
#define REP(k) for (int rep_ = 0; rep_ < ((k) == PROBE_DOUBLE ? two_ : 1); ++rep_, ((k) == PROBE_DOUBLE && rep_ == 1 && fused ? xcd_barrier(bar) : (void)0))
#else
#define REP(k)
#endif

    bf16* XN = (bf16*)(ws + WS_R1);
    float* modp = (float*)(ws + WS_MOD);

    REP(0) if (IN(0)) { p0_prologue(F, args); } SEAM(0);
    REP(1) if (IN(1)) {
        norm_mod_rows<true>(F, (const float*)args.in[0], (const float*)args.in[5], modp, 0, 1024, XN, (const int*)args.in[2], (float*)(ws + WS_CS), (float*)(ws + WS_SA));
        {
            LAS float* scr = (LAS float*)(F.lds + RING_OFF + F.wave * 16384);
            for (int it = F.vcu * NWAVES + F.wave; it < (D / 64) * (IN_W / 32); it += F.G * NWAVES)
                win_fp8_item((const float*)args.in[6], (const unsigned*)(ws + WS_CTL) + CW_AMAX, (unsigned char*)(ws + WS_WIN), (float*)(ws + WS_SW), scr, it, F.lane); }
    } SEAM(1);
    REP(2) if (IN(2)) {
#if defined(P2_STAGGER)
        {
            const unsigned long long t0_ = __builtin_amdgcn_s_memrealtime(); const unsigned long long wait_ = (unsigned long long)((F.vcu & 3) * P2_STAGGER) * 100ull;
            while (__builtin_amdgcn_s_memrealtime() - t0_ < wait_) __builtin_amdgcn_s_sleep(32);
        }
#endif
        int kdim = D / 2; asm volatile("" : "+s"(kdim));
        pg8::Gemm g{XN, (const bf16*)(ws + WS_WIN), T, IN_W, kdim}; pg8::StaticOrder S; S.init(T, IN_W, F.G, (int)blockIdx.x);
        pg8::EpiInProj E{(bf16*)(ws + WS_QA), (bf16*)(ws + WS_KA), (bf16*)(ws + WS_VA), (bf16*)(ws + WS_QB), (bf16*)(ws + WS_KB), (bf16*)(ws + WS_VB), (bf16*)args.out, (const float*)args.in[7],
                          (const float*)args.in[8], (const float*)args.in[9], (const float*)args.in[11], (const float*)args.in[12], (const float*)(ws + WS_CS), QSCALE, (const float*)(ws + WS_SA), (const float*)(ws + WS_SW)};
        pg8::gemm_phase<pg8::EpiInProj, pg8::StaticOrder, true, true, true>(F.lds + RING_OFF, g, S, E
#ifdef PROBE_GSTAMP
            , modp + MOD_LAM + 24
#endif
            );
    } SEAM(2);
    REP(4) if (IN(4)) {
        p3_vt8(F, args); __syncthreads();
        attn_body::dil_phase((char*)lds + RING_OFF, (const attn_body::bf16*)(ws + WS_QA), (const attn_body::bf16*)(ws + WS_KA), (const attn_body::bf16*)(ws + WS_VA),
                             (attn_body::bf16*)(ws + WS_OUTG), (float*)(ws + WS_LSE), F.vcu, F.G);
    } SEAM(4);
    REP(5) if (IN(5)) {
        p6_combine(F, args);
        const attn_body::DiffFusedOrder S((int)F.G, (int)blockIdx.x);
        float pscale;
        { const float gq = fabsf(((const float*)args.in[11])[F.lane]), gk = fabsf(((const float*)args.in[12])[F.lane]);
          float mq = gq, mk = gk;
#pragma unroll
          for (int o = 1; o < 64; o <<= 1) { mq = fmaxf(mq, __shfl_xor(mq, o)); mk = fmaxf(mk, __shfl_xor(mk, o)); }
          const float smax = 64.0f * QSCALE * mq * mk * 1.02f;
          pscale = exp2f(fmaxf(0.0f, ceilf(smax - 8.5f))); }
#if QK_FP8
        attn_body::diff128q8_phase((char*)lds + RING_OFF, (const unsigned char*)(ws + WS_QB), (const unsigned char*)(ws + WS_KB), (const unsigned char*)(ws + WS_VT8),
                                   (attn_body::bf16*)(ws + WS_O1), (attn_body::bf16*)(ws + WS_OB), pscale, modp[MOD_LAM], (const float*)args.in[17], S);
#else
        attn_body::diff128f8_phase((char*)lds + RING_OFF, (const attn_body::bf16*)(ws + WS_QB), (const attn_body::bf16*)(ws + WS_KB), (const unsigned char*)(ws + WS_VT8),
                                   (attn_body::bf16*)(ws + WS_O1), (attn_body::bf16*)(ws + WS_OB), pscale, modp[MOD_LAM], (const float*)args.in[17], S
#ifdef PROBE_STAMP
                                   , modp + MOD_LAM + 16
#endif
                                   );
#endif
    } SEAM(5);
    REP(7) if (IN(7)) {
#ifdef PROBE7
        if (!(args.pad & 1))
#endif
        { int kdim = DIL_OUT; asm volatile("" : "+s"(kdim));
          pg8::Gemm g{(const bf16*)(ws + WS_OA), (const bf16*)(ws + WS_WPA), T, D, kdim}; pg8::StaticOrder S; S.init(T, D, F.G, (int)blockIdx.x);
          pg8::EpiBf16 E{(bf16*)(ws + WS_TMP), D};
          pg8::gemm_phase<pg8::EpiBf16, pg8::StaticOrder, true, true>(F.lds + RING_OFF, g, S, E); }
#ifdef PROBE7
        if (!(args.pad & 2))
#endif
        { pg8::Gemm g{(const bf16*)(ws + WS_OB), (const bf16*)(ws + WS_WPB), T, D, D}; pg8::StaticOrder S; S.init(T, D, F.G, (int)blockIdx.x);
          pg8::EpiBranchB E{(const bf16*)(ws + WS_TMP), (const unsigned char*)args.out, (bf16*)(ws + WS_MIX)};
          pg8::gemm_phase<pg8::EpiBranchB, pg8::StaticOrder, true, true>(F.lds + RING_OFF, g, S, E); }
    } SEAM(7);
    REP(8) if (IN(8)) {
        pg8::Gemm g{(const bf16*)(ws + WS_MIX), (const bf16*)(ws + WS_WOUT), T, D, D}; pg8::StaticOrder S; S.init(T, D, F.G, (int)blockIdx.x);
        pg8::EpiOut E{modp, (bf16*)(ws + WS_DELTA)};
        pg8::gemm_phase<pg8::EpiOut, pg8::StaticOrder, true, true>(F.lds + RING_OFF, g, S, E);
    } SEAM(8);
    REP(9) if (IN(9)) {
        norm_mod_rows<false>(F, (const float*)args.in[0], (const float*)args.in[20], modp, 3072, 4096, XN, nullptr, nullptr, nullptr, (const bf16*)(ws + WS_DELTA));
        convert_fp8_slices(F, (const float*)args.in[23], (unsigned char*)(ws + WS_EU), (float*)(ws + WS_ESC));
        convert_fp8_slices(F, (const float*)args.in[24], (unsigned char*)(ws + WS_EV), (float*)(ws + WS_ESC) + NEXP);
    } SEAM(9);
    REP(10) if (IN(10)) {
        pg8::Gemm g{XN, (const bf16*)(ws + WS_WQ), T, PEER_QW, D}; pg8::StaticOrder S; S.init(T, PEER_QW, F.G, (int)blockIdx.x);
        pg8::EpiQF E{(bf16*)(ws + WS_QP)};
        pg8::gemm_phase<pg8::EpiQF, pg8::StaticOrder, true, true>(F.lds + RING_OFF, g, S, E);
    } SEAM(10);
    REP(11) if (IN(11)) { p11_peer_topk(F, args); } SEAM(11);
    REP(12) if (IN(12)) { p12_gather(F, args); }
#ifdef PROBE_GSTAMP
    if (fused) { xcd_barrier(bar);
        if (blockIdx.x == 0 && F.tid == 0) { const float e_ = modp[MOD_LAM + 24], u_ = modp[MOD_LAM + 25];
            args.out[0] = (PROBE_GSTAMP == 0) ? 10.0f + 89.0f * e_ / u_ : 10.0f + u_ * (1.0f / (15.0f * 1000.0f)); } }
#endif
#ifdef PROBE_STAMP
    if (fused) { xcd_barrier(bar);
        if (blockIdx.x == 0 && F.tid == 0) { const float a_ = modp[MOD_LAM + 16], b_ = modp[MOD_LAM + 17], w_ = (PROBE_STAMP == 4) ? modp[MOD_LAM + 19] : modp[MOD_LAM + 18]; const float tot = a_ + b_ + modp[MOD_LAM + 18] + modp[MOD_LAM + 19];
            const float v = (PROBE_STAMP == 0) ? a_ / tot : (PROBE_STAMP == 1) ? b_ / tot : (PROBE_STAMP == 2 || PROBE_STAMP == 4) ? w_ / tot : tot * (1.0f / (4.0f * 60.0f * 100.0f));
            args.out[0] = 10.0f + 89.0f * (PROBE_STAMP != 3 ? v : 0.f) + (PROBE_STAMP == 3 ? v : 0.f); } }
#endif
#undef IN
#undef SEAM
}

extern "C" void kernel_launch(void* const* d_in, const int* in_sizes, int n_in, void* d_out, int out_size, void* d_ws, size_t ws_size, hipStream_t stream) {
    static int grid = 0;
    if (grid == 0) {
        if (n_in != 25 || in_sizes[0] != T * D || out_size != T * D || ws_size < WS_END) {
            fprintf(stderr, "kernel_launch: built for 25 inputs, x and out of %d floats, >= %zu bytes of workspace; got n_in %d, in0 %d, out %d, ws %zu; nothing launched\n", T * D, (size_t)WS_END, n_in, n_in > 0 ? in_sizes[0] : -1, out_size, ws_size); grid = -1; return; }
        int dev = 0, cus = 0, per_cu = 0;
        if (hipGetDevice(&dev) != hipSuccess || hipDeviceGetAttribute(&cus, hipDeviceAttributeMultiprocessorCount, dev) != hipSuccess) { fprintf(stderr, "kernel_launch: hipGetDevice / hipDeviceGetAttribute failed\n"); grid = -1; return; }
        if (hipFuncSetAttribute((const void*)fwd_kernel, hipFuncAttributeMaxDynamicSharedMemorySize, LDS_BYTES) != hipSuccess) { fprintf(stderr, "kernel_launch: hipFuncSetAttribute failed\n"); grid = -1; return; }
        if (hipOccupancyMaxActiveBlocksPerMultiprocessor(&per_cu, (const void*)fwd_kernel, NWAVES * 64, LDS_BYTES) != hipSuccess || per_cu < 1)
            fprintf(stderr, "kernel_launch: note: occupancy query reports %d workgroups per CU\n", per_cu);
        (void)hipGetLastError();
        grid = cus;
    }
    if (grid < 0) return;
    if (hipMemsetAsync((char*)d_ws + WS_CTL, 0, CTL_ZERO_BYTES, stream) != hipSuccess) { fprintf(stderr, "kernel_launch: hipMemsetAsync failed\n"); return; }
    Args a{};
    for (int i = 0; i < 25; ++i) a.in[i] = d_in[i];
    a.out = (float*)d_out; a.ws = (unsigned char*)d_ws;
#if defined(PROBE_RELAUNCH)
    a.ph_lo = 0; a.ph_hi = PROBE_RELAUNCH + 1; hipLaunchKernelGGL(fwd_kernel, dim3(grid), dim3(NWAVES * 64), LDS_BYTES, stream, a);
    a.bar_region = 1; a.ph_lo = PROBE_RELAUNCH; a.ph_hi = PROBE_RELAUNCH + 1;
#ifdef PROBE11
    a.pad = PROBE11;
#endif
#ifdef PROBE7
    a.pad = PROBE7;
#endif
    hipLaunchKernelGGL(fwd_kernel, dim3(grid), dim3(NWAVES * 64), LDS_BYTES, stream, a);
    a.pad = 0;
    if (PROBE_RELAUNCH + 1 < N_PHASES) { a.bar_region = 2; a.ph_lo = PROBE_RELAUNCH + 1; a.ph_hi = N_PHASES; hipLaunchKernelGGL(fwd_kernel, dim3(grid), dim3(NWAVES * 64), LDS_BYTES, stream, a); }
#elif MK_N_LAUNCHES == 1
    a.ph_lo = 0; a.ph_hi = N_PHASES;
    hipLaunchKernelGGL(fwd_kernel, dim3(grid), dim3(NWAVES * 64), LDS_BYTES, stream, a);
#else
    for (int p = 0; p < N_PHASES; ++p) { a.ph_lo = p; a.ph_hi = p + 1;
        hipLaunchKernelGGL(fwd_kernel, dim3(grid), dim3(NWAVES * 64), LDS_BYTES, stream, a); }
#endif
    const hipError_t le = hipPeekAtLastError();
    if (le != hipSuccess) fprintf(stderr, "kernel_launch: launch failed: %s\n", hipGetErrorName(le));
}
```

```cpp
#include <hip/hip_runtime.h>
#include <hip/hip_bf16.h>
#include <cstdio>
#include <cstdint>
#include <cmath>

#ifndef MK_N_LAUNCHES
#define MK_N_LAUNCHES 1
#endif

constexpr int BATCH = 8, SEQ = 4096, D = 1024, T = BATCH * SEQ;
constexpr int DIL_W = 768, DIL_HEADS = 12, DIL_OUT = 256;
constexpr int DIFF_W = 1024, DIFF_HEADS = 8;
constexpr int IN_W = 7424, GATE_W = 2048;
constexpr int PEER_H = 8, PEER_NK = 128, PEER_QW = 2048, NEXP = 16384;
constexpr float EPS = 1e-6f;
constexpr float LAM_INIT = 0.2f;
constexpr float QSCALE = 0.125f * 1.4426950408889634f;

namespace pg8 {
#define PG8_LAS __attribute__((address_space(3)))
typedef unsigned short bf16_t;
typedef short bf16x8 __attribute__((ext_vector_type(8)));
typedef float f32x4 __attribute__((ext_vector_type(4)));
typedef unsigned u32x4 __attribute__((ext_vector_type(4)));
typedef int v4i32_t __attribute__((ext_vector_type(4)));
typedef int v8i32_t __attribute__((ext_vector_type(8)));
constexpr int BM = 256, BK = 64, HALF = 128, HTB = HALF * BK * 2  , STAGE_BYTES = 8 * HTB, NXCD = 8, WGM = 8;

__host__ __device__ __forceinline__ int lds_byte(int r, int c) { const int st = (r >> 4) * 2 + (c >> 5), rr = r & 15, cc = c & 31, ob = rr * 64 + cc * 2; return st * 1024 + (ob ^ (((ob >> 9) & 1) << 5)); }
__host__ __device__ __forceinline__ void stage_rc(int b, int& R, int& C) { const int st = b / 1024, sb = b % 1024, swz = sb ^ (((sb >> 9) & 1) << 5); R = (st >> 1) * 16 + swz / 64; C = (st & 1) * 32 + (swz % 64) / 2; }
__host__ __device__ __forceinline__ int perm32(int rho) { const int n = rho >> 4, i = rho & 15; return 8 * (i >> 2) + 4 * n + (i & 3); }

struct Unit { int pm, pn; };
struct Gemm { const bf16_t* A; const bf16_t* Bt; int M, N, K; };

struct StaticOrder {
    int nM, nN, nwg, G, c;
    __host__ __device__ void init(int M, int N, int G_, int c_) { nM = M / BM; nN = N / BM; nwg = nM * nN; G = G_; c = c_; }
    __host__ __device__ bool next(int i, Unit& u) const {
        const long L = (long)i * G + c; if (L >= nwg) return false;
        int wgid = (int)L; { const int q = nwg / NXCD, r = nwg % NXCD, xcd = wgid % NXCD, off = wgid / NXCD; wgid = (xcd < r ? xcd * (q + 1) : r * (q + 1) + (xcd - r) * q) + off; }
        const int nig = WGM * nN, gid = wgid / nig, fm = gid * WGM, gsz = (nM - fm) < WGM ? (nM - fm) : WGM;
        u.pm = fm + ((wgid % nig) % gsz); u.pn = (wgid % nig) / gsz; return true;
    }
    __device__ __forceinline__ void a_ready(const Unit&) const {}
    __device__ __forceinline__ void done(const Unit&) const {}
};

__device__ __forceinline__ unsigned cvt_pk_bf16(float lo, float hi) { unsigned r; asm volatile("v_cvt_pk_bf16_f32 %0, %1, %2" : "=v"(r) : "v"(lo), "v"(hi)); return r; }
typedef float f32x2 __attribute__((ext_vector_type(2)));
typedef unsigned u32x2 __attribute__((ext_vector_type(2)));
#ifndef QK_FP8
#define QK_FP8 1
#endif
#ifndef G_U8
#define G_U8 1
#endif
__device__ __forceinline__ float bf_lo(unsigned w) { return __uint_as_float(w << 16); }
__device__ __forceinline__ float bf_hi(unsigned w) { return __uint_as_float(w & 0xffff0000u); }

struct EpiBf16 {
    static constexpr bool PERM = true, AFTER_DRAIN = false;
    bf16_t* O; int ldc;
    __device__ __forceinline__ void operator()(const f32x4 (&acc)[2][2][4][2], const Unit& u, int wr, int wc, int fr, int fq) const {
        const int row0 = u.pm * BM + wr * 64 + fr; const int col0 = u.pn * BM + wc * 32 + 8 * fq;
#pragma unroll
        for (int ai = 0; ai < 2; ++ai)
#pragma unroll
            for (int m = 0; m < 4; ++m) { bf16_t* rowp = O + (size_t)(row0 + ai * HALF + m * 16) * ldc + col0;
#pragma unroll
                for (int bj = 0; bj < 2; ++bj) { const f32x4 v0 = acc[ai][bj][m][0], v1 = acc[ai][bj][m][1];
                    u32x4 w; w.x = cvt_pk_bf16(v0[0], v0[1]); w.y = cvt_pk_bf16(v0[2], v0[3]); w.z = cvt_pk_bf16(v1[0], v1[1]); w.w = cvt_pk_bf16(v1[2], v1[3]);
                    *(u32x4*)(rowp + bj * HALF) = w; } }
    }
};

struct EpiQF {
    static constexpr bool PERM = true, AFTER_DRAIN = false;
    bf16_t* O;
    __device__ __forceinline__ void operator()(const f32x4 (&acc)[2][2][4][2], const Unit& u, int wr, int wc, int fr, int fq) const {
#pragma unroll
        for (int ai = 0; ai < 2; ++ai)
#pragma unroll
            for (int m = 0; m < 4; ++m) { const int rb = u.pm * 8 + ai * 4 + wr * 2 + (m >> 1), r32 = (m & 1) * 16 + fr;
#pragma unroll
                for (int bj = 0; bj < 2; ++bj) { const f32x4 v0 = acc[ai][bj][m][0], v1 = acc[ai][bj][m][1];
                    u32x4 w; w.x = cvt_pk_bf16(v0[0], v0[1]); w.y = cvt_pk_bf16(v0[2], v0[3]); w.z = cvt_pk_bf16(v1[0], v1[1]); w.w = cvt_pk_bf16(v1[2], v1[3]);
                    const size_t off = ((((size_t)(rb * 8 + u.pn) * 2 + bj) * 8 + 2 * wc + (fq >> 1)) * 64 + (fq & 1) * 32 + r32) * 8;
                    *(u32x4*)(O + off) = w; } }
    }
};

struct EpiInProj {
    static constexpr bool PERM = true, AFTER_DRAIN = false;
    bf16_t *QA, *KA, *VA, *QB, *KB, *VB, *G; const float* b_gate; const float *qn_a, *kn_a, *qn_b, *kn_b; const float* CS; float qscale;
    const float* sA; const float* sW;
    __device__ __forceinline__ void operator()(const f32x4 (&acc)[2][2][4][2], const Unit& u, int wr, int wc, int fr, int fq) const {
        const int pn = u.pn; bf16_t* base; int ldc, colt; int mode = 0; const float* gn = nullptr; float qs = 1.f;
        bool f8 = false;
        if (pn < 3)       { base = QA; ldc = 768;  colt = pn * BM; mode = 2; gn = qn_a; qs = qscale; }
        else if (pn < 6)  { base = KA; ldc = 768;  colt = (pn - 3) * BM; mode = 2; gn = kn_a; }
        else if (pn < 9)  { base = VA; ldc = 768;  colt = (pn - 6) * BM; }
        else if (pn < 13) { base = QB; ldc = 1024; colt = (pn - 9) * BM; mode = 2; gn = qn_b; qs = qscale * (QK_FP8 ? 64.f : 1.f); f8 = QK_FP8; }
        else if (pn < 17) { base = KB; ldc = 1024; colt = (pn - 13) * BM; mode = 2; gn = kn_b; qs = QK_FP8 ? 16.f : 1.f; f8 = QK_FP8; }
        else if (pn < 21) { base = VB; ldc = 1024; colt = (pn - 17) * BM; mode = 3; }
        else              { base = G;  ldc = 2048; colt = (pn - 21) * BM; mode = 1; }
        const int row0 = u.pm * BM + wr * 64 + fr;
        if (mode == 2) {
            const f32x4 g1a = *(const f32x4*)(gn + 8 * fq), g1b = *(const f32x4*)(gn + 8 * fq + 4), g2a = *(const f32x4*)(gn + 32 + 8 * fq), g2b = *(const f32x4*)(gn + 32 + 8 * fq + 4);
            const int col0 = colt + wc * 64 + 8 * fq;
            float rav[2][4];
#pragma unroll
            for (int ai = 0; ai < 2; ++ai)
#pragma unroll
                for (int m = 0; m < 4; ++m) rav[ai][m] = sA[row0 + ai * HALF + m * 16];
            const float* swp = sW + pn * BM + wc * 32 + 8 * fq;
            const f32x4 w1a = *(const f32x4*)swp, w1b = *(const f32x4*)(swp + 4), w2a = *(const f32x4*)(swp + HALF), w2b = *(const f32x4*)(swp + HALF + 4);
#pragma unroll
            for (int ai = 0; ai < 2; ++ai)
#pragma unroll
                for (int m = 0; m < 4; ++m) { const size_t row = (size_t)(row0 + ai * HALF + m * 16);
                    const float ra = rav[ai][m];
                    const f32x4 x1a = acc[ai][0][m][0] * w1a * ra, x1b = acc[ai][0][m][1] * w1b * ra, x2a = acc[ai][1][m][0] * w2a * ra, x2b = acc[ai][1][m][1] * w2b * ra;
                    const float* cp = CS + row * 64 + 8 * fq;
                    const f32x4 ca = *(const f32x4*)cp, cb = *(const f32x4*)(cp + 4), sa = *(const f32x4*)(cp + 32), sb = *(const f32x4*)(cp + 36);
                    float ss = 0.f;
#pragma unroll
                    for (int e = 0; e < 4; ++e) ss += (x1a[e] * x1a[e] + x1b[e] * x1b[e]) + (x2a[e] * x2a[e] + x2b[e] * x2b[e]);
                    ss += __shfl_xor(ss, 16); ss += __shfl_xor(ss, 32);
                    const float rs = qs / sqrtf(ss * (1.f / 64.f) + 1e-6f);
                    const f32x4 y1a = x1a * g1a * rs, y1b = x1b * g1b * rs, y2a = x2a * g2a * rs, y2b = x2b * g2b * rs;
                    const f32x4 o1a = y1a * ca - y2a * sa, o1b = y1b * cb - y2b * sb, o2a = y2a * ca + y1a * sa, o2b = y2b * cb + y1b * sb;
                    if (f8) {
                        int t0 = __builtin_amdgcn_cvt_pk_fp8_f32(o1a[0], o1a[1], 0, false); t0 = __builtin_amdgcn_cvt_pk_fp8_f32(o1a[2], o1a[3], t0, true);
                        int t1 = __builtin_amdgcn_cvt_pk_fp8_f32(o1b[0], o1b[1], 0, false); t1 = __builtin_amdgcn_cvt_pk_fp8_f32(o1b[2], o1b[3], t1, true);
                        int t2 = __builtin_amdgcn_cvt_pk_fp8_f32(o2a[0], o2a[1], 0, false); t2 = __builtin_amdgcn_cvt_pk_fp8_f32(o2a[2], o2a[3], t2, true);
                        int t3 = __builtin_amdgcn_cvt_pk_fp8_f32(o2b[0], o2b[1], 0, false); t3 = __builtin_amdgcn_cvt_pk_fp8_f32(o2b[2], o2b[3], t3, true);
                        unsigned char* rp8 = (unsigned char*)base + row * 1024 + col0;
                        *(u32x2*)rp8 = (u32x2){(unsigned)t0, (unsigned)t1}; *(u32x2*)(rp8 + 32) = (u32x2){(unsigned)t2, (unsigned)t3};
                        if (m == 3) asm volatile("" ::: "memory");
                        continue; }
                    u32x4 w1, w2;
                    w1.x = cvt_pk_bf16(o1a[0], o1a[1]); w1.y = cvt_pk_bf16(o1a[2], o1a[3]); w1.z = cvt_pk_bf16(o1b[0], o1b[1]); w1.w = cvt_pk_bf16(o1b[2], o1b[3]);
                    w2.x = cvt_pk_bf16(o2a[0], o2a[1]); w2.y = cvt_pk_bf16(o2a[2], o2a[3]); w2.z = cvt_pk_bf16(o2b[0], o2b[1]); w2.w = cvt_pk_bf16(o2b[2], o2b[3]);
                    bf16_t* rowp = base + row * ldc + col0;
                    *(u32x4*)rowp = w1; *(u32x4*)(rowp + 32) = w2;
                    if (m == 3) asm volatile("" ::: "memory"); }
            return;
        }
        const bool gate = mode == 1;
        const int col0 = colt + wc * 32 + 8 * fq;
        f32x4 bv[2][2], sw[2][2];
#pragma unroll
        for (int bj = 0; bj < 2; ++bj)
#pragma unroll
            for (int n = 0; n < 2; ++n) { bv[bj][n] = gate ? *(const f32x4*)(b_gate + col0 + bj * HALF + 4 * n) : (f32x4){0.f, 0.f, 0.f, 0.f}; sw[bj][n] = *(const f32x4*)(sW + pn * BM + wc * 32 + 8 * fq + bj * HALF + 4 * n); }
#pragma unroll
        for (int ai = 0; ai < 2; ++ai)
#pragma unroll
            for (int m = 0; m < 4; ++m) { bf16_t* rowp = base + (size_t)(row0 + ai * HALF + m * 16) * ldc + col0; const float ra = sA[row0 + ai * HALF + m * 16];
#pragma unroll
                for (int bj = 0; bj < 2; ++bj) { f32x4 v0 = acc[ai][bj][m][0] * sw[bj][0] * ra, v1 = acc[ai][bj][m][1] * sw[bj][1] * ra;
                    if (gate) {
                        v0 = v0 + bv[bj][0]; v1 = v1 + bv[bj][1];
#pragma unroll
                        for (int e = 0; e < 4; ++e) { v0[e] = 1.0f / (1.0f + __expf(-v0[e])); v1[e] = 1.0f / (1.0f + __expf(-v1[e])); }
                    }
                    if (mode == 3) {
#define V8C(x) __builtin_amdgcn_fmed3f((x) * 8.f, -448.f, 448.f)
                        int t0 = __builtin_amdgcn_cvt_pk_fp8_f32(V8C(v0[0]), V8C(v0[1]), 0, false); t0 = __builtin_amdgcn_cvt_pk_fp8_f32(V8C(v0[2]), V8C(v0[3]), t0, true);
                        int t1 = __builtin_amdgcn_cvt_pk_fp8_f32(V8C(v1[0]), V8C(v1[1]), 0, false); t1 = __builtin_amdgcn_cvt_pk_fp8_f32(V8C(v1[2]), V8C(v1[3]), t1, true);
#undef V8C
                        *(u32x2*)((unsigned char*)base + (size_t)(row0 + ai * HALF + m * 16) * 1024 + col0 + bj * HALF) = (u32x2){(unsigned)t0, (unsigned)t1};
                    } else if (G_U8 && gate) {
                        unsigned t0 = 0, t1 = 0;
#pragma unroll
                        for (int e = 0; e < 4; ++e) { t0 = __builtin_amdgcn_cvt_pk_u8_f32(__builtin_rintf(v0[e] * 255.f), e, t0); t1 = __builtin_amdgcn_cvt_pk_u8_f32(__builtin_rintf(v1[e] * 255.f), e, t1); }
                        *(u32x2*)((unsigned char*)base + (size_t)(row0 + ai * HALF + m * 16) * 2048 + col0 + bj * HALF) = (u32x2){(unsigned)t0, (unsigned)t1};
                    } else {
                    u32x4 w; w.x = cvt_pk_bf16(v0[0], v0[1]); w.y = cvt_pk_bf16(v0[2], v0[3]); w.z = cvt_pk_bf16(v1[0], v1[1]); w.w = cvt_pk_bf16(v1[2], v1[3]);
                    *(u32x4*)(rowp + bj * HALF) = w; } } }
    }
};

struct EpiBranchB {
    static constexpr bool PERM = true, AFTER_DRAIN = false;
    const bf16_t* ta; const unsigned char* G; bf16_t* mixed;
    __device__ __forceinline__ void operator()(const f32x4 (&acc)[2][2][4][2], const Unit& u, int wr, int wc, int fr, int fq) const {
        const int row0 = u.pm * BM + wr * 64 + fr; const int col0 = u.pn * BM + wc * 32 + 8 * fq;
#pragma unroll
        for (int ai = 0; ai < 2; ++ai)
#pragma unroll
            for (int m = 0; m < 4; ++m) { const size_t row = (size_t)(row0 + ai * HALF + m * 16);
                const bf16_t* tp = ta + row * 1024 + col0; bf16_t* mp = mixed + row * 1024 + col0;
#pragma unroll
                for (int bj = 0; bj < 2; ++bj) { const int c = bj * HALF;
                    const u32x4 t = *(const u32x4*)(tp + c); const f32x4 a0 = acc[ai][bj][m][0], a1 = acc[ai][bj][m][1];
                    float g0[8], g1[8];
                    if (G_U8) { const unsigned char* gp = G + row * 2048 + col0 + c; const u32x2 q0 = *(const u32x2*)gp, q1 = *(const u32x2*)(gp + 1024);
#pragma unroll
                        for (int e = 0; e < 4; ++e) { g0[e] = (float)((q0.x >> (8 * e)) & 255u) * (1.f / 255.f); g0[4 + e] = (float)((q0.y >> (8 * e)) & 255u) * (1.f / 255.f);
                                                      g1[e] = (float)((q1.x >> (8 * e)) & 255u) * (1.f / 255.f); g1[4 + e] = (float)((q1.y >> (8 * e)) & 255u) * (1.f / 255.f); } }
                    else { const bf16_t* gp = (const bf16_t*)G + row * 2048 + col0 + c; const u32x4 q0 = *(const u32x4*)gp, q1 = *(const u32x4*)(gp + 1024);
                        g0[0] = bf_lo(q0.x); g0[1] = bf_hi(q0.x); g0[2] = bf_lo(q0.y); g0[3] = bf_hi(q0.y); g0[4] = bf_lo(q0.z); g0[5] = bf_hi(q0.z); g0[6] = bf_lo(q0.w); g0[7] = bf_hi(q0.w);
                        g1[0] = bf_lo(q1.x); g1[1] = bf_hi(q1.x); g1[2] = bf_lo(q1.y); g1[3] = bf_hi(q1.y); g1[4] = bf_lo(q1.z); g1[5] = bf_hi(q1.z); g1[6] = bf_lo(q1.w); g1[7] = bf_hi(q1.w); }
                    u32x4 w;
                    w.x = cvt_pk_bf16(bf_lo(t.x) * g0[0] + a0[0] * g1[0], bf_hi(t.x) * g0[1] + a0[1] * g1[1]);
                    w.y = cvt_pk_bf16(bf_lo(t.y) * g0[2] + a0[2] * g1[2], bf_hi(t.y) * g0[3] + a0[3] * g1[3]);
                    w.z = cvt_pk_bf16(bf_lo(t.z) * g0[4] + a1[0] * g1[4], bf_hi(t.z) * g0[5] + a1[1] * g1[5]);
                    w.w = cvt_pk_bf16(bf_lo(t.w) * g0[6] + a1[2] * g1[6], bf_hi(t.w) * g0[7] + a1[3] * g1[7]);
                    *(u32x4*)(mp + c) = w; }
                asm volatile("" ::: "memory"); }
    }
};
struct EpiOut {
    static constexpr bool PERM = true, AFTER_DRAIN = false;
    const float* mod; bf16_t* delta;
    __device__ __forceinline__ void operator()(const f32x4 (&acc)[2][2][4][2], const Unit& u, int wr, int wc, int fr, int fq) const {
        const int row0 = u.pm * BM + wr * 64 + fr; const int col0 = u.pn * BM + wc * 32 + 8 * fq;
        const int b = (u.pm * BM) >> 12;
        f32x4 gv[2][2];
#pragma unroll
        for (int bj = 0; bj < 2; ++bj)
#pragma unroll
            for (int n = 0; n < 2; ++n) gv[bj][n] = *(const f32x4*)(mod + (size_t)b * 6144 + 2048 + col0 + bj * HALF + 4 * n);
#pragma unroll
        for (int ai = 0; ai < 2; ++ai)
#pragma unroll
            for (int m = 0; m < 4; ++m) { bf16_t* rowp = delta + (size_t)(row0 + ai * HALF + m * 16) * 1024 + col0;
#pragma unroll
                for (int bj = 0; bj < 2; ++bj) { const f32x4 v0 = gv[bj][0] * acc[ai][bj][m][0], v1 = gv[bj][1] * acc[ai][bj][m][1];
                    u32x4 w; w.x = cvt_pk_bf16(v0[0], v0[1]); w.y = cvt_pk_bf16(v0[2], v0[3]); w.z = cvt_pk_bf16(v1[0], v1[1]); w.w = cvt_pk_bf16(v1[2], v1[3]);
                    *(u32x4*)(rowp + bj * HALF) = w; } }
    }
};


template <class Epi, class Sched, bool ALIGN_EPI = false, bool SP2 = false, bool FP8 = false>
__device__ __forceinline__ void gemm_phase(PG8_LAS unsigned char* lds, const Gemm g, const Sched& S, const Epi& E, float* gstamp = nullptr) {
    const int tid = threadIdx.x, wid = __builtin_amdgcn_readfirstlane(tid >> 6), lane = tid & 63, wr = wid >> 2, wc = wid & 3, fr = lane & 15, fq = lane >> 4;
    const int K = g.K, nt = K / BK;
    unsigned voffA[2], voffB[2];
#pragma unroll
    for (int i = 0; i < 2; ++i) { int R, C; stage_rc(tid * 16 + i * 8192, R, C); const int Rb = Epi::PERM ? ((R & ~31) + perm32(R & 31)) : R;
        voffA[i] = (unsigned)(R * K + C) * 2u; voffB[i] = (unsigned)(Rb * K + C) * 2u; }
    const size_t kstep = (size_t)(BK * 2);
    const size_t hstep = (size_t)HALF * K * 2;
    const size_t tstep = 2 * hstep;
    const unsigned ldsw = (unsigned)wid * 1024u;
    const int aoff = FP8 ? lds_byte(wr * 64 + fr, fq * 16) : lds_byte(wr * 64 + fr, fq * 8), boff = FP8 ? lds_byte(wc * 32 + fr, fq * 16) : lds_byte(wc * 32 + fr, fq * 8);
#define PG8_SA(b, h) (((b) * 2 + (h)) * HTB)
#define PG8_SB(b, h) ((4 + (b) * 2 + (h)) * HTB)
#define PG8_STAGE(bufoff, gbase, voff) do { _Pragma("unroll") for (int _i = 0; _i < 2; ++_i) \
        __builtin_amdgcn_global_load_lds((const unsigned*)((const char*)(gbase) + (voff)[_i]), (PG8_LAS unsigned*)(lds + (bufoff) + ldsw + _i * 8192), 16, 0, 0); } while (0)
#define PG8_LD32(p) __builtin_shufflevector(*(const PG8_LAS v4i32_t*)(p), *(const PG8_LAS v4i32_t*)((p) + 16), 0, 1, 2, 3, 4, 5, 6, 7)
#define PG8_LDA(dst, b, h) do { if constexpr (FP8) { _Pragma("unroll") for (int m = 0; m < 4; ++m) dst##8[m] = PG8_LD32(lds + PG8_SA(b, h) + aoff + m * 2048); } \
        else { _Pragma("unroll") for (int m = 0; m < 4; ++m) _Pragma("unroll") for (int k = 0; k < 2; ++k) dst[m][k] = *(const PG8_LAS bf16x8*)(lds + PG8_SA(b, h) + aoff + m * 2048 + k * 1024); } } while (0)
#define PG8_LDB(dst, b, h) do { if constexpr (FP8) { _Pragma("unroll") for (int n = 0; n < 2; ++n) dst##8[n] = PG8_LD32(lds + PG8_SB(b, h) + boff + n * 2048); } \
        else { _Pragma("unroll") for (int n = 0; n < 2; ++n) _Pragma("unroll") for (int k = 0; k < 2; ++k) dst[n][k] = *(const PG8_LAS bf16x8*)(lds + PG8_SB(b, h) + boff + n * 2048 + k * 1024); } } while (0)
#define PG8_MMA(ai, bj, At, Bt) do { __builtin_amdgcn_s_setprio(1); \
        if constexpr (FP8) { _Pragma("unroll") for (int m = 0; m < 4; ++m) _Pragma("unroll") for (int n = 0; n < 2; ++n) \
            asm volatile("v_mfma_scale_f32_16x16x128_f8f6f4 %0, %1, %2, %0, %3, %3 op_sel_hi:[0,0,0]" : "+v"(acc[ai][bj][m][n]) : "v"(Bt##8[n]), "v"(At##8[m]), "v"(mxone)); } \
        else { _Pragma("unroll") for (int m = 0; m < 4; ++m) _Pragma("unroll") for (int n = 0; n < 2; ++n) _Pragma("unroll") for (int k = 0; k < 2; ++k) \
            acc[ai][bj][m][n] = __builtin_amdgcn_mfma_f32_16x16x32_bf16(Bt[n][k], At[m][k], acc[ai][bj][m][n], 0, 0, 0); } \
        __builtin_amdgcn_s_setprio(0); } while (0)
#define PG8_WAIT_V(n) asm volatile("s_waitcnt vmcnt(" #n ")" ::: "memory")
#define PG8_WAIT_L(n) asm volatile("s_waitcnt lgkmcnt(" #n ")" ::: "memory")
#define PG8_BAR __builtin_amdgcn_s_barrier()
#define PG8_SCHED __builtin_amdgcn_sched_barrier(0)
    Unit cur, nxt; int ui = 0;
    if (!S.next(0, cur)) return;
    f32x4 acc[2][2][4][2];
#pragma unroll
    for (int a = 0; a < 2; ++a)
#pragma unroll
        for (int b = 0; b < 2; ++b)
#pragma unroll
            for (int m = 0; m < 4; ++m)
#pragma unroll
                for (int n = 0; n < 2; ++n) acc[a][b][m][n] = (f32x4){0.f, 0.f, 0.f, 0.f};
    bf16x8 At[4][2], B0[2][2], B1[2][2]; v8i32_t At8[4], B08[2], B18[2];
    int mxone = 0x7F7F7F7F; asm volatile("" : "+v"(mxone));
    const char* cA = (const char*)g.A + (size_t)cur.pm * tstep; const char* cB = (const char*)g.Bt + (size_t)cur.pn * tstep;
    S.a_ready(cur);
    if constexpr (SP2) {
        PG8_STAGE(PG8_SB(0, 0), cB, voffB); PG8_STAGE(PG8_SB(0, 1), cB + hstep, voffB); PG8_STAGE(PG8_SA(0, 0), cA, voffA); PG8_STAGE(PG8_SA(0, 1), cA + hstep, voffA);
        if (wr == 1) PG8_BAR;
        PG8_WAIT_V(2); PG8_BAR;
        PG8_STAGE(PG8_SB(1, 0), cB + kstep, voffB); PG8_STAGE(PG8_SA(1, 0), cA + kstep, voffA); PG8_STAGE(PG8_SB(1, 1), cB + hstep + kstep, voffB);
        PG8_WAIT_V(6); PG8_BAR;
    } else {
        PG8_STAGE(PG8_SB(0, 0), cB, voffB); PG8_STAGE(PG8_SA(0, 0), cA, voffA); PG8_STAGE(PG8_SB(0, 1), cB + hstep, voffB); PG8_STAGE(PG8_SA(0, 1), cA + hstep, voffA);
        if (wr == 1) PG8_BAR;
        PG8_WAIT_V(4); PG8_BAR;
        PG8_STAGE(PG8_SB(1, 0), cB + kstep, voffB); PG8_STAGE(PG8_SA(1, 0), cA + kstep, voffA); PG8_STAGE(PG8_SB(1, 1), cB + hstep + kstep, voffB);
        PG8_WAIT_V(6); PG8_BAR;
    }
#if defined(PROBE_GSTAMP)
    unsigned long long tu0_; asm volatile("s_memtime %0\n\ts_waitcnt lgkmcnt(0)" : "=s"(tu0_) :: "memory");
#endif
    for (;;) {
        const bool has_next = S.next(ui + 1, nxt);
        const char* nA = has_next ? (const char*)g.A + (size_t)nxt.pm * tstep : cA; const char* nB = has_next ? (const char*)g.Bt + (size_t)nxt.pn * tstep : cB;
        for (int t = 0; t < nt; t += 2) {
            const bool last = (t == nt - 2);
            const char* a1 = cA + (size_t)(t + 1) * kstep;
            const char* a2 = last ? nA : cA + (size_t)(t + 2) * kstep; const char* b2 = last ? nB : cB + (size_t)(t + 2) * kstep;
            const char* a3 = a2 + kstep; const char* b3 = b2 + kstep;
            if (last && has_next) S.a_ready(nxt);
            if constexpr (SP2) {
            PG8_LDB(B0, 0, 0); PG8_LDB(B1, 0, 1); PG8_SCHED; PG8_LDA(At, 0, 0); PG8_STAGE(PG8_SA(1, 1), a1 + hstep, voffA);
            PG8_WAIT_V(8); PG8_WAIT_L(0); PG8_BAR; PG8_MMA(0, 0, At, B0); PG8_MMA(0, 1, At, B1); PG8_BAR; PG8_SCHED;
            PG8_LDA(At, 0, 1); PG8_STAGE(PG8_SB(0, 0), b2, voffB); PG8_STAGE(PG8_SB(0, 1), b2 + hstep, voffB); PG8_STAGE(PG8_SA(0, 0), a2, voffA);
            PG8_WAIT_V(8); PG8_WAIT_L(0); PG8_BAR; PG8_MMA(1, 0, At, B0); PG8_MMA(1, 1, At, B1); PG8_BAR; PG8_SCHED;
            PG8_LDB(B0, 1, 0); PG8_LDB(B1, 1, 1); PG8_SCHED; PG8_LDA(At, 1, 0); PG8_STAGE(PG8_SA(0, 1), a2 + hstep, voffA);
            PG8_WAIT_V(8); PG8_WAIT_L(0); PG8_BAR; PG8_MMA(0, 0, At, B0); PG8_MMA(0, 1, At, B1); PG8_BAR; PG8_SCHED;
            PG8_LDA(At, 1, 1); PG8_STAGE(PG8_SB(1, 0), b3, voffB); PG8_STAGE(PG8_SB(1, 1), b3 + hstep, voffB); PG8_STAGE(PG8_SA(1, 0), a3, voffA);
            PG8_WAIT_V(8); PG8_WAIT_L(0); PG8_BAR; PG8_MMA(1, 0, At, B0); PG8_MMA(1, 1, At, B1); PG8_BAR; PG8_SCHED;
            } else {
            PG8_LDB(B0, 0, 0); PG8_SCHED; PG8_LDA(At, 0, 0); PG8_STAGE(PG8_SA(1, 1), a1 + hstep, voffA);
            PG8_WAIT_L(8); PG8_BAR; PG8_WAIT_L(0); PG8_MMA(0, 0, At, B0); PG8_BAR; PG8_SCHED;
            PG8_LDB(B1, 0, 1); PG8_STAGE(PG8_SB(0, 0), b2, voffB);
            PG8_BAR; PG8_WAIT_L(0); PG8_MMA(0, 1, At, B1); PG8_BAR;
            PG8_LDA(At, 0, 1); PG8_STAGE(PG8_SA(0, 0), a2, voffA);
            PG8_BAR; PG8_WAIT_L(0); PG8_MMA(1, 0, At, B0); PG8_BAR; PG8_SCHED;
            PG8_STAGE(PG8_SB(0, 1), b2 + hstep, voffB);
            PG8_WAIT_V(6); PG8_BAR; PG8_MMA(1, 1, At, B1); PG8_BAR;
            PG8_LDB(B0, 1, 0); PG8_SCHED; PG8_LDA(At, 1, 0); PG8_STAGE(PG8_SA(0, 1), a2 + hstep, voffA);
            PG8_WAIT_L(8); PG8_BAR; PG8_WAIT_L(0); PG8_MMA(0, 0, At, B0); PG8_BAR; PG8_SCHED;
            PG8_LDB(B1, 1, 1); PG8_STAGE(PG8_SB(1, 0), b3, voffB);
            PG8_BAR; PG8_WAIT_L(0); PG8_MMA(0, 1, At, B1); PG8_BAR;
            PG8_LDA(At, 1, 1); PG8_STAGE(PG8_SA(1, 0), a3, voffA);
            PG8_BAR; PG8_WAIT_L(0); PG8_MMA(1, 0, At, B0); PG8_BAR; PG8_SCHED;
            PG8_STAGE(PG8_SB(1, 1), b3 + hstep, voffB);
            PG8_WAIT_V(6); PG8_BAR; PG8_MMA(1, 1, At, B1); PG8_BAR;
            }
        }
        if constexpr (FP8) asm volatile("s_nop 15\n\ts_nop 15" ::: "memory");
        if constexpr (ALIGN_EPI) { if (wr == 0) PG8_BAR; }
#if defined(PROBE_GSTAMP)
        unsigned long long te0_; asm volatile("s_memtime %0\n\ts_waitcnt lgkmcnt(0)" : "=s"(te0_) :: "memory");
#endif
        if constexpr (!Epi::AFTER_DRAIN) { E(acc, cur, wr, wc, fr, fq); S.done(cur); }
#if defined(PROBE_GSTAMP)
        if (gstamp) { asm volatile("s_waitcnt vmcnt(0)" ::: "memory"); unsigned long long te1_; asm volatile("s_memtime %0\n\ts_waitcnt lgkmcnt(0)" : "=s"(te1_) :: "memory");
            if (blockIdx.x == 0 && threadIdx.x == 0) { gstamp[0] += (float)(te1_ - te0_); gstamp[1] += (float)(te1_ - tu0_); } tu0_ = te1_; }
#endif
        if (!has_next) break;
#pragma unroll
        for (int a = 0; a < 2; ++a)
#pragma unroll
            for (int b = 0; b < 2; ++b)
#pragma unroll
                for (int m = 0; m < 4; ++m)
#pragma unroll
                    for (int n = 0; n < 2; ++n) acc[a][b][m][n] = (f32x4){0.f, 0.f, 0.f, 0.f};
        cur = nxt; cA = nA; cB = nB; ++ui;
        if constexpr (ALIGN_EPI) { if (wr == 1) PG8_BAR; }
    }
    PG8_WAIT_V(0);
    if constexpr (!ALIGN_EPI) { if (wr == 0) PG8_BAR; }
    PG8_BAR;
    if constexpr (Epi::AFTER_DRAIN) { E.fused(acc, cur, wr, wc, fr, fq, lds, wid, lane); S.done(cur); }
#undef PG8_SA
#undef PG8_SB
#undef PG8_STAGE
#undef PG8_LDA
#undef PG8_LDB
#undef PG8_MMA
#undef PG8_LD32
#undef PG8_WAIT_V
#undef PG8_WAIT_L
#undef PG8_BAR
#undef PG8_SCHED
}
}
#include <hip/hip_bf16.h>
#include <cmath>
namespace attn_body {
using bf16=__hip_bfloat16;
using bf16x8=__attribute__((ext_vector_type(8)))short;
using s16x4=__attribute__((ext_vector_type(4)))short;
using f32x16=__attribute__((ext_vector_type(16)))float;
using u32x4=__attribute__((ext_vector_type(4)))unsigned;
constexpr int BATCH=8,NHEAD=16,SEQ=4096,D=64,DM=NHEAD*D;
constexpr int NW=8,QBLK=32,QB=QBLK*NW,KVBLK=64,NQB=SEQ/QB;
constexpr int ATTN_PITCH=DM, ATTN_UNIT_ROWS=QB;
__device__ __forceinline__ int crow(int r,int hi){return (r&3)+8*(r>>2)+4*hi;}
#define SBAR() __builtin_amdgcn_sched_barrier(0)
__device__ __forceinline__ void cmask(f32x16&p0,f32x16&p1,int jb,int qrel,int hi){
  const float NEG=-INFINITY; int kb=64*jb+4*hi;
  #pragma unroll
  for(int r=0;r<16;++r){int kv=kb+(r&3)+8*(r>>2); if(kv>qrel)p0[r]=NEG; if(kv+32>qrel)p1[r]=NEG;}
}

constexpr int NSLOT=3, SLOTB=8192;
constexpr int LDS_K=0, LDS_V=NSLOT*SLOTB, LDS_WS=2*NSLOT*SLOTB, LDS_OST=LDS_WS+NW*64*4, LDS_BYTES=LDS_OST+NW*4096;
constexpr float C2=0.125f*1.4426950408889634f;
__device__ __forceinline__ void glds16(const void*gsrc,unsigned lds_dst){unsigned keep;
  asm volatile("s_mov_b32 %0, m0\n\ts_mov_b32 m0, %2\n\ts_nop 0\n\tglobal_load_lds_dwordx4 %1, off\n\ts_mov_b32 m0, %0":"=&s"(keep):"v"(gsrc),"s"(lds_dst):"memory");}
__device__ __forceinline__ float max3f(float a,float b,float c){float r;asm("v_max3_f32 %0, %1, %2, %3":"=v"(r):"v"(a),"v"(b),"v"(c));return r;}
__device__ __forceinline__ float max2f(float a,float b){float r;asm("v_max_f32_e32 %0, %1, %2":"=v"(r):"v"(a),"v"(b));return r;}
__device__ __forceinline__ float fadd_s(float a,float b){float r;asm("v_add_f32_e32 %0, %1, %2":"=v"(r):"v"(a),"v"(b));return r;}
__device__ __forceinline__ float fsub_s(float a,float b){float r;asm("v_sub_f32_e32 %0, %1, %2":"=v"(r):"v"(a),"v"(b));return r;}
typedef float f32x2_t __attribute__((ext_vector_type(2))); typedef __bf16 bf16x2_t __attribute__((ext_vector_type(2)));
__device__ __forceinline__ unsigned cvtpk_s(float lo,float hi){f32x2_t v={lo,hi};bf16x2_t b=__builtin_convertvector(v,bf16x2_t);return __builtin_bit_cast(unsigned,b);}
#define WAIT_BAR(N) asm volatile("s_waitcnt vmcnt(" #N ") lgkmcnt(0)\n\ts_barrier":::"memory")

__device__ __forceinline__ void qkt(f32x16&p0,f32x16&p1,const char*Kslot,const bf16x8*qr,const f32x16&negm,int r32,int hi){
  const char*kb=Kslot+hi*1024+r32*16;
  #pragma unroll
  for(int d0=0;d0<4;++d0){
    const bf16x8 b0=*reinterpret_cast<const bf16x8*>(kb+d0*2048);
    const bf16x8 b1=*reinterpret_cast<const bf16x8*>(kb+d0*2048+512);
    if(d0==0){p0=__builtin_amdgcn_mfma_f32_32x32x16_bf16(b0,qr[0],negm,0,0,0);p1=__builtin_amdgcn_mfma_f32_32x32x16_bf16(b1,qr[0],negm,0,0,0);}
    else{p0=__builtin_amdgcn_mfma_f32_32x32x16_bf16(b0,qr[d0],p0,0,0,0);p1=__builtin_amdgcn_mfma_f32_32x32x16_bf16(b1,qr[d0],p1,0,0,0);}}
}
typedef __attribute__((address_space(3))) const char* lds_cptr;
typedef short v4i16_t __attribute__((ext_vector_type(4)));
__device__ __forceinline__ void kload8(bf16x8*kf,lds_cptr kp){
  kf[0]=*(const __attribute__((address_space(3))) bf16x8*)(kp);      kf[1]=*(const __attribute__((address_space(3))) bf16x8*)(kp+512);
  kf[2]=*(const __attribute__((address_space(3))) bf16x8*)(kp+2048); kf[3]=*(const __attribute__((address_space(3))) bf16x8*)(kp+2560);
  kf[4]=*(const __attribute__((address_space(3))) bf16x8*)(kp+4096); kf[5]=*(const __attribute__((address_space(3))) bf16x8*)(kp+4608);
  kf[6]=*(const __attribute__((address_space(3))) bf16x8*)(kp+6144); kf[7]=*(const __attribute__((address_space(3))) bf16x8*)(kp+6656);
}
__device__ __forceinline__ void kload2(bf16x8*kf,lds_cptr kp,int j){ kf[2*j]=*(const __attribute__((address_space(3))) bf16x8*)(kp+j*2048); kf[2*j+1]=*(const __attribute__((address_space(3))) bf16x8*)(kp+j*2048+512); }
__device__ __forceinline__ s16x4 vtr(lds_cptr p){ return __builtin_bit_cast(s16x4,__builtin_amdgcn_ds_read_tr16_b64_v4i16((__attribute__((address_space(3))) v4i16_t*)p)); }
__device__ __forceinline__ float rowmax(const f32x16&p0,const f32x16&p1){
  float a=max3f(p0[0],p0[1],p1[0]),b=max3f(p0[2],p0[3],p1[1]);a=max3f(a,p1[2],p1[3]);
  #pragma unroll
  for(int r=4;r<16;r+=4){a=max3f(a,p0[r],p0[r+1]);b=max3f(b,p0[r+2],p0[r+3]);a=max3f(a,p1[r],p1[r+1]);b=max3f(b,p1[r+2],p1[r+3]);}
  const float m=max2f(a,b);
  auto rr=__builtin_amdgcn_permlane32_swap(__float_as_uint(m),__float_as_uint(m),false,false);
  return max2f(__uint_as_float(rr[0]),__uint_as_float(rr[1]));
}
__device__ __forceinline__ void pv(f32x16*o,int vb,bf16x8 pa0,bf16x8 pa1,bf16x8 pa2,bf16x8 pa3){
  #pragma unroll
  for(int d0=0;d0<2;++d0){s16x4 lo[4],hi[4];
    #pragma unroll
    for(int ks=0;ks<4;++ks){
      asm volatile("ds_read_b64_tr_b16 %0,%1 offset:%c2":"=&v"(lo[ks]):"v"(vb),"i"(d0*4096+ks*1024):"memory");
      asm volatile("ds_read_b64_tr_b16 %0,%1 offset:%c2":"=&v"(hi[ks]):"v"(vb),"i"(d0*4096+ks*1024+512):"memory");}
    asm volatile("s_waitcnt lgkmcnt(0)":::"memory");SBAR();
    #define PK(k) (bf16x8){lo[k][0],lo[k][1],lo[k][2],lo[k][3],hi[k][0],hi[k][1],hi[k][2],hi[k][3]}
    o[d0]=__builtin_amdgcn_mfma_f32_32x32x16_bf16(pa0,PK(0),o[d0],0,0,0);
    o[d0]=__builtin_amdgcn_mfma_f32_32x32x16_bf16(pa1,PK(1),o[d0],0,0,0);
    o[d0]=__builtin_amdgcn_mfma_f32_32x32x16_bf16(pa2,PK(2),o[d0],0,0,0);
    o[d0]=__builtin_amdgcn_mfma_f32_32x32x16_bf16(pa3,PK(3),o[d0],0,0,0);
    #undef PK
  }
}

#ifndef ATTN_STORE16
#define ATTN_STORE16(p,v) (*(u32x4*)(p)=(v))
#endif
template<int THRL> __device__ __forceinline__ void attn_unit(int b,int h,int qb,const bf16*Q,const bf16*__restrict__ K,const bf16*__restrict__ V,bf16*O,char*shm){
  const int tid=threadIdx.x,lane=tid&63,r32=lane&31,hi=lane>>5; const int wid=__builtin_amdgcn_readfirstlane(tid>>6);
  const long rowbase=(long)b*SEQ; const int q0=qb*QB;
  const bf16*Qw=Q+(rowbase+q0+wid*QBLK)*DM+h*D;
  const bf16*Kh=K+rowbase*DM+h*D,*Vh=V+rowbase*DM+h*D;
  const unsigned lds0=(unsigned)(uintptr_t)shm;
  float*wsf=(float*)(shm+LDS_WS)+wid*64;
  const bf16*ksrc=Kh+(long)lane*DM+wid*8;
  const bf16*vsrc=Vh+(long)(16*(wid&3)+(lane>>2))*DM+(wid>>2)*32+(lane&3)*8;
  const unsigned kdst=lds0+LDS_K+wid*1024, vdst=lds0+LDS_V+wid*1024;
  #define DMA_K(t,slot) glds16(ksrc+(long)(t)*KVBLK*DM,(unsigned)__builtin_amdgcn_readfirstlane(kdst+(slot)))
  #define DMA_V(t,slot) glds16(vsrc+(long)(t)*KVBLK*DM,(unsigned)__builtin_amdgcn_readfirstlane(vdst+(slot)))
  const int vb0=(int)(lds0+LDS_V)+((lane>>4)&1)*32+(lane&3)*8+(4*hi+((lane&15)>>2))*64;
  const char*Kbase=shm+LDS_K; bf16x8 kf[8];
  const lds_cptr shm3=(lds_cptr)shm; const lds_cptr kp0=shm3+LDS_K+hi*1024+r32*16; const lds_cptr vp0=shm3+LDS_V+((lane>>4)&1)*32+(lane&3)*8+(4*hi+((lane&15)>>2))*64;
  const int NT=SEQ/KVBLK;
  DMA_K(0,0);DMA_V(0,0);DMA_K(1,SLOTB);
  bf16x8 qr[4];
  #pragma unroll
  for(int d0=0;d0<4;++d0)qr[d0]=*reinterpret_cast<const bf16x8*>(&Qw[(long)r32*DM+d0*16+hi*8]);
  float mhat=0.f,l_reg=0.f;f32x16 o[2];o[0]=f32x16{};o[1]=f32x16{};f32x16 negm=f32x16{};asm volatile("":"+v"(negm));
  const int qrel=wid*QBLK+r32;
  #define CMASK(P0,P1,t) do{}while(0)
  bool resc=false;
  #define START(P0,P1) do{ const float rm=rowmax(P0,P1); resc=false; \
    { const float dl=rm; mhat=fadd_s(mhat,dl); \
      _Pragma("unroll") for(int r=0;r<16;++r){P0[r]=fsub_s(P0[r],dl);P1[r]=fsub_s(P1[r],dl);} \
      _Pragma("unroll") for(int r=0;r<16;++r)negm[r]=-mhat; asm volatile("":"+v"(negm)); } \
    _Pragma("unroll") for(int r=0;r<16;++r)P0[r]=__builtin_amdgcn_exp2f(P0[r]); }while(0)
  #define RESC() do{ if(resc){ asm volatile("s_waitcnt lgkmcnt(0)":::"memory"); \
      _Pragma("unroll") for(int d_=0;d_<2;++d_) _Pragma("unroll") for(int r=0;r<16;++r)o[d_][r]*=wsf[crow(r,hi)]; } }while(0)
  f32x16 pA0,pA1,pB0,pB1;
  int sl_prev=0,sl_cur=0,sl_next=SLOTB;
  #define ROT() do{sl_prev=sl_cur;sl_cur=sl_next;sl_next=(sl_next==(NSLOT-1)*SLOTB)?0:sl_next+SLOTB;}while(0)
  DMA_K(2,2*SLOTB);
  WAIT_BAR(3);
  qkt(pA0,pA1,Kbase,qr,negm,r32,hi);asm volatile("s_nop 15\n\ts_nop 7":"+v"(pA0),"+v"(pA1));CMASK(pA0,pA1,0);
  START(pA0,pA1);
  _Pragma("unroll") for(int r=0;r<16;++r)pA1[r]=__builtin_amdgcn_exp2f(pA1[r]);
  WAIT_BAR(0);
  DMA_K(3,0);DMA_V(1,SLOTB);
  ROT();
  kload8(kf,kp0+sl_cur);
  WAIT_BAR(2);
  s16x4 vlo[8],vhi[8]; u32x4 pw0,pw1,pw2,pw3;
  #define PKW(P,B) cvtpk_s(P[B],P[B+1])
  #define PAF(k) __builtin_bit_cast(bf16x8,pw##k)
  #define VFR(i) (bf16x8){vlo[i][0],vlo[i][1],vlo[i][2],vlo[i][3],vhi[i][0],vhi[i][1],vhi[i][2],vhi[i][3]}
  #define PIN(x) asm volatile("":"+v"(x))
  #define MX3(a,b,c) __builtin_fmaxf(__builtin_fmaxf((a),(b)),(c))
  #define GAPA(MF,A0,A1,A2,A3,W0,W1,PW) do{ MF; sacc+=A0; sacc+=A1; sacc+=A2; sacc+=A3; PIN(sacc); W0; W1; PIN(PW); SBAR(); }while(0)
  #define EX(v) __builtin_amdgcn_exp2f(v)
  #define GAPB(MF,X,B) do{ MF; X[B]=EX(X[B]); X[B+1]=EX(X[B+1]); X[B+2]=EX(X[B+2]); X[B+3]=EX(X[B+3]); PIN(X); SBAR(); }while(0)
  #define VRD(i) do{ vlo[i]=vtr(vp_+(((i)>>2)*4096+((i)&3)*1024)); vhi[i]=vtr(vp_+(((i)>>2)*4096+((i)&3)*1024+512)); }while(0)
  #define KRD(G,j) do{ if(G){ kload2(kf,kp0+sl_next,j); SBAR(); } }while(0)
  #define STEP(C0,C1,P0,P1,t,GK,GV,GL) do{ SBAR(); \
    const lds_cptr vp_=vp0+sl_prev; \
    VRD(0); SBAR(); float sacc=(P0[0]+P0[1]); \
    GAPA(C0=__builtin_amdgcn_mfma_f32_32x32x16_bf16(kf[0],qr[0],negm,0,0,0), P0[2],P0[3],P0[4],P0[5],     pw0[0]=PKW(P0,0), pw0[1]=PKW(P0,2), pw0); \
    VRD(4); SBAR(); GAPA(C1=__builtin_amdgcn_mfma_f32_32x32x16_bf16(kf[1],qr[0],negm,0,0,0), P0[6],P0[7],P0[8],P0[9],     pw0[2]=PKW(P0,4), pw0[3]=PKW(P0,6), pw0); \
    VRD(1); SBAR(); GAPA(C0=__builtin_amdgcn_mfma_f32_32x32x16_bf16(kf[2],qr[1],C0,0,0,0),   P0[10],P0[11],P0[12],P0[13], pw1[0]=PKW(P0,8), pw1[1]=PKW(P0,10), pw1); \
    VRD(5); SBAR(); GAPA(C1=__builtin_amdgcn_mfma_f32_32x32x16_bf16(kf[3],qr[1],C1,0,0,0),   P0[14],P0[15],P1[0],P1[1],   pw1[2]=PKW(P0,12),pw1[3]=PKW(P0,14), pw1); \
    VRD(2); SBAR(); GAPA(C0=__builtin_amdgcn_mfma_f32_32x32x16_bf16(kf[4],qr[2],C0,0,0,0),   P1[2],P1[3],P1[4],P1[5],     pw2[0]=PKW(P1,0), pw2[1]=PKW(P1,2), pw2); \
    VRD(6); SBAR(); GAPA(C1=__builtin_amdgcn_mfma_f32_32x32x16_bf16(kf[5],qr[2],C1,0,0,0),   P1[6],P1[7],P1[8],P1[9],     pw2[2]=PKW(P1,4), pw2[3]=PKW(P1,6), pw2); \
    VRD(3); SBAR(); GAPA(C0=__builtin_amdgcn_mfma_f32_32x32x16_bf16(kf[6],qr[3],C0,0,0,0),   P1[10],P1[11],P1[12],P1[13], pw3[0]=PKW(P1,8), pw3[1]=PKW(P1,10), pw3); \
    VRD(7); SBAR(); GAPA(C1=__builtin_amdgcn_mfma_f32_32x32x16_bf16(kf[7],qr[3],C1,0,0,0),   P1[14],P1[15],0.f,0.f,       pw3[2]=PKW(P1,12),pw3[3]=PKW(P1,14), pw3); \
    l_reg+=sacc; \
    if(GK){DMA_K((t)+3,sl_cur);} if(GV){DMA_V((t)+1,sl_next);} \
    CMASK(C0,C1,t); \
    { float a=MX3(C0[0],C0[1],C1[0]),b=MX3(C0[2],C0[3],C1[1]); a=MX3(a,C1[2],C1[3]); \
      _Pragma("unroll") for(int r=4;r<16;r+=4){a=MX3(a,C0[r],C0[r+1]);b=MX3(b,C0[r+2],C0[r+3]);a=MX3(a,C1[r],C1[r+1]);b=MX3(b,C1[r+2],C1[r+3]);} \
      float rm=__builtin_fmaxf(a,b); { auto rr=__builtin_amdgcn_permlane32_swap(__float_as_uint(rm),__float_as_uint(rm),false,false); rm=__builtin_fmaxf(__uint_as_float(rr[0]),__uint_as_float(rr[1])); } \
      resc=false; \
      if(__builtin_expect(__any(rm>(float)THRL),0)){ const float dl=__builtin_fmaxf(rm,0.f); mhat+=dl; \
        _Pragma("unroll") for(int r=0;r<16;++r){C0[r]-=dl;C1[r]-=dl;} \
        _Pragma("unroll") for(int r=0;r<16;++r)negm[r]=-mhat; asm volatile("":"+v"(negm)); \
        const float f=__builtin_amdgcn_exp2f(-dl); l_reg*=f; if(hi==0)wsf[r32]=f; resc=true; } } \
    SBAR(); \
    GAPB(o[0]=__builtin_amdgcn_mfma_f32_32x32x16_bf16(PAF(0),VFR(0),o[0],0,0,0), C0,0); \
    GAPB(o[1]=__builtin_amdgcn_mfma_f32_32x32x16_bf16(PAF(0),VFR(4),o[1],0,0,0), C0,4); \
    KRD(GL,0); GAPB(o[0]=__builtin_amdgcn_mfma_f32_32x32x16_bf16(PAF(1),VFR(1),o[0],0,0,0), C0,8); \
    KRD(GL,1); GAPB(o[1]=__builtin_amdgcn_mfma_f32_32x32x16_bf16(PAF(1),VFR(5),o[1],0,0,0), C0,12); \
    KRD(GL,2); GAPB(o[0]=__builtin_amdgcn_mfma_f32_32x32x16_bf16(PAF(2),VFR(2),o[0],0,0,0), C1,0); \
    KRD(GL,3); GAPB(o[1]=__builtin_amdgcn_mfma_f32_32x32x16_bf16(PAF(2),VFR(6),o[1],0,0,0), C1,4); \
    GAPB(o[0]=__builtin_amdgcn_mfma_f32_32x32x16_bf16(PAF(3),VFR(3),o[0],0,0,0), C1,8); \
    GAPB(o[1]=__builtin_amdgcn_mfma_f32_32x32x16_bf16(PAF(3),VFR(7),o[1],0,0,0), C1,12); \
    }while(0)
  int t=1;
  #undef CMASK
  #define CMASK(P0,P1,t) do{}while(0)
  for(;t+5<NT;t+=2){
    STEP(pB0,pB1,pA0,pA1,t,true,true,true);     WAIT_BAR(2); RESC(); ROT();
    STEP(pA0,pA1,pB0,pB1,t+1,true,true,true);   WAIT_BAR(2); RESC(); ROT();
  }
  #undef CMASK
  #define CMASK(P0,P1,t) do{}while(0)
  #define ENDW(tt) do{ if((tt)+3<NT){WAIT_BAR(2);} else if((tt)+2<NT){WAIT_BAR(1);} else {WAIT_BAR(0);} }while(0)
  for(;t+1<NT;t+=2){
    STEP(pB0,pB1,pA0,pA1,t,(t+3<NT),(t+1<NT),(t+1<NT));       ENDW(t);   RESC(); ROT();
    STEP(pA0,pA1,pB0,pB1,t+1,(t+4<NT),(t+2<NT),(t+2<NT));     ENDW(t+1); RESC(); ROT();
  }
  STEP(pB0,pB1,pA0,pA1,NT-1,false,false,false); RESC();
  { float sacc=pB0[0]+pB0[1]; _Pragma("unroll") for(int r=2;r<16;++r)sacc+=pB0[r]; _Pragma("unroll") for(int r=0;r<16;++r)sacc+=pB1[r]; l_reg+=sacc;
    pw0=(u32x4){PKW(pB0,0),PKW(pB0,2),PKW(pB0,4),PKW(pB0,6)};pw1=(u32x4){PKW(pB0,8),PKW(pB0,10),PKW(pB0,12),PKW(pB0,14)};pw2=(u32x4){PKW(pB1,0),PKW(pB1,2),PKW(pB1,4),PKW(pB1,6)};pw3=(u32x4){PKW(pB1,8),PKW(pB1,10),PKW(pB1,12),PKW(pB1,14)};
    SBAR(); pv(o,vb0+sl_cur,PAF(0),PAF(1),PAF(2),PAF(3)); }
  #undef PKW
  #undef PAF
  #undef VFR
  #undef PIN
  #undef MX3
  #undef GAPA
  #undef GAPB
  #undef EX
  #undef VRD
  #undef KRD
  #undef STEP
  #undef ENDW
  {auto rr=__builtin_amdgcn_permlane32_swap(__float_as_uint(l_reg),__float_as_uint(l_reg),false,false);l_reg=__uint_as_float(rr[0])+__uint_as_float(rr[1]);}
  if(hi==0)wsf[32+r32]=l_reg;asm volatile("s_waitcnt lgkmcnt(0)":::"memory");
  float rli[16];
  #pragma unroll
  for(int r=0;r<16;++r)rli[r]=__builtin_amdgcn_rcpf(wsf[32+crow(r,hi)]);
  bf16*Ow=O+(rowbase+q0+wid*QBLK)*DM+h*D;
  { bf16*stg=(bf16*)(shm+LDS_OST)+wid*2048;
    #pragma unroll
    for(int r=0;r<16;++r){const int orow=crow(r,hi);
      #pragma unroll
      for(int d0=0;d0<2;++d0)stg[orow*64+d0*32+r32]=__float2bfloat16(o[d0][r]*rli[r]);}
    asm volatile("s_waitcnt lgkmcnt(0)":::"memory");
    #pragma unroll
    for(int i=0;i<4;++i){const int row=i*8+(lane>>3),ch=lane&7; const u32x4 v=*(const u32x4*)(stg+row*64+ch*8); ATTN_STORE16(Ow+(long)row*DM+ch*8,v);} }
  asm volatile("s_waitcnt lgkmcnt(0)\n\ts_barrier":::"memory");
  #undef DMA_K
  #undef DMA_V
  #undef CMASK
  #undef START
  #undef RESC
  #undef ROT
}

constexpr int V_SLOTB=16384;
constexpr int L2_K=0, L2_V=NSLOT*SLOTB, L2_WS=L2_V+NSLOT*V_SLOTB, L2_OST=L2_WS+NW*64*4, L2_BYTES=L2_OST+NW*4096;
__device__ __forceinline__ void pv128(f32x16*o,int vb,bf16x8 pa0,bf16x8 pa1,bf16x8 pa2,bf16x8 pa3){
  #pragma unroll
  for(int d0=0;d0<4;++d0){s16x4 lo[4],hi[4];
    #pragma unroll
    for(int ks=0;ks<4;++ks){
      asm volatile("ds_read_b64_tr_b16 %0,%1 offset:%c2":"=&v"(lo[ks]):"v"(vb),"i"(d0*4096+ks*1024):"memory");
      asm volatile("ds_read_b64_tr_b16 %0,%1 offset:%c2":"=&v"(hi[ks]):"v"(vb),"i"(d0*4096+ks*1024+512):"memory");}
    asm volatile("s_waitcnt lgkmcnt(0)":::"memory");SBAR();
    #define PK(k) (bf16x8){lo[k][0],lo[k][1],lo[k][2],lo[k][3],hi[k][0],hi[k][1],hi[k][2],hi[k][3]}
    o[d0]=__builtin_amdgcn_mfma_f32_32x32x16_bf16(pa0,PK(0),o[d0],0,0,0);
    o[d0]=__builtin_amdgcn_mfma_f32_32x32x16_bf16(pa1,PK(1),o[d0],0,0,0);
    o[d0]=__builtin_amdgcn_mfma_f32_32x32x16_bf16(pa2,PK(2),o[d0],0,0,0);
    o[d0]=__builtin_amdgcn_mfma_f32_32x32x16_bf16(pa3,PK(3),o[d0],0,0,0);
    #undef PK
  }
}
#ifndef A128_NOPIN
#define SB128() SBAR()
#else
#define SB128() do{}while(0)
#endif
#if defined(PROBE_MFMA)
  #define PROBE_HOOK(C0,C1) do{ const bf16x8 zf_=bf16x8{}; _Pragma("unroll") for(int q_=0;q_<8;++q_) o[q_&3]=__builtin_amdgcn_mfma_f32_32x32x16_bf16(__builtin_bit_cast(bf16x8,pw0),zf_,o[q_&3],0,0,0); }while(0)
#elif defined(PROBE_EXP)
  #define PROBE_HOOK(C0,C1) do{ _Pragma("unroll") for(int q_=0;q_<16;++q_){ float j0_=__builtin_amdgcn_exp2f(C0[q_]), j1_=__builtin_amdgcn_exp2f(C1[q_]); asm volatile(""::"v"(j0_),"v"(j1_)); } }while(0)
#elif defined(PROBE_LDS)
  #define PROBE_HOOK(C0,C1) do{ bf16x8 jk_[8]; kload8(jk_,kp0+sl_cur); _Pragma("unroll") for(int q_=0;q_<8;++q_) asm volatile(""::"v"(jk_[q_])); }while(0)
#else
  #define PROBE_HOOK(C0,C1) do{}while(0)
#endif
__device__ __forceinline__ void attn128_unit(int b,int qb,const bf16*Q,const bf16*__restrict__ K,const bf16*__restrict__ V,bf16*O,char*shm){
  const int tid=threadIdx.x,lane=tid&63,r32=lane&31,hi=lane>>5; const int wid=__builtin_amdgcn_readfirstlane(tid>>6);
  const long rowbase=(long)b*SEQ; const int q0=qb*QB;
  const bf16*Qw=Q+(rowbase+q0+wid*QBLK)*DM;
  const bf16*Kh=K+rowbase*DM,*Vh=V+rowbase*DM;
  const unsigned lds0=(unsigned)(uintptr_t)shm;
  float*wsf=(float*)(shm+L2_WS)+wid*64;
  const bf16*ksrc=Kh+(long)lane*DM+wid*8;
  const bf16*vsrc=Vh+(long)(16*(wid&3)+(lane>>2))*DM+(wid>>2)*32+(lane&3)*8;
  const unsigned kdst=lds0+L2_K+wid*1024, vdst=lds0+L2_V+wid*1024;
  #define DMA_K(t,slot) glds16(ksrc+(long)(t)*KVBLK*DM,(unsigned)__builtin_amdgcn_readfirstlane(kdst+(slot)))
  #define DMA_V(t,slot) do{ glds16(vsrc+(long)(t)*KVBLK*DM,(unsigned)__builtin_amdgcn_readfirstlane(vdst+2*(slot))); glds16(vsrc+(long)(t)*KVBLK*DM+64,(unsigned)__builtin_amdgcn_readfirstlane(vdst+2*(slot)+8192)); }while(0)
  const int vb0=(int)(lds0+L2_V)+((lane>>4)&1)*32+(lane&3)*8+(4*hi+((lane&15)>>2))*64;
  const char*Kbase=shm+L2_K; bf16x8 kf[8];
  const lds_cptr shm3=(lds_cptr)shm; const lds_cptr kp0=shm3+L2_K+hi*1024+r32*16; const lds_cptr vp0=shm3+L2_V+((lane>>4)&1)*32+(lane&3)*8+(4*hi+((lane&15)>>2))*64;
  const int NT=SEQ/KVBLK;
  DMA_K(0,0);DMA_V(0,0);DMA_K(1,SLOTB);
  bf16x8 qr[4];
  #pragma unroll
  for(int d0=0;d0<4;++d0)qr[d0]=*reinterpret_cast<const bf16x8*>(&Qw[(long)r32*DM+d0*16+hi*8]);
  float l_reg=0.f;f32x16 o[4];o[0]=f32x16{};o[1]=f32x16{};o[2]=f32x16{};o[3]=f32x16{};
  const f32x16 zero=f32x16{};
  f32x16 pA0,pA1,pB0,pB1;
  int sl_prev=0,sl_cur=0,sl_next=SLOTB;
  #define ROT() do{sl_prev=sl_cur;sl_cur=sl_next;sl_next=(sl_next==(NSLOT-1)*SLOTB)?0:sl_next+SLOTB;}while(0)
  DMA_K(2,2*SLOTB);
  WAIT_BAR(4);
  qkt(pA0,pA1,Kbase,qr,zero,r32,hi);
  _Pragma("unroll") for(int r=0;r<16;++r){pA0[r]=__builtin_amdgcn_exp2f(pA0[r]);pA1[r]=__builtin_amdgcn_exp2f(pA1[r]);}
  WAIT_BAR(0);
  DMA_K(3,0);DMA_V(1,SLOTB);
  ROT();
  kload8(kf,kp0+sl_cur);
  WAIT_BAR(3);
  s16x4 vlo[8],vhi[8],wlo[8],whi[8]; u32x4 pw0,pw1,pw2,pw3;
  #define PKW(P,B) cvtpk_s(P[B],P[B+1])
  #define PAF(k) __builtin_bit_cast(bf16x8,pw##k)
  #define VFR(i) (bf16x8){vlo[i][0],vlo[i][1],vlo[i][2],vlo[i][3],vhi[i][0],vhi[i][1],vhi[i][2],vhi[i][3]}
  #define WFR(i) (bf16x8){wlo[i][0],wlo[i][1],wlo[i][2],wlo[i][3],whi[i][0],whi[i][1],whi[i][2],whi[i][3]}
  #define PIN(x) asm volatile("":"+v"(x))
  #define GAPA(MF,A0,A1,A2,A3,W0,W1,PW) do{ MF; sacc+=A0; sacc+=A1; sacc+=A2; sacc+=A3; PIN(sacc); W0; W1; PIN(PW); SB128(); }while(0)
  #define EX(v) __builtin_amdgcn_exp2f(v)
  #define GAPB2(MF,X,B) do{ MF; X[B]=EX(X[B]); X[B+1]=EX(X[B+1]); PIN(X); SB128(); }while(0)
  #define VRD(i) do{ vlo[i]=vtr(vp_+(((i)>>2)*4096+((i)&3)*1024)); vhi[i]=vtr(vp_+(((i)>>2)*4096+((i)&3)*1024+512)); }while(0)
  #define WRD(i) do{ wlo[i]=vtr(vp_+(8192+((i)>>2)*4096+((i)&3)*1024)); whi[i]=vtr(vp_+(8192+((i)>>2)*4096+((i)&3)*1024+512)); }while(0)
  #define KRD(G,j) do{ if(G){ kload2(kf,kp0+sl_next,j); SB128(); } }while(0)
  #define STEP(C0,C1,P0,P1,t,GK,GV,GL) do{ SB128(); \
    const lds_cptr vp_=vp0+2*sl_prev; \
    VRD(0); SB128(); float sacc=(P0[0]+P0[1]); \
    GAPA(C0=__builtin_amdgcn_mfma_f32_32x32x16_bf16(kf[0],qr[0],zero,0,0,0), P0[2],P0[3],P0[4],P0[5],     pw0[0]=PKW(P0,0), pw0[1]=PKW(P0,2), pw0); \
    VRD(4); SB128(); GAPA(C1=__builtin_amdgcn_mfma_f32_32x32x16_bf16(kf[1],qr[0],zero,0,0,0), P0[6],P0[7],P0[8],P0[9],     pw0[2]=PKW(P0,4), pw0[3]=PKW(P0,6), pw0); \
    VRD(1); SB128(); GAPA(C0=__builtin_amdgcn_mfma_f32_32x32x16_bf16(kf[2],qr[1],C0,0,0,0),   P0[10],P0[11],P0[12],P0[13], pw1[0]=PKW(P0,8), pw1[1]=PKW(P0,10), pw1); \
    VRD(5); SB128(); GAPA(C1=__builtin_amdgcn_mfma_f32_32x32x16_bf16(kf[3],qr[1],C1,0,0,0),   P0[14],P0[15],P1[0],P1[1],   pw1[2]=PKW(P0,12),pw1[3]=PKW(P0,14), pw1); \
    VRD(2); SB128(); GAPA(C0=__builtin_amdgcn_mfma_f32_32x32x16_bf16(kf[4],qr[2],C0,0,0,0),   P1[2],P1[3],P1[4],P1[5],     pw2[0]=PKW(P1,0), pw2[1]=PKW(P1,2), pw2); \
    VRD(6); SB128(); GAPA(C1=__builtin_amdgcn_mfma_f32_32x32x16_bf16(kf[5],qr[2],C1,0,0,0),   P1[6],P1[7],P1[8],P1[9],     pw2[2]=PKW(P1,4), pw2[3]=PKW(P1,6), pw2); \
    VRD(3); SB128(); GAPA(C0=__builtin_amdgcn_mfma_f32_32x32x16_bf16(kf[6],qr[3],C0,0,0,0),   P1[10],P1[11],P1[12],P1[13], pw3[0]=PKW(P1,8), pw3[1]=PKW(P1,10), pw3); \
    VRD(7); SB128(); GAPA(C1=__builtin_amdgcn_mfma_f32_32x32x16_bf16(kf[7],qr[3],C1,0,0,0),   P1[14],P1[15],0.f,0.f,       pw3[2]=PKW(P1,12),pw3[3]=PKW(P1,14), pw3); \
    l_reg+=sacc; \
    if(GK){DMA_K((t)+3,sl_cur);} if(GV){DMA_V((t)+1,sl_next);} \
    SB128(); \
    PROBE_HOOK(C0,C1); \
    WRD(0); GAPB2(o[0]=__builtin_amdgcn_mfma_f32_32x32x16_bf16(PAF(0),VFR(0),o[0],0,0,0), C0,0); \
    WRD(4); GAPB2(o[1]=__builtin_amdgcn_mfma_f32_32x32x16_bf16(PAF(0),VFR(4),o[1],0,0,0), C0,2); \
    WRD(1); KRD(GL,0); GAPB2(o[0]=__builtin_amdgcn_mfma_f32_32x32x16_bf16(PAF(1),VFR(1),o[0],0,0,0), C0,4); \
    WRD(5); KRD(GL,1); GAPB2(o[1]=__builtin_amdgcn_mfma_f32_32x32x16_bf16(PAF(1),VFR(5),o[1],0,0,0), C0,6); \
    WRD(2); KRD(GL,2); GAPB2(o[0]=__builtin_amdgcn_mfma_f32_32x32x16_bf16(PAF(2),VFR(2),o[0],0,0,0), C0,8); \
    WRD(6); KRD(GL,3); GAPB2(o[1]=__builtin_amdgcn_mfma_f32_32x32x16_bf16(PAF(2),VFR(6),o[1],0,0,0), C0,10); \
    WRD(3); GAPB2(o[0]=__builtin_amdgcn_mfma_f32_32x32x16_bf16(PAF(3),VFR(3),o[0],0,0,0), C0,12); \
    WRD(7); GAPB2(o[1]=__builtin_amdgcn_mfma_f32_32x32x16_bf16(PAF(3),VFR(7),o[1],0,0,0), C0,14); \
    GAPB2(o[2]=__builtin_amdgcn_mfma_f32_32x32x16_bf16(PAF(0),WFR(0),o[2],0,0,0), C1,0); \
    GAPB2(o[3]=__builtin_amdgcn_mfma_f32_32x32x16_bf16(PAF(0),WFR(4),o[3],0,0,0), C1,2); \
    GAPB2(o[2]=__builtin_amdgcn_mfma_f32_32x32x16_bf16(PAF(1),WFR(1),o[2],0,0,0), C1,4); \
    GAPB2(o[3]=__builtin_amdgcn_mfma_f32_32x32x16_bf16(PAF(1),WFR(5),o[3],0,0,0), C1,6); \
    GAPB2(o[2]=__builtin_amdgcn_mfma_f32_32x32x16_bf16(PAF(2),WFR(2),o[2],0,0,0), C1,8); \
    GAPB2(o[3]=__builtin_amdgcn_mfma_f32_32x32x16_bf16(PAF(2),WFR(6),o[3],0,0,0), C1,10); \
    GAPB2(o[2]=__builtin_amdgcn_mfma_f32_32x32x16_bf16(PAF(3),WFR(3),o[2],0,0,0), C1,12); \
    GAPB2(o[3]=__builtin_amdgcn_mfma_f32_32x32x16_bf16(PAF(3),WFR(7),o[3],0,0,0), C1,14); \
    }while(0)
  int t=1;
  for(;t+5<NT;t+=2){
    STEP(pB0,pB1,pA0,pA1,t,true,true,true);     WAIT_BAR(3); ROT();
    STEP(pA0,pA1,pB0,pB1,t+1,true,true,true);   WAIT_BAR(3); ROT();
  }
  #define ENDW(tt) do{ if((tt)+3<NT){WAIT_BAR(3);} else if((tt)+2<NT){WAIT_BAR(2);} else {WAIT_BAR(0);} }while(0)
  for(;t+1<NT;t+=2){
    STEP(pB0,pB1,pA0,pA1,t,(t+3<NT),(t+1<NT),(t+1<NT));       ENDW(t);   ROT();
    STEP(pA0,pA1,pB0,pB1,t+1,(t+4<NT),(t+2<NT),(t+2<NT));     ENDW(t+1); ROT();
  }
  STEP(pB0,pB1,pA0,pA1,NT-1,false,false,false);
  { float sacc=pB0[0]+pB0[1]; _Pragma("unroll") for(int r=2;r<16;++r)sacc+=pB0[r]; _Pragma("unroll") for(int r=0;r<16;++r)sacc+=pB1[r]; l_reg+=sacc;
    pw0=(u32x4){PKW(pB0,0),PKW(pB0,2),PKW(pB0,4),PKW(pB0,6)};pw1=(u32x4){PKW(pB0,8),PKW(pB0,10),PKW(pB0,12),PKW(pB0,14)};pw2=(u32x4){PKW(pB1,0),PKW(pB1,2),PKW(pB1,4),PKW(pB1,6)};pw3=(u32x4){PKW(pB1,8),PKW(pB1,10),PKW(pB1,12),PKW(pB1,14)};
    SB128(); pv128(o,vb0+2*sl_cur,PAF(0),PAF(1),PAF(2),PAF(3)); }
  #undef PKW
  #undef PAF
  #undef VFR
  #undef WFR
  #undef PIN
  #undef GAPA
  #undef GAPB2
  #undef EX
  #undef VRD
  #undef WRD
  #undef KRD
  #undef STEP
  #undef ENDW
  {auto rr=__builtin_amdgcn_permlane32_swap(__float_as_uint(l_reg),__float_as_uint(l_reg),false,false);l_reg=__uint_as_float(rr[0])+__uint_as_float(rr[1]);}
  if(hi==0)wsf[32+r32]=l_reg;asm volatile("s_waitcnt lgkmcnt(0)":::"memory");
  float rli[16];
  #pragma unroll
  for(int r=0;r<16;++r)rli[r]=__builtin_amdgcn_rcpf(wsf[32+crow(r,hi)]);
  bf16*Ow=O+(rowbase+q0+wid*QBLK)*DM;
  { bf16*stg=(bf16*)(shm+L2_OST)+wid*2048;
    #pragma unroll
    for(int hh=0;hh<2;++hh){
      #pragma unroll
      for(int r=0;r<16;++r){const int orow=crow(r,hi);
        #pragma unroll
        for(int d0=0;d0<2;++d0)stg[orow*64+d0*32+r32]=__float2bfloat16(o[2*hh+d0][r]*rli[r]);}
      asm volatile("s_waitcnt lgkmcnt(0)":::"memory");
      #pragma unroll
      for(int i=0;i<4;++i){const int row=i*8+(lane>>3),ch=lane&7; const u32x4 v=*(const u32x4*)(stg+row*64+ch*8); ATTN_STORE16(Ow+(long)row*DM+hh*64+ch*8,v);}
      asm volatile("s_waitcnt lgkmcnt(0)":::"memory");
    } }
  asm volatile("s_waitcnt lgkmcnt(0)\n\ts_barrier":::"memory");
  #undef DMA_K
  #undef DMA_V
  #undef ROT
}
struct Diff128Order {
  int vcu,G,blk;
  __device__ __forceinline__ explicit Diff128Order(int grid,int block):vcu((block%8)*(grid/8)+block/8),G(grid),blk(block){}
  __device__ __forceinline__ bool next(int i,int&pair,int&qb)const{
    if(G==256){ if(i>=8)return false; pair=(vcu>>5)*16+2*i+((vcu>>4)&1); qb=vcu&15; return true; }
    const int L=i*G+blk; if(L>=2048)return false; pair=L>>4; qb=L&15; return true; }
};
__device__ __forceinline__ void diff128_phase(char*lds,const bf16*QB,const bf16*KB,const bf16*VB,bf16*O1,bf16*O2,const Diff128Order&S){
  int pair,qb;
  for(int i=0;S.next(i,pair,qb);++i){ const int m=pair&1,h=(pair>>1)&7,b=pair>>4;
    attn128_unit(b,qb,QB+h*128+m*64,KB+h*128+m*64,VB+h*128,(m?O2:O1)+h*128,lds); }
}

__device__ __forceinline__ void dil_unit(int b,int head,int dsh,int r,int chunk,const bf16*QA,const bf16*__restrict__ KA,const bf16*__restrict__ VA,bf16*OG,float*LS,char*shm){
  constexpr int PA=768;
  const int tid=threadIdx.x,lane=tid&63,r32=lane&31,hi=lane>>5; const int wid=__builtin_amdgcn_readfirstlane(tid>>6);
  const int L=SEQ>>dsh, j0=chunk<<8, jb=j0-64;
  const long tok0=(long)b*SEQ+r;
  const unsigned lds0=(unsigned)(uintptr_t)shm;
  float*wsf=(float*)(shm+LDS_WS)+wid*64;
  const bf16*Kc=KA+head*64+wid*8; const bf16*Vc=VA+head*64+(wid>>2)*32+(lane&3)*8;
  const int vrow=16*(wid&3)+(lane>>2);
  const unsigned kdst=lds0+LDS_K+wid*1024, vdst=lds0+LDS_V+wid*1024;
  #define CLAMPJ(x) ((x)<0?0:((x)>L-1?L-1:(x)))
  #define DMA_K(t,slot) do{ const int jj_=CLAMPJ(jb+64*(t)+lane); glds16(Kc+(tok0+((long)jj_<<dsh))*PA,(unsigned)__builtin_amdgcn_readfirstlane(kdst+(slot))); }while(0)
  #define DMA_V(t,slot) do{ const int jj_=CLAMPJ(jb+64*(t)+vrow); glds16(Vc+(tok0+((long)jj_<<dsh))*PA,(unsigned)__builtin_amdgcn_readfirstlane(vdst+(slot))); }while(0)
  const int vb0=(int)(lds0+LDS_V)+((lane>>4)&1)*32+(lane&3)*8+(4*hi+((lane&15)>>2))*64;
  const char*Kbase=shm+LDS_K; bf16x8 kf[8];
  const lds_cptr shm3=(lds_cptr)shm; const lds_cptr kp0=shm3+LDS_K+hi*1024+r32*16; const lds_cptr vp0=shm3+LDS_V+((lane>>4)&1)*32+(lane&3)*8+(4*hi+((lane&15)>>2))*64;
  constexpr int NT=6;
  DMA_K(0,0);DMA_V(0,0);DMA_K(1,SLOTB);
  const int jq=j0+wid*QBLK+r32;
  const bf16*Qw=QA+(tok0+((long)jq<<dsh))*PA+head*64;
  bf16x8 qr[4];
  #pragma unroll
  for(int d0=0;d0<4;++d0)qr[d0]=*reinterpret_cast<const bf16x8*>(&Qw[d0*16+hi*8]);
  float l_reg=0.f;f32x16 o[2];o[0]=f32x16{};o[1]=f32x16{};
  const f32x16 zero=f32x16{};
  #define DMASK(P0,P1,t) do{ const int kb_=jb+64*(t)+4*hi; \
    _Pragma("unroll") for(int r_=0;r_<16;++r_){ const int k0_=kb_+(r_&3)+8*(r_>>2), k1_=k0_+32; \
      const bool v0_=(k0_>=jq-64)&&(k0_<=jq+64)&&(k0_>=0)&&(k0_<L), v1_=(k1_>=jq-64)&&(k1_<=jq+64)&&(k1_>=0)&&(k1_<L); \
      P0[r_]=v0_?P0[r_]:-INFINITY; P1[r_]=v1_?P1[r_]:-INFINITY; } }while(0)
  f32x16 pA0,pA1,pB0,pB1;
  int sl_prev=0,sl_cur=0,sl_next=SLOTB;
  #define ROT() do{sl_prev=sl_cur;sl_cur=sl_next;sl_next=(sl_next==(NSLOT-1)*SLOTB)?0:sl_next+SLOTB;}while(0)
  DMA_K(2,2*SLOTB);
  WAIT_BAR(3);
  qkt(pA0,pA1,Kbase,qr,zero,r32,hi);
  DMASK(pA0,pA1,0);
  _Pragma("unroll") for(int r=0;r<16;++r){pA0[r]=__builtin_amdgcn_exp2f(pA0[r]);pA1[r]=__builtin_amdgcn_exp2f(pA1[r]);}
  WAIT_BAR(0);
  DMA_K(3,0);DMA_V(1,SLOTB);
  ROT();
  kload8(kf,kp0+sl_cur);
  WAIT_BAR(2);
  s16x4 vlo[8],vhi[8]; u32x4 pw0,pw1,pw2,pw3;
  #define PKW(P,B) cvtpk_s(P[B],P[B+1])
  #define PAF(k) __builtin_bit_cast(bf16x8,pw##k)
  #define VFR(i) (bf16x8){vlo[i][0],vlo[i][1],vlo[i][2],vlo[i][3],vhi[i][0],vhi[i][1],vhi[i][2],vhi[i][3]}
  #define PIN(x) asm volatile("":"+v"(x))
  #define GAPA(MF,A0,A1,A2,A3,W0,W1,PW) do{ MF; sacc+=A0; sacc+=A1; sacc+=A2; sacc+=A3; PIN(sacc); W0; W1; PIN(PW); SBAR(); }while(0)
  #define EX(v) __builtin_amdgcn_exp2f(v)
  #define GAPB(MF,X,B) do{ MF; X[B]=EX(X[B]); X[B+1]=EX(X[B+1]); X[B+2]=EX(X[B+2]); X[B+3]=EX(X[B+3]); PIN(X); SBAR(); }while(0)
  #define VRD(i) do{ vlo[i]=vtr(vp_+(((i)>>2)*4096+((i)&3)*1024)); vhi[i]=vtr(vp_+(((i)>>2)*4096+((i)&3)*1024+512)); }while(0)
  #define KRD(G,j) do{ if(G){ kload2(kf,kp0+sl_next,j); SBAR(); } }while(0)
  #define STEP(C0,C1,P0,P1,t,GK,GV,GL) do{ SBAR(); \
    const lds_cptr vp_=vp0+sl_prev; \
    VRD(0); SBAR(); float sacc=(P0[0]+P0[1]); \
    GAPA(C0=__builtin_amdgcn_mfma_f32_32x32x16_bf16(kf[0],qr[0],zero,0,0,0), P0[2],P0[3],P0[4],P0[5],     pw0[0]=PKW(P0,0), pw0[1]=PKW(P0,2), pw0); \
    VRD(4); SBAR(); GAPA(C1=__builtin_amdgcn_mfma_f32_32x32x16_bf16(kf[1],qr[0],zero,0,0,0), P0[6],P0[7],P0[8],P0[9],     pw0[2]=PKW(P0,4), pw0[3]=PKW(P0,6), pw0); \
    VRD(1); SBAR(); GAPA(C0=__builtin_amdgcn_mfma_f32_32x32x16_bf16(kf[2],qr[1],C0,0,0,0),   P0[10],P0[11],P0[12],P0[13], pw1[0]=PKW(P0,8), pw1[1]=PKW(P0,10), pw1); \
    VRD(5); SBAR(); GAPA(C1=__builtin_amdgcn_mfma_f32_32x32x16_bf16(kf[3],qr[1],C1,0,0,0),   P0[14],P0[15],P1[0],P1[1],   pw1[2]=PKW(P0,12),pw1[3]=PKW(P0,14), pw1); \
    VRD(2); SBAR(); GAPA(C0=__builtin_amdgcn_mfma_f32_32x32x16_bf16(kf[4],qr[2],C0,0,0,0),   P1[2],P1[3],P1[4],P1[5],     pw2[0]=PKW(P1,0), pw2[1]=PKW(P1,2), pw2); \
    VRD(6); SBAR(); GAPA(C1=__builtin_amdgcn_mfma_f32_32x32x16_bf16(kf[5],qr[2],C1,0,0,0),   P1[6],P1[7],P1[8],P1[9],     pw2[2]=PKW(P1,4), pw2[3]=PKW(P1,6), pw2); \
    VRD(3); SBAR(); GAPA(C0=__builtin_amdgcn_mfma_f32_32x32x16_bf16(kf[6],qr[3],C0,0,0,0),   P1[10],P1[11],P1[12],P1[13], pw3[0]=PKW(P1,8), pw3[1]=PKW(P1,10), pw3); \
    VRD(7); SBAR(); GAPA(C1=__builtin_amdgcn_mfma_f32_32x32x16_bf16(kf[7],qr[3],C1,0,0,0),   P1[14],P1[15],0.f,0.f,       pw3[2]=PKW(P1,12),pw3[3]=PKW(P1,14), pw3); \
    l_reg+=sacc; \
    if(GK){DMA_K((t)+3,sl_cur);} if(GV){DMA_V((t)+1,sl_next);} \
    DMASK(C0,C1,t); \
    SBAR(); \
    GAPB(o[0]=__builtin_amdgcn_mfma_f32_32x32x16_bf16(PAF(0),VFR(0),o[0],0,0,0), C0,0); \
    GAPB(o[1]=__builtin_amdgcn_mfma_f32_32x32x16_bf16(PAF(0),VFR(4),o[1],0,0,0), C0,4); \
    KRD(GL,0); GAPB(o[0]=__builtin_amdgcn_mfma_f32_32x32x16_bf16(PAF(1),VFR(1),o[0],0,0,0), C0,8); \
    KRD(GL,1); GAPB(o[1]=__builtin_amdgcn_mfma_f32_32x32x16_bf16(PAF(1),VFR(5),o[1],0,0,0), C0,12); \
    KRD(GL,2); GAPB(o[0]=__builtin_amdgcn_mfma_f32_32x32x16_bf16(PAF(2),VFR(2),o[0],0,0,0), C1,0); \
    KRD(GL,3); GAPB(o[1]=__builtin_amdgcn_mfma_f32_32x32x16_bf16(PAF(2),VFR(6),o[1],0,0,0), C1,4); \
    GAPB(o[0]=__builtin_amdgcn_mfma_f32_32x32x16_bf16(PAF(3),VFR(3),o[0],0,0,0), C1,8); \
    GAPB(o[1]=__builtin_amdgcn_mfma_f32_32x32x16_bf16(PAF(3),VFR(7),o[1],0,0,0), C1,12); \
    }while(0)
  #define ENDW(tt) do{ if((tt)+3<NT){WAIT_BAR(2);} else if((tt)+2<NT){WAIT_BAR(1);} else {WAIT_BAR(0);} }while(0)
  STEP(pB0,pB1,pA0,pA1,1,true,true,true);    ENDW(1); ROT();
  STEP(pA0,pA1,pB0,pB1,2,true,true,true);    ENDW(2); ROT();
  STEP(pB0,pB1,pA0,pA1,3,false,true,true);   ENDW(3); ROT();
  STEP(pA0,pA1,pB0,pB1,4,false,true,true);   ENDW(4); ROT();
  STEP(pB0,pB1,pA0,pA1,5,false,false,false);
  { float sacc=pB0[0]+pB0[1]; _Pragma("unroll") for(int r=2;r<16;++r)sacc+=pB0[r]; _Pragma("unroll") for(int r=0;r<16;++r)sacc+=pB1[r]; l_reg+=sacc;
    pw0=(u32x4){PKW(pB0,0),PKW(pB0,2),PKW(pB0,4),PKW(pB0,6)};pw1=(u32x4){PKW(pB0,8),PKW(pB0,10),PKW(pB0,12),PKW(pB0,14)};pw2=(u32x4){PKW(pB1,0),PKW(pB1,2),PKW(pB1,4),PKW(pB1,6)};pw3=(u32x4){PKW(pB1,8),PKW(pB1,10),PKW(pB1,12),PKW(pB1,14)};
    SBAR(); pv(o,vb0+sl_cur,PAF(0),PAF(1),PAF(2),PAF(3)); }
  #undef PKW
  #undef PAF
  #undef VFR
  #undef PIN
  #undef GAPA
  #undef GAPB
  #undef EX
  #undef VRD
  #undef KRD
  #undef STEP
  #undef ENDW
  #undef DMASK
  {auto rr=__builtin_amdgcn_permlane32_swap(__float_as_uint(l_reg),__float_as_uint(l_reg),false,false);l_reg=__uint_as_float(rr[0])+__uint_as_float(rr[1]);}
  if(hi==0)wsf[32+r32]=l_reg;asm volatile("s_waitcnt lgkmcnt(0)":::"memory");
  float rli[16];
  #pragma unroll
  for(int r=0;r<16;++r)rli[r]=__builtin_amdgcn_rcpf(wsf[32+crow(r,hi)]);
  const int gidx=dsh>>1, hslot=head&3;
  { bf16*stg=(bf16*)(shm+LDS_OST)+wid*2048;
    #pragma unroll
    for(int r=0;r<16;++r){const int orow=crow(r,hi);
      #pragma unroll
      for(int d0=0;d0<2;++d0)stg[orow*64+d0*32+r32]=__float2bfloat16(o[d0][r]*rli[r]);}
    asm volatile("s_waitcnt lgkmcnt(0)":::"memory");
    #pragma unroll
    for(int i=0;i<4;++i){const int row=i*8+(lane>>3),ch=lane&7; const u32x4 v=*(const u32x4*)(stg+row*64+ch*8);
      const long tk=tok0+((long)(j0+wid*QBLK+row)<<dsh); ATTN_STORE16(OG+((long)gidx*(BATCH*SEQ)+tk)*256+hslot*64+ch*8,v);} }
  if(hi==0){ const long tk=tok0+((long)jq<<dsh); LS[((long)gidx*(BATCH*SEQ)+tk)*4+hslot]=__builtin_amdgcn_logf(l_reg); }
  asm volatile("s_waitcnt lgkmcnt(0)\n\ts_barrier":::"memory");
  #undef DMA_K
  #undef DMA_V
  #undef CLAMPJ
  #undef ROT
}
__device__ __forceinline__ void dil_phase(char*lds,const bf16*QA,const bf16*KA,const bf16*VA,bf16*OG,float*LS,int vcu,int G){
  for(int u=vcu;u<1536;u+=G){ const int rc=u&15,bh=u>>4,head=bh%12,b=bh/12,g=head>>2; const int dsh=2*g,L=SEQ>>dsh,nchunk=L>>8; const int r=rc/nchunk,chunk=rc%nchunk;
    dil_unit(b,head,dsh,r,chunk,QA,KA,VA,OG,LS,lds); }
}
constexpr float VT8_SCALE=8.0f;
typedef int v8i32a __attribute__((ext_vector_type(8)));
typedef int v4i32a __attribute__((ext_vector_type(4)));
typedef short v2i16a __attribute__((ext_vector_type(2)));
#if defined(PROBE_DMA)
  #define PROBE_DMA_HOOK(t) do{ glds16(ksrc+(long)(t)*KVBLK*DM,(unsigned)__builtin_amdgcn_readfirstlane(lds0+118784+wid*1024)); }while(0)
#else
  #define PROBE_DMA_HOOK(t) do{}while(0)
#endif
#ifndef DMA_POS
#define DMA_POS 1
#endif
#define DMA_AT(pos,GK,GV,t) do{ if((pos)==DMA_POS){ if(GK){DMA_K((t)+3,sl_cur);} if(GV){DMA_V((t)+1,sl_next);} } else if(DMA_POS==3&&(pos)==1){ if(GK){DMA_K((t)+3,sl_cur);} } }while(0)
#ifndef STAMP_TID
#define STAMP_TID 0
#endif
#if defined(PROBE_STAMP)
  #define STAMP(k) do{ __builtin_amdgcn_sched_barrier(0); unsigned long long t_; asm volatile("s_memtime %0\n\ts_waitcnt lgkmcnt(0)":"=s"(t_)::"memory"); __builtin_amdgcn_sched_barrier(0); \
      if((k)==1) segA+=t_-tprev; else if((k)==2) segB+=t_-tprev; else if((k)==3) segW+=t_-tprev; else if((k)==4) segX+=t_-tprev; tprev=t_; }while(0)
  #define WAIT_BAR2(N) do{ asm volatile("s_waitcnt vmcnt(" #N ") lgkmcnt(0)":::"memory"); STAMP(3); asm volatile("s_barrier":::"memory"); STAMP(4); }while(0)
#else
  #define STAMP(k) do{}while(0)
  #define WAIT_BAR2(N) WAIT_BAR(N)
#endif
template<bool FINAL> __device__ __forceinline__ void attn128f8_unit(int b,int qb,const bf16*Q,const bf16*__restrict__ K,const unsigned char*__restrict__ VT,bf16*O,float pscale,char*shm,const bf16*O1=nullptr,float lam=0.f,const float*subg=nullptr,float*stampout=nullptr){
  const int tid=threadIdx.x,lane=tid&63,r32=lane&31,hi=lane>>5; const int wid=__builtin_amdgcn_readfirstlane(tid>>6);
  const long rowbase=(long)b*SEQ; const int q0=qb*QB;
#if defined(PROBE_STAMP)
  unsigned long long segA=0,segB=0,segW=0,segX=0,tprev=0;
#endif
  const bf16*Qw=Q+(rowbase+q0+wid*QBLK)*DM;
  const bf16*Kh=K+rowbase*DM;
  const unsigned lds0=(unsigned)(uintptr_t)shm;
  float*wsf=(float*)(shm+LDS_WS)+wid*64;
  const int krow_=8*wid+(lane>>3);
  const bf16*ksrc=Kh+(long)krow_*DM+(((lane&7)^((krow_>>1)&7))*8);
  const int vrow_=16*wid+(lane>>2);
  const unsigned char*vsrc=VT+(long)vrow_*64+(((lane&3)^((vrow_>>2)&3))*16);
  const unsigned kdst=lds0+LDS_K+wid*1024, vdst=lds0+LDS_V+wid*1024;
  #define DMA_K(t,slot) glds16(ksrc+(long)(t)*KVBLK*DM,(unsigned)__builtin_amdgcn_readfirstlane(kdst+(slot)))
  #define DMA_V(t,slot) glds16(vsrc+(long)(t)*8192,(unsigned)__builtin_amdgcn_readfirstlane(vdst+(slot)))
  bf16x8 kf[8];
  const lds_cptr shm3=(lds_cptr)shm;
  const int kx_=(r32>>1)&7; const lds_cptr kq0=shm3+LDS_K+r32*128+(((0+hi)^kx_)*16),kq1=shm3+LDS_K+r32*128+(((2+hi)^kx_)*16),kq2=shm3+LDS_K+r32*128+(((4+hi)^kx_)*16),kq3=shm3+LDS_K+r32*128+(((6+hi)^kx_)*16);
  #define KLD(j,base,so) do{ kf[2*(j)]=*(const __attribute__((address_space(3))) bf16x8*)((base)+(so)); kf[2*(j)+1]=*(const __attribute__((address_space(3))) bf16x8*)((base)+(so)+4096); }while(0)
  const int vx_=(r32>>2)&3; const lds_cptr vq0=shm3+LDS_V+r32*64+(((2*hi)^vx_)*16), vq1=shm3+LDS_V+r32*64+(((2*hi+1)^vx_)*16);
  const int NT=SEQ/KVBLK;
  DMA_K(0,0);DMA_V(0,0);DMA_K(1,SLOTB);
  bf16x8 qr[4];
  #pragma unroll
  for(int d0=0;d0<4;++d0)qr[d0]=*reinterpret_cast<const bf16x8*>(&Qw[(long)r32*DM+d0*16+hi*8]);
  float l_reg=0.f;f32x16 o[4];o[0]=f32x16{};o[1]=f32x16{};o[2]=f32x16{};o[3]=f32x16{};
  const f32x16 zero=f32x16{};
  f32x16 pA0,pA1,pB0,pB1;
  int sl_prev=0,sl_cur=0,sl_next=SLOTB;
  #define ROT() do{sl_prev=sl_cur;sl_cur=sl_next;sl_next=(sl_next==(NSLOT-1)*SLOTB)?0:sl_next+SLOTB;}while(0)
  DMA_K(2,2*SLOTB);
  WAIT_BAR(3);
  KLD(0,kq0,0);KLD(1,kq1,0);KLD(2,kq2,0);KLD(3,kq3,0);
  pA0=__builtin_amdgcn_mfma_f32_32x32x16_bf16(kf[0],qr[0],zero,0,0,0);pA1=__builtin_amdgcn_mfma_f32_32x32x16_bf16(kf[1],qr[0],zero,0,0,0);
  _Pragma("unroll") for(int d0=1;d0<4;++d0){pA0=__builtin_amdgcn_mfma_f32_32x32x16_bf16(kf[2*d0],qr[d0],pA0,0,0,0);pA1=__builtin_amdgcn_mfma_f32_32x32x16_bf16(kf[2*d0+1],qr[d0],pA1,0,0,0);}
  _Pragma("unroll") for(int r=0;r<16;++r){pA0[r]=__builtin_amdgcn_exp2f(pA0[r]);pA1[r]=__builtin_amdgcn_exp2f(pA1[r]);}
  WAIT_BAR(0);
  DMA_K(3,0);DMA_V(1,SLOTB);
  ROT();
  KLD(0,kq0,sl_cur);KLD(1,kq1,sl_cur);KLD(2,kq2,sl_cur);KLD(3,kq3,sl_cur);
  WAIT_BAR(2);
  v8i32a vf[4]; v8i32a p8; int mxone=0x7F7F7F7F; asm volatile("":"+v"(mxone));
  #define P8CVT(P,B) __builtin_bit_cast(int,__builtin_amdgcn_cvt_scalef32_pk_fp8_f32(__builtin_amdgcn_cvt_scalef32_pk_fp8_f32((v2i16a){0,0},P[B],P[(B)+1],pscale,false),P[(B)+2],P[(B)+3],pscale,true))
  #define PIN(x) asm volatile("":"+v"(x))
  #define GAPA8(MF,A0,A1,A2,A3,W) do{ MF; sacc+=A0; sacc+=A1; sacc+=A2; sacc+=A3; PIN(sacc); W; SB128(); }while(0)
  #define EX(v) __builtin_amdgcn_exp2f(v)
  #define GAPB8(MF,X,B) do{ MF; X[B]=EX(X[B]); X[B+1]=EX(X[B+1]); X[B+2]=EX(X[B+2]); X[B+3]=EX(X[B+3]); X[B+4]=EX(X[B+4]); X[B+5]=EX(X[B+5]); X[B+6]=EX(X[B+6]); X[B+7]=EX(X[B+7]); PIN(X); SB128(); }while(0)
  #define VRDA(i) do{ const v4i32a t_=*(const __attribute__((address_space(3))) v4i32a*)(vq0+sl_prev+(i)*2048); vf[i][0]=t_[0];vf[i][1]=t_[1];vf[i][2]=t_[2];vf[i][3]=t_[3]; }while(0)
  #define VRDB(i) do{ const v4i32a t_=*(const __attribute__((address_space(3))) v4i32a*)(vq1+sl_prev+(i)*2048); vf[i][4]=t_[0];vf[i][5]=t_[1];vf[i][6]=t_[2];vf[i][7]=t_[3]; }while(0)
  #define VF8(i) vf[i]
  #define P8V() p8
  #define PVMF(i) asm volatile("s_nop 3\n\tv_mfma_scale_f32_32x32x64_f8f6f4 %0, %1, %2, %0, %3, %3 op_sel_hi:[0,0,0]":"+v"(o[i]):"v"(P8V()),"v"(VF8(i)),"v"(mxone))
  #define KRD(G,j) do{ if(G){ KLD(j,kq##j,sl_next); SB128(); } }while(0)
#if defined(A128_COARSE)
  #define STEP(C0,C1,P0,P1,t,GK,GV,GL) do{ SB128(); STAMP(0); \
    C0=__builtin_amdgcn_mfma_f32_32x32x16_bf16(kf[0],qr[0],zero,0,0,0); C1=__builtin_amdgcn_mfma_f32_32x32x16_bf16(kf[1],qr[0],zero,0,0,0); \
    C0=__builtin_amdgcn_mfma_f32_32x32x16_bf16(kf[2],qr[1],C0,0,0,0);   C1=__builtin_amdgcn_mfma_f32_32x32x16_bf16(kf[3],qr[1],C1,0,0,0); \
    C0=__builtin_amdgcn_mfma_f32_32x32x16_bf16(kf[4],qr[2],C0,0,0,0);   C1=__builtin_amdgcn_mfma_f32_32x32x16_bf16(kf[5],qr[2],C1,0,0,0); \
    C0=__builtin_amdgcn_mfma_f32_32x32x16_bf16(kf[6],qr[3],C0,0,0,0);   C1=__builtin_amdgcn_mfma_f32_32x32x16_bf16(kf[7],qr[3],C1,0,0,0); \
    SB128(); \
    VRDA(0);VRDB(0);VRDA(1);VRDB(1);VRDA(2);VRDB(2);VRDA(3);VRDB(3); \
    { float sacc=(P0[0]+P0[1]),sacd=(P1[0]+P1[1]); \
      _Pragma("unroll") for(int r_=2;r_<16;++r_){ sacc+=P0[r_]; sacd+=P1[r_]; } \
      l_reg+=sacc+sacd; } \
    p8[0]=P8CVT(P0,0);p8[1]=P8CVT(P0,4);p8[2]=P8CVT(P0,8);p8[3]=P8CVT(P0,12);p8[4]=P8CVT(P1,0);p8[5]=P8CVT(P1,4);p8[6]=P8CVT(P1,8);p8[7]=P8CVT(P1,12); \
    STAMP(1); SB128(); \
    PVMF(0);PVMF(1);PVMF(2);PVMF(3); \
    SB128(); \
    _Pragma("unroll") for(int r_=0;r_<16;++r_){ C0[r_]=EX(C0[r_]); C1[r_]=EX(C1[r_]); } \
    if(GL){ KLD(0,kq0,sl_next);KLD(1,kq1,sl_next);KLD(2,kq2,sl_next);KLD(3,kq3,sl_next); } \
    if(GK){DMA_K((t)+3,sl_cur);} if(GV){DMA_V((t)+1,sl_next);} \
    STAMP(2); SB128(); \
    }while(0)
#else
  #define STEP(C0,C1,P0,P1,t,GK,GV,GL) do{ SB128(); STAMP(0); \
    if(DMA_POS==3){ if(GV){DMA_V((t)+1,sl_next);} } \
    VRDA(0); SB128(); float sacc=(P0[0]+P0[1]); \
    GAPA8(C0=__builtin_amdgcn_mfma_f32_32x32x16_bf16(kf[0],qr[0],zero,0,0,0), P0[2],P0[3],P0[4],P0[5],     p8[0]=P8CVT(P0,0)); \
    VRDB(0); SB128(); GAPA8(C1=__builtin_amdgcn_mfma_f32_32x32x16_bf16(kf[1],qr[0],zero,0,0,0), P0[6],P0[7],P0[8],P0[9],     p8[1]=P8CVT(P0,4)); \
    VRDA(1); SB128(); GAPA8(C0=__builtin_amdgcn_mfma_f32_32x32x16_bf16(kf[2],qr[1],C0,0,0,0),   P0[10],P0[11],P0[12],P0[13], p8[2]=P8CVT(P0,8)); \
    VRDB(1); SB128(); GAPA8(C1=__builtin_amdgcn_mfma_f32_32x32x16_bf16(kf[3],qr[1],C1,0,0,0),   P0[14],P0[15],P1[0],P1[1],   p8[3]=P8CVT(P0,12)); \
    VRDA(2); SB128(); GAPA8(C0=__builtin_amdgcn_mfma_f32_32x32x16_bf16(kf[4],qr[2],C0,0,0,0),   P1[2],P1[3],P1[4],P1[5],     p8[4]=P8CVT(P1,0)); \
    VRDB(2); SB128(); GAPA8(C1=__builtin_amdgcn_mfma_f32_32x32x16_bf16(kf[5],qr[2],C1,0,0,0),   P1[6],P1[7],P1[8],P1[9],     p8[5]=P8CVT(P1,4)); \
    VRDA(3); SB128(); GAPA8(C0=__builtin_amdgcn_mfma_f32_32x32x16_bf16(kf[6],qr[3],C0,0,0,0),   P1[10],P1[11],P1[12],P1[13], p8[6]=P8CVT(P1,8)); \
    VRDB(3); SB128(); GAPA8(C1=__builtin_amdgcn_mfma_f32_32x32x16_bf16(kf[7],qr[3],C1,0,0,0),   P1[14],P1[15],0.f,0.f,       p8[7]=P8CVT(P1,12)); \
    l_reg+=sacc; STAMP(1); \
    PROBE_DMA_HOOK(t); DMA_AT(0,GK,GV,t); \
    SB128(); \
    GAPB8(PVMF(0), C0,0); \
    KRD(GL,0); KRD(GL,1); GAPB8(PVMF(1), C0,8); \
    KRD(GL,2); KRD(GL,3); GAPB8(PVMF(2), C1,0); DMA_AT(1,GK,GV,t); \
    GAPB8(PVMF(3), C1,8); DMA_AT(2,GK,GV,t); STAMP(2); \
    }while(0)
#endif
#if defined(A128_PRIO)
  if(wid>=4) __builtin_amdgcn_s_setprio(A128_PRIO);
#endif
  int t=1;
  for(;t+5<NT;t+=2){
    STEP(pB0,pB1,pA0,pA1,t,true,true,true);     WAIT_BAR2(2); ROT();
    STEP(pA0,pA1,pB0,pB1,t+1,true,true,true);   WAIT_BAR2(2); ROT();
  }
  #define ENDW(tt) do{ if((tt)+3<NT){WAIT_BAR(2);} else if((tt)+2<NT){WAIT_BAR(1);} else {WAIT_BAR(0);} }while(0)
  for(;t+1<NT;t+=2){
    STEP(pB0,pB1,pA0,pA1,t,(t+3<NT),(t+1<NT),(t+1<NT));       ENDW(t);   ROT();
    STEP(pA0,pA1,pB0,pB1,t+1,(t+4<NT),(t+2<NT),(t+2<NT));     ENDW(t+1); ROT();
  }
  STEP(pB0,pB1,pA0,pA1,NT-1,false,false,false);
  { float sacc=pB0[0]+pB0[1]; _Pragma("unroll") for(int r=2;r<16;++r)sacc+=pB0[r]; _Pragma("unroll") for(int r=0;r<16;++r)sacc+=pB1[r]; l_reg+=sacc;
    p8[0]=P8CVT(pB0,0);p8[1]=P8CVT(pB0,4);p8[2]=P8CVT(pB0,8);p8[3]=P8CVT(pB0,12);p8[4]=P8CVT(pB1,0);p8[5]=P8CVT(pB1,4);p8[6]=P8CVT(pB1,8);p8[7]=P8CVT(pB1,12);
    sl_prev=sl_cur;
    VRDA(0);VRDB(0);VRDA(1);VRDB(1);VRDA(2);VRDB(2);VRDA(3);VRDB(3);
    PVMF(0);PVMF(1);PVMF(2);PVMF(3); asm volatile("s_nop 15\n\ts_nop 15":"+v"(o[0]),"+v"(o[1]),"+v"(o[2]),"+v"(o[3])); }
  #undef P8CVT
  #undef PIN
  #undef GAPA8
  #undef GAPB8
  #undef EX
  #undef VRDA
  #undef VRDB
  #undef VF8
  #undef P8V
  #undef PVMF
  #undef KRD
  #undef KLD
  #undef STEP
  #undef ENDW
#if defined(A128_PRIO)
  __builtin_amdgcn_s_setprio(0);
#endif
  {auto rr=__builtin_amdgcn_permlane32_swap(__float_as_uint(l_reg),__float_as_uint(l_reg),false,false);l_reg=__uint_as_float(rr[0])+__uint_as_float(rr[1]);}
  if(hi==0)wsf[32+r32]=l_reg*(VT8_SCALE/pscale);asm volatile("s_waitcnt lgkmcnt(0)":::"memory");
  float rli[16];
  #pragma unroll
  for(int r=0;r<16;++r)rli[r]=__builtin_amdgcn_rcpf(wsf[32+crow(r,hi)]);
  bf16*Ow=O+(rowbase+q0+wid*QBLK)*DM;
  if constexpr(!FINAL){
  { bf16*stg=(bf16*)(shm+LDS_OST)+wid*4096;
    #pragma unroll
    for(int hh=0;hh<2;++hh){
      #pragma unroll
      for(int r=0;r<16;++r){const int orow=crow(r,hi);
        #pragma unroll
        for(int d0=0;d0<2;++d0)stg[orow*64+d0*32+r32]=__float2bfloat16(o[2*hh+d0][r]*rli[r]);}
      asm volatile("s_waitcnt lgkmcnt(0)":::"memory");
      #pragma unroll
      for(int i=0;i<4;++i){const int row=i*8+(lane>>3),ch=lane&7; const u32x4 v=*(const u32x4*)(stg+row*64+ch*8); ATTN_STORE16(Ow+(long)row*DM+hh*64+ch*8,v);}
      asm volatile("s_waitcnt lgkmcnt(0)":::"memory");
    } }
  } else {
  { bf16*stg=(bf16*)(shm+LDS_OST)+wid*4096;
    #pragma unroll
    for(int r=0;r<16;++r){const int orow=crow(r,hi);
      #pragma unroll
      for(int d0=0;d0<4;++d0)stg[orow*128+d0*32+r32]=__float2bfloat16(o[d0][r]*rli[r]);}
    asm volatile("s_waitcnt lgkmcnt(0)":::"memory");
    const float*subg2=subg; const bf16*O1b=O1; float lam2=lam; asm volatile("":"+s"(subg2),"+s"(O1b),"+v"(lam2));
    const int ch=lane&15; float sg[8];
    #pragma unroll
    for(int e=0;e<8;++e)sg[e]=subg2[ch*8+e]*0.8f;
    const bf16*O1w=O1b+(rowbase+q0+wid*QBLK)*DM;
    #pragma unroll 1
    for(int i=0;i<8;++i){const int row=i*4+(lane>>4);
      const u32x4 a2=*(const u32x4*)(stg+row*128+ch*8); const u32x4 a1=*(const u32x4*)(O1w+(long)row*DM+ch*8);
      float v[8]; const unsigned w1[4]={a1.x,a1.y,a1.z,a1.w},w2[4]={a2.x,a2.y,a2.z,a2.w};
      #pragma unroll
      for(int e=0;e<4;++e){ v[2*e]=__uint_as_float(w1[e]<<16)-lam2*__uint_as_float(w2[e]<<16); v[2*e+1]=__uint_as_float(w1[e]&0xffff0000u)-lam2*__uint_as_float(w2[e]&0xffff0000u); }
      float ss=0.f;
      #pragma unroll
      for(int e=0;e<8;++e)ss+=v[e]*v[e];
      ss+=__shfl_xor(ss,1);ss+=__shfl_xor(ss,2);ss+=__shfl_xor(ss,4);ss+=__shfl_xor(ss,8);
      const float rstd=1.f/sqrtf(ss*(1.f/128.f)+1e-6f);
      u32x4 wo; wo.x=cvtpk_s(v[0]*rstd*sg[0],v[1]*rstd*sg[1]); wo.y=cvtpk_s(v[2]*rstd*sg[2],v[3]*rstd*sg[3]); wo.z=cvtpk_s(v[4]*rstd*sg[4],v[5]*rstd*sg[5]); wo.w=cvtpk_s(v[6]*rstd*sg[6],v[7]*rstd*sg[7]);
      ATTN_STORE16(Ow+(long)row*DM+ch*8,wo); if(i&1) asm volatile("":::"memory"); }
    asm volatile("s_waitcnt lgkmcnt(0)":::"memory");
  }
  }
#if defined(PROBE_STAMP)
  if(blockIdx.x==0&&tid==STAMP_TID&&stampout){ stampout[0]+=(float)segA; stampout[1]+=(float)segB; stampout[2]+=(float)segW; stampout[3]+=(float)segX; }
#endif
  asm volatile("s_waitcnt lgkmcnt(0)\n\ts_barrier":::"memory");
  #undef DMA_K
  #undef DMA_V
  #undef ROT
}
#ifndef Q8_OLDDMA
#define Q8_OLDDMA 0
#endif
__device__ __forceinline__ void glds16_old(const void*gsrc,unsigned lds_dst,int wid){unsigned keep;
  asm volatile("s_cmp_lt_u32 %3, 4\n\ts_cbranch_scc0 1f\n\ts_mov_b32 %0, m0\n\ts_mov_b32 m0, %2\n\ts_nop 0\n\tglobal_load_lds_dwordx4 %1, off\n\ts_mov_b32 m0, %0\n1:":"=&s"(keep):"v"(gsrc),"s"(lds_dst),"s"(wid):"memory","scc");}
constexpr int Q8_KSLOT=8192  , Q8_LDS_K=0, Q8_LDS_V=3*Q8_KSLOT, Q8_LDS_WS=Q8_LDS_V+3*8192, Q8_LDS_OST=Q8_LDS_WS+NW*64*4;
template<bool FINAL> __device__ __forceinline__ void attn128q8_unit(int b,int qb,const unsigned char*Q8,const unsigned char*__restrict__ K8,const unsigned char*__restrict__ VT,bf16*O,float pscale,char*shm,const bf16*O1=nullptr,float lam=0.f,const float*subg=nullptr){
  const int tid=threadIdx.x,lane=tid&63,r32=lane&31,hi=lane>>5; const int wid=__builtin_amdgcn_readfirstlane(tid>>6);
  const long rowbase=(long)b*SEQ; const int q0=qb*QB;
  const unsigned lds0=(unsigned)(uintptr_t)shm;
  float*wsf=(float*)(shm+Q8_LDS_WS)+wid*64;
#if Q8_OLDDMA
  const int krow_=16*(wid&3)+(lane>>2);
  const unsigned char*ksrc=K8+(rowbase+krow_)*DM+(((lane&3)^((krow_>>2)&3))*16);
  const int vrow_=16*(wid&3)+(lane>>2);
#else
  const int krow_=16*(wid&3)+(lane>>2);
  const unsigned char*ksrc=K8+(rowbase+(wid>>2)*64+krow_)*DM+(((lane&3)^((krow_>>2)&3))*16);
  const int vrow_=16*wid+(lane>>2);
#endif
  const unsigned char*vsrc=VT+(long)vrow_*64+(((lane&3)^((vrow_>>2)&3))*16);
#if Q8_OLDDMA
  const unsigned kdst=lds0+Q8_LDS_K+(wid&3)*1024, vdst=lds0+Q8_LDS_V+(wid&3)*1024;
#else
  const unsigned kdst=lds0+Q8_LDS_K+wid*1024, vdst=lds0+Q8_LDS_V+wid*1024;
#endif
#if Q8_OLDDMA
  #define DMA_KD(dbl,slot) do{ glds16_old(ksrc+(long)(dbl)*(2*KVBLK)*DM,(unsigned)__builtin_amdgcn_readfirstlane(kdst+(slot)),wid); glds16_old(ksrc+(long)(dbl)*(2*KVBLK)*DM+(long)KVBLK*DM,(unsigned)__builtin_amdgcn_readfirstlane(kdst+(slot)+4096),wid); }while(0)
  #define DMA_V(t,slot) do{ glds16_old(vsrc+(long)(t)*8192,(unsigned)__builtin_amdgcn_readfirstlane(vdst+(slot)),wid); glds16_old(vsrc+(long)(t)*8192+4096,(unsigned)__builtin_amdgcn_readfirstlane(vdst+(slot)+4096),wid); }while(0)
  #define WB_(a,b) WAIT_BAR(b)
#else
  #define DMA_KD(dbl,slot) glds16(ksrc+(long)(dbl)*(2*KVBLK)*DM,(unsigned)__builtin_amdgcn_readfirstlane(kdst+(slot)))
  #define DMA_V(t,slot) glds16(vsrc+(long)(t)*8192,(unsigned)__builtin_amdgcn_readfirstlane(vdst+(slot)))
  #define WB_(a,b) WAIT_BAR(a)
#endif
  const lds_cptr shm3=(lds_cptr)shm;
  const int vx_=(r32>>2)&3;
  const lds_cptr kq0=shm3+Q8_LDS_K+r32*64+(((2*hi)^vx_)*16), kq1=shm3+Q8_LDS_K+r32*64+(((2*hi+1)^vx_)*16);
  const lds_cptr vq0=shm3+Q8_LDS_V+r32*64+(((2*hi)^vx_)*16), vq1=shm3+Q8_LDS_V+r32*64+(((2*hi+1)^vx_)*16);
  constexpr int NT=SEQ/KVBLK;
  DMA_KD(0,0);DMA_V(0,0);DMA_KD(1,SLOTB);
  v8i32a qf;
  { const unsigned char*qp=Q8+(rowbase+q0+wid*QBLK+r32)*DM+hi*32; const v4i32a a_=*(const v4i32a*)qp, b_=*(const v4i32a*)(qp+16);
    qf[0]=a_[0];qf[1]=a_[1];qf[2]=a_[2];qf[3]=a_[3];qf[4]=b_[0];qf[5]=b_[1];qf[6]=b_[2];qf[7]=b_[3]; }
  float l_reg=0.f;f32x16 o[4];o[0]=f32x16{};o[1]=f32x16{};o[2]=f32x16{};o[3]=f32x16{};
  f32x16 pA0,pA1,pB0,pB1;
  int sl_prev=0,sl_cur=0,sl_next=SLOTB;
  #define ROT() do{sl_prev=sl_cur;sl_cur=sl_next;sl_next=(sl_next==(NSLOT-1)*SLOTB)?0:sl_next+SLOTB;}while(0)
  v8i32a kfa,kfb,vf[4],p8; int mxone=0x7F7F7F7F,mxk=0x7B7B7B7B,mxq=0x79797979; asm volatile("":"+v"(mxone),"+v"(mxk),"+v"(mxq));
  #define KLD8(so) do{ const v4i32a a_=*(const __attribute__((address_space(3))) v4i32a*)(kq0+(so)), b_=*(const __attribute__((address_space(3))) v4i32a*)(kq1+(so)), \
      c_=*(const __attribute__((address_space(3))) v4i32a*)(kq0+(so)+2048), d_=*(const __attribute__((address_space(3))) v4i32a*)(kq1+(so)+2048); \
      kfa[0]=a_[0];kfa[1]=a_[1];kfa[2]=a_[2];kfa[3]=a_[3];kfa[4]=b_[0];kfa[5]=b_[1];kfa[6]=b_[2];kfa[7]=b_[3]; kfb[0]=c_[0];kfb[1]=c_[1];kfb[2]=c_[2];kfb[3]=c_[3];kfb[4]=d_[0];kfb[5]=d_[1];kfb[6]=d_[2];kfb[7]=d_[3]; }while(0)
#if defined(Q8_PRIO)
  #define QKMF(C,KF) asm volatile("s_setprio 1\n\ts_nop 1\n\tv_mfma_scale_f32_32x32x64_f8f6f4 %0, %1, %2, 0, %3, %4 op_sel_hi:[0,0,0]\n\ts_setprio 0":"=&v"(C):"v"(KF),"v"(qf),"v"(mxk),"v"(mxq))
#else
  #define QKMF(C,KF) asm volatile("s_nop 1\n\tv_mfma_scale_f32_32x32x64_f8f6f4 %0, %1, %2, 0, %3, %4 op_sel_hi:[0,0,0]":"=&v"(C):"v"(KF),"v"(qf),"v"(mxk),"v"(mxq))
#endif
  WAIT_BAR(0);
  KLD8(0);
  QKMF(pA0,kfa);QKMF(pA1,kfb);
  asm volatile("s_nop 15\n\ts_nop 15":"+v"(pA0),"+v"(pA1));
  _Pragma("unroll") for(int r=0;r<16;++r){pA0[r]=__builtin_amdgcn_exp2f(pA0[r]);pA1[r]=__builtin_amdgcn_exp2f(pA1[r]);}
  DMA_KD(2,2*SLOTB);DMA_V(1,SLOTB);
  ROT();
  KLD8(4096);
  WB_(2,4);
  int kcur=SLOTB,kprev=0,knext=2*SLOTB;
  v2i16a p8undef_;
  #define P8CVT(P,B) __builtin_bit_cast(int,__builtin_amdgcn_cvt_scalef32_pk_fp8_f32(__builtin_amdgcn_cvt_scalef32_pk_fp8_f32(p8undef_,P[B],P[(B)+1],pscale,false),P[(B)+2],P[(B)+3],pscale,true))
  #define EX(v) __builtin_amdgcn_exp2f(v)
  #define VRDA(i) do{ const v4i32a t_=*(const __attribute__((address_space(3))) v4i32a*)(vq0+sl_prev+(i)*2048); vf[i][0]=t_[0];vf[i][1]=t_[1];vf[i][2]=t_[2];vf[i][3]=t_[3]; }while(0)
  #define VRDB(i) do{ const v4i32a t_=*(const __attribute__((address_space(3))) v4i32a*)(vq1+sl_prev+(i)*2048); vf[i][4]=t_[0];vf[i][5]=t_[1];vf[i][6]=t_[2];vf[i][7]=t_[3]; }while(0)
#if defined(Q8_PRIO)
  #define PVMF(i) asm volatile("s_setprio 1\n\ts_nop 3\n\tv_mfma_scale_f32_32x32x64_f8f6f4 %0, %1, %2, %0, %3, %3 op_sel_hi:[0,0,0]\n\ts_setprio 0":"+v"(o[i]):"v"(p8),"v"(vf[i]),"v"(mxone))
#else
  #define PVMF(i) asm volatile("s_nop 3\n\tv_mfma_scale_f32_32x32x64_f8f6f4 %0, %1, %2, %0, %3, %3 op_sel_hi:[0,0,0]":"+v"(o[i]):"v"(p8),"v"(vf[i]),"v"(mxone))
#endif
  #define EX8(X,B) do{ X[B]=EX(X[B]); X[B+1]=EX(X[B+1]); X[B+2]=EX(X[B+2]); X[B+3]=EX(X[B+3]); X[B+4]=EX(X[B+4]); X[B+5]=EX(X[B+5]); X[B+6]=EX(X[B+6]); X[B+7]=EX(X[B+7]); }while(0)
  #define STEP(C0,C1,P0,P1,t,KOFF,GK,KD,GV,GL) do{ SB128(); \
    QKMF(C0,kfa); \
    VRDA(0);VRDB(0);VRDA(1);VRDB(1); \
    { float sacc=(P0[0]+P0[1]); _Pragma("unroll") for(int r_=2;r_<16;++r_) sacc+=P0[r_]; l_reg+=sacc; } \
    p8[0]=P8CVT(P0,0);p8[1]=P8CVT(P0,4);p8[2]=P8CVT(P0,8);p8[3]=P8CVT(P0,12); SB128(); \
    QKMF(C1,kfb); \
    VRDA(2);VRDB(2);VRDA(3);VRDB(3); \
    { float sacc=(P1[0]+P1[1]); _Pragma("unroll") for(int r_=2;r_<16;++r_) sacc+=P1[r_]; l_reg+=sacc; } \
    p8[4]=P8CVT(P1,0);p8[5]=P8CVT(P1,4);p8[6]=P8CVT(P1,8);p8[7]=P8CVT(P1,12); SB128(); \
    PVMF(0); asm volatile("s_nop 7":"+v"(C0),"+v"(C1)); EX8(C0,0); SB128(); \
    PVMF(1); EX8(C0,8); if(GL){ KLD8(KOFF); } SB128(); \
    PVMF(2); EX8(C1,0); if(GK){DMA_KD(KD,kprev);} if(GV){DMA_V((t)+1,sl_next);} SB128(); \
    PVMF(3); EX8(C1,8); SB128(); \
    }while(0)
  #define KROT() do{ const int o_=kprev; kprev=kcur; kcur=knext; knext=o_; }while(0)
  int t=1;
  for(;t+5<NT;t+=2){
    STEP(pB0,pB1,pA0,pA1,t,  kcur,     false,0,          true,true);   WB_(1,2); ROT();
    STEP(pA0,pA1,pB0,pB1,t+1,kcur+4096,true,((t+1)>>1)+2,true,true);   WB_(2,4); ROT(); KROT();
  }
  STEP(pB0,pB1,pA0,pA1,t,  kcur,     false,0,true,true);   WB_(1,2); ROT();
  STEP(pA0,pA1,pB0,pB1,t+1,kcur+4096,false,0,true,true);   WB_(1,2); ROT(); KROT();
  STEP(pB0,pB1,pA0,pA1,t+2,kcur,     false,0,true,true);   WB_(1,2); ROT();
  STEP(pA0,pA1,pB0,pB1,t+3,kcur+4096,false,0,true,true);   WAIT_BAR(0); ROT(); KROT();
  STEP(pB0,pB1,pA0,pA1,NT-1,0,false,0,false,false);
  { float sacc=pB0[0]+pB0[1]; _Pragma("unroll") for(int r=2;r<16;++r)sacc+=pB0[r]; _Pragma("unroll") for(int r=0;r<16;++r)sacc+=pB1[r]; l_reg+=sacc;
    p8[0]=P8CVT(pB0,0);p8[1]=P8CVT(pB0,4);p8[2]=P8CVT(pB0,8);p8[3]=P8CVT(pB0,12);p8[4]=P8CVT(pB1,0);p8[5]=P8CVT(pB1,4);p8[6]=P8CVT(pB1,8);p8[7]=P8CVT(pB1,12);
    sl_prev=sl_cur;
    VRDA(0);VRDB(0);VRDA(1);VRDB(1);VRDA(2);VRDB(2);VRDA(3);VRDB(3);
    PVMF(0);PVMF(1);PVMF(2);PVMF(3); asm volatile("s_nop 15\n\ts_nop 15":"+v"(o[0]),"+v"(o[1]),"+v"(o[2]),"+v"(o[3])); }
  #undef P8CVT
  #undef EX
  #undef EX8
  #undef VRDA
  #undef VRDB
  #undef PVMF
  #undef QKMF
  #undef KLD8
  #undef STEP
  #undef KROT
  {auto rr=__builtin_amdgcn_permlane32_swap(__float_as_uint(l_reg),__float_as_uint(l_reg),false,false);l_reg=__uint_as_float(rr[0])+__uint_as_float(rr[1]);}
  if(hi==0)wsf[32+r32]=l_reg*(VT8_SCALE/pscale);asm volatile("s_waitcnt lgkmcnt(0)":::"memory");
  float rli[16];
  #pragma unroll
  for(int r=0;r<16;++r)rli[r]=__builtin_amdgcn_rcpf(wsf[32+crow(r,hi)]);
  bf16*Ow=O+(rowbase+q0+wid*QBLK)*DM;
  if constexpr(!FINAL){
  { bf16*stg=(bf16*)(shm+Q8_LDS_OST)+wid*4096;
    #pragma unroll
    for(int hh=0;hh<2;++hh){
      #pragma unroll
      for(int r=0;r<16;++r){const int orow=crow(r,hi);
        #pragma unroll
        for(int d0=0;d0<2;++d0)stg[orow*64+d0*32+r32]=__float2bfloat16(o[2*hh+d0][r]*rli[r]);}
      asm volatile("s_waitcnt lgkmcnt(0)":::"memory");
      #pragma unroll
      for(int i=0;i<4;++i){const int row=i*8+(lane>>3),ch=lane&7; const u32x4 v=*(const u32x4*)(stg+row*64+ch*8); ATTN_STORE16(Ow+(long)row*DM+hh*64+ch*8,v);}
      asm volatile("s_waitcnt lgkmcnt(0)":::"memory");
    } }
  } else {
  { bf16*stg=(bf16*)(shm+Q8_LDS_OST)+wid*4096;
    #pragma unroll
    for(int r=0;r<16;++r){const int orow=crow(r,hi);
      #pragma unroll
      for(int d0=0;d0<4;++d0)stg[orow*128+d0*32+r32]=__float2bfloat16(o[d0][r]*rli[r]);}
    asm volatile("s_waitcnt lgkmcnt(0)":::"memory");
    const float*subg2=subg; const bf16*O1b=O1; float lam2=lam; asm volatile("":"+s"(subg2),"+s"(O1b),"+v"(lam2));
    const int ch=lane&15; float sg[8];
    #pragma unroll
    for(int e=0;e<8;++e)sg[e]=subg2[ch*8+e]*0.8f;
    const bf16*O1w=O1b+(rowbase+q0+wid*QBLK)*DM;
    #pragma unroll 1
    for(int i=0;i<8;++i){const int row=i*4+(lane>>4);
      const u32x4 a2=*(const u32x4*)(stg+row*128+ch*8); const u32x4 a1=*(const u32x4*)(O1w+(long)row*DM+ch*8);
      float v[8]; const unsigned w1[4]={a1.x,a1.y,a1.z,a1.w},w2[4]={a2.x,a2.y,a2.z,a2.w};
      #pragma unroll
      for(int e=0;e<4;++e){ v[2*e]=__uint_as_float(w1[e]<<16)-lam2*__uint_as_float(w2[e]<<16); v[2*e+1]=__uint_as_float(w1[e]&0xffff0000u)-lam2*__uint_as_float(w2[e]&0xffff0000u); }
      float ss=0.f;
      #pragma unroll
      for(int e=0;e<8;++e)ss+=v[e]*v[e];
      ss+=__shfl_xor(ss,1);ss+=__shfl_xor(ss,2);ss+=__shfl_xor(ss,4);ss+=__shfl_xor(ss,8);
      const float rstd=1.f/sqrtf(ss*(1.f/128.f)+1e-6f);
      u32x4 wo; wo.x=cvtpk_s(v[0]*rstd*sg[0],v[1]*rstd*sg[1]); wo.y=cvtpk_s(v[2]*rstd*sg[2],v[3]*rstd*sg[3]); wo.z=cvtpk_s(v[4]*rstd*sg[4],v[5]*rstd*sg[5]); wo.w=cvtpk_s(v[6]*rstd*sg[6],v[7]*rstd*sg[7]);
      ATTN_STORE16(Ow+(long)row*DM+ch*8,wo); }
    asm volatile("s_waitcnt lgkmcnt(0)":::"memory");
  }
  }
  asm volatile("s_waitcnt lgkmcnt(0)\n\ts_barrier":::"memory");
  #undef DMA_KD
  #undef DMA_V
  #undef WB_
  #undef ROT
}
struct DiffFusedOrder {
  int vcu,G,blk;
  __device__ __forceinline__ explicit DiffFusedOrder(int grid,int block):vcu((block%8)*(grid/8)+block/8),G(grid),blk(block){}
  __device__ __forceinline__ bool next(int i,int&bh,int&qb)const{
    if(G==256){ if(i>=4)return false; bh=(vcu>>5)*8+2*i+((vcu>>4)&1); qb=vcu&15; return true; }
    const int L=i*G+blk; if(L>=1024)return false; bh=L>>4; qb=L&15; return true; }
};
__device__ __forceinline__ void diff128f8_phase(char*lds,const bf16*QB,const bf16*KB,const unsigned char*VT8,bf16*O1,bf16*OB,float pscale,float lam,const float*subg,const DiffFusedOrder&S,float*stampout=nullptr){
  int bh,qb;
  for(int i=0;S.next(i,bh,qb);++i){ const int h=bh&7,b=bh>>3;
    attn128f8_unit<false>(b,qb,QB+h*128,KB+h*128,VT8+(size_t)bh*(64*8192),O1+h*128,pscale,lds,nullptr,0.f,nullptr,stampout); }
  asm volatile("s_waitcnt vmcnt(0)":::"memory");
  for(int i=0;S.next(i,bh,qb);++i){ const int h=bh&7,b=bh>>3;
    attn128f8_unit<true>(b,qb,QB+h*128+64,KB+h*128+64,VT8+(size_t)bh*(64*8192),OB+h*128,pscale,lds,O1+h*128,lam,subg); }
}
__device__ __forceinline__ void diff128q8_phase(char*lds,const unsigned char*Q8,const unsigned char*K8,const unsigned char*VT8,bf16*O1,bf16*OB,float pscale,float lam,const float*subg,const DiffFusedOrder&S){
  int bh,qb;
  for(int i=0;S.next(i,bh,qb);++i){ const int h=bh&7,b=bh>>3;
    attn128q8_unit<false>(b,qb,Q8+h*128,K8+h*128,VT8+(size_t)bh*(64*8192),O1+h*128,pscale,lds); }
  asm volatile("s_waitcnt vmcnt(0)":::"memory");
  for(int i=0;S.next(i,bh,qb);++i){ const int h=bh&7,b=bh>>3;
    attn128q8_unit<true>(b,qb,Q8+h*128+64,K8+h*128+64,VT8+(size_t)bh*(64*8192),OB+h*128,pscale,lds,O1+h*128,lam,subg); }
}
constexpr int ATTN_LDS_BYTES=LDS_BYTES;
struct AttnUnit { int pair; int qb; };
struct DiffOrder {
  int vcu,G,blk;
  __device__ __forceinline__ explicit DiffOrder(int grid,int block):vcu((block%8)*(grid/8)+block/8),G(grid),blk(block){}
  __device__ __forceinline__ bool next(int i,AttnUnit&u)const{
    if(G==256){ if(i>=16)return false; u.pair=(vcu&~31)+2*i+((vcu>>4)&1); u.qb=vcu&15; return true; }
    const int L=i*G+blk; if(L>=4096)return false; u.pair=L>>4; u.qb=L&15; return true; }
};
template<int THRL=8> __device__ __forceinline__ void diff_attn_phase(char*lds,const bf16*QB,const bf16*KB,const bf16*VB,bf16*O1,bf16*O2,const DiffOrder&S){
  AttnUnit u;
  for(int i=0;S.next(i,u);++i){ const int b=u.pair>>5,vh=u.pair&31,h=vh>>2,m=(vh>>1)&1,c=vh&1;
    attn_unit<THRL>(b,0,u.qb,QB+h*128+m*64,KB+h*128+m*64,VB+h*128+c*64,(m?O2:O1)+h*128+c*64,lds); }
}
#undef SBAR
#undef WAIT_BAR
}

constexpr int NWAVES = 8;
constexpr size_t MiB = 1u << 20;
constexpr size_t WS_CTL = 0, CTL_ZERO_BYTES = 1 * MiB;
constexpr size_t WS_MOD = 1 * MiB;
constexpr int MOD_LAM = 8 * 6144;
constexpr size_t WS_WIN = 2 * MiB, WS_WPA = 17 * MiB, WS_WPB = 18 * MiB, WS_WOUT = 20 * MiB, WS_WQ = 22 * MiB, WS_SK = 26 * MiB;
constexpr size_t WS_R1 = 32 * MiB;
constexpr size_t WS_QA = 96 * MiB, WS_KA = 144 * MiB, WS_VA = 192 * MiB;
constexpr size_t WS_O1 = 96 * MiB;
constexpr size_t WS_OB = 160 * MiB, WS_OA = 368 * MiB;
constexpr size_t WS_VT8 = 64 * MiB;
constexpr size_t WS_EU = 96 * MiB, WS_EV = 112 * MiB, WS_ESC = 128 * MiB;
constexpr size_t WS_QB = 240 * MiB, WS_KB = 304 * MiB, WS_VB = 368 * MiB;
constexpr size_t WS_MIX = 240 * MiB, WS_TMP = 304 * MiB;
constexpr size_t WS_QP = 240 * MiB;
constexpr size_t WS_OUTG = 432 * MiB, WS_LSE = 480 * MiB;
constexpr size_t WS_IDX = 432 * MiB, WS_GATE = 448 * MiB;
constexpr size_t WS_CS = 432 * MiB;
constexpr size_t WS_DELTA = 368 * MiB;
constexpr size_t WS_END = 512 * MiB;
constexpr int CW_TMO = 0, CW_BAR = 4096, CW_AMAX = 32768;
constexpr size_t WS_SA = 1 * MiB + 256 * 1024, WS_SW = 1 * MiB + 512 * 1024;
constexpr int RING_OFF = 0, RING_BYTES = 131072;
constexpr int LDSCTL_OFF = RING_BYTES, MISC_OFF = LDSCTL_OFF + 320;
constexpr int LDS_BYTES = 147456;
constexpr int N_PHASES = 13;

#define GAS __attribute__((address_space(1)))
#define LAS __attribute__((address_space(3)))
typedef unsigned short bf16;
typedef unsigned v4u __attribute__((ext_vector_type(4)));
typedef float f32x4 __attribute__((ext_vector_type(4)));
typedef short bf16x8 __attribute__((ext_vector_type(8)));
typedef GAS unsigned gu32;
typedef GAS unsigned long long gu64;
#define RLX_AGENT __ATOMIC_RELAXED, __HIP_MEMORY_SCOPE_AGENT
#define LDS_WAIT() asm volatile("s_waitcnt lgkmcnt(0)" ::: "memory")
#define VM_WAIT() asm volatile("s_waitcnt vmcnt(0)" ::: "memory")
__device__ __forceinline__ unsigned long long rt() { return __builtin_amdgcn_s_memrealtime(); }
__device__ __forceinline__ unsigned f2bf(float f) { unsigned u = __builtin_bit_cast(unsigned, f); return (u + 0x7fffu + ((u >> 16) & 1u)) >> 16; }
__device__ __forceinline__ unsigned pk2(float lo, float hi) { return f2bf(lo) | (f2bf(hi) << 16); }

#define XB_TMO      128
#define XB_XCNT(j)  (256  + 64 * (j))
#define XB_XSUB(j)  (1280 + 64 * (j))
#define XB_XGEN(j)  (2304 + 64 * (j))
#define XB_TOP      3328
#define XB_TOPGEN   3392
#define XCD_BAR_WORDS 3456
#define XB_SPIN_CAP (1u << 18)

__device__ __forceinline__ unsigned xb_ld(unsigned* p)              { return __hip_atomic_load(p, __ATOMIC_RELAXED, __HIP_MEMORY_SCOPE_AGENT); }
__device__ __forceinline__ unsigned xb_add(unsigned* p, unsigned v) { return __hip_atomic_fetch_add(p, v, __ATOMIC_RELAXED, __HIP_MEMORY_SCOPE_AGENT); }
__device__ __forceinline__ unsigned xb_xcc_id() { return (unsigned)__builtin_amdgcn_s_getreg((3 << 11) | 20) & 0xFu; }
#define XB_SPIN(cond, bar) do { unsigned _sp = 0; while (cond) { __builtin_amdgcn_s_sleep(1); \
    if ((++_sp & 255u) == 0u) { if (xb_ld(&(bar)[XB_TMO])) break; if (_sp > XB_SPIN_CAP) { atomicAdd(&(bar)[XB_TMO], 1u); break; } } } } while (0)

struct XcdBarrier {
    unsigned* bar; unsigned x;
    volatile LAS unsigned* st;
};

__device__ __forceinline__ XcdBarrier xcd_barrier_post(unsigned* bar, volatile LAS unsigned* st) {
    XcdBarrier b; b.bar = bar; b.x = xb_xcc_id(); b.st = st;
    if (threadIdx.x == 0) (void)xb_add(&bar[XB_XCNT(b.x)], 1u);
    return b;
}
__device__ __forceinline__ void xcd_barrier_complete(unsigned* bar, unsigned x, unsigned& nloc, unsigned& nx) {
    const unsigned G = gridDim.x * gridDim.y * gridDim.z;
    unsigned sum, cnt, mine, sp = 0u;
    for (;;) {
        sum = 0u; cnt = 0u; mine = 0u;
#pragma unroll
        for (unsigned j = 0; j < 16; ++j) { const unsigned c = xb_ld(&bar[XB_XCNT(j)]); sum += c; cnt += (c > 0u) ? 1u : 0u; mine = (j == x) ? c : mine; }
        if (sum == G) break;
        __builtin_amdgcn_s_sleep(1);
        if ((++sp & 255u) == 0u) { if (xb_ld(&bar[XB_TMO])) break; if (sp > XB_SPIN_CAP) { atomicAdd(&bar[XB_TMO], 1u); break; } }
    }
    nloc = mine > 0u ? mine : 1u; nx = cnt > 0u ? cnt : 1u;
}

__device__ __forceinline__ void xcd_barrier(const XcdBarrier& b) {
    asm volatile("s_waitcnt vmcnt(0)" ::: "memory");
    __syncthreads();
    if (threadIdx.x == 0) {
        unsigned* bar = b.bar;
        __builtin_amdgcn_s_waitcnt(0);
        unsigned nloc = b.st[0], nx = b.st[1];
        if (nloc == 0u) { xcd_barrier_complete(bar, b.x, nloc, nx); b.st[0] = nloc; b.st[1] = nx; }
        const unsigned old = xb_add(&bar[XB_XSUB(b.x)], 1u);
        const unsigned gen = old / nloc;
        if (old + 1u == (gen + 1u) * nloc) {
            __builtin_amdgcn_fence(__ATOMIC_RELEASE, "agent");
            asm volatile("s_waitcnt vmcnt(0)" ::: "memory");
            const unsigned og = xb_add(&bar[XB_TOP], 1u);
            const unsigned tg = og / nx;
            if (og + 1u == (tg + 1u) * nx) xb_add(&bar[XB_TOPGEN], 1u);
            else XB_SPIN(xb_ld(&bar[XB_TOPGEN]) == tg, bar);
            __builtin_amdgcn_fence(__ATOMIC_ACQUIRE, "agent");
            xb_add(&bar[XB_XGEN(b.x)], 1u);
            asm volatile("s_waitcnt vmcnt(0)" ::: "memory");
        } else {
            XB_SPIN(xb_ld(&bar[XB_XGEN(b.x)]) == gen, bar);
            __builtin_amdgcn_fence(__ATOMIC_ACQUIRE, "agent");
            asm volatile("s_waitcnt vmcnt(0)" ::: "memory");
        }
    }
    __syncthreads();
}
__device__ __forceinline__ float wave_sum(float v) {
#pragma unroll
    for (int o = 1; o < 64; o <<= 1) v += __shfl_xor(v, o);
    return v;
}
__device__ __forceinline__ void p0_transpose_item(const float* W, int K, int N, bf16* WT, int row_off, LAS float* scr, int item, int lane) {
    const int nblk = N / 32, kb = item / nblk, nb = item % nblk, k0 = 64 * kb, n0 = 32 * nb;
#pragma unroll 8
    for (int i = 0; i < 32; ++i) { const int kk = 2 * i + (lane >> 5); scr[kk * 33 + (lane & 31)] = W[(size_t)(k0 + kk) * N + n0 + (lane & 31)]; }
    LDS_WAIT(); asm volatile("" ::: "memory");
    const int c = lane & 7;
#pragma unroll
    for (int j = 0; j < 4; ++j) { const int n = (lane >> 3) + 8 * j; const LAS float* s = scr + (8 * c) * 33 + n;
        v4u o; o.x = pk2(s[0 * 33], s[1 * 33]); o.y = pk2(s[2 * 33], s[3 * 33]); o.z = pk2(s[4 * 33], s[5 * 33]); o.w = pk2(s[6 * 33], s[7 * 33]);
        *(GAS v4u*)(WT + (size_t)(row_off + n0 + n) * K + k0 + 8 * c) = o; }
    LDS_WAIT(); asm volatile("" ::: "memory");
}

typedef float f32x16 __attribute__((ext_vector_type(16)));
typedef unsigned u32x2 __attribute__((ext_vector_type(2)));
typedef __bf16 bf16x2v __attribute__((ext_vector_type(2)));
struct Frame {
    LAS unsigned char* lds;
    volatile LAS unsigned* MISC;
    gu32* ctl;
    int tid, lane, wave;
    int vcu, G;
};
struct Args { const void* in[25]; float* out; unsigned char* ws; int ph_lo, ph_hi, bar_region, pad; };

__device__ __forceinline__ float bflo(unsigned w) { return __uint_as_float(w << 16); }
__device__ __forceinline__ float bfhi(unsigned w) { return __uint_as_float(w & 0xffff0000u); }
__device__ __forceinline__ float dot2bf(unsigned a, unsigned b, float acc) { return __builtin_amdgcn_fdot2_f32_bf16(__builtin_bit_cast(bf16x2v, a), __builtin_bit_cast(bf16x2v, b), acc, false); }

__device__ __forceinline__ int win_slot(int col) {
    const int pn = col >> 8;
    if (pn < 6 || (pn >= 9 && pn < 17)) { const int within = col & 255; return pn * 256 + 128 * ((within >> 5) & 1) + 32 * (within >> 6) + (within & 31); }
    return col;
}
__device__ __forceinline__ void win_fp8_item(const float* W, const unsigned* amax, unsigned char* WT8, float* sW, LAS float* scr, int item, int lane) {
    constexpr int nblk = IN_W / 32; const int kb = item / nblk, nb = item % nblk, k0 = 64 * kb, n0 = 32 * nb;
#pragma unroll 8
    for (int i = 0; i < 32; ++i) { const int kk = 2 * i + (lane >> 5); scr[kk * 33 + (lane & 31)] = W[(size_t)(k0 + kk) * IN_W + n0 + (lane & 31)]; }
    LDS_WAIT(); asm volatile("" ::: "memory");
    const int n = lane >> 1, hf = lane & 1, slot = win_slot(n0 + n);
    const float am = __uint_as_float(amax[slot]); const float sc = am > 0.f ? 240.0f / am : 1.0f;
    const LAS float* sp = scr + (hf * 32) * 33 + n;
    unsigned w[8];
#pragma unroll
    for (int j = 0; j < 8; ++j) { int t = __builtin_amdgcn_cvt_pk_fp8_f32(sp[(4 * j) * 33] * sc, sp[(4 * j + 1) * 33] * sc, 0, false); t = __builtin_amdgcn_cvt_pk_fp8_f32(sp[(4 * j + 2) * 33] * sc, sp[(4 * j + 3) * 33] * sc, t, true); w[j] = (unsigned)t; }
    unsigned char* dp = WT8 + (size_t)slot * 1024 + k0 + hf * 32;
    *(GAS v4u*)dp = (v4u){w[0], w[1], w[2], w[3]}; *(GAS v4u*)(dp + 16) = (v4u){w[4], w[5], w[6], w[7]};
    if (kb == 0 && hf == 0) sW[slot] = am > 0.f ? am * (1.0f / 240.0f) : 1.0f;
    LDS_WAIT(); asm volatile("" ::: "memory");
}

__device__ __forceinline__ void p0_prologue(Frame& F, const Args& a) {
    float* modp = (float*)(a.ws + WS_MOD);
    {
        LAS float* sc = (LAS float*)F.lds;
        LAS float* red = (LAS float*)(F.lds + 32768);
        const float* c = (const float*)a.in[1]; const float* w_ada = (const float*)a.in[3]; const float* b_ada = (const float*)a.in[4];
        bool did = false;
        for (int u = F.vcu; u < 192; u += F.G) {
            if (!did) { for (int i = F.tid; i < 8192; i += NWAVES * 64) { const float v = c[i]; sc[i] = v / (1.f + __expf(-v)); } __syncthreads(); did = true; }
            const int cc = F.tid & 31, kg = F.tid >> 5, col = u * 32 + cc;
            float acc[8];
#pragma unroll
            for (int b = 0; b < 8; ++b) acc[b] = 0.f;
#pragma unroll 8
            for (int k = kg * 64; k < kg * 64 + 64; ++k) { const float w = w_ada[(size_t)k * 6144 + col];
#pragma unroll
                for (int b = 0; b < 8; ++b) acc[b] += sc[b * 1024 + k] * w; }
#pragma unroll
            for (int b = 0; b < 8; ++b) red[(kg * 8 + b) * 32 + cc] = acc[b];
            __syncthreads();
            if (F.tid < 256) { const int b = F.tid >> 5; float s = b_ada[col];
#pragma unroll
                for (int g = 0; g < 16; ++g) s += red[(g * 8 + b) * 32 + cc];
                modp[b * 6144 + col] = s; }
            __syncthreads();
        }
        if (F.vcu == F.G - 1 && F.wave == 0) {
            const float p1 = ((const float*)a.in[13])[F.lane] * ((const float*)a.in[14])[F.lane];
            const float p2 = ((const float*)a.in[15])[F.lane] * ((const float*)a.in[16])[F.lane];
            const float s1 = wave_sum(p1), s2 = wave_sum(p2);
            if (F.lane == 0) { modp[MOD_LAM] = expf(s1) - expf(s2) + LAM_INIT; modp[MOD_LAM + 16] = 0.f; modp[MOD_LAM + 17] = 0.f; modp[MOD_LAM + 18] = 0.f; modp[MOD_LAM + 19] = 0.f; modp[MOD_LAM + 24] = 0.f; modp[MOD_LAM + 25] = 0.f; }
        }
        __syncthreads();
    }
    { const float* w_in = (const float*)a.in[6]; unsigned* amax = (unsigned*)(a.ws + WS_CTL) + CW_AMAX;
      for (int u = F.vcu; u < 4 * (IN_W / 128); u += F.G) { const int cu = u % (IN_W / 128), kq = u / (IN_W / 128);
          const int col = cu * 128 + (F.tid & 127), kb = kq * 256 + (F.tid >> 7) * 64; float m = 0.f;
#pragma unroll 8
          for (int k = kb; k < kb + 64; ++k) m = fmaxf(m, fabsf(w_in[(size_t)k * IN_W + col]));
          atomicMax(amax + win_slot(col), __float_as_uint(m)); } }
    LAS float* scr = (LAS float*)(F.lds + RING_OFF + F.wave * 16384);
    const int gw = F.vcu * NWAVES + F.wave, NGW = F.G * NWAVES;
    constexpr int I_PA = (DIL_OUT / 64) * (D / 32), I_PB = (D / 64) * (D / 32), I_OUT = I_PB, I_Q = (D / 64) * (PEER_QW / 32);
    constexpr int NITEMS = I_PA + I_PB + I_OUT + I_Q;
    for (int it = gw; it < NITEMS; it += NGW) {
        int r = it;
        if (r < I_PA) { p0_transpose_item((const float*)a.in[10], DIL_OUT, D, (bf16*)(a.ws + WS_WPA), 0, scr, r, F.lane); continue; } r -= I_PA;
        if (r < I_PB) { p0_transpose_item((const float*)a.in[18], D, D, (bf16*)(a.ws + WS_WPB), 0, scr, r, F.lane); continue; } r -= I_PB;
        if (r < I_OUT) { p0_transpose_item((const float*)a.in[19], D, D, (bf16*)(a.ws + WS_WOUT), 0, scr, r, F.lane); continue; } r -= I_OUT;
        p0_transpose_item((const float*)a.in[21], D, PEER_QW, (bf16*)(a.ws + WS_WQ), 0, scr, r, F.lane);
    }
    { const float* sk = (const float*)a.in[22]; bf16* o = (bf16*)(a.ws + WS_SK);
      for (int i = (F.vcu * NWAVES * 64 + F.tid); i < 8 * 2 * 128 * 128 / 8; i += F.G * NWAVES * 64) {
          const f32x4 v0 = *(const GAS f32x4*)(sk + (size_t)i * 8), v1 = *(const GAS f32x4*)(sk + (size_t)i * 8 + 4);
          v4u w; w.x = pk2(v0.x, v0.y); w.y = pk2(v0.z, v0.w); w.z = pk2(v1.x, v1.y); w.w = pk2(v1.z, v1.w);
          const int row = i >> 4, grp = i & 15, hh = row >> 7, n = row & 127;
          const size_t dst = ((((size_t)hh * 4 + (n >> 5)) * 8 + (grp >> 1)) * 64 + (grp & 1) * 32 + (n & 31)) * 8;
          *(GAS v4u*)(o + dst) = w; } }
}

__device__ __forceinline__ void convert_bf16(Frame& F, const float* src, bf16* dst, size_t n8) {
    for (size_t i = (size_t)F.vcu * NWAVES * 64 + F.tid; i < n8; i += (size_t)F.G * NWAVES * 64) {
        const f32x4 v0 = *(const GAS f32x4*)(src + i * 8), v1 = *(const GAS f32x4*)(src + i * 8 + 4);
        v4u w; w.x = pk2(v0.x, v0.y); w.y = pk2(v0.z, v0.w); w.z = pk2(v1.x, v1.y); w.w = pk2(v1.z, v1.w);
        *(GAS v4u*)(dst + i * 8) = w; }
}

typedef float f32x2v __attribute__((ext_vector_type(2)));
__device__ __forceinline__ void convert_fp8_slices(Frame& F, const float* src, unsigned char* dst, float* scale) {
    const int gw = F.vcu * NWAVES + F.wave, NGW = F.G * NWAVES, l = F.lane;
    for (int e = gw; e < NEXP; e += NGW) {
        const GAS f32x4* rp = (const GAS f32x4*)(src + (size_t)e * 1024 + l * 16);
        const f32x4 v0 = rp[0], v1 = rp[1], v2 = rp[2], v3 = rp[3];
        float am = fmaxf(fmaxf(fmaxf(fabsf(v0.x), fabsf(v0.y)), fmaxf(fabsf(v0.z), fabsf(v0.w))), fmaxf(fmaxf(fabsf(v1.x), fabsf(v1.y)), fmaxf(fabsf(v1.z), fabsf(v1.w))));
        am = fmaxf(am, fmaxf(fmaxf(fmaxf(fabsf(v2.x), fabsf(v2.y)), fmaxf(fabsf(v2.z), fabsf(v2.w))), fmaxf(fmaxf(fabsf(v3.x), fabsf(v3.y)), fmaxf(fabsf(v3.z), fabsf(v3.w)))));
#pragma unroll
        for (int o = 1; o < 64; o <<= 1) am = fmaxf(am, __shfl_xor(am, o));
        const float sc = am > 0.f ? 256.0f / am : 1.0f;
        v4u w;
        { int t = __builtin_amdgcn_cvt_pk_fp8_f32(v0.x * sc, v0.y * sc, 0, false); t = __builtin_amdgcn_cvt_pk_fp8_f32(v0.z * sc, v0.w * sc, t, true); w.x = (unsigned)t; }
        { int t = __builtin_amdgcn_cvt_pk_fp8_f32(v1.x * sc, v1.y * sc, 0, false); t = __builtin_amdgcn_cvt_pk_fp8_f32(v1.z * sc, v1.w * sc, t, true); w.y = (unsigned)t; }
        { int t = __builtin_amdgcn_cvt_pk_fp8_f32(v2.x * sc, v2.y * sc, 0, false); t = __builtin_amdgcn_cvt_pk_fp8_f32(v2.z * sc, v2.w * sc, t, true); w.z = (unsigned)t; }
        { int t = __builtin_amdgcn_cvt_pk_fp8_f32(v3.x * sc, v3.y * sc, 0, false); t = __builtin_amdgcn_cvt_pk_fp8_f32(v3.z * sc, v3.w * sc, t, true); w.w = (unsigned)t; }
        *(GAS v4u*)(dst + ((size_t)(l >> 3) * NEXP + e) * 128 + (l & 7) * 16) = w;
        if (l == 0) scale[e] = am > 0.f ? am * (1.0f / 256.0f) : 1.0f;
    }
}

template <bool FP8OUT>
__device__ __forceinline__ void norm_mod_rows(Frame& F, const float* xin, const float* g, const float* modp, int sh_off, int sc_off, bf16* out, const int* positions = nullptr, float* CS = nullptr, float* sA = nullptr, const bf16* delta = nullptr) {
    const int gw = F.vcu * NWAVES + F.wave, NGW = F.G * NWAVES;
    f32x4 gg[4];
#pragma unroll
    for (int j = 0; j < 4; ++j) gg[j] = ((const GAS f32x4*)g)[F.lane + 64 * j];
    for (int m = gw; m < T; m += NGW) {
        const int b = m >> 12;
        const GAS f32x4* xr = (const GAS f32x4*)(xin + (size_t)m * D) + F.lane;
        f32x4 v[4]; float s = 0.f;
#pragma unroll
        for (int j = 0; j < 4; ++j) { v[j] = xr[64 * j];
            if (delta) { const u32x2 dl = *((const GAS u32x2*)(delta + (size_t)m * D) + F.lane + 64 * j); v[j].x += bflo(dl.x); v[j].y += bfhi(dl.x); v[j].z += bflo(dl.y); v[j].w += bfhi(dl.y); }
            s += (v[j].x * v[j].x + v[j].y * v[j].y) + (v[j].z * v[j].z + v[j].w * v[j].w); }
        const float rstd = 1.f / sqrtf(wave_sum(s) * (1.f / D) + EPS);
        const GAS f32x4* shp = (const GAS f32x4*)(modp + (size_t)b * 6144 + sh_off) + F.lane;
        const GAS f32x4* scp = (const GAS f32x4*)(modp + (size_t)b * 6144 + sc_off) + F.lane;
        GAS unsigned long long* o8 = (GAS unsigned long long*)(out + (size_t)m * D) + F.lane;
        if constexpr (FP8OUT) {
            f32x4 y[4]; float am = 0.f;
#pragma unroll
            for (int j = 0; j < 4; ++j) { const f32x4 sc = scp[64 * j], sh = shp[64 * j]; y[j] = v[j] * rstd * gg[j] * (sc + 1.0f) + sh;
                am = fmaxf(am, fmaxf(fmaxf(fabsf(y[j].x), fabsf(y[j].y)), fmaxf(fabsf(y[j].z), fabsf(y[j].w)))); }
#pragma unroll
            for (int o = 1; o < 64; o <<= 1) am = fmaxf(am, __shfl_xor(am, o));
            const float qs = am > 0.f ? 240.0f / am : 1.0f;
            GAS unsigned* o4 = (GAS unsigned*)((unsigned char*)out + (size_t)m * D) + F.lane;
#pragma unroll
            for (int j = 0; j < 4; ++j) { int t = __builtin_amdgcn_cvt_pk_fp8_f32(y[j].x * qs, y[j].y * qs, 0, false); t = __builtin_amdgcn_cvt_pk_fp8_f32(y[j].z * qs, y[j].w * qs, t, true); o4[64 * j] = (unsigned)t; }
            if (F.lane == 0) sA[m] = am > 0.f ? am * (1.0f / 240.0f) : 1.0f;
        } else {
#pragma unroll
        for (int j = 0; j < 4; ++j) { const f32x4 sc = scp[64 * j], sh = shp[64 * j];
            const f32x4 y = v[j] * rstd * gg[j] * (sc + 1.0f) + sh;
            o8[64 * j] = (unsigned long long)pk2(y.x, y.y) | ((unsigned long long)pk2(y.z, y.w) << 32); }
        }
        if (CS) {
            constexpr float L2T = 13.287712379549449f / 32.f;
            const int i = F.lane & 31; const float ang = (float)positions[m] * exp2f(-(float)i * L2T);
            float sn, cs; sincosf(ang, &sn, &cs);
            CS[(size_t)m * 64 + F.lane] = (F.lane < 32) ? cs : sn; }
    }
}

template <int NIT>
__device__ __forceinline__ void normrope_buf(bf16* base, int hq, int dd, const float (&g)[4], float c0, float s0, float c1, float s1, float qs) {
    unsigned lo[NIT], hi[NIT];
#pragma unroll
    for (int it = 0; it < NIT; ++it) { const bf16* p = base + (it * 4 + hq) * 64 + dd; lo[it] = *(const GAS unsigned*)p; hi[it] = *(const GAS unsigned*)(p + 32); }
#pragma unroll
    for (int it = 0; it < NIT; ++it) {
        const float x1a = bflo(lo[it]), x1b = bfhi(lo[it]), x2a = bflo(hi[it]), x2b = bfhi(hi[it]);
        float ss = (x1a * x1a + x1b * x1b) + (x2a * x2a + x2b * x2b);
        ss += __shfl_xor(ss, 1); ss += __shfl_xor(ss, 2); ss += __shfl_xor(ss, 4); ss += __shfl_xor(ss, 8);
        const float rstd = 1.f / sqrtf(ss * (1.f / 64.f) + EPS);
        const float y1a = x1a * rstd * g[0], y1b = x1b * rstd * g[1], y2a = x2a * rstd * g[2], y2b = x2b * rstd * g[3];
        const float o1a = (y1a * c0 - y2a * s0) * qs, o2a = (y2a * c0 + y1a * s0) * qs;
        const float o1b = (y1b * c1 - y2b * s1) * qs, o2b = (y2b * c1 + y1b * s1) * qs;
        bf16* p = base + (it * 4 + hq) * 64 + dd;
        *(GAS unsigned*)p = pk2(o1a, o1b); *(GAS unsigned*)(p + 32) = pk2(o2a, o2b);
    }
}
__device__ __forceinline__ void p3_normrope(Frame& F, const Args& a) {
    const int gw = F.vcu * NWAVES + F.wave, NGW = F.G * NWAVES;
    const int sub = F.lane & 15, hq = F.lane >> 4, dd = 2 * sub;
    bf16* QA = (bf16*)(a.ws + WS_QA); bf16* KA = (bf16*)(a.ws + WS_KA); bf16* QB = (bf16*)(a.ws + WS_QB); bf16* KB = (bf16*)(a.ws + WS_KB);
    const int* positions = (const int*)a.in[2];
    float g[4][4];
    { const float* gp[4] = {(const float*)a.in[8], (const float*)a.in[9], (const float*)a.in[11], (const float*)a.in[12]};
#pragma unroll
      for (int i = 0; i < 4; ++i) { g[i][0] = gp[i][dd]; g[i][1] = gp[i][dd + 1]; g[i][2] = gp[i][dd + 32]; g[i][3] = gp[i][dd + 33]; } }
    constexpr float L2T = 13.287712379549449f / 32.f;
    const float f0 = exp2f(-(float)dd * L2T), f1 = exp2f(-(float)(dd + 1) * L2T);
    for (int t = gw; t < T; t += NGW) {
        const float pos = (float)positions[t];
        float s0, c0, s1, c1; sincosf(pos * f0, &s0, &c0); sincosf(pos * f1, &s1, &c1);
        normrope_buf<3>(QA + (size_t)t * 768, hq, dd, g[0], c0, s0, c1, s1, QSCALE);
        normrope_buf<3>(KA + (size_t)t * 768, hq, dd, g[1], c0, s0, c1, s1, 1.0f);
        normrope_buf<4>(QB + (size_t)t * 1024, hq, dd, g[2], c0, s0, c1, s1, QSCALE);
        normrope_buf<4>(KB + (size_t)t * 1024, hq, dd, g[3], c0, s0, c1, s1, 1.0f);
    }
}

__device__ __forceinline__ void p4_dilated(Frame& F, const Args& a) {
    constexpr int ROWB = 144;
    const bf16* QA = (const bf16*)(a.ws + WS_QA); const bf16* KA = (const bf16*)(a.ws + WS_KA); const bf16* VA = (const bf16*)(a.ws + WS_VA);
    bf16* OUTG = (bf16*)(a.ws + WS_OUTG); float* LSE = (float*)(a.ws + WS_LSE);
    LAS unsigned char* Ks = F.lds; LAS unsigned char* Vs = F.lds + 384 * ROWB;
    const int tid = F.tid, l = F.lane, qi = F.wave * 32 + (l & 31), hf = l >> 5;
    for (int u = F.vcu; u < 1536; u += F.G) {
        const int rc = u & 15, bh = u >> 4, head = bh % 12, b = bh / 12, g = head >> 2, hslot = head & 3;
        const int dsh = 2 * g, L = SEQ >> dsh, nchunk = L >> 8;
        const int r = rc / nchunk, chunk = rc % nchunk, j0 = chunk << 8;
#pragma unroll
        for (int p = 0; p < 6; ++p) { const int row = p * 64 + (tid >> 3), ch = tid & 7, jj = j0 - 64 + row;
            v4u kv = (v4u){0u, 0u, 0u, 0u}, vv = (v4u){0u, 0u, 0u, 0u};
            if ((unsigned)jj < (unsigned)L) { const size_t tok = (size_t)b * SEQ + r + ((size_t)jj << dsh);
                kv = *(const GAS v4u*)(KA + tok * 768 + head * 64 + ch * 8); vv = *(const GAS v4u*)(VA + tok * 768 + head * 64 + ch * 8); }
            *(LAS v4u*)(Ks + row * ROWB + ch * 16) = kv; *(LAS v4u*)(Vs + row * ROWB + ch * 16) = vv; }
        const int j = j0 + qi; const size_t qtok = (size_t)b * SEQ + r + ((size_t)j << dsh);
        unsigned q[32];
#pragma unroll
        for (int c = 0; c < 8; ++c) { const v4u t4 = *(const GAS v4u*)(QA + qtok * 768 + head * 64 + c * 8); q[4 * c] = t4.x; q[4 * c + 1] = t4.y; q[4 * c + 2] = t4.z; q[4 * c + 3] = t4.w; }
        __syncthreads();
        float m = -INFINITY, lsum = 0.f; float o[64];
#pragma unroll
        for (int i = 0; i < 64; ++i) o[i] = 0.f;
        const int rowbase = qi + hf * 64, nk = 64 + hf;
        for (int kk = 0; kk < nk; ++kk) {
            const int row = rowbase + kk, jj = j0 - 64 + row;
            if ((unsigned)jj < (unsigned)L) {
                const LAS v4u* kp = (const LAS v4u*)(Ks + row * ROWB);
                float s0 = 0.f, s1 = 0.f, s2 = 0.f, s3 = 0.f;
#pragma unroll
                for (int c = 0; c < 8; ++c) { const v4u kv = kp[c]; s0 = dot2bf(kv.x, q[4 * c], s0); s1 = dot2bf(kv.y, q[4 * c + 1], s1); s2 = dot2bf(kv.z, q[4 * c + 2], s2); s3 = dot2bf(kv.w, q[4 * c + 3], s3); }
                const float s = (s0 + s1) + (s2 + s3);
                if (s > m + 8.f) { const float f = exp2f(m - s); lsum *= f;
#pragma unroll
                    for (int i = 0; i < 64; ++i) o[i] *= f;
                    m = s; }
                const float p = exp2f(s - m); lsum += p;
                const LAS v4u* vp = (const LAS v4u*)(Vs + row * ROWB);
#pragma unroll
                for (int c = 0; c < 8; ++c) { const v4u vv = vp[c];
                    o[8 * c + 0] += p * bflo(vv.x); o[8 * c + 1] += p * bfhi(vv.x); o[8 * c + 2] += p * bflo(vv.y); o[8 * c + 3] += p * bfhi(vv.y);
                    o[8 * c + 4] += p * bflo(vv.z); o[8 * c + 5] += p * bfhi(vv.z); o[8 * c + 6] += p * bflo(vv.w); o[8 * c + 7] += p * bfhi(vv.w); }
            }
        }
        const float mo = __shfl_xor(m, 32), M = fmaxf(m, mo);
        const float f = exp2f(m - M);
        float lt = lsum * f; lt += __shfl_xor(lt, 32);
        const float inv = 1.f / lt;
        unsigned pk[16];
#pragma unroll
        for (int i = 0; i < 32; i += 2) {
            float a0 = o[i] * f, a1 = o[i + 1] * f, b0 = o[32 + i] * f, b1 = o[33 + i] * f;
            a0 += __shfl_xor(a0, 32); a1 += __shfl_xor(a1, 32); b0 += __shfl_xor(b0, 32); b1 += __shfl_xor(b1, 32);
            pk[i >> 1] = hf ? pk2(b0 * inv, b1 * inv) : pk2(a0 * inv, a1 * inv);
        }
        bf16* op = OUTG + ((size_t)g * T + qtok) * 256 + hslot * 64 + hf * 32;
#pragma unroll
        for (int c = 0; c < 4; ++c) *(GAS v4u*)(op + c * 8) = (v4u){pk[4 * c], pk[4 * c + 1], pk[4 * c + 2], pk[4 * c + 3]};
        if (hf == 0) LSE[((size_t)g * T + qtok) * 4 + hslot] = M + log2f(lt);
        __syncthreads();
    }
}

__device__ __forceinline__ void p3_vt8(Frame& F, const Args& a) {
    const unsigned char* VB8 = (const unsigned char*)(a.ws + WS_VB); unsigned char* VT8 = (unsigned char*)(a.ws + WS_VT8);
    LAS unsigned char* img = F.lds + F.wave * 8192;
    const int l = F.lane;
    for (int u = F.vcu * NWAVES + F.wave; u < BATCH * 8 * 64; u += F.G * NWAVES) {
        const int tile = u & 63, bh = u >> 6, h = bh & 7, b = bh >> 3;
        const unsigned char* src = VB8 + ((size_t)b * SEQ + tile * 64) * 1024 + h * 128;
#pragma unroll
        for (int i = 0; i < 8; ++i) { const int key = i * 8 + (l >> 3), ch = l & 7;
            *(LAS v4u*)(img + key * 128 + ch * 16) = *(const GAS v4u*)(src + (size_t)key * 1024 + ch * 16); }
        LDS_WAIT(); asm volatile("" ::: "memory");
#pragma unroll
        for (int dd = 0; dd < 2; ++dd) { const int d = l + 64 * dd;
            unsigned w[16];
#pragma unroll
            for (int j = 0; j < 16; ++j) { unsigned x = 0;
#pragma unroll
                for (int e = 0; e < 4; ++e) { const int pp = 4 * j + e; const int key = 32 * ((pp >> 4) & 1) + 8 * ((pp & 15) >> 2) + 4 * (pp >> 5) + (pp & 3);
                    x |= (unsigned)img[key * 128 + d] << (8 * e); }
                w[j] = x; }
            unsigned char* dst = VT8 + ((size_t)bh * 64 + tile) * 8192 + d * 64;
#pragma unroll
            for (int c = 0; c < 4; ++c) *(GAS v4u*)(dst + c * 16) = (v4u){w[4 * c], w[4 * c + 1], w[4 * c + 2], w[4 * c + 3]}; }
        LDS_WAIT(); asm volatile("" ::: "memory");
    }
}

__device__ __forceinline__ void p6_combine(Frame& F, const Args& a) {
    const int gw = F.vcu * NWAVES + F.wave, NGW = F.G * NWAVES, l = F.lane;
    const bf16* OUTG = (const bf16*)(a.ws + WS_OUTG); const float* LSE = (const float*)(a.ws + WS_LSE);
    bf16* OA = (bf16*)(a.ws + WS_OA);
    for (int t = gw; t < T; t += NGW) {
        const int hslot = l >> 4, d4 = (l & 15) * 4;
        float ls[3];
#pragma unroll
        for (int g = 0; g < 3; ++g) ls[g] = LSE[((size_t)g * T + t) * 4 + hslot];
        const float M = fmaxf(fmaxf(ls[0], ls[1]), ls[2]);
        float acc0 = 0.f, acc1 = 0.f, acc2 = 0.f, acc3 = 0.f, wsum = 0.f;
#pragma unroll
        for (int g = 0; g < 3; ++g) { const float w = exp2f(ls[g] - M); wsum += w;
            const u32x2 v = *(const GAS u32x2*)(OUTG + ((size_t)g * T + t) * 256 + hslot * 64 + d4);
            acc0 += w * bflo(v.x); acc1 += w * bfhi(v.x); acc2 += w * bflo(v.y); acc3 += w * bfhi(v.y); }
        const float iw = 1.f / wsum;
        u32x2 w2; w2.x = pk2(acc0 * iw, acc1 * iw); w2.y = pk2(acc2 * iw, acc3 * iw);
        *(GAS u32x2*)(OA + (size_t)t * 256 + hslot * 64 + d4) = w2;
    }
}

#define CE_DESC(a, b) do { const float hi_ = fmaxf(a, b), lo_ = fminf(a, b); a = hi_; b = lo_; } while (0)
#define CE_ASC(a, b)  do { const float hi_ = fmaxf(a, b), lo_ = fminf(a, b); a = lo_; b = hi_; } while (0)
template <int N> __device__ __forceinline__ void bitonic_sort_desc(float (&v)[N]) {
#pragma unroll
    for (int k = 2; k <= N; k <<= 1)
#pragma unroll
        for (int j = k >> 1; j > 0; j >>= 1)
#pragma unroll
            for (int i = 0; i < N; ++i) { const int l = i ^ j; if (l > i) { if ((i & k) == 0) CE_DESC(v[i], v[l]); else CE_ASC(v[i], v[l]); } }
}
template <int X> __device__ __forceinline__ void merge_top16(float (&a)[16]) {
    float c[16];
#pragma unroll
    for (int i = 0; i < 16; ++i) c[i] = fmaxf(a[i], __shfl_xor(a[15 - i], X));
#pragma unroll
    for (int j = 8; j > 0; j >>= 1)
#pragma unroll
        for (int i = 0; i < 16; ++i) { const int l = i ^ j; if (l > i) CE_DESC(c[i], c[l]); }
#pragma unroll
    for (int i = 0; i < 16; ++i) a[i] = c[i];
}
template <int X> __device__ __forceinline__ void merge_8_8(const float (&a)[8], float (&c)[16]) {
#pragma unroll
    for (int i = 0; i < 8; ++i) { c[i] = a[i]; c[8 + i] = __shfl_xor(a[7 - i], X); }
#pragma unroll
    for (int j = 8; j > 0; j >>= 1)
#pragma unroll
        for (int i = 0; i < 16; ++i) { const int l = i ^ j; if (l > i) CE_DESC(c[i], c[l]); }
}
struct P11Frags { bf16x8 a0[8], a1[8], b[8]; };
__device__ __forceinline__ void p11_load_a(P11Frags& R, const bf16* QF, int u, int w, int l) {
    const int h = u & 7, rb = (u >> 3) * 2, half = w >> 2;
    const bf16* ap0 = QF + ((((size_t)(rb * 8 + h) * 2 + half) * 8) * 64 + l) * 8;
    const bf16* ap1 = QF + ((((size_t)((rb + 1) * 8 + h) * 2 + half) * 8) * 64 + l) * 8;
#pragma unroll
    for (int s = 0; s < 8; ++s) { R.a0[s] = *(const GAS bf16x8*)(ap0 + s * 512); R.a1[s] = *(const GAS bf16x8*)(ap1 + s * 512); }
}
__device__ __forceinline__ void p11_load_b(P11Frags& R, const bf16* SKF, int h, int w, int l) {
    const int half = w >> 2, kt = w & 3;
    const bf16* bp = SKF + ((((size_t)(h * 2 + half) * 4 + kt) * 8) * 64 + l) * 8;
#pragma unroll
    for (int s = 0; s < 8; ++s) R.b[s] = *(const GAS bf16x8*)(bp + s * 512);
}
__device__ __forceinline__ void p11_peer_topk(Frame& F, const Args& a) {
    constexpr int RS = 132;
    const bf16* QF = (const bf16*)(a.ws + WS_QP); const bf16* SKF = (const bf16*)(a.ws + WS_SK);
    int* IDX = (int*)(a.ws + WS_IDX); float* GATE = (float*)(a.ws + WS_GATE);
    LAS float* sc = (LAS float*)F.lds;
    LAS float* tv = (LAS float*)(F.lds + 67584);
    LAS unsigned char* tab = (LAS unsigned char*)(F.lds + 67584 + 8192);
    const int tid = F.tid, l = F.lane, w = F.wave;
    if (tid < 64) {
        int q = tid, ci = 255, n = 0;
        for (int i = 0; i < 16; ++i) for (int j = 0; j < 16; ++j) if ((i + 1) * (j + 1) <= 16) { if (n == q) ci = i * 16 + j; ++n; }
        tab[tid] = (unsigned char)ci;
    }
    __syncthreads();
#define LDS_BAR() do { asm volatile("s_waitcnt lgkmcnt(0)" ::: "memory"); __builtin_amdgcn_s_barrier(); asm volatile("" ::: "memory"); } while (0)
#ifdef PROBE11
    const int pm_ = a.pad;
#else
    constexpr int pm_ = 0;
#endif
    P11Frags R;
    int hcur = F.vcu & 7;
    if (F.vcu < 4096) { p11_load_b(R, SKF, hcur, w, l); p11_load_a(R, QF, F.vcu, w, l); }
    for (int u = F.vcu; u < 4096; u += F.G) {
        const int h = u & 7, t0 = (u >> 3) * 64;
        if (h != hcur) { hcur = h; p11_load_b(R, SKF, h, w, l); }
        if (!(pm_ & 4)) {   const int half = w >> 2, kt = w & 3, r32 = l & 31, hi = l >> 5;
            f32x16 acc0, acc1;
#pragma unroll
            for (int i = 0; i < 16; ++i) { acc0[i] = 0.f; acc1[i] = 0.f; }
#pragma unroll
            for (int s = 0; s < 8; ++s) {
                acc0 = __builtin_amdgcn_mfma_f32_32x32x16_bf16(R.a0[s], R.b[s], acc0, 0, 0, 0);
                acc1 = __builtin_amdgcn_mfma_f32_32x32x16_bf16(R.a1[s], R.b[s], acc1, 0, 0, 0);
            }
#pragma unroll
            for (int r = 0; r < 16; ++r) { const int row = (r & 3) + 8 * (r >> 2) + 4 * hi;
                sc[(half * 64 + row) * RS + kt * 32 + r32] = acc0[r]; sc[(half * 64 + 32 + row) * RS + kt * 32 + r32] = acc1[r]; }
        }
        if (u + F.G < 4096) p11_load_a(R, QF, u + F.G, w, l);
        LDS_BAR();
        if (!(pm_ & 1)) {
            const int row = tid >> 2, part = tid & 3;
            float v[32];
#pragma unroll
            for (int k = 0; k < 32; ++k) v[k] = __uint_as_float((__float_as_uint(sc[row * RS + 4 * k + part]) & ~0x7Fu) | (unsigned)(127 - (4 * k + part)));
            bitonic_sort_desc<32>(v);
            float t16[16];
#pragma unroll
            for (int i = 0; i < 16; ++i) t16[i] = v[i];
            merge_top16<1>(t16); merge_top16<2>(t16);
            if (part == 0) {
#pragma unroll
                for (int i = 0; i < 4; ++i) *(LAS f32x4*)(tv + row * 16 + 4 * i) = (f32x4){t16[4 * i], t16[4 * i + 1], t16[4 * i + 2], t16[4 * i + 3]}; }
        }
        LDS_BAR();
        if (!(pm_ & 2)) {
            const int tok = tid >> 3, part = tid & 7;
            float c8[8];
#pragma unroll
            for (int k = 0; k < 8; ++k) { const int ci = tab[part * 8 + k]; const int ii = (ci >> 4) & 15, jj = ci & 15;
                const float sum = tv[tok * 16 + ii] + tv[(64 + tok) * 16 + jj];
                c8[k] = (ci == 255) ? -INFINITY : __uint_as_float((__float_as_uint(sum) & ~0xFFu) | (unsigned)(255 - ci)); }
            bitonic_sort_desc<8>(c8);
            float c[16];
            merge_8_8<1>(c8, c); merge_top16<2>(c); merge_top16<4>(c);
            const float mx = c[0]; float den = 0.f;
#pragma unroll
            for (int k = 0; k < 16; ++k) den += __expf(c[k] - mx);
            const float iden = 1.f / den;
            int ev[2]; float gv[2];
#pragma unroll
            for (int kk = 0; kk < 2; ++kk) {
                float val = c[0];
#pragma unroll
                for (int k = 0; k < 16; ++k) val = (k == part * 2 + kk) ? c[k] : val;
                const int ci = 255 - (int)(__float_as_uint(val) & 0xFFu);
                const int e1 = 127 - (int)(__float_as_uint(tv[tok * 16 + (ci >> 4)]) & 0x7Fu), e2 = 127 - (int)(__float_as_uint(tv[(64 + tok) * 16 + (ci & 15)]) & 0x7Fu);
                ev[kk] = e1 * 128 + e2; gv[kk] = __expf(val - mx) * iden; }
            if (pm_ == 0) {
                const size_t o = ((size_t)h * T + t0 + tok) * 16 + 2 * part;
                *(GAS u32x2*)(IDX + o) = (u32x2){(unsigned)ev[0], (unsigned)ev[1]}; *(GAS f32x2v*)(GATE + o) = (f32x2v){gv[0], gv[1]}; }
            else if (pm_ & 8) { if (ev[0] == 12345 && gv[1] == 7.f) IDX[0] = ev[1]; }
        }
        LDS_BAR();
    }
}

#undef LDS_BAR
typedef int v4i __attribute__((ext_vector_type(4)));
__device__ __forceinline__ float gelu_erf(float x) { return 0.5f * x * (1.0f + erff(x * 0.70710678118654752f)); }
struct GBuf { v4u r[16]; v4u h0, h1; unsigned dl; f32x2v xv, gv; };
template <bool WITH_H> __device__ __forceinline__ void peer_issue(GBuf& B, const unsigned char* tab, const bf16* H2, const LAS int* il, int tbase, int it, int g, int c) {
    const int s = it >> 4, tt = it & 15;
    const LAS v4i* ip = (const LAS v4i*)(il + tt * 128 + g * 16);
    const v4i i0 = ip[0], i1 = ip[1], i2 = ip[2], i3 = ip[3];
    const int e[16] = {i0.x, i0.y, i0.z, i0.w, i1.x, i1.y, i1.z, i1.w, i2.x, i2.y, i2.z, i2.w, i3.x, i3.y, i3.z, i3.w};
    const unsigned char* ts = tab + (size_t)s * NEXP * 128;
    if (WITH_H) { const bf16* hp = H2 + (size_t)(tbase + tt) * 1024 + s * 128 + c * 16; B.h0 = __builtin_nontemporal_load((const GAS v4u*)hp); B.h1 = __builtin_nontemporal_load((const GAS v4u*)(hp + 8)); __builtin_amdgcn_sched_barrier(0); }
#pragma unroll
    for (int i = 0; i < 16; ++i) { B.r[i] = *(const GAS v4u*)(ts + (((unsigned)e[i] << 7) | (unsigned)(c * 16))); __builtin_amdgcn_sched_barrier(0); }
}
template <bool REFILL> __device__ __forceinline__ void peer_u_compute(GBuf& B, LAS float* wl, int it, int g, int c, const unsigned char* tab = nullptr, const bf16* H2 = nullptr, const LAS int* il = nullptr, int tbase = 0, int itn = 0) {
    const int tt = it & 15;
    const unsigned hw[8] = {B.h0.x, B.h0.y, B.h0.z, B.h0.w, B.h1.x, B.h1.y, B.h1.z, B.h1.w};
    int en[16]; const unsigned char* tsn = nullptr;
    if constexpr (REFILL) { const LAS v4i* ip = (const LAS v4i*)(il + (itn & 15) * 128 + g * 16); const v4i i0 = ip[0], i1 = ip[1], i2 = ip[2], i3 = ip[3];
        en[0] = i0.x; en[1] = i0.y; en[2] = i0.z; en[3] = i0.w; en[4] = i1.x; en[5] = i1.y; en[6] = i1.z; en[7] = i1.w; en[8] = i2.x; en[9] = i2.y; en[10] = i2.z; en[11] = i2.w; en[12] = i3.x; en[13] = i3.y; en[14] = i3.z; en[15] = i3.w;
        tsn = tab + (size_t)(itn >> 4) * NEXP * 128; }
    if constexpr (REFILL) { __builtin_amdgcn_sched_barrier(0);
        const bf16* hp = H2 + (size_t)(tbase + (itn & 15)) * 1024 + (itn >> 4) * 128 + c * 16; B.h0 = __builtin_nontemporal_load((const GAS v4u*)hp); B.h1 = __builtin_nontemporal_load((const GAS v4u*)(hp + 8)); __builtin_amdgcn_sched_barrier(0); }
    float d[16];
#pragma unroll
    for (int i = 0; i < 16; i += 2) {
#pragma unroll
        for (int r = 0; r < 2; ++r) { const unsigned uw[4] = {B.r[i + r].x, B.r[i + r].y, B.r[i + r].z, B.r[i + r].w};
            float a0 = 0.f;
#pragma unroll
            for (int j = 0; j < 4; ++j) {
                a0 = __builtin_amdgcn_fdot2_f32_bf16(__builtin_amdgcn_cvt_scalef32_pk_bf16_fp8(uw[j], 1.0f, false), __builtin_bit_cast(bf16x2v, hw[2 * j]), a0, false);
                a0 = __builtin_amdgcn_fdot2_f32_bf16(__builtin_amdgcn_cvt_scalef32_pk_bf16_fp8(uw[j], 1.0f, true), __builtin_bit_cast(bf16x2v, hw[2 * j + 1]), a0, false); }
            d[i + r] = a0; }
        if constexpr (REFILL) { __builtin_amdgcn_sched_barrier(0); B.r[i] = *(const GAS v4u*)(tsn + (((unsigned)en[i] << 7) | (unsigned)(c * 16))); B.r[i + 1] = *(const GAS v4u*)(tsn + (((unsigned)en[i + 1] << 7) | (unsigned)(c * 16))); __builtin_amdgcn_sched_barrier(0); }
    }
    const bool u4 = (c & 4) != 0, u2 = (c & 2) != 0, u1 = (c & 1) != 0;
    float r8[8], r4[4], r2[2];
#pragma unroll
    for (int j = 0; j < 8; ++j) { const float keep = u4 ? d[8 + j] : d[j], send = u4 ? d[j] : d[8 + j]; r8[j] = keep + __shfl_xor(send, 4); }
#pragma unroll
    for (int j = 0; j < 4; ++j) { const float keep = u2 ? r8[4 + j] : r8[j], send = u2 ? r8[j] : r8[4 + j]; r4[j] = keep + __shfl_xor(send, 2); }
#pragma unroll
    for (int j = 0; j < 2; ++j) { const float keep = u1 ? r4[2 + j] : r4[j], send = u1 ? r4[j] : r4[2 + j]; r2[j] = keep + __shfl_xor(send, 1); }
    LAS f32x2v* wp = (LAS f32x2v*)(wl + tt * 128 + g * 16 + 2 * c);
    f32x2v cur = *wp; cur.x += r2[0]; cur.y += r2[1]; *wp = cur;
}
__device__ __forceinline__ void peer_v_resid(GBuf& B, const float* modp, const float* xin, const bf16* delta, int tbase, int it, int g, int c) {
    const int s = it >> 4, t = tbase + (it & 15); const int b = t >> 12; const int col = s * 128 + c * 16 + 2 * g;
    B.gv = *(const GAS f32x2v*)(modp + (size_t)b * 6144 + 5120 + col);
    B.xv = __builtin_nontemporal_load((const GAS f32x2v*)(xin + (size_t)t * 1024 + col)); B.dl = __builtin_nontemporal_load((const GAS unsigned*)(delta + (size_t)t * 1024 + col));
    __builtin_amdgcn_sched_barrier(0);
}
template <bool REFILL> __device__ __forceinline__ void peer_v_compute(GBuf& B, const LAS float* wl, float* out, const float* modp, const float* xin, const bf16* delta, int tbase, int it, int g, int c, const unsigned char* tab = nullptr, const LAS int* il = nullptr, int itn = 0) {
    const int s = it >> 4, tt = it & 15, t = tbase + tt;
    int en[16]; const unsigned char* tsn = nullptr;
    if constexpr (REFILL) { const LAS v4i* ip = (const LAS v4i*)(il + (itn & 15) * 128 + g * 16); const v4i i0 = ip[0], i1 = ip[1], i2 = ip[2], i3 = ip[3];
        en[0] = i0.x; en[1] = i0.y; en[2] = i0.z; en[3] = i0.w; en[4] = i1.x; en[5] = i1.y; en[6] = i1.z; en[7] = i1.w; en[8] = i2.x; en[9] = i2.y; en[10] = i2.z; en[11] = i2.w; en[12] = i3.x; en[13] = i3.y; en[14] = i3.z; en[15] = i3.w;
        tsn = tab + (size_t)(itn >> 4) * NEXP * 128; }
    const int col = s * 128 + c * 16 + 2 * g;
    GAS f32x2v* op = (GAS f32x2v*)(out + (size_t)t * 1024 + col);
    const LAS f32x4* wp = (const LAS f32x4*)(wl + tt * 128 + g * 16);
    const f32x4 w0 = wp[0], w1 = wp[1], w2 = wp[2], w3 = wp[3];
    const float w[16] = {w0.x, w0.y, w0.z, w0.w, w1.x, w1.y, w1.z, w1.w, w2.x, w2.y, w2.z, w2.w, w3.x, w3.y, w3.z, w3.w};
    f32x2v o2[8];
#pragma unroll
    for (int j = 0; j < 8; ++j) o2[j] = (f32x2v){0.f, 0.f};
#pragma unroll
    for (int i = 0; i < 16; ++i) {
        const unsigned vw[4] = {B.r[i].x, B.r[i].y, B.r[i].z, B.r[i].w}; const f32x2v ww = (f32x2v){w[i], w[i]};
#pragma unroll
        for (int j = 0; j < 4; ++j) {
            o2[2 * j] = __builtin_elementwise_fma(__builtin_amdgcn_cvt_pk_f32_fp8((int)vw[j], false), ww, o2[2 * j]);
            o2[2 * j + 1] = __builtin_elementwise_fma(__builtin_amdgcn_cvt_pk_f32_fp8((int)vw[j], true), ww, o2[2 * j + 1]); }
#ifdef PROBE_V2X
        {   f32x2v zw_ = (f32x2v){0.f, 0.f}; asm volatile("" : "+v"(zw_));
#pragma unroll
            for (int j = 0; j < 4; ++j) {
                o2[2 * j] = __builtin_elementwise_fma(__builtin_amdgcn_cvt_pk_f32_fp8((int)vw[j], false), zw_, o2[2 * j]);
                o2[2 * j + 1] = __builtin_elementwise_fma(__builtin_amdgcn_cvt_pk_f32_fp8((int)vw[j], true), zw_, o2[2 * j + 1]); } }
#endif
        if constexpr (REFILL) { __builtin_amdgcn_sched_barrier(0); B.r[i] = *(const GAS v4u*)(tsn + (((unsigned)en[i] << 7) | (unsigned)(c * 16))); __builtin_amdgcn_sched_barrier(0); }
    }
    float o[16];
#pragma unroll
    for (int j = 0; j < 8; ++j) { o[2 * j] = o2[j].x; o[2 * j + 1] = o2[j].y; }
    const bool u4 = (g & 4) != 0, u2 = (g & 2) != 0, u1 = (g & 1) != 0;
    float r8[8], r4[4], r2[2];
#pragma unroll
    for (int j = 0; j < 8; ++j) { const float keep = u4 ? o[8 + j] : o[j], send = u4 ? o[j] : o[8 + j]; r8[j] = keep + __shfl_xor(send, 32); }
#pragma unroll
    for (int j = 0; j < 4; ++j) { const float keep = u2 ? r8[4 + j] : r8[j], send = u2 ? r8[j] : r8[4 + j]; r4[j] = keep + __shfl_xor(send, 16); }
#pragma unroll
    for (int j = 0; j < 2; ++j) { const float keep = u1 ? r4[2 + j] : r4[j], send = u1 ? r4[j] : r4[2 + j]; r2[j] = keep + __shfl_xor(send, 8); }
    f32x2v xv = B.xv; xv.x += bflo(B.dl) + B.gv.x * r2[0]; xv.y += bfhi(B.dl) + B.gv.y * r2[1]; __builtin_nontemporal_store(xv, op);
    if constexpr (REFILL) { __builtin_amdgcn_sched_barrier(0); peer_v_resid(B, modp, xin, delta, tbase, itn, g, c); }
}
__device__ __forceinline__ void p12_gather(Frame& F, const Args& a) {
    const int l = F.lane, g = l >> 3, c = l & 7;
    const bf16* H2 = (const bf16*)(a.ws + WS_R1); const int* IDX = (const int*)(a.ws + WS_IDX); const float* GATE = (const float*)(a.ws + WS_GATE);
    const unsigned char* EU = (const unsigned char*)(a.ws + WS_EU); const unsigned char* EV = (const unsigned char*)(a.ws + WS_EV);
    const float* SU = (const float*)(a.ws + WS_ESC); const float* SV = SU + NEXP;
    const float* modp = (const float*)(a.ws + WS_MOD); float* out = a.out; const float* xin = (const float*)a.in[0]; const bf16* delta = (const bf16*)(a.ws + WS_DELTA);
    LAS float* wl = (LAS float*)(F.lds + F.wave * 8192);
    LAS int* il = (LAS int*)(F.lds + 65536 + F.wave * 8192);
    for (int tbase = (F.vcu * NWAVES + F.wave) * 16; tbase < T; tbase += F.G * NWAVES * 16) {
#pragma unroll
        for (int tt = 0; tt < 16; ++tt) { il[tt * 128 + l] = IDX[((size_t)(l >> 4) * T + tbase + tt) * 16 + (l & 15)]; il[tt * 128 + 64 + l] = IDX[((size_t)(4 + (l >> 4)) * T + tbase + tt) * 16 + (l & 15)];
            wl[tt * 128 + l] = 0.f; wl[tt * 128 + 64 + l] = 0.f; }
        {   GBuf b0, b1;
            peer_issue<true>(b0, EU, H2, il, tbase, 0, g, c); peer_issue<true>(b1, EU, H2, il, tbase, 1, g, c);
            for (int it = 0; it < 126; it += 2) {
                peer_u_compute<true>(b0, wl, it, g, c, EU, H2, il, tbase, it + 2);
                peer_u_compute<true>(b1, wl, it + 1, g, c, EU, H2, il, tbase, it + 3);
            }
            peer_u_compute<false>(b0, wl, 126, g, c); peer_u_compute<false>(b1, wl, 127, g, c);
        }
#pragma unroll 4
        for (int tt = 0; tt < 16; ++tt) { const int t = tbase + tt;
#pragma unroll
            for (int j = 0; j < 2; ++j) { const int k = 2 * c + j; const int e = il[tt * 128 + g * 16 + k];
                wl[tt * 128 + g * 16 + k] = GATE[((size_t)g * T + t) * 16 + k] * gelu_erf(wl[tt * 128 + g * 16 + k] * SU[e]) * SV[e]; } }
        {   GBuf b0, b1;
            peer_issue<false>(b0, EV, H2, il, tbase, 0, g, c); peer_v_resid(b0, modp, xin, delta, tbase, 0, g, c); peer_issue<false>(b1, EV, H2, il, tbase, 1, g, c); peer_v_resid(b1, modp, xin, delta, tbase, 1, g, c);
            for (int it = 0; it < 126; it += 2) {
                peer_v_compute<true>(b0, wl, out, modp, xin, delta, tbase, it, g, c, EV, il, it + 2);
                peer_v_compute<true>(b1, wl, out, modp, xin, delta, tbase, it + 1, g, c, EV, il, it + 3);
            }
            peer_v_compute<false>(b0, wl, out, modp, xin, delta, tbase, 126, g, c); peer_v_compute<false>(b1, wl, out, modp, xin, delta, tbase, 127, g, c);
        }
    }
}


__global__ void __launch_bounds__(NWAVES * 64, 2) fwd_kernel(Args args) {
    extern __shared__ __attribute__((aligned(16))) unsigned char lds[];
    Frame F;
    F.lds = (LAS unsigned char*)lds;
    F.MISC = (volatile LAS unsigned*)(F.lds + MISC_OFF);
    F.tid = threadIdx.x; F.lane = F.tid & 63; F.wave = __builtin_amdgcn_readfirstlane(F.tid >> 6);
    F.G = gridDim.x; { const int bx = blockIdx.x; F.vcu = (F.G % 8 == 0) ? (bx % 8) * (F.G / 8) + bx / 8 : bx; }
    unsigned char* ws = args.ws;
    F.ctl = (gu32*)(ws + WS_CTL);
    for (int u = F.tid; u < (LDS_BYTES - LDSCTL_OFF) / 4; u += NWAVES * 64) ((LAS unsigned*)(F.lds + LDSCTL_OFF))[u] = 0u;
    __syncthreads();
    const int lo = args.ph_lo, hi = args.ph_hi;
    const bool fused = (hi - lo) > 1;
    XcdBarrier bar; bar.bar = (unsigned*)(F.ctl + CW_BAR) + args.bar_region * XCD_BAR_WORDS; bar.x = 0; bar.st = nullptr;
    if (fused) bar = xcd_barrier_post((unsigned*)(F.ctl + CW_BAR) + args.bar_region * XCD_BAR_WORDS, F.MISC + 8);
#ifndef PHASE_MASK
#define PHASE_MASK 0xFFFF
#endif
#define IN(k) (((PHASE_MASK >> (k)) & 1) && lo <= (k) && (k) < hi)
#ifdef PROBE_BAR2
#define SEAM(k) do { if (IN(k) && IN((k) + 1)) { xcd_barrier(bar); xcd_barrier(bar); } } while (0)
#elif defined(PROBE_PHT)
    unsigned long long pht_prev = __builtin_amdgcn_s_memrealtime(); float pht_val = 0.f;
#define SEAM(k) do { if (IN(k) && IN((k) + 1)) { xcd_barrier(bar); const unsigned long long now_ = __builtin_amdgcn_s_memrealtime(); if ((k) == PROBE_PHT) pht_val = (float)(now_ - pht_prev) * 0.001f; pht_prev = now_; } } while (0)
#else
#define SEAM(k) do { if (IN(k) && IN((k) + 1)) xcd_barrier(bar); } while (0)
#endif
#ifdef PROBE_DOUBLE
    int two_ = 2; asm volatile("" : "+s"(two_));
#define REP(k) for (int rep_ = 0; rep_ < ((k) == PROBE_DOUBLE ? two_ : 1); ++rep_, ((k) == PROBE_DOUBLE && rep_ == 1 && fused ? xcd_barrier(bar) : (void)0))
#else
#define REP(k)
#endif

    bf16* XN = (bf16*)(ws + WS_R1);
    float* modp = (float*)(ws + WS_MOD);

    REP(0) if (IN(0)) { p0_prologue(F, args); } SEAM(0);
    REP(1) if (IN(1)) {
        norm_mod_rows<true>(F, (const float*)args.in[0], (const float*)args.in[5], modp, 0, 1024, XN, (const int*)args.in[2], (float*)(ws + WS_CS), (float*)(ws + WS_SA));
        {
            LAS float* scr = (LAS float*)(F.lds + RING_OFF + F.wave * 16384);
            for (int it = F.vcu * NWAVES + F.wave; it < (D / 64) * (IN_W / 32); it += F.G * NWAVES)
                win_fp8_item((const float*)args.in[6], (const unsigned*)(ws + WS_CTL) + CW_AMAX, (unsigned char*)(ws + WS_WIN), (float*)(ws + WS_SW), scr, it, F.lane); }
    } SEAM(1);
    REP(2) if (IN(2)) {
#if defined(P2_STAGGER)
        {
            const unsigned long long t0_ = __builtin_amdgcn_s_memrealtime(); const unsigned long long wait_ = (unsigned long long)((F.vcu & 3) * P2_STAGGER) * 100ull;
            while (__builtin_amdgcn_s_memrealtime() - t0_ < wait_) __builtin_amdgcn_s_sleep(32);
        }
#endif
        int kdim = D / 2; asm volatile("" : "+s"(kdim));
        pg8::Gemm g{XN, (const bf16*)(ws + WS_WIN), T, IN_W, kdim}; pg8::StaticOrder S; S.init(T, IN_W, F.G, (int)blockIdx.x);
        pg8::EpiInProj E{(bf16*)(ws + WS_QA), (bf16*)(ws + WS_KA), (bf16*)(ws + WS_VA), (bf16*)(ws + WS_QB), (bf16*)(ws + WS_KB), (bf16*)(ws + WS_VB), (bf16*)args.out, (const float*)args.in[7],
                          (const float*)args.in[8], (const float*)args.in[9], (const float*)args.in[11], (const float*)args.in[12], (const float*)(ws + WS_CS), QSCALE, (const float*)(ws + WS_SA), (const float*)(ws + WS_SW)};
        pg8::gemm_phase<pg8::EpiInProj, pg8::StaticOrder, true, true, true>(F.lds + RING_OFF, g, S, E
#ifdef PROBE_GSTAMP
            , modp + MOD_LAM + 24
#endif
            );
    } SEAM(2);
    REP(4) if (IN(4)) {
        p3_vt8(F, args); __syncthreads();
        attn_body::dil_phase((char*)lds + RING_OFF, (const attn_body::bf16*)(ws + WS_QA), (const attn_body::bf16*)(ws + WS_KA), (const attn_body::bf16*)(ws + WS_VA),
                             (attn_body::bf16*)(ws + WS_OUTG), (float*)(ws + WS_LSE), F.vcu, F.G);
    } SEAM(4);
    REP(5) if (IN(5)) {
        p6_combine(F, args);
        const attn_body::DiffFusedOrder S((int)F.G, (int)blockIdx.x);
        float pscale;
        { const float gq = fabsf(((const float*)args.in[11])[F.lane]), gk = fabsf(((const float*)args.in[12])[F.lane]);
          float mq = gq, mk = gk;
#pragma unroll
          for (int o = 1; o < 64; o <<= 1) { mq = fmaxf(mq, __shfl_xor(mq, o)); mk = fmaxf(mk, __shfl_xor(mk, o)); }
          const float smax = 64.0f * QSCALE * mq * mk * 1.02f;
          pscale = exp2f(fmaxf(0.0f, ceilf(smax - 8.5f))); }
#if QK_FP8
        attn_body::diff128q8_phase((char*)lds + RING_OFF, (const unsigned char*)(ws + WS_QB), (const unsigned char*)(ws + WS_KB), (const unsigned char*)(ws + WS_VT8),
                                   (attn_body::bf16*)(ws + WS_O1), (attn_body::bf16*)(ws + WS_OB), pscale, modp[MOD_LAM], (const float*)args.in[17], S);
#else
        attn_body::diff128f8_phase((char*)lds + RING_OFF, (const attn_body::bf16*)(ws + WS_QB), (const attn_body::bf16*)(ws + WS_KB), (const unsigned char*)(ws + WS_VT8),
                                   (attn_body::bf16*)(ws + WS_O1), (attn_body::bf16*)(ws + WS_OB), pscale, modp[MOD_LAM], (const float*)args.in[17], S
#ifdef PROBE_STAMP
                                   , modp + MOD_LAM + 16
#endif
                                   );
#endif
    } SEAM(5);
    REP(7) if (IN(7)) {
#ifdef PROBE7
        if (!(args.pad & 1))
#endif
        { int kdim = DIL_OUT; asm volatile("" : "+s"(kdim));
          pg8::Gemm g{(const bf16*)(ws + WS_OA), (const bf16*)(ws + WS_WPA), T, D, kdim}; pg8::StaticOrder S; S.init(T, D, F.G, (int)blockIdx.x);
          pg8::EpiBf16 E{(bf16*)(ws + WS_TMP), D};
          pg8::gemm_phase<pg8::EpiBf16, pg8::StaticOrder, true, true>(F.lds + RING_OFF, g, S, E); }
#ifdef PROBE7
        if (!(args.pad & 2))
#endif
        { pg8::Gemm g{(const bf16*)(ws + WS_OB), (const bf16*)(ws + WS_WPB), T, D, D}; pg8::StaticOrder S; S.init(T, D, F.G, (int)blockIdx.x);
          pg8::EpiBranchB E{(const bf16*)(ws + WS_TMP), (const unsigned char*)args.out, (bf16*)(ws + WS_MIX)};
          pg8::gemm_phase<pg8::EpiBranchB, pg8::StaticOrder, true, true>(F.lds + RING_OFF, g, S, E); }
    } SEAM(7);
    REP(8) if (IN(8)) {
        pg8::Gemm g{(const bf16*)(ws + WS_MIX), (const bf16*)(ws + WS_WOUT), T, D, D}; pg8::StaticOrder S; S.init(T, D, F.G, (int)blockIdx.x);
        pg8::EpiOut E{modp, (bf16*)(ws + WS_DELTA)};
        pg8::gemm_phase<pg8::EpiOut, pg8::StaticOrder, true, true>(F.lds + RING_OFF, g, S, E);
    } SEAM(8);
    REP(9) if (IN(9)) {
        norm_mod_rows<false>(F, (const float*)args.in[0], (const float*)args.in[20], modp, 3072, 4096, XN, nullptr, nullptr, nullptr, (const bf16*)(ws + WS_DELTA));
        convert_fp8_slices(F, (const float*)args.in[23], (unsigned char*)(ws + WS_EU), (float*)(ws + WS_ESC));
        convert_fp8_slices(F, (const float*)args.in[24], (unsigned char*)(ws + WS_EV), (float*)(ws + WS_ESC) + NEXP);
    } SEAM(9);
    REP(10) if (IN(10)) {
        pg8::Gemm g{XN, (const bf16*)(ws + WS_WQ), T, PEER_QW, D}; pg8::StaticOrder S; S.init(T, PEER_QW, F.G, (int)blockIdx.x);
        pg8::EpiQF E{(bf16*)(ws + WS_QP)};
        pg8::gemm_phase<pg8::EpiQF, pg8::StaticOrder, true, true>(F.lds + RING_OFF, g, S, E);
    } SEAM(10);
    REP(11) if (IN(11)) { p11_peer_topk(F, args); } SEAM(11);
    REP(12) if (IN(12)) { p12_gather(F, args); }
#ifdef PROBE_PHT
    if (fused) { xcd_barrier(bar); const unsigned long long now_ = __builtin_amdgcn_s_memrealtime(); if (PROBE_PHT == 12) pht_val = (float)(now_ - pht_prev) * 0.001f;
        if (blockIdx.x == 0 && F.tid == 0) args.out[0] = pht_val < 16.f ? rintf(pht_val * 4.f) * 0.25f : rintf(pht_val * 0.5f) * 2.f; }
#endif
#ifdef PROBE_GSTAMP
    if (fused) { xcd_barrier(bar);
        if (blockIdx.x == 0 && F.tid == 0) { const float e_ = modp[MOD_LAM + 24], u_ = modp[MOD_LAM + 25];
            args.out[0] = (PROBE_GSTAMP == 0) ? 10.0f + 89.0f * e_ / u_ : 10.0f + u_ * (1.0f / (15.0f * 1000.0f)); } }
#endif
#ifdef PROBE_STAMP
    if (fused) { xcd_barrier(bar);
        if (blockIdx.x == 0 && F.tid == 0) { const float a_ = modp[MOD_LAM + 16], b_ = modp[MOD_LAM + 17], w_ = (PROBE_STAMP == 4) ? modp[MOD_LAM + 19] : modp[MOD_LAM + 18]; const float tot = a_ + b_ + modp[MOD_LAM + 18] + modp[MOD_LAM + 19];
            const float v = (PROBE_STAMP == 0) ? a_ / tot : (PROBE_STAMP == 1) ? b_ / tot : (PROBE_STAMP == 2 || PROBE_STAMP == 4) ? w_ / tot : tot * (1.0f / (4.0f * 60.0f * 100.0f));
            args.out[0] = 10.0f + 89.0f * (PROBE_STAMP != 3 ? v : 0.f) + (PROBE_STAMP == 3 ? v : 0.f); } }
#endif
#undef IN
#undef SEAM
}

extern "C" void kernel_launch(void* const* d_in, const int* in_sizes, int n_in, void* d_out, int out_size, void* d_ws, size_t ws_size, hipStream_t stream) {
    static int grid = 0;
    if (grid == 0) {
        if (n_in != 25 || in_sizes[0] != T * D || out_size != T * D || ws_size < WS_END) {
            fprintf(stderr, "kernel_launch: built for 25 inputs, x and out of %d floats, >= %zu bytes of workspace; got n_in %d, in0 %d, out %d, ws %zu; nothing launched\n", T * D, (size_t)WS_END, n_in, n_in > 0 ? in_sizes[0] : -1, out_size, ws_size); grid = -1; return; }
        int dev = 0, cus = 0, per_cu = 0;
        if (hipGetDevice(&dev) != hipSuccess || hipDeviceGetAttribute(&cus, hipDeviceAttributeMultiprocessorCount, dev) != hipSuccess) { fprintf(stderr, "kernel_launch: hipGetDevice / hipDeviceGetAttribute failed\n"); grid = -1; return; }
        if (hipFuncSetAttribute((const void*)fwd_kernel, hipFuncAttributeMaxDynamicSharedMemorySize, LDS_BYTES) != hipSuccess) { fprintf(stderr, "kernel_launch: hipFuncSetAttribute failed\n"); grid = -1; return; }
        if (hipOccupancyMaxActiveBlocksPerMultiprocessor(&per_cu, (const void*)fwd_kernel, NWAVES * 64, LDS_BYTES) != hipSuccess || per_cu < 1)
            fprintf(stderr, "kernel_launch: note: occupancy query reports %d workgroups per CU\n", per_cu);
        (void)hipGetLastError();
        grid = cus;
    }
    if (grid < 0) return;
    if (hipMemsetAsync((char*)d_ws + WS_CTL, 0, CTL_ZERO_BYTES, stream) != hipSuccess) { fprintf(stderr, "kernel_launch: hipMemsetAsync failed\n"); return; }
    Args a{};
    for (int i = 0; i < 25; ++i) a.in[i] = d_in[i];
    a.out = (float*)d_out; a.ws = (unsigned char*)d_ws;
#if defined(PROBE_RELAUNCH)
    a.ph_lo = 0; a.ph_hi = PROBE_RELAUNCH + 1; hipLaunchKernelGGL(fwd_kernel, dim3(grid), dim3(NWAVES * 64), LDS_BYTES, stream, a);
    a.bar_region = 1; a.ph_lo = PROBE_RELAUNCH; a.ph_hi = PROBE_RELAUNCH + 1;
#ifdef PROBE11
    a.pad = PROBE11;
#endif
#ifdef PROBE7
    a.pad = PROBE7;
#endif
    hipLaunchKernelGGL(fwd_kernel, dim3(grid), dim3(NWAVES * 64), LDS_BYTES, stream, a);
    a.pad = 0;
    if (PROBE_RELAUNCH + 1 < N_PHASES) { a.bar_region = 2; a.ph_lo = PROBE_RELAUNCH + 1; a.ph_hi = N_PHASES; hipLaunchKernelGGL(fwd_kernel, dim3(grid), dim3(NWAVES * 64), LDS_BYTES, stream, a); }
#elif MK_N_LAUNCHES == 1
    a.ph_lo = 0; a.ph_hi = N_PHASES;
    hipLaunchKernelGGL(fwd_kernel, dim3(grid), dim3(NWAVES * 64), LDS_BYTES, stream, a);
#else
    for (int p = 0; p < N_PHASES; ++p) { a.ph_lo = p; a.ph_hi = p + 1;
        hipLaunchKernelGGL(fwd_kernel, dim3(grid), dim3(NWAVES * 64), LDS_BYTES, stream, a); }
#endif
    const hipError_t le = hipPeekAtLastError();
    if (le != hipSuccess) fprintf(stderr, "kernel_launch: launch failed: %s\n", hipGetErrorName(le));
}
```

```cpp
#include <hip/hip_runtime.h>
#include <hip/hip_bf16.h>
#include <cstdio>
#include <cstdint>
#include <cmath>

#ifndef MK_N_LAUNCHES
#define MK_N_LAUNCHES 1
#endif

constexpr int BATCH = 8, SEQ = 4096, D = 1024, T = BATCH * SEQ;
constexpr int DIL_W = 768, DIL_HEADS = 12, DIL_OUT = 256;
constexpr int DIFF_W = 1024, DIFF_HEADS = 8;
constexpr int IN_W = 7424, GATE_W = 2048;
constexpr int PEER_H = 8, PEER_NK = 128, PEER_QW = 2048, NEXP = 16384;
constexpr float EPS = 1e-6f;
constexpr float LAM_INIT = 0.2f;
constexpr float QSCALE = 0.125f * 1.4426950408889634f;

#ifndef P12_SPLIT
#define P12_SPLIT 0
#endif
#ifndef U_MFMA
#define U_MFMA 0
#endif
#ifndef V_STAGE
#define V_STAGE 0
#endif
#ifndef EXPERT_TAIL
#define EXPERT_TAIL 16384
#endif
#ifndef EXPERT_TAIL_V
#define EXPERT_TAIL_V 0
#endif
#ifndef COMBINE_RIDER
#define COMBINE_RIDER 0
#endif
#ifndef WT_STORES
#define WT_STORES 0
#endif
#define WT16_(p, v) asm volatile("global_store_dwordx4 %0, %1, off sc1" :: "v"(p), "v"(v) : "memory")
#if WT_STORES & 1
#define ATTN_STORE16(p, v) WT16_(p, v)
#endif
#if WT_STORES & 2
#define WT16(p, v) WT16_(p, v)
#else
#define WT16(p, v) (*(u32x4*)(p) = (v))
#endif
#ifndef X1_BF16
#define X1_BF16 1
#endif
#ifndef EPI_WIDE8
#define EPI_WIDE8 1
#endif
#ifndef MIX_KB
#define MIX_KB 0
#endif
#ifndef V_IN_P11
#define V_IN_P11 0
#endif
#ifndef P9_MIX
#define P9_MIX 0
#endif
#ifndef P12_ALTPRIO
#define P12_ALTPRIO 0
#endif
#ifndef P12_PREFETCH
#define P12_PREFETCH 0
#endif
namespace pg8 {
#define PG8_LAS __attribute__((address_space(3)))
typedef unsigned short bf16_t;
typedef short bf16x8 __attribute__((ext_vector_type(8)));
typedef float f32x4 __attribute__((ext_vector_type(4)));
typedef unsigned u32x4 __attribute__((ext_vector_type(4)));
typedef int v4i32_t __attribute__((ext_vector_type(4)));
typedef int v8i32_t __attribute__((ext_vector_type(8)));
constexpr int BM = 256, BK = 64, HALF = 128, HTB = HALF * BK * 2  , STAGE_BYTES = 8 * HTB, NXCD = 8, WGM = 8;

__host__ __device__ __forceinline__ int lds_byte(int r, int c) { const int st = (r >> 4) * 2 + (c >> 5), rr = r & 15, cc = c & 31, ob = rr * 64 + cc * 2; return st * 1024 + (ob ^ (((ob >> 9) & 1) << 5)); }
__host__ __device__ __forceinline__ void stage_rc(int b, int& R, int& C) { const int st = b / 1024, sb = b % 1024, swz = sb ^ (((sb >> 9) & 1) << 5); R = (st >> 1) * 16 + swz / 64; C = (st & 1) * 32 + (swz % 64) / 2; }
__host__ __device__ __forceinline__ int perm32(int rho) { const int n = rho >> 4, i = rho & 15; return 8 * (i >> 2) + 4 * n + (i & 3); }

struct Unit { int pm, pn; };
struct Gemm { const bf16_t* A; const bf16_t* Bt; int M, N, K; int kb = 0; };
__host__ __device__ __forceinline__ size_t kb_off(size_t r, int k, int K) { return (((r >> 8) * (size_t)(K >> 6) + (size_t)(k >> 6)) << 14) + ((r & 255) << 6) + (size_t)(k & 63); }

struct StaticOrder {
    int nM, nN, nwg, G, c;
    __host__ __device__ void init(int M, int N, int G_, int c_) { nM = M / BM; nN = N / BM; nwg = nM * nN; G = G_; c = c_; }
    __host__ __device__ bool next(int i, Unit& u) const {
        const long L = (long)i * G + c; if (L >= nwg) return false;
        int wgid = (int)L; { const int q = nwg / NXCD, r = nwg % NXCD, xcd = wgid % NXCD, off = wgid / NXCD; wgid = (xcd < r ? xcd * (q + 1) : r * (q + 1) + (xcd - r) * q) + off; }
        const int nig = WGM * nN, gid = wgid / nig, fm = gid * WGM, gsz = (nM - fm) < WGM ? (nM - fm) : WGM;
        u.pm = fm + ((wgid % nig) % gsz); u.pn = (wgid % nig) / gsz; return true;
    }
    __device__ __forceinline__ void a_ready(const Unit&) const {}
    __device__ __forceinline__ void done(const Unit&) const {}
};

#ifdef PROBE_TWICE
struct TwiceOrder { StaticOrder s;
    __host__ __device__ bool next(int i, Unit& u) const { return s.next(i >> 1, u); }
    __device__ __forceinline__ void a_ready(const Unit&) const {}
    __device__ __forceinline__ void done(const Unit&) const {}
};
#endif
__device__ __forceinline__ unsigned cvt_pk_bf16(float lo, float hi) { unsigned r; asm volatile("v_cvt_pk_bf16_f32 %0, %1, %2" : "=v"(r) : "v"(lo), "v"(hi)); return r; }
typedef float f32x2 __attribute__((ext_vector_type(2)));
typedef unsigned u32x2 __attribute__((ext_vector_type(2)));
#ifndef QK_FP8
#define QK_FP8 1
#endif
#ifndef G_U8
#define G_U8 1
#endif
__device__ __forceinline__ float bf_lo(unsigned w) { return __uint_as_float(w << 16); }
__device__ __forceinline__ float bf_hi(unsigned w) { return __uint_as_float(w & 0xffff0000u); }

struct EpiBf16 {
    static constexpr bool PERM = true, AFTER_DRAIN = false;
    bf16_t* O; int ldc;
    __device__ __forceinline__ void operator()(const f32x4 (&acc)[2][2][4][2], const Unit& u, int wr, int wc, int fr, int fq) const {
        const int row0 = u.pm * BM + wr * 64 + fr; const int col0 = u.pn * BM + wc * 32 + 8 * fq;
#pragma unroll
        for (int ai = 0; ai < 2; ++ai)
#pragma unroll
            for (int m = 0; m < 4; ++m) { bf16_t* rowp = O + (size_t)(row0 + ai * HALF + m * 16) * ldc + col0;
#pragma unroll
                for (int bj = 0; bj < 2; ++bj) { const f32x4 v0 = acc[ai][bj][m][0], v1 = acc[ai][bj][m][1];
                    u32x4 w; w.x = cvt_pk_bf16(v0[0], v0[1]); w.y = cvt_pk_bf16(v0[2], v0[3]); w.z = cvt_pk_bf16(v1[0], v1[1]); w.w = cvt_pk_bf16(v1[2], v1[3]);
                    *(u32x4*)(rowp + bj * HALF) = w; } }
    }
};

struct EpiQF {
    static constexpr bool PERM = true, AFTER_DRAIN = false;
    bf16_t* O;
    __device__ __forceinline__ void operator()(const f32x4 (&acc)[2][2][4][2], const Unit& u, int wr, int wc, int fr, int fq) const {
#pragma unroll
        for (int ai = 0; ai < 2; ++ai)
#pragma unroll
            for (int m = 0; m < 4; ++m) { const int rb = u.pm * 8 + ai * 4 + wr * 2 + (m >> 1), r32 = (m & 1) * 16 + fr;
#pragma unroll
                for (int bj = 0; bj < 2; ++bj) { const f32x4 v0 = acc[ai][bj][m][0], v1 = acc[ai][bj][m][1];
                    u32x4 w; w.x = cvt_pk_bf16(v0[0], v0[1]); w.y = cvt_pk_bf16(v0[2], v0[3]); w.z = cvt_pk_bf16(v1[0], v1[1]); w.w = cvt_pk_bf16(v1[2], v1[3]);
                    const size_t off = ((((size_t)(rb * 8 + u.pn) * 2 + bj) * 8 + 2 * wc + (fq >> 1)) * 64 + (fq & 1) * 32 + r32) * 8;
                    WT16(O + off, w); } }
    }
};

#if EPI_WIDE8
__device__ __forceinline__ void store8_pair(unsigned char* p, size_t ld, int fq, unsigned a0, unsigned a1, unsigned b0, unsigned b1) {
    const auto r0 = __builtin_amdgcn_permlane16_swap(a0, b0, false, false); const auto r1 = __builtin_amdgcn_permlane16_swap(a1, b1, false, false);
    unsigned char* q = (fq & 1) ? p + 16 * ld - 8 : p;
    *(u32x4*)q = (u32x4){r0[0], r1[0], r0[1], r1[1]};
}
#endif
struct EpiInProj {
    static constexpr bool PERM = true, AFTER_DRAIN = false;
    bf16_t *QA, *KA, *VA, *QB, *KB, *VB, *G; const float* b_gate; const float *qn_a, *kn_a, *qn_b, *kn_b; const float* CS; float qscale;
    const float* sA; const float* sW;
    __device__ __forceinline__ void operator()(const f32x4 (&acc)[2][2][4][2], const Unit& u, int wr, int wc, int fr, int fq) const {
        const int pn = u.pn; bf16_t* base; int ldc, colt; int mode = 0; const float* gn = nullptr; float qs = 1.f;
        bool f8 = false;
        if (pn < 3)       { base = QA; ldc = 768;  colt = pn * BM; mode = 2; gn = qn_a; qs = qscale; }
        else if (pn < 6)  { base = KA; ldc = 768;  colt = (pn - 3) * BM; mode = 2; gn = kn_a; }
        else if (pn < 9)  { base = VA; ldc = 768;  colt = (pn - 6) * BM; }
        else if (pn < 13) { base = QB; ldc = 1024; colt = (pn - 9) * BM; mode = 2; gn = qn_b; qs = qscale * (QK_FP8 ? 64.f : 1.f); f8 = QK_FP8; }
        else if (pn < 17) { base = KB; ldc = 1024; colt = (pn - 13) * BM; mode = 2; gn = kn_b; qs = QK_FP8 ? 16.f : 1.f; f8 = QK_FP8; }
        else if (pn < 21) { base = VB; ldc = 1024; colt = (pn - 17) * BM; mode = 3; }
        else              { base = G;  ldc = 2048; colt = (pn - 21) * BM; mode = 1; }
        const int row0 = u.pm * BM + wr * 64 + fr;
        const float sa_lo = sA[u.pm * BM + wr * 64 + fq * 16 + fr], sa_hi = sA[u.pm * BM + HALF + wr * 64 + fq * 16 + fr];
#define SA_ROW(ai, m) __shfl((ai) ? sa_hi : sa_lo, (m) * 16 + fr)
        if (mode == 2) {
            const f32x4 g1a = *(const f32x4*)(gn + 8 * fq), g1b = *(const f32x4*)(gn + 8 * fq + 4), g2a = *(const f32x4*)(gn + 32 + 8 * fq), g2b = *(const f32x4*)(gn + 32 + 8 * fq + 4);
            const int col0 = colt + wc * 64 + 8 * fq;
            const float* swp = sW + pn * BM + wc * 32 + 8 * fq;
            const f32x4 w1a = *(const f32x4*)swp, w1b = *(const f32x4*)(swp + 4), w2a = *(const f32x4*)(swp + HALF), w2b = *(const f32x4*)(swp + HALF + 4);
            int pend8[4] = {0, 0, 0, 0};
            f32x4 cn0, cn1, cn2, cn3;
            { const float* cp = CS + (size_t)row0 * 64 + 8 * fq; cn0 = *(const f32x4*)cp; cn1 = *(const f32x4*)(cp + 4); cn2 = *(const f32x4*)(cp + 32); cn3 = *(const f32x4*)(cp + 36); }
#pragma unroll
            for (int ai = 0; ai < 2; ++ai)
#pragma unroll
                for (int m = 0; m < 4; ++m) { const size_t row = (size_t)(row0 + ai * HALF + m * 16);
                    const float ra = SA_ROW(ai, m);
                    const f32x4 x1a = acc[ai][0][m][0] * w1a * ra, x1b = acc[ai][0][m][1] * w1b * ra, x2a = acc[ai][1][m][0] * w2a * ra, x2b = acc[ai][1][m][1] * w2b * ra;
                    const f32x4 ca = cn0, cb = cn1, sa = cn2, sb = cn3;
                    float ss = 0.f;
#pragma unroll
                    for (int e = 0; e < 4; ++e) ss += (x1a[e] * x1a[e] + x1b[e] * x1b[e]) + (x2a[e] * x2a[e] + x2b[e] * x2b[e]);
                    ss += __shfl_xor(ss, 16); ss += __shfl_xor(ss, 32);
                    const float rs = qs * __builtin_amdgcn_rsqf(ss * (1.f / 64.f) + 1e-6f);
                    const f32x4 y1a = x1a * g1a * rs, y1b = x1b * g1b * rs, y2a = x2a * g2a * rs, y2b = x2b * g2b * rs;
                    const f32x4 o1a = y1a * ca - y2a * sa, o1b = y1b * cb - y2b * sb, o2a = y2a * ca + y1a * sa, o2b = y2b * cb + y1b * sb;
                    if (ai * 4 + m < 7) { const int nx = ai * 4 + m + 1; const float* cp = CS + (size_t)(row0 + (nx >> 2) * HALF + (nx & 3) * 16) * 64 + 8 * fq;
                        __builtin_amdgcn_sched_barrier(0);
                        cn0 = *(const f32x4*)cp; cn1 = *(const f32x4*)(cp + 4); cn2 = *(const f32x4*)(cp + 32); cn3 = *(const f32x4*)(cp + 36);
                        __builtin_amdgcn_sched_barrier(0); }
                    if (f8) {
                        int t0 = __builtin_amdgcn_cvt_pk_fp8_f32(o1a[0], o1a[1], 0, false); t0 = __builtin_amdgcn_cvt_pk_fp8_f32(o1a[2], o1a[3], t0, true);
                        int t1 = __builtin_amdgcn_cvt_pk_fp8_f32(o1b[0], o1b[1], 0, false); t1 = __builtin_amdgcn_cvt_pk_fp8_f32(o1b[2], o1b[3], t1, true);
                        int t2 = __builtin_amdgcn_cvt_pk_fp8_f32(o2a[0], o2a[1], 0, false); t2 = __builtin_amdgcn_cvt_pk_fp8_f32(o2a[2], o2a[3], t2, true);
                        int t3 = __builtin_amdgcn_cvt_pk_fp8_f32(o2b[0], o2b[1], 0, false); t3 = __builtin_amdgcn_cvt_pk_fp8_f32(o2b[2], o2b[3], t3, true);
#if EPI_WIDE8
                        if ((m & 1) == 0) { pend8[0] = t0; pend8[1] = t1; pend8[2] = t2; pend8[3] = t3; }
                        else { unsigned char* rp8 = (unsigned char*)base + (row - 16) * 1024 + col0;
                            store8_pair(rp8, 1024, fq, (unsigned)pend8[0], (unsigned)pend8[1], (unsigned)t0, (unsigned)t1); store8_pair(rp8 + 32, 1024, fq, (unsigned)pend8[2], (unsigned)pend8[3], (unsigned)t2, (unsigned)t3); }
#else
                        unsigned char* rp8 = (unsigned char*)base + row * 1024 + col0;
                        *(u32x2*)rp8 = (u32x2){(unsigned)t0, (unsigned)t1}; *(u32x2*)(rp8 + 32) = (u32x2){(unsigned)t2, (unsigned)t3};
#endif
                        if (m == 3) asm volatile("" ::: "memory");
                        continue; }
                    u32x4 w1, w2;
                    w1.x = cvt_pk_bf16(o1a[0], o1a[1]); w1.y = cvt_pk_bf16(o1a[2], o1a[3]); w1.z = cvt_pk_bf16(o1b[0], o1b[1]); w1.w = cvt_pk_bf16(o1b[2], o1b[3]);
                    w2.x = cvt_pk_bf16(o2a[0], o2a[1]); w2.y = cvt_pk_bf16(o2a[2], o2a[3]); w2.z = cvt_pk_bf16(o2b[0], o2b[1]); w2.w = cvt_pk_bf16(o2b[2], o2b[3]);
                    bf16_t* rowp = base + row * ldc + col0;
                    WT16(rowp, w1); WT16(rowp + 32, w2);
                    if (m == 3) asm volatile("" ::: "memory"); }
            return;
        }
        const bool gate = mode == 1;
        const int col0 = colt + wc * 32 + 8 * fq;
        f32x4 bv[2][2], sw[2][2];
#pragma unroll
        for (int bj = 0; bj < 2; ++bj)
#pragma unroll
            for (int n = 0; n < 2; ++n) { bv[bj][n] = gate ? *(const f32x4*)(b_gate + col0 + bj * HALF + 4 * n) : (f32x4){0.f, 0.f, 0.f, 0.f}; sw[bj][n] = *(const f32x4*)(sW + pn * BM + wc * 32 + 8 * fq + bj * HALF + 4 * n); }
        unsigned pendg[2][2] = {{0u, 0u}, {0u, 0u}};
#pragma unroll
        for (int ai = 0; ai < 2; ++ai)
#pragma unroll
            for (int m = 0; m < 4; ++m) { bf16_t* rowp = base + (size_t)(row0 + ai * HALF + m * 16) * ldc + col0; const float ra = SA_ROW(ai, m);
#pragma unroll
                for (int bj = 0; bj < 2; ++bj) { f32x4 v0 = acc[ai][bj][m][0] * sw[bj][0] * ra, v1 = acc[ai][bj][m][1] * sw[bj][1] * ra;
                    if (gate) {
                        v0 = v0 + bv[bj][0]; v1 = v1 + bv[bj][1];
#pragma unroll
                        for (int e = 0; e < 4; ++e) { v0[e] = __builtin_amdgcn_rcpf(1.0f + __expf(-v0[e])); v1[e] = __builtin_amdgcn_rcpf(1.0f + __expf(-v1[e])); }
                    }
                    if (mode == 3) {
#define V8C(x) __builtin_amdgcn_fmed3f((x) * 8.f, -448.f, 448.f)
                        int t0 = __builtin_amdgcn_cvt_pk_fp8_f32(V8C(v0[0]), V8C(v0[1]), 0, false); t0 = __builtin_amdgcn_cvt_pk_fp8_f32(V8C(v0[2]), V8C(v0[3]), t0, true);
                        int t1 = __builtin_amdgcn_cvt_pk_fp8_f32(V8C(v1[0]), V8C(v1[1]), 0, false); t1 = __builtin_amdgcn_cvt_pk_fp8_f32(V8C(v1[2]), V8C(v1[3]), t1, true);
#undef V8C
#if EPI_WIDE8
                        if ((m & 1) == 0) { pendg[bj][0] = (unsigned)t0; pendg[bj][1] = (unsigned)t1; }
                        else store8_pair((unsigned char*)base + (size_t)(row0 + ai * HALF + (m - 1) * 16) * 1024 + col0 + bj * HALF, 1024, fq, pendg[bj][0], pendg[bj][1], (unsigned)t0, (unsigned)t1);
#else
                        *(u32x2*)((unsigned char*)base + (size_t)(row0 + ai * HALF + m * 16) * 1024 + col0 + bj * HALF) = (u32x2){(unsigned)t0, (unsigned)t1};
#endif
                    } else if (G_U8 && gate) {
                        unsigned t0 = 0, t1 = 0;
#pragma unroll
                        for (int e = 0; e < 4; ++e) { t0 = __builtin_amdgcn_cvt_pk_u8_f32(__builtin_rintf(v0[e] * 255.f), e, t0); t1 = __builtin_amdgcn_cvt_pk_u8_f32(__builtin_rintf(v1[e] * 255.f), e, t1); }
#if EPI_WIDE8
                        if ((m & 1) == 0) { pendg[bj][0] = t0; pendg[bj][1] = t1; }
                        else store8_pair((unsigned char*)base + (size_t)(row0 + ai * HALF + (m - 1) * 16) * 2048 + col0 + bj * HALF, 2048, fq, pendg[bj][0], pendg[bj][1], t0, t1);
#else
                        *(u32x2*)((unsigned char*)base + (size_t)(row0 + ai * HALF + m * 16) * 2048 + col0 + bj * HALF) = (u32x2){(unsigned)t0, (unsigned)t1};
#endif
                    } else {
                    u32x4 w; w.x = cvt_pk_bf16(v0[0], v0[1]); w.y = cvt_pk_bf16(v0[2], v0[3]); w.z = cvt_pk_bf16(v1[0], v1[1]); w.w = cvt_pk_bf16(v1[2], v1[3]);
                    WT16(rowp + bj * HALF, w); } } }
    }
};
#undef SA_ROW

struct EpiBranchB {
    static constexpr bool PERM = true, AFTER_DRAIN = false;
    const bf16_t* ta; const unsigned char* G; bf16_t* mixed;
    __device__ __forceinline__ void operator()(const f32x4 (&acc)[2][2][4][2], const Unit& u, int wr, int wc, int fr, int fq) const {
        const int row0 = u.pm * BM + wr * 64 + fr; const int col0 = u.pn * BM + wc * 32 + 8 * fq;
        static_assert(G_U8, "byte gates");
#pragma unroll
        for (int ai = 0; ai < 2; ++ai) {
            u32x4 tv[4][2]; u32x2 q0v[4][2], q1v[4][2];
#pragma unroll
            for (int m = 0; m < 4; ++m) { const size_t row = (size_t)(row0 + ai * HALF + m * 16);
#pragma unroll
                for (int bj = 0; bj < 2; ++bj) { const int c = bj * HALF; tv[m][bj] = *(const u32x4*)(ta + row * 1024 + col0 + c);
                    const unsigned char* gp = G + row * 2048 + col0 + c; q0v[m][bj] = *(const u32x2*)gp; q1v[m][bj] = *(const u32x2*)(gp + 1024); } }
#pragma unroll
            for (int m = 0; m < 4; ++m) { const size_t row = (size_t)(row0 + ai * HALF + m * 16); bf16_t* mp = MIX_KB ? mixed + kb_off(row, col0, 1024) : mixed + row * 1024 + col0;
#pragma unroll
                for (int bj = 0; bj < 2; ++bj) { const int c = bj * HALF;
                    const u32x4 t = tv[m][bj]; const f32x4 a0 = acc[ai][bj][m][0], a1 = acc[ai][bj][m][1]; const u32x2 q0 = q0v[m][bj], q1 = q1v[m][bj];
                    float g0[8], g1[8];
#pragma unroll
                    for (int e = 0; e < 4; ++e) { g0[e] = (float)((q0.x >> (8 * e)) & 255u) * (1.f / 255.f); g0[4 + e] = (float)((q0.y >> (8 * e)) & 255u) * (1.f / 255.f);
                                                  g1[e] = (float)((q1.x >> (8 * e)) & 255u) * (1.f / 255.f); g1[4 + e] = (float)((q1.y >> (8 * e)) & 255u) * (1.f / 255.f); }
                    u32x4 w;
                    w.x = cvt_pk_bf16(bf_lo(t.x) * g0[0] + a0[0] * g1[0], bf_hi(t.x) * g0[1] + a0[1] * g1[1]);
                    w.y = cvt_pk_bf16(bf_lo(t.y) * g0[2] + a0[2] * g1[2], bf_hi(t.y) * g0[3] + a0[3] * g1[3]);
                    w.z = cvt_pk_bf16(bf_lo(t.z) * g0[4] + a1[0] * g1[4], bf_hi(t.z) * g0[5] + a1[1] * g1[5]);
                    w.w = cvt_pk_bf16(bf_lo(t.w) * g0[6] + a1[2] * g1[6], bf_hi(t.w) * g0[7] + a1[3] * g1[7]);
                    WT16(mp + (MIX_KB ? bj * 32768 : c), w); } }
            asm volatile("" ::: "memory"); }
    }
};
struct EpiOut {
    static constexpr bool PERM = true, AFTER_DRAIN = false;
    const float* mod; bf16_t* delta; const float* x;
    __device__ __forceinline__ void operator()(const f32x4 (&acc)[2][2][4][2], const Unit& u, int wr, int wc, int fr, int fq) const {
        const int row0 = u.pm * BM + wr * 64 + fr; const int col0 = u.pn * BM + wc * 32 + 8 * fq;
        const int b = (u.pm * BM) >> 12;
        f32x4 gv[2][2];
#pragma unroll
        for (int bj = 0; bj < 2; ++bj)
#pragma unroll
            for (int n = 0; n < 2; ++n) gv[bj][n] = *(const f32x4*)(mod + (size_t)b * 6144 + 2048 + col0 + bj * HALF + 4 * n);
#pragma unroll
        for (int ai = 0; ai < 2; ++ai) {
            f32x4 xv[4][2][2];
#pragma unroll
            for (int m = 0; m < 4; ++m)
#pragma unroll
                for (int bj = 0; bj < 2; ++bj) { if (x) { const float* xp = x + (size_t)(row0 + ai * HALF + m * 16) * 1024 + col0 + bj * HALF; xv[m][bj][0] = *(const f32x4*)xp; xv[m][bj][1] = *(const f32x4*)(xp + 4); }
                                                 else { xv[m][bj][0] = (f32x4){0.f, 0.f, 0.f, 0.f}; xv[m][bj][1] = (f32x4){0.f, 0.f, 0.f, 0.f}; } }
#pragma unroll
            for (int m = 0; m < 4; ++m) { bf16_t* rowp = delta + (size_t)(row0 + ai * HALF + m * 16) * 1024 + col0;
#pragma unroll
                for (int bj = 0; bj < 2; ++bj) { const f32x4 v0 = gv[bj][0] * acc[ai][bj][m][0] + xv[m][bj][0], v1 = gv[bj][1] * acc[ai][bj][m][1] + xv[m][bj][1];
                    u32x4 w; w.x = cvt_pk_bf16(v0[0], v0[1]); w.y = cvt_pk_bf16(v0[2], v0[3]); w.z = cvt_pk_bf16(v1[0], v1[1]); w.w = cvt_pk_bf16(v1[2], v1[3]);
                    WT16(rowp + bj * HALF, w); } }
            asm volatile("" ::: "memory"); }
    }
};


template <class Epi, class Sched, bool ALIGN_EPI = false, bool SP2 = false, bool FP8 = false>
__device__ __forceinline__ void gemm_phase(PG8_LAS unsigned char* lds, const Gemm g, const Sched& S, const Epi& E, float* gstamp = nullptr) {
    const int tid = threadIdx.x, wid = __builtin_amdgcn_readfirstlane(tid >> 6), lane = tid & 63, wr = wid >> 2, wc = wid & 3, fr = lane & 15, fq = lane >> 4;
    const int K = g.K, nt = K / BK;
    unsigned voffA[2], voffB[2];
#pragma unroll
    for (int i = 0; i < 2; ++i) { int R, C; stage_rc(tid * 16 + i * 8192, R, C); const int Rb = Epi::PERM ? ((R & ~31) + perm32(R & 31)) : R;
        voffA[i] = (unsigned)(R * (g.kb ? BK : K) + C) * 2u; voffB[i] = (unsigned)(Rb * (g.kb ? BK : K) + C) * 2u; }
    const size_t kstep = g.kb ? (size_t)(BM * BK * 2) : (size_t)(BK * 2);
    const size_t hstep = g.kb ? (size_t)(HALF * BK * 2) : (size_t)HALF * K * 2;
    const size_t tstep = (size_t)BM * K * 2;
    const unsigned ldsw = (unsigned)wid * 1024u;
    const int aoff = FP8 ? lds_byte(wr * 64 + fr, fq * 16) : lds_byte(wr * 64 + fr, fq * 8), boff = FP8 ? lds_byte(wc * 32 + fr, fq * 16) : lds_byte(wc * 32 + fr, fq * 8);
#define PG8_SA(b, h) (((b) * 2 + (h)) * HTB)
#define PG8_SB(b, h) ((4 + (b) * 2 + (h)) * HTB)
#define PG8_STAGE(bufoff, gbase, voff) do { _Pragma("unroll") for (int _i = 0; _i < 2; ++_i) \
        __builtin_amdgcn_global_load_lds((const unsigned*)((const char*)(gbase) + (voff)[_i]), (PG8_LAS unsigned*)(lds + (bufoff) + ldsw + _i * 8192), 16, 0, 0); } while (0)
#define PG8_LD32(p) __builtin_shufflevector(*(const PG8_LAS v4i32_t*)(p), *(const PG8_LAS v4i32_t*)((p) + 16), 0, 1, 2, 3, 4, 5, 6, 7)
#define PG8_LDA(dst, b, h) do { if constexpr (FP8) { _Pragma("unroll") for (int m = 0; m < 4; ++m) dst##8[m] = PG8_LD32(lds + PG8_SA(b, h) + aoff + m * 2048); } \
        else { _Pragma("unroll") for (int m = 0; m < 4; ++m) _Pragma("unroll") for (int k = 0; k < 2; ++k) dst[m][k] = *(const PG8_LAS bf16x8*)(lds + PG8_SA(b, h) + aoff + m * 2048 + k * 1024); } } while (0)
#define PG8_LDB(dst, b, h) do { if constexpr (FP8) { _Pragma("unroll") for (int n = 0; n < 2; ++n) dst##8[n] = PG8_LD32(lds + PG8_SB(b, h) + boff + n * 2048); } \
        else { _Pragma("unroll") for (int n = 0; n < 2; ++n) _Pragma("unroll") for (int k = 0; k < 2; ++k) dst[n][k] = *(const PG8_LAS bf16x8*)(lds + PG8_SB(b, h) + boff + n * 2048 + k * 1024); } } while (0)
#define PG8_MMA(ai, bj, At, Bt) do { __builtin_amdgcn_s_setprio(1); \
        if constexpr (FP8) { _Pragma("unroll") for (int m = 0; m < 4; ++m) _Pragma("unroll") for (int n = 0; n < 2; ++n) \
            asm volatile("v_mfma_scale_f32_16x16x128_f8f6f4 %0, %1, %2, %0, %3, %3 op_sel_hi:[0,0,0]" : "+v"(acc[ai][bj][m][n]) : "v"(Bt##8[n]), "v"(At##8[m]), "v"(mxone)); } \
        else { _Pragma("unroll") for (int m = 0; m < 4; ++m) _Pragma("unroll") for (int n = 0; n < 2; ++n) _Pragma("unroll") for (int k = 0; k < 2; ++k) \
            acc[ai][bj][m][n] = __builtin_amdgcn_mfma_f32_16x16x32_bf16(Bt[n][k], At[m][k], acc[ai][bj][m][n], 0, 0, 0); } \
        __builtin_amdgcn_s_setprio(0); } while (0)
#define PG8_WAIT_V(n) asm volatile("s_waitcnt vmcnt(" #n ")" ::: "memory")
#define PG8_WAIT_L(n) asm volatile("s_waitcnt lgkmcnt(" #n ")" ::: "memory")
#define PG8_BAR __builtin_amdgcn_s_barrier()
#define PG8_SCHED __builtin_amdgcn_sched_barrier(0)
    Unit cur, nxt; int ui = 0;
    if (!S.next(0, cur)) return;
    f32x4 acc[2][2][4][2];
#pragma unroll
    for (int a = 0; a < 2; ++a)
#pragma unroll
        for (int b = 0; b < 2; ++b)
#pragma unroll
            for (int m = 0; m < 4; ++m)
#pragma unroll
                for (int n = 0; n < 2; ++n) acc[a][b][m][n] = (f32x4){0.f, 0.f, 0.f, 0.f};
    bf16x8 At[4][2], B0[2][2], B1[2][2]; v8i32_t At8[4], B08[2], B18[2];
    int mxone = 0x7F7F7F7F; asm volatile("" : "+v"(mxone));
    const char* cA = (const char*)g.A + (size_t)cur.pm * tstep; const char* cB = (const char*)g.Bt + (size_t)cur.pn * tstep;
    S.a_ready(cur);
    if constexpr (SP2) {
        PG8_STAGE(PG8_SB(0, 0), cB, voffB); PG8_STAGE(PG8_SB(0, 1), cB + hstep, voffB); PG8_STAGE(PG8_SA(0, 0), cA, voffA); PG8_STAGE(PG8_SA(0, 1), cA + hstep, voffA);
        if (wr == 1) PG8_BAR;
        PG8_WAIT_V(2); PG8_BAR;
        PG8_STAGE(PG8_SB(1, 0), cB + kstep, voffB); PG8_STAGE(PG8_SA(1, 0), cA + kstep, voffA); PG8_STAGE(PG8_SB(1, 1), cB + hstep + kstep, voffB);
        PG8_WAIT_V(6); PG8_BAR;
    } else {
        PG8_STAGE(PG8_SB(0, 0), cB, voffB); PG8_STAGE(PG8_SA(0, 0), cA, voffA); PG8_STAGE(PG8_SB(0, 1), cB + hstep, voffB); PG8_STAGE(PG8_SA(0, 1), cA + hstep, voffA);
        if (wr == 1) PG8_BAR;
        PG8_WAIT_V(4); PG8_BAR;
        PG8_STAGE(PG8_SB(1, 0), cB + kstep, voffB); PG8_STAGE(PG8_SA(1, 0), cA + kstep, voffA); PG8_STAGE(PG8_SB(1, 1), cB + hstep + kstep, voffB);
        PG8_WAIT_V(6); PG8_BAR;
    }
#if defined(PROBE_GSTAMP)
    unsigned long long tu0_; asm volatile("s_memtime %0\n\ts_waitcnt lgkmcnt(0)" : "=s"(tu0_) :: "memory");
#endif
    for (;;) {
        const bool has_next = S.next(ui + 1, nxt);
        const char* nA = has_next ? (const char*)g.A + (size_t)nxt.pm * tstep : cA; const char* nB = has_next ? (const char*)g.Bt + (size_t)nxt.pn * tstep : cB;
        for (int t = 0; t < nt; t += 2) {
            const bool last = (t == nt - 2);
            const char* a1 = cA + (size_t)(t + 1) * kstep;
            const char* a2 = last ? nA : cA + (size_t)(t + 2) * kstep; const char* b2 = last ? nB : cB + (size_t)(t + 2) * kstep;
            const char* a3 = a2 + kstep; const char* b3 = b2 + kstep;
            if (last && has_next) S.a_ready(nxt);
            if constexpr (SP2) {
            PG8_LDB(B0, 0, 0); PG8_LDB(B1, 0, 1); PG8_SCHED; PG8_LDA(At, 0, 0); PG8_STAGE(PG8_SA(1, 1), a1 + hstep, voffA);
            PG8_WAIT_V(8); PG8_WAIT_L(0); PG8_BAR; PG8_MMA(0, 0, At, B0); PG8_MMA(0, 1, At, B1); PG8_BAR; PG8_SCHED;
            PG8_LDA(At, 0, 1); PG8_STAGE(PG8_SB(0, 0), b2, voffB); PG8_STAGE(PG8_SB(0, 1), b2 + hstep, voffB); PG8_STAGE(PG8_SA(0, 0), a2, voffA);
            PG8_WAIT_V(8); PG8_WAIT_L(0); PG8_BAR; PG8_MMA(1, 0, At, B0); PG8_MMA(1, 1, At, B1); PG8_BAR; PG8_SCHED;
            PG8_LDB(B0, 1, 0); PG8_LDB(B1, 1, 1); PG8_SCHED; PG8_LDA(At, 1, 0); PG8_STAGE(PG8_SA(0, 1), a2 + hstep, voffA);
            PG8_WAIT_V(8); PG8_WAIT_L(0); PG8_BAR; PG8_MMA(0, 0, At, B0); PG8_MMA(0, 1, At, B1); PG8_BAR; PG8_SCHED;
            PG8_LDA(At, 1, 1); PG8_STAGE(PG8_SB(1, 0), b3, voffB); PG8_STAGE(PG8_SB(1, 1), b3 + hstep, voffB); PG8_STAGE(PG8_SA(1, 0), a3, voffA);
            PG8_WAIT_V(8); PG8_WAIT_L(0); PG8_BAR; PG8_MMA(1, 0, At, B0); PG8_MMA(1, 1, At, B1); PG8_BAR; PG8_SCHED;
            } else {
            PG8_LDB(B0, 0, 0); PG8_SCHED; PG8_LDA(At, 0, 0); PG8_STAGE(PG8_SA(1, 1), a1 + hstep, voffA);
            PG8_WAIT_L(8); PG8_BAR; PG8_WAIT_L(0); PG8_MMA(0, 0, At, B0); PG8_BAR; PG8_SCHED;
            PG8_LDB(B1, 0, 1); PG8_STAGE(PG8_SB(0, 0), b2, voffB);
            PG8_BAR; PG8_WAIT_L(0); PG8_MMA(0, 1, At, B1); PG8_BAR;
            PG8_LDA(At, 0, 1); PG8_STAGE(PG8_SA(0, 0), a2, voffA);
            PG8_BAR; PG8_WAIT_L(0); PG8_MMA(1, 0, At, B0); PG8_BAR; PG8_SCHED;
            PG8_STAGE(PG8_SB(0, 1), b2 + hstep, voffB);
            PG8_WAIT_V(6); PG8_BAR; PG8_MMA(1, 1, At, B1); PG8_BAR;
            PG8_LDB(B0, 1, 0); PG8_SCHED; PG8_LDA(At, 1, 0); PG8_STAGE(PG8_SA(0, 1), a2 + hstep, voffA);
            PG8_WAIT_L(8); PG8_BAR; PG8_WAIT_L(0); PG8_MMA(0, 0, At, B0); PG8_BAR; PG8_SCHED;
            PG8_LDB(B1, 1, 1); PG8_STAGE(PG8_SB(1, 0), b3, voffB);
            PG8_BAR; PG8_WAIT_L(0); PG8_MMA(0, 1, At, B1); PG8_BAR;
            PG8_LDA(At, 1, 1); PG8_STAGE(PG8_SA(1, 0), a3, voffA);
            PG8_BAR; PG8_WAIT_L(0); PG8_MMA(1, 0, At, B0); PG8_BAR; PG8_SCHED;
            PG8_STAGE(PG8_SB(1, 1), b3 + hstep, voffB);
            PG8_WAIT_V(6); PG8_BAR; PG8_MMA(1, 1, At, B1); PG8_BAR;
            }
        }
        if constexpr (FP8) asm volatile("s_nop 15\n\ts_nop 15" ::: "memory");
        if constexpr (ALIGN_EPI) { if (wr == 0) PG8_BAR; }
#if defined(PROBE_GSTAMP)
        unsigned long long te0_; asm volatile("s_memtime %0\n\ts_waitcnt lgkmcnt(0)" : "=s"(te0_) :: "memory");
#endif
        if constexpr (!Epi::AFTER_DRAIN) { E(acc, cur, wr, wc, fr, fq); S.done(cur); }
#if defined(PROBE_GSTAMP)
        if (gstamp) { asm volatile("s_waitcnt vmcnt(0)" ::: "memory"); unsigned long long te1_; asm volatile("s_memtime %0\n\ts_waitcnt lgkmcnt(0)" : "=s"(te1_) :: "memory");
            if (blockIdx.x == 0 && threadIdx.x == 0) { gstamp[0] += (float)(te1_ - te0_); gstamp[1] += (float)(te1_ - tu0_); } tu0_ = te1_; }
#endif
        if (!has_next) break;
#pragma unroll
        for (int a = 0; a < 2; ++a)
#pragma unroll
            for (int b = 0; b < 2; ++b)
#pragma unroll
                for (int m = 0; m < 4; ++m)
#pragma unroll
                    for (int n = 0; n < 2; ++n) acc[a][b][m][n] = (f32x4){0.f, 0.f, 0.f, 0.f};
        cur = nxt; cA = nA; cB = nB; ++ui;
        if constexpr (ALIGN_EPI) { if (wr == 1) PG8_BAR; }
    }
    PG8_WAIT_V(0);
    if constexpr (!ALIGN_EPI) { if (wr == 0) PG8_BAR; }
    PG8_BAR;
    if constexpr (Epi::AFTER_DRAIN) { E.fused(acc, cur, wr, wc, fr, fq, lds, wid, lane); S.done(cur); }
#undef PG8_SA
#undef PG8_SB
#undef PG8_STAGE
#undef PG8_LDA
#undef PG8_LDB
#undef PG8_MMA
#undef PG8_LD32
#undef PG8_WAIT_V
#undef PG8_WAIT_L
#undef PG8_BAR
#undef PG8_SCHED
}
}
#include <hip/hip_bf16.h>
#include <cmath>
namespace attn_body {
using bf16=__hip_bfloat16;
using bf16x8=__attribute__((ext_vector_type(8)))short;
using s16x4=__attribute__((ext_vector_type(4)))short;
using f32x16=__attribute__((ext_vector_type(16)))float;
using u32x4=__attribute__((ext_vector_type(4)))unsigned;
constexpr int BATCH=8,NHEAD=16,SEQ=4096,D=64,DM=NHEAD*D;
constexpr int NW=8,QBLK=32,QB=QBLK*NW,KVBLK=64,NQB=SEQ/QB;
constexpr int ATTN_PITCH=DM, ATTN_UNIT_ROWS=QB;
__device__ __forceinline__ int crow(int r,int hi){return (r&3)+8*(r>>2)+4*hi;}
#define SBAR() __builtin_amdgcn_sched_barrier(0)
__device__ __forceinline__ void cmask(f32x16&p0,f32x16&p1,int jb,int qrel,int hi){
  const float NEG=-INFINITY; int kb=64*jb+4*hi;
  #pragma unroll
  for(int r=0;r<16;++r){int kv=kb+(r&3)+8*(r>>2); if(kv>qrel)p0[r]=NEG; if(kv+32>qrel)p1[r]=NEG;}
}

constexpr int NSLOT=3, SLOTB=8192;
constexpr int LDS_K=0, LDS_V=NSLOT*SLOTB, LDS_WS=2*NSLOT*SLOTB, LDS_OST=LDS_WS+NW*64*4, LDS_BYTES=LDS_OST+NW*4096;
constexpr float C2=0.125f*1.4426950408889634f;
__device__ __forceinline__ void glds16(const void*gsrc,unsigned lds_dst){unsigned keep;
  asm volatile("s_mov_b32 %0, m0\n\ts_mov_b32 m0, %2\n\ts_nop 0\n\tglobal_load_lds_dwordx4 %1, off\n\ts_mov_b32 m0, %0":"=&s"(keep):"v"(gsrc),"s"(lds_dst):"memory");}
__device__ __forceinline__ float max3f(float a,float b,float c){float r;asm("v_max3_f32 %0, %1, %2, %3":"=v"(r):"v"(a),"v"(b),"v"(c));return r;}
__device__ __forceinline__ float max2f(float a,float b){float r;asm("v_max_f32_e32 %0, %1, %2":"=v"(r):"v"(a),"v"(b));return r;}
__device__ __forceinline__ float fadd_s(float a,float b){float r;asm("v_add_f32_e32 %0, %1, %2":"=v"(r):"v"(a),"v"(b));return r;}
__device__ __forceinline__ float fsub_s(float a,float b){float r;asm("v_sub_f32_e32 %0, %1, %2":"=v"(r):"v"(a),"v"(b));return r;}
typedef float f32x2_t __attribute__((ext_vector_type(2))); typedef __bf16 bf16x2_t __attribute__((ext_vector_type(2)));
__device__ __forceinline__ unsigned cvtpk_s(float lo,float hi){f32x2_t v={lo,hi};bf16x2_t b=__builtin_convertvector(v,bf16x2_t);return __builtin_bit_cast(unsigned,b);}
#define WAIT_BAR(N) asm volatile("s_waitcnt vmcnt(" #N ") lgkmcnt(0)\n\ts_barrier":::"memory")

__device__ __forceinline__ void qkt(f32x16&p0,f32x16&p1,const char*Kslot,const bf16x8*qr,const f32x16&negm,int r32,int hi){
  const char*kb=Kslot+hi*1024+r32*16;
  #pragma unroll
  for(int d0=0;d0<4;++d0){
    const bf16x8 b0=*reinterpret_cast<const bf16x8*>(kb+d0*2048);
    const bf16x8 b1=*reinterpret_cast<const bf16x8*>(kb+d0*2048+512);
    if(d0==0){p0=__builtin_amdgcn_mfma_f32_32x32x16_bf16(b0,qr[0],negm,0,0,0);p1=__builtin_amdgcn_mfma_f32_32x32x16_bf16(b1,qr[0],negm,0,0,0);}
    else{p0=__builtin_amdgcn_mfma_f32_32x32x16_bf16(b0,qr[d0],p0,0,0,0);p1=__builtin_amdgcn_mfma_f32_32x32x16_bf16(b1,qr[d0],p1,0,0,0);}}
}
typedef __attribute__((address_space(3))) const char* lds_cptr;
typedef short v4i16_t __attribute__((ext_vector_type(4)));
__device__ __forceinline__ void kload8(bf16x8*kf,lds_cptr kp){
  kf[0]=*(const __attribute__((address_space(3))) bf16x8*)(kp);      kf[1]=*(const __attribute__((address_space(3))) bf16x8*)(kp+512);
  kf[2]=*(const __attribute__((address_space(3))) bf16x8*)(kp+2048); kf[3]=*(const __attribute__((address_space(3))) bf16x8*)(kp+2560);
  kf[4]=*(const __attribute__((address_space(3))) bf16x8*)(kp+4096); kf[5]=*(const __attribute__((address_space(3))) bf16x8*)(kp+4608);
  kf[6]=*(const __attribute__((address_space(3))) bf16x8*)(kp+6144); kf[7]=*(const __attribute__((address_space(3))) bf16x8*)(kp+6656);
}
__device__ __forceinline__ void kload2(bf16x8*kf,lds_cptr kp,int j){ kf[2*j]=*(const __attribute__((address_space(3))) bf16x8*)(kp+j*2048); kf[2*j+1]=*(const __attribute__((address_space(3))) bf16x8*)(kp+j*2048+512); }
__device__ __forceinline__ s16x4 vtr(lds_cptr p){ return __builtin_bit_cast(s16x4,__builtin_amdgcn_ds_read_tr16_b64_v4i16((__attribute__((address_space(3))) v4i16_t*)p)); }
__device__ __forceinline__ float rowmax(const f32x16&p0,const f32x16&p1){
  float a=max3f(p0[0],p0[1],p1[0]),b=max3f(p0[2],p0[3],p1[1]);a=max3f(a,p1[2],p1[3]);
  #pragma unroll
  for(int r=4;r<16;r+=4){a=max3f(a,p0[r],p0[r+1]);b=max3f(b,p0[r+2],p0[r+3]);a=max3f(a,p1[r],p1[r+1]);b=max3f(b,p1[r+2],p1[r+3]);}
  const float m=max2f(a,b);
  auto rr=__builtin_amdgcn_permlane32_swap(__float_as_uint(m),__float_as_uint(m),false,false);
  return max2f(__uint_as_float(rr[0]),__uint_as_float(rr[1]));
}
__device__ __forceinline__ void pv(f32x16*o,int vb,bf16x8 pa0,bf16x8 pa1,bf16x8 pa2,bf16x8 pa3){
  #pragma unroll
  for(int d0=0;d0<2;++d0){s16x4 lo[4],hi[4];
    #pragma unroll
    for(int ks=0;ks<4;++ks){
      asm volatile("ds_read_b64_tr_b16 %0,%1 offset:%c2":"=&v"(lo[ks]):"v"(vb),"i"(d0*4096+ks*1024):"memory");
      asm volatile("ds_read_b64_tr_b16 %0,%1 offset:%c2":"=&v"(hi[ks]):"v"(vb),"i"(d0*4096+ks*1024+512):"memory");}
    asm volatile("s_waitcnt lgkmcnt(0)":::"memory");SBAR();
    #define PK(k) (bf16x8){lo[k][0],lo[k][1],lo[k][2],lo[k][3],hi[k][0],hi[k][1],hi[k][2],hi[k][3]}
    o[d0]=__builtin_amdgcn_mfma_f32_32x32x16_bf16(pa0,PK(0),o[d0],0,0,0);
    o[d0]=__builtin_amdgcn_mfma_f32_32x32x16_bf16(pa1,PK(1),o[d0],0,0,0);
    o[d0]=__builtin_amdgcn_mfma_f32_32x32x16_bf16(pa2,PK(2),o[d0],0,0,0);
    o[d0]=__builtin_amdgcn_mfma_f32_32x32x16_bf16(pa3,PK(3),o[d0],0,0,0);
    #undef PK
  }
}

#ifndef ATTN_STORE16
#define ATTN_STORE16(p,v) (*(u32x4*)(p)=(v))
#endif
template<int THRL> __device__ __forceinline__ void attn_unit(int b,int h,int qb,const bf16*Q,const bf16*__restrict__ K,const bf16*__restrict__ V,bf16*O,char*shm){
  const int tid=threadIdx.x,lane=tid&63,r32=lane&31,hi=lane>>5; const int wid=__builtin_amdgcn_readfirstlane(tid>>6);
  const long rowbase=(long)b*SEQ; const int q0=qb*QB;
  const bf16*Qw=Q+(rowbase+q0+wid*QBLK)*DM+h*D;
  const bf16*Kh=K+rowbase*DM+h*D,*Vh=V+rowbase*DM+h*D;
  const unsigned lds0=(unsigned)(uintptr_t)shm;
  float*wsf=(float*)(shm+LDS_WS)+wid*64;
  const bf16*ksrc=Kh+(long)lane*DM+wid*8;
  const bf16*vsrc=Vh+(long)(16*(wid&3)+(lane>>2))*DM+(wid>>2)*32+(lane&3)*8;
  const unsigned kdst=lds0+LDS_K+wid*1024, vdst=lds0+LDS_V+wid*1024;
  #define DMA_K(t,slot) glds16(ksrc+(long)(t)*KVBLK*DM,(unsigned)__builtin_amdgcn_readfirstlane(kdst+(slot)))
  #define DMA_V(t,slot) glds16(vsrc+(long)(t)*KVBLK*DM,(unsigned)__builtin_amdgcn_readfirstlane(vdst+(slot)))
  const int vb0=(int)(lds0+LDS_V)+((lane>>4)&1)*32+(lane&3)*8+(4*hi+((lane&15)>>2))*64;
  const char*Kbase=shm+LDS_K; bf16x8 kf[8];
  const lds_cptr shm3=(lds_cptr)shm; const lds_cptr kp0=shm3+LDS_K+hi*1024+r32*16; const lds_cptr vp0=shm3+LDS_V+((lane>>4)&1)*32+(lane&3)*8+(4*hi+((lane&15)>>2))*64;
  const int NT=SEQ/KVBLK;
  DMA_K(0,0);DMA_V(0,0);DMA_K(1,SLOTB);
  bf16x8 qr[4];
  #pragma unroll
  for(int d0=0;d0<4;++d0)qr[d0]=*reinterpret_cast<const bf16x8*>(&Qw[(long)r32*DM+d0*16+hi*8]);
  float mhat=0.f,l_reg=0.f;f32x16 o[2];o[0]=f32x16{};o[1]=f32x16{};f32x16 negm=f32x16{};asm volatile("":"+v"(negm));
  const int qrel=wid*QBLK+r32;
  #define CMASK(P0,P1,t) do{}while(0)
  bool resc=false;
  #define START(P0,P1) do{ const float rm=rowmax(P0,P1); resc=false; \
    { const float dl=rm; mhat=fadd_s(mhat,dl); \
      _Pragma("unroll") for(int r=0;r<16;++r){P0[r]=fsub_s(P0[r],dl);P1[r]=fsub_s(P1[r],dl);} \
      _Pragma("unroll") for(int r=0;r<16;++r)negm[r]=-mhat; asm volatile("":"+v"(negm)); } \
    _Pragma("unroll") for(int r=0;r<16;++r)P0[r]=__builtin_amdgcn_exp2f(P0[r]); }while(0)
  #define RESC() do{ if(resc){ asm volatile("s_waitcnt lgkmcnt(0)":::"memory"); \
      _Pragma("unroll") for(int d_=0;d_<2;++d_) _Pragma("unroll") for(int r=0;r<16;++r)o[d_][r]*=wsf[crow(r,hi)]; } }while(0)
  f32x16 pA0,pA1,pB0,pB1;
  int sl_prev=0,sl_cur=0,sl_next=SLOTB;
  #define ROT() do{sl_prev=sl_cur;sl_cur=sl_next;sl_next=(sl_next==(NSLOT-1)*SLOTB)?0:sl_next+SLOTB;}while(0)
  DMA_K(2,2*SLOTB);
  WAIT_BAR(3);
  qkt(pA0,pA1,Kbase,qr,negm,r32,hi);asm volatile("s_nop 15\n\ts_nop 7":"+v"(pA0),"+v"(pA1));CMASK(pA0,pA1,0);
  START(pA0,pA1);
  _Pragma("unroll") for(int r=0;r<16;++r)pA1[r]=__builtin_amdgcn_exp2f(pA1[r]);
  WAIT_BAR(0);
  DMA_K(3,0);DMA_V(1,SLOTB);
  ROT();
  kload8(kf,kp0+sl_cur);
  WAIT_BAR(2);
  s16x4 vlo[8],vhi[8]; u32x4 pw0,pw1,pw2,pw3;
  #define PKW(P,B) cvtpk_s(P[B],P[B+1])
  #define PAF(k) __builtin_bit_cast(bf16x8,pw##k)
  #define VFR(i) (bf16x8){vlo[i][0],vlo[i][1],vlo[i][2],vlo[i][3],vhi[i][0],vhi[i][1],vhi[i][2],vhi[i][3]}
  #define PIN(x) asm volatile("":"+v"(x))
  #define MX3(a,b,c) __builtin_fmaxf(__builtin_fmaxf((a),(b)),(c))
  #define GAPA(MF,A0,A1,A2,A3,W0,W1,PW) do{ MF; sacc+=A0; sacc+=A1; sacc+=A2; sacc+=A3; PIN(sacc); W0; W1; PIN(PW); SBAR(); }while(0)
  #define EX(v) __builtin_amdgcn_exp2f(v)
  #define GAPB(MF,X,B) do{ MF; X[B]=EX(X[B]); X[B+1]=EX(X[B+1]); X[B+2]=EX(X[B+2]); X[B+3]=EX(X[B+3]); PIN(X); SBAR(); }while(0)
  #define VRD(i) do{ vlo[i]=vtr(vp_+(((i)>>2)*4096+((i)&3)*1024)); vhi[i]=vtr(vp_+(((i)>>2)*4096+((i)&3)*1024+512)); }while(0)
  #define KRD(G,j) do{ if(G){ kload2(kf,kp0+sl_next,j); SBAR(); } }while(0)
  #define STEP(C0,C1,P0,P1,t,GK,GV,GL) do{ SBAR(); \
    const lds_cptr vp_=vp0+sl_prev; \
    VRD(0); SBAR(); float sacc=(P0[0]+P0[1]); \
    GAPA(C0=__builtin_amdgcn_mfma_f32_32x32x16_bf16(kf[0],qr[0],negm,0,0,0), P0[2],P0[3],P0[4],P0[5],     pw0[0]=PKW(P0,0), pw0[1]=PKW(P0,2), pw0); \
    VRD(4); SBAR(); GAPA(C1=__builtin_amdgcn_mfma_f32_32x32x16_bf16(kf[1],qr[0],negm,0,0,0), P0[6],P0[7],P0[8],P0[9],     pw0[2]=PKW(P0,4), pw0[3]=PKW(P0,6), pw0); \
    VRD(1); SBAR(); GAPA(C0=__builtin_amdgcn_mfma_f32_32x32x16_bf16(kf[2],qr[1],C0,0,0,0),   P0[10],P0[11],P0[12],P0[13], pw1[0]=PKW(P0,8), pw1[1]=PKW(P0,10), pw1); \
    VRD(5); SBAR(); GAPA(C1=__builtin_amdgcn_mfma_f32_32x32x16_bf16(kf[3],qr[1],C1,0,0,0),   P0[14],P0[15],P1[0],P1[1],   pw1[2]=PKW(P0,12),pw1[3]=PKW(P0,14), pw1); \
    VRD(2); SBAR(); GAPA(C0=__builtin_amdgcn_mfma_f32_32x32x16_bf16(kf[4],qr[2],C0,0,0,0),   P1[2],P1[3],P1[4],P1[5],     pw2[0]=PKW(P1,0), pw2[1]=PKW(P1,2), pw2); \
    VRD(6); SBAR(); GAPA(C1=__builtin_amdgcn_mfma_f32_32x32x16_bf16(kf[5],qr[2],C1,0,0,0),   P1[6],P1[7],P1[8],P1[9],     pw2[2]=PKW(P1,4), pw2[3]=PKW(P1,6), pw2); \
    VRD(3); SBAR(); GAPA(C0=__builtin_amdgcn_mfma_f32_32x32x16_bf16(kf[6],qr[3],C0,0,0,0),   P1[10],P1[11],P1[12],P1[13], pw3[0]=PKW(P1,8), pw3[1]=PKW(P1,10), pw3); \
    VRD(7); SBAR(); GAPA(C1=__builtin_amdgcn_mfma_f32_32x32x16_bf16(kf[7],qr[3],C1,0,0,0),   P1[14],P1[15],0.f,0.f,       pw3[2]=PKW(P1,12),pw3[3]=PKW(P1,14), pw3); \
    l_reg+=sacc; \
    if(GK){DMA_K((t)+3,sl_cur);} if(GV){DMA_V((t)+1,sl_next);} \
    CMASK(C0,C1,t); \
    { float a=MX3(C0[0],C0[1],C1[0]),b=MX3(C0[2],C0[3],C1[1]); a=MX3(a,C1[2],C1[3]); \
      _Pragma("unroll") for(int r=4;r<16;r+=4){a=MX3(a,C0[r],C0[r+1]);b=MX3(b,C0[r+2],C0[r+3]);a=MX3(a,C1[r],C1[r+1]);b=MX3(b,C1[r+2],C1[r+3]);} \
      float rm=__builtin_fmaxf(a,b); { auto rr=__builtin_amdgcn_permlane32_swap(__float_as_uint(rm),__float_as_uint(rm),false,false); rm=__builtin_fmaxf(__uint_as_float(rr[0]),__uint_as_float(rr[1])); } \
      resc=false; \
      if(__builtin_expect(__any(rm>(float)THRL),0)){ const float dl=__builtin_fmaxf(rm,0.f); mhat+=dl; \
        _Pragma("unroll") for(int r=0;r<16;++r){C0[r]-=dl;C1[r]-=dl;} \
        _Pragma("unroll") for(int r=0;r<16;++r)negm[r]=-mhat; asm volatile("":"+v"(negm)); \
        const float f=__builtin_amdgcn_exp2f(-dl); l_reg*=f; if(hi==0)wsf[r32]=f; resc=true; } } \
    SBAR(); \
    GAPB(o[0]=__builtin_amdgcn_mfma_f32_32x32x16_bf16(PAF(0),VFR(0),o[0],0,0,0), C0,0); \
    GAPB(o[1]=__builtin_amdgcn_mfma_f32_32x32x16_bf16(PAF(0),VFR(4),o[1],0,0,0), C0,4); \
    KRD(GL,0); GAPB(o[0]=__builtin_amdgcn_mfma_f32_32x32x16_bf16(PAF(1),VFR(1),o[0],0,0,0), C0,8); \
    KRD(GL,1); GAPB(o[1]=__builtin_amdgcn_mfma_f32_32x32x16_bf16(PAF(1),VFR(5),o[1],0,0,0), C0,12); \
    KRD(GL,2); GAPB(o[0]=__builtin_amdgcn_mfma_f32_32x32x16_bf16(PAF(2),VFR(2),o[0],0,0,0), C1,0); \
    KRD(GL,3); GAPB(o[1]=__builtin_amdgcn_mfma_f32_32x32x16_bf16(PAF(2),VFR(6),o[1],0,0,0), C1,4); \
    GAPB(o[0]=__builtin_amdgcn_mfma_f32_32x32x16_bf16(PAF(3),VFR(3),o[0],0,0,0), C1,8); \
    GAPB(o[1]=__builtin_amdgcn_mfma_f32_32x32x16_bf16(PAF(3),VFR(7),o[1],0,0,0), C1,12); \
    }while(0)
  int t=1;
  #undef CMASK
  #define CMASK(P0,P1,t) do{}while(0)
  for(;t+5<NT;t+=2){
    STEP(pB0,pB1,pA0,pA1,t,true,true,true);     WAIT_BAR(2); RESC(); ROT();
    STEP(pA0,pA1,pB0,pB1,t+1,true,true,true);   WAIT_BAR(2); RESC(); ROT();
  }
  #undef CMASK
  #define CMASK(P0,P1,t) do{}while(0)
  #define ENDW(tt) do{ if((tt)+3<NT){WAIT_BAR(2);} else if((tt)+2<NT){WAIT_BAR(1);} else {WAIT_BAR(0);} }while(0)
  for(;t+1<NT;t+=2){
    STEP(pB0,pB1,pA0,pA1,t,(t+3<NT),(t+1<NT),(t+1<NT));       ENDW(t);   RESC(); ROT();
    STEP(pA0,pA1,pB0,pB1,t+1,(t+4<NT),(t+2<NT),(t+2<NT));     ENDW(t+1); RESC(); ROT();
  }
  STEP(pB0,pB1,pA0,pA1,NT-1,false,false,false); RESC();
  { float sacc=pB0[0]+pB0[1]; _Pragma("unroll") for(int r=2;r<16;++r)sacc+=pB0[r]; _Pragma("unroll") for(int r=0;r<16;++r)sacc+=pB1[r]; l_reg+=sacc;
    pw0=(u32x4){PKW(pB0,0),PKW(pB0,2),PKW(pB0,4),PKW(pB0,6)};pw1=(u32x4){PKW(pB0,8),PKW(pB0,10),PKW(pB0,12),PKW(pB0,14)};pw2=(u32x4){PKW(pB1,0),PKW(pB1,2),PKW(pB1,4),PKW(pB1,6)};pw3=(u32x4){PKW(pB1,8),PKW(pB1,10),PKW(pB1,12),PKW(pB1,14)};
    SBAR(); pv(o,vb0+sl_cur,PAF(0),PAF(1),PAF(2),PAF(3)); }
  #undef PKW
  #undef PAF
  #undef VFR
  #undef PIN
  #undef MX3
  #undef GAPA
  #undef GAPB
  #undef EX
  #undef VRD
  #undef KRD
  #undef STEP
  #undef ENDW
  {auto rr=__builtin_amdgcn_permlane32_swap(__float_as_uint(l_reg),__float_as_uint(l_reg),false,false);l_reg=__uint_as_float(rr[0])+__uint_as_float(rr[1]);}
  if(hi==0)wsf[32+r32]=l_reg;asm volatile("s_waitcnt lgkmcnt(0)":::"memory");
  float rli[16];
  #pragma unroll
  for(int r=0;r<16;++r)rli[r]=__builtin_amdgcn_rcpf(wsf[32+crow(r,hi)]);
  bf16*Ow=O+(rowbase+q0+wid*QBLK)*DM+h*D;
  { bf16*stg=(bf16*)(shm+LDS_OST)+wid*2048;
    #pragma unroll
    for(int r=0;r<16;++r){const int orow=crow(r,hi);
      #pragma unroll
      for(int d0=0;d0<2;++d0)stg[orow*64+d0*32+r32]=__float2bfloat16(o[d0][r]*rli[r]);}
    asm volatile("s_waitcnt lgkmcnt(0)":::"memory");
    #pragma unroll
    for(int i=0;i<4;++i){const int row=i*8+(lane>>3),ch=lane&7; const u32x4 v=*(const u32x4*)(stg+row*64+ch*8); ATTN_STORE16(Ow+(long)row*DM+ch*8,v);} }
  asm volatile("s_waitcnt lgkmcnt(0)\n\ts_barrier":::"memory");
  #undef DMA_K
  #undef DMA_V
  #undef CMASK
  #undef START
  #undef RESC
  #undef ROT
}

constexpr int V_SLOTB=16384;
constexpr int L2_K=0, L2_V=NSLOT*SLOTB, L2_WS=L2_V+NSLOT*V_SLOTB, L2_OST=L2_WS+NW*64*4, L2_BYTES=L2_OST+NW*4096;
__device__ __forceinline__ void pv128(f32x16*o,int vb,bf16x8 pa0,bf16x8 pa1,bf16x8 pa2,bf16x8 pa3){
  #pragma unroll
  for(int d0=0;d0<4;++d0){s16x4 lo[4],hi[4];
    #pragma unroll
    for(int ks=0;ks<4;++ks){
      asm volatile("ds_read_b64_tr_b16 %0,%1 offset:%c2":"=&v"(lo[ks]):"v"(vb),"i"(d0*4096+ks*1024):"memory");
      asm volatile("ds_read_b64_tr_b16 %0,%1 offset:%c2":"=&v"(hi[ks]):"v"(vb),"i"(d0*4096+ks*1024+512):"memory");}
    asm volatile("s_waitcnt lgkmcnt(0)":::"memory");SBAR();
    #define PK(k) (bf16x8){lo[k][0],lo[k][1],lo[k][2],lo[k][3],hi[k][0],hi[k][1],hi[k][2],hi[k][3]}
    o[d0]=__builtin_amdgcn_mfma_f32_32x32x16_bf16(pa0,PK(0),o[d0],0,0,0);
    o[d0]=__builtin_amdgcn_mfma_f32_32x32x16_bf16(pa1,PK(1),o[d0],0,0,0);
    o[d0]=__builtin_amdgcn_mfma_f32_32x32x16_bf16(pa2,PK(2),o[d0],0,0,0);
    o[d0]=__builtin_amdgcn_mfma_f32_32x32x16_bf16(pa3,PK(3),o[d0],0,0,0);
    #undef PK
  }
}
#ifndef A128_NOPIN
#define SB128() SBAR()
#else
#define SB128() do{}while(0)
#endif
#if defined(PROBE_MFMA)
  #define PROBE_HOOK(C0,C1) do{ const bf16x8 zf_=bf16x8{}; _Pragma("unroll") for(int q_=0;q_<8;++q_) o[q_&3]=__builtin_amdgcn_mfma_f32_32x32x16_bf16(__builtin_bit_cast(bf16x8,pw0),zf_,o[q_&3],0,0,0); }while(0)
#elif defined(PROBE_EXP)
  #define PROBE_HOOK(C0,C1) do{ _Pragma("unroll") for(int q_=0;q_<16;++q_){ float j0_=__builtin_amdgcn_exp2f(C0[q_]), j1_=__builtin_amdgcn_exp2f(C1[q_]); asm volatile(""::"v"(j0_),"v"(j1_)); } }while(0)
#elif defined(PROBE_LDS)
  #define PROBE_HOOK(C0,C1) do{ bf16x8 jk_[8]; kload8(jk_,kp0+sl_cur); _Pragma("unroll") for(int q_=0;q_<8;++q_) asm volatile(""::"v"(jk_[q_])); }while(0)
#else
  #define PROBE_HOOK(C0,C1) do{}while(0)
#endif
__device__ __forceinline__ void attn128_unit(int b,int qb,const bf16*Q,const bf16*__restrict__ K,const bf16*__restrict__ V,bf16*O,char*shm){
  const int tid=threadIdx.x,lane=tid&63,r32=lane&31,hi=lane>>5; const int wid=__builtin_amdgcn_readfirstlane(tid>>6);
  const long rowbase=(long)b*SEQ; const int q0=qb*QB;
  const bf16*Qw=Q+(rowbase+q0+wid*QBLK)*DM;
  const bf16*Kh=K+rowbase*DM,*Vh=V+rowbase*DM;
  const unsigned lds0=(unsigned)(uintptr_t)shm;
  float*wsf=(float*)(shm+L2_WS)+wid*64;
  const bf16*ksrc=Kh+(long)lane*DM+wid*8;
  const bf16*vsrc=Vh+(long)(16*(wid&3)+(lane>>2))*DM+(wid>>2)*32+(lane&3)*8;
  const unsigned kdst=lds0+L2_K+wid*1024, vdst=lds0+L2_V+wid*1024;
  #define DMA_K(t,slot) glds16(ksrc+(long)(t)*KVBLK*DM,(unsigned)__builtin_amdgcn_readfirstlane(kdst+(slot)))
  #define DMA_V(t,slot) do{ glds16(vsrc+(long)(t)*KVBLK*DM,(unsigned)__builtin_amdgcn_readfirstlane(vdst+2*(slot))); glds16(vsrc+(long)(t)*KVBLK*DM+64,(unsigned)__builtin_amdgcn_readfirstlane(vdst+2*(slot)+8192)); }while(0)
  const int vb0=(int)(lds0+L2_V)+((lane>>4)&1)*32+(lane&3)*8+(4*hi+((lane&15)>>2))*64;
  const char*Kbase=shm+L2_K; bf16x8 kf[8];
  const lds_cptr shm3=(lds_cptr)shm; const lds_cptr kp0=shm3+L2_K+hi*1024+r32*16; const lds_cptr vp0=shm3+L2_V+((lane>>4)&1)*32+(lane&3)*8+(4*hi+((lane&15)>>2))*64;
  const int NT=SEQ/KVBLK;
  DMA_K(0,0);DMA_V(0,0);DMA_K(1,SLOTB);
  bf16x8 qr[4];
  #pragma unroll
  for(int d0=0;d0<4;++d0)qr[d0]=*reinterpret_cast<const bf16x8*>(&Qw[(long)r32*DM+d0*16+hi*8]);
  float l_reg=0.f;f32x16 o[4];o[0]=f32x16{};o[1]=f32x16{};o[2]=f32x16{};o[3]=f32x16{};
  const f32x16 zero=f32x16{};
  f32x16 pA0,pA1,pB0,pB1;
  int sl_prev=0,sl_cur=0,sl_next=SLOTB;
  #define ROT() do{sl_prev=sl_cur;sl_cur=sl_next;sl_next=(sl_next==(NSLOT-1)*SLOTB)?0:sl_next+SLOTB;}while(0)
  DMA_K(2,2*SLOTB);
  WAIT_BAR(4);
  qkt(pA0,pA1,Kbase,qr,zero,r32,hi);
  _Pragma("unroll") for(int r=0;r<16;++r){pA0[r]=__builtin_amdgcn_exp2f(pA0[r]);pA1[r]=__builtin_amdgcn_exp2f(pA1[r]);}
  WAIT_BAR(0);
  DMA_K(3,0);DMA_V(1,SLOTB);
  ROT();
  kload8(kf,kp0+sl_cur);
  WAIT_BAR(3);
  s16x4 vlo[8],vhi[8],wlo[8],whi[8]; u32x4 pw0,pw1,pw2,pw3;
  #define PKW(P,B) cvtpk_s(P[B],P[B+1])
  #define PAF(k) __builtin_bit_cast(bf16x8,pw##k)
  #define VFR(i) (bf16x8){vlo[i][0],vlo[i][1],vlo[i][2],vlo[i][3],vhi[i][0],vhi[i][1],vhi[i][2],vhi[i][3]}
  #define WFR(i) (bf16x8){wlo[i][0],wlo[i][1],wlo[i][2],wlo[i][3],whi[i][0],whi[i][1],whi[i][2],whi[i][3]}
  #define PIN(x) asm volatile("":"+v"(x))
  #define GAPA(MF,A0,A1,A2,A3,W0,W1,PW) do{ MF; sacc+=A0; sacc+=A1; sacc+=A2; sacc+=A3; PIN(sacc); W0; W1; PIN(PW); SB128(); }while(0)
  #define EX(v) __builtin_amdgcn_exp2f(v)
  #define GAPB2(MF,X,B) do{ MF; X[B]=EX(X[B]); X[B+1]=EX(X[B+1]); PIN(X); SB128(); }while(0)
  #define VRD(i) do{ vlo[i]=vtr(vp_+(((i)>>2)*4096+((i)&3)*1024)); vhi[i]=vtr(vp_+(((i)>>2)*4096+((i)&3)*1024+512)); }while(0)
  #define WRD(i) do{ wlo[i]=vtr(vp_+(8192+((i)>>2)*4096+((i)&3)*1024)); whi[i]=vtr(vp_+(8192+((i)>>2)*4096+((i)&3)*1024+512)); }while(0)
  #define KRD(G,j) do{ if(G){ kload2(kf,kp0+sl_next,j); SB128(); } }while(0)
  #define STEP(C0,C1,P0,P1,t,GK,GV,GL) do{ SB128(); \
    const lds_cptr vp_=vp0+2*sl_prev; \
    VRD(0); SB128(); float sacc=(P0[0]+P0[1]); \
    GAPA(C0=__builtin_amdgcn_mfma_f32_32x32x16_bf16(kf[0],qr[0],zero,0,0,0), P0[2],P0[3],P0[4],P0[5],     pw0[0]=PKW(P0,0), pw0[1]=PKW(P0,2), pw0); \
    VRD(4); SB128(); GAPA(C1=__builtin_amdgcn_mfma_f32_32x32x16_bf16(kf[1],qr[0],zero,0,0,0), P0[6],P0[7],P0[8],P0[9],     pw0[2]=PKW(P0,4), pw0[3]=PKW(P0,6), pw0); \
    VRD(1); SB128(); GAPA(C0=__builtin_amdgcn_mfma_f32_32x32x16_bf16(kf[2],qr[1],C0,0,0,0),   P0[10],P0[11],P0[12],P0[13], pw1[0]=PKW(P0,8), pw1[1]=PKW(P0,10), pw1); \
    VRD(5); SB128(); GAPA(C1=__builtin_amdgcn_mfma_f32_32x32x16_bf16(kf[3],qr[1],C1,0,0,0),   P0[14],P0[15],P1[0],P1[1],   pw1[2]=PKW(P0,12),pw1[3]=PKW(P0,14), pw1); \
    VRD(2); SB128(); GAPA(C0=__builtin_amdgcn_mfma_f32_32x32x16_bf16(kf[4],qr[2],C0,0,0,0),   P1[2],P1[3],P1[4],P1[5],     pw2[0]=PKW(P1,0), pw2[1]=PKW(P1,2), pw2); \
    VRD(6); SB128(); GAPA(C1=__builtin_amdgcn_mfma_f32_32x32x16_bf16(kf[5],qr[2],C1,0,0,0),   P1[6],P1[7],P1[8],P1[9],     pw2[2]=PKW(P1,4), pw2[3]=PKW(P1,6), pw2); \
    VRD(3); SB128(); GAPA(C0=__builtin_amdgcn_mfma_f32_32x32x16_bf16(kf[6],qr[3],C0,0,0,0),   P1[10],P1[11],P1[12],P1[13], pw3[0]=PKW(P1,8), pw3[1]=PKW(P1,10), pw3); \
    VRD(7); SB128(); GAPA(C1=__builtin_amdgcn_mfma_f32_32x32x16_bf16(kf[7],qr[3],C1,0,0,0),   P1[14],P1[15],0.f,0.f,       pw3[2]=PKW(P1,12),pw3[3]=PKW(P1,14), pw3); \
    l_reg+=sacc; \
    if(GK){DMA_K((t)+3,sl_cur);} if(GV){DMA_V((t)+1,sl_next);} \
    SB128(); \
    PROBE_HOOK(C0,C1); \
    WRD(0); GAPB2(o[0]=__builtin_amdgcn_mfma_f32_32x32x16_bf16(PAF(0),VFR(0),o[0],0,0,0), C0,0); \
    WRD(4); GAPB2(o[1]=__builtin_amdgcn_mfma_f32_32x32x16_bf16(PAF(0),VFR(4),o[1],0,0,0), C0,2); \
    WRD(1); KRD(GL,0); GAPB2(o[0]=__builtin_amdgcn_mfma_f32_32x32x16_bf16(PAF(1),VFR(1),o[0],0,0,0), C0,4); \
    WRD(5); KRD(GL,1); GAPB2(o[1]=__builtin_amdgcn_mfma_f32_32x32x16_bf16(PAF(1),VFR(5),o[1],0,0,0), C0,6); \
    WRD(2); KRD(GL,2); GAPB2(o[0]=__builtin_amdgcn_mfma_f32_32x32x16_bf16(PAF(2),VFR(2),o[0],0,0,0), C0,8); \
    WRD(6); KRD(GL,3); GAPB2(o[1]=__builtin_amdgcn_mfma_f32_32x32x16_bf16(PAF(2),VFR(6),o[1],0,0,0), C0,10); \
    WRD(3); GAPB2(o[0]=__builtin_amdgcn_mfma_f32_32x32x16_bf16(PAF(3),VFR(3),o[0],0,0,0), C0,12); \
    WRD(7); GAPB2(o[1]=__builtin_amdgcn_mfma_f32_32x32x16_bf16(PAF(3),VFR(7),o[1],0,0,0), C0,14); \
    GAPB2(o[2]=__builtin_amdgcn_mfma_f32_32x32x16_bf16(PAF(0),WFR(0),o[2],0,0,0), C1,0); \
    GAPB2(o[3]=__builtin_amdgcn_mfma_f32_32x32x16_bf16(PAF(0),WFR(4),o[3],0,0,0), C1,2); \
    GAPB2(o[2]=__builtin_amdgcn_mfma_f32_32x32x16_bf16(PAF(1),WFR(1),o[2],0,0,0), C1,4); \
    GAPB2(o[3]=__builtin_amdgcn_mfma_f32_32x32x16_bf16(PAF(1),WFR(5),o[3],0,0,0), C1,6); \
    GAPB2(o[2]=__builtin_amdgcn_mfma_f32_32x32x16_bf16(PAF(2),WFR(2),o[2],0,0,0), C1,8); \
    GAPB2(o[3]=__builtin_amdgcn_mfma_f32_32x32x16_bf16(PAF(2),WFR(6),o[3],0,0,0), C1,10); \
    GAPB2(o[2]=__builtin_amdgcn_mfma_f32_32x32x16_bf16(PAF(3),WFR(3),o[2],0,0,0), C1,12); \
    GAPB2(o[3]=__builtin_amdgcn_mfma_f32_32x32x16_bf16(PAF(3),WFR(7),o[3],0,0,0), C1,14); \
    }while(0)
  int t=1;
  for(;t+5<NT;t+=2){
    STEP(pB0,pB1,pA0,pA1,t,true,true,true);     WAIT_BAR(3); ROT();
    STEP(pA0,pA1,pB0,pB1,t+1,true,true,true);   WAIT_BAR(3); ROT();
  }
  #define ENDW(tt) do{ if((tt)+3<NT){WAIT_BAR(3);} else if((tt)+2<NT){WAIT_BAR(2);} else {WAIT_BAR(0);} }while(0)
  for(;t+1<NT;t+=2){
    STEP(pB0,pB1,pA0,pA1,t,(t+3<NT),(t+1<NT),(t+1<NT));       ENDW(t);   ROT();
    STEP(pA0,pA1,pB0,pB1,t+1,(t+4<NT),(t+2<NT),(t+2<NT));     ENDW(t+1); ROT();
  }
  STEP(pB0,pB1,pA0,pA1,NT-1,false,false,false);
  { float sacc=pB0[0]+pB0[1]; _Pragma("unroll") for(int r=2;r<16;++r)sacc+=pB0[r]; _Pragma("unroll") for(int r=0;r<16;++r)sacc+=pB1[r]; l_reg+=sacc;
    pw0=(u32x4){PKW(pB0,0),PKW(pB0,2),PKW(pB0,4),PKW(pB0,6)};pw1=(u32x4){PKW(pB0,8),PKW(pB0,10),PKW(pB0,12),PKW(pB0,14)};pw2=(u32x4){PKW(pB1,0),PKW(pB1,2),PKW(pB1,4),PKW(pB1,6)};pw3=(u32x4){PKW(pB1,8),PKW(pB1,10),PKW(pB1,12),PKW(pB1,14)};
    SB128(); pv128(o,vb0+2*sl_cur,PAF(0),PAF(1),PAF(2),PAF(3)); }
  #undef PKW
  #undef PAF
  #undef VFR
  #undef WFR
  #undef PIN
  #undef GAPA
  #undef GAPB2
  #undef EX
  #undef VRD
  #undef WRD
  #undef KRD
  #undef STEP
  #undef ENDW
  {auto rr=__builtin_amdgcn_permlane32_swap(__float_as_uint(l_reg),__float_as_uint(l_reg),false,false);l_reg=__uint_as_float(rr[0])+__uint_as_float(rr[1]);}
  if(hi==0)wsf[32+r32]=l_reg;asm volatile("s_waitcnt lgkmcnt(0)":::"memory");
  float rli[16];
  #pragma unroll
  for(int r=0;r<16;++r)rli[r]=__builtin_amdgcn_rcpf(wsf[32+crow(r,hi)]);
  bf16*Ow=O+(rowbase+q0+wid*QBLK)*DM;
  { bf16*stg=(bf16*)(shm+L2_OST)+wid*2048;
    #pragma unroll
    for(int hh=0;hh<2;++hh){
      #pragma unroll
      for(int r=0;r<16;++r){const int orow=crow(r,hi);
        #pragma unroll
        for(int d0=0;d0<2;++d0)stg[orow*64+d0*32+r32]=__float2bfloat16(o[2*hh+d0][r]*rli[r]);}
      asm volatile("s_waitcnt lgkmcnt(0)":::"memory");
      #pragma unroll
      for(int i=0;i<4;++i){const int row=i*8+(lane>>3),ch=lane&7; const u32x4 v=*(const u32x4*)(stg+row*64+ch*8); ATTN_STORE16(Ow+(long)row*DM+hh*64+ch*8,v);}
      asm volatile("s_waitcnt lgkmcnt(0)":::"memory");
    } }
  asm volatile("s_waitcnt lgkmcnt(0)\n\ts_barrier":::"memory");
  #undef DMA_K
  #undef DMA_V
  #undef ROT
}
struct Diff128Order {
  int vcu,G,blk;
  __device__ __forceinline__ explicit Diff128Order(int grid,int block):vcu((block%8)*(grid/8)+block/8),G(grid),blk(block){}
  __device__ __forceinline__ bool next(int i,int&pair,int&qb)const{
    if(G==256){ if(i>=8)return false; pair=(vcu>>5)*16+2*i+((vcu>>4)&1); qb=vcu&15; return true; }
    const int L=i*G+blk; if(L>=2048)return false; pair=L>>4; qb=L&15; return true; }
};
__device__ __forceinline__ void diff128_phase(char*lds,const bf16*QB,const bf16*KB,const bf16*VB,bf16*O1,bf16*O2,const Diff128Order&S){
  int pair,qb;
  for(int i=0;S.next(i,pair,qb);++i){ const int m=pair&1,h=(pair>>1)&7,b=pair>>4;
    attn128_unit(b,qb,QB+h*128+m*64,KB+h*128+m*64,VB+h*128,(m?O2:O1)+h*128,lds); }
}

__device__ __forceinline__ void dil_unit(int b,int head,int dsh,int r,int chunk,const bf16*QA,const bf16*__restrict__ KA,const bf16*__restrict__ VA,bf16*OG,float*LS,char*shm){
  constexpr int PA=768;
  const int tid=threadIdx.x,lane=tid&63,r32=lane&31,hi=lane>>5; const int wid=__builtin_amdgcn_readfirstlane(tid>>6);
  const int L=SEQ>>dsh, j0=chunk<<8, jb=j0-64;
  const long tok0=(long)b*SEQ+r;
  const unsigned lds0=(unsigned)(uintptr_t)shm;
  float*wsf=(float*)(shm+LDS_WS)+wid*64;
  const bf16*Kc=KA+head*64+wid*8; const bf16*Vc=VA+head*64+(wid>>2)*32+(lane&3)*8;
  const int vrow=16*(wid&3)+(lane>>2);
  const unsigned kdst=lds0+LDS_K+wid*1024, vdst=lds0+LDS_V+wid*1024;
  #define CLAMPJ(x) ((x)<0?0:((x)>L-1?L-1:(x)))
  #define DMA_K(t,slot) do{ const int jj_=CLAMPJ(jb+64*(t)+lane); glds16(Kc+(tok0+((long)jj_<<dsh))*PA,(unsigned)__builtin_amdgcn_readfirstlane(kdst+(slot))); }while(0)
  #define DMA_V(t,slot) do{ const int jj_=CLAMPJ(jb+64*(t)+vrow); glds16(Vc+(tok0+((long)jj_<<dsh))*PA,(unsigned)__builtin_amdgcn_readfirstlane(vdst+(slot))); }while(0)
  const int vb0=(int)(lds0+LDS_V)+((lane>>4)&1)*32+(lane&3)*8+(4*hi+((lane&15)>>2))*64;
  const char*Kbase=shm+LDS_K; bf16x8 kf[8];
  const lds_cptr shm3=(lds_cptr)shm; const lds_cptr kp0=shm3+LDS_K+hi*1024+r32*16; const lds_cptr vp0=shm3+LDS_V+((lane>>4)&1)*32+(lane&3)*8+(4*hi+((lane&15)>>2))*64;
  constexpr int NT=6;
  DMA_K(0,0);DMA_V(0,0);DMA_K(1,SLOTB);
  const int jq=j0+wid*QBLK+r32;
  const bf16*Qw=QA+(tok0+((long)jq<<dsh))*PA+head*64;
  bf16x8 qr[4];
  #pragma unroll
  for(int d0=0;d0<4;++d0)qr[d0]=*reinterpret_cast<const bf16x8*>(&Qw[d0*16+hi*8]);
  float l_reg=0.f;f32x16 o[2];o[0]=f32x16{};o[1]=f32x16{};
  const f32x16 zero=f32x16{};
  #define DMASK(P0,P1,t) do{ const int kb_=jb+64*(t)+4*hi; \
    _Pragma("unroll") for(int r_=0;r_<16;++r_){ const int k0_=kb_+(r_&3)+8*(r_>>2), k1_=k0_+32; \
      const bool v0_=(k0_>=jq-64)&&(k0_<=jq+64)&&(k0_>=0)&&(k0_<L), v1_=(k1_>=jq-64)&&(k1_<=jq+64)&&(k1_>=0)&&(k1_<L); \
      P0[r_]=v0_?P0[r_]:-INFINITY; P1[r_]=v1_?P1[r_]:-INFINITY; } }while(0)
  f32x16 pA0,pA1,pB0,pB1;
  int sl_prev=0,sl_cur=0,sl_next=SLOTB;
  #define ROT() do{sl_prev=sl_cur;sl_cur=sl_next;sl_next=(sl_next==(NSLOT-1)*SLOTB)?0:sl_next+SLOTB;}while(0)
  DMA_K(2,2*SLOTB);
  WAIT_BAR(3);
  qkt(pA0,pA1,Kbase,qr,zero,r32,hi);
  DMASK(pA0,pA1,0);
  _Pragma("unroll") for(int r=0;r<16;++r){pA0[r]=__builtin_amdgcn_exp2f(pA0[r]);pA1[r]=__builtin_amdgcn_exp2f(pA1[r]);}
  WAIT_BAR(0);
  DMA_K(3,0);DMA_V(1,SLOTB);
  ROT();
  kload8(kf,kp0+sl_cur);
  WAIT_BAR(2);
  s16x4 vlo[8],vhi[8]; u32x4 pw0,pw1,pw2,pw3;
  #define PKW(P,B) cvtpk_s(P[B],P[B+1])
  #define PAF(k) __builtin_bit_cast(bf16x8,pw##k)
  #define VFR(i) (bf16x8){vlo[i][0],vlo[i][1],vlo[i][2],vlo[i][3],vhi[i][0],vhi[i][1],vhi[i][2],vhi[i][3]}
  #define PIN(x) asm volatile("":"+v"(x))
  #define GAPA(MF,A0,A1,A2,A3,W0,W1,PW) do{ MF; sacc+=A0; sacc+=A1; sacc+=A2; sacc+=A3; PIN(sacc); W0; W1; PIN(PW); SBAR(); }while(0)
  #define EX(v) __builtin_amdgcn_exp2f(v)
  #define GAPB(MF,X,B) do{ MF; X[B]=EX(X[B]); X[B+1]=EX(X[B+1]); X[B+2]=EX(X[B+2]); X[B+3]=EX(X[B+3]); PIN(X); SBAR(); }while(0)
  #define VRD(i) do{ vlo[i]=vtr(vp_+(((i)>>2)*4096+((i)&3)*1024)); vhi[i]=vtr(vp_+(((i)>>2)*4096+((i)&3)*1024+512)); }while(0)
  #define KRD(G,j) do{ if(G){ kload2(kf,kp0+sl_next,j); SBAR(); } }while(0)
  #define STEP(C0,C1,P0,P1,t,GK,GV,GL) do{ SBAR(); \
    const lds_cptr vp_=vp0+sl_prev; \
    VRD(0); SBAR(); float sacc=(P0[0]+P0[1]); \
    GAPA(C0=__builtin_amdgcn_mfma_f32_32x32x16_bf16(kf[0],qr[0],zero,0,0,0), P0[2],P0[3],P0[4],P0[5],     pw0[0]=PKW(P0,0), pw0[1]=PKW(P0,2), pw0); \
    VRD(4); SBAR(); GAPA(C1=__builtin_amdgcn_mfma_f32_32x32x16_bf16(kf[1],qr[0],zero,0,0,0), P0[6],P0[7],P0[8],P0[9],     pw0[2]=PKW(P0,4), pw0[3]=PKW(P0,6), pw0); \
    VRD(1); SBAR(); GAPA(C0=__builtin_amdgcn_mfma_f32_32x32x16_bf16(kf[2],qr[1],C0,0,0,0),   P0[10],P0[11],P0[12],P0[13], pw1[0]=PKW(P0,8), pw1[1]=PKW(P0,10), pw1); \
    VRD(5); SBAR(); GAPA(C1=__builtin_amdgcn_mfma_f32_32x32x16_bf16(kf[3],qr[1],C1,0,0,0),   P0[14],P0[15],P1[0],P1[1],   pw1[2]=PKW(P0,12),pw1[3]=PKW(P0,14), pw1); \
    VRD(2); SBAR(); GAPA(C0=__builtin_amdgcn_mfma_f32_32x32x16_bf16(kf[4],qr[2],C0,0,0,0),   P1[2],P1[3],P1[4],P1[5],     pw2[0]=PKW(P1,0), pw2[1]=PKW(P1,2), pw2); \
    VRD(6); SBAR(); GAPA(C1=__builtin_amdgcn_mfma_f32_32x32x16_bf16(kf[5],qr[2],C1,0,0,0),   P1[6],P1[7],P1[8],P1[9],     pw2[2]=PKW(P1,4), pw2[3]=PKW(P1,6), pw2); \
    VRD(3); SBAR(); GAPA(C0=__builtin_amdgcn_mfma_f32_32x32x16_bf16(kf[6],qr[3],C0,0,0,0),   P1[10],P1[11],P1[12],P1[13], pw3[0]=PKW(P1,8), pw3[1]=PKW(P1,10), pw3); \
    VRD(7); SBAR(); GAPA(C1=__builtin_amdgcn_mfma_f32_32x32x16_bf16(kf[7],qr[3],C1,0,0,0),   P1[14],P1[15],0.f,0.f,       pw3[2]=PKW(P1,12),pw3[3]=PKW(P1,14), pw3); \
    l_reg+=sacc; \
    if(GK){DMA_K((t)+3,sl_cur);} if(GV){DMA_V((t)+1,sl_next);} \
    DMASK(C0,C1,t); \
    SBAR(); \
    GAPB(o[0]=__builtin_amdgcn_mfma_f32_32x32x16_bf16(PAF(0),VFR(0),o[0],0,0,0), C0,0); \
    GAPB(o[1]=__builtin_amdgcn_mfma_f32_32x32x16_bf16(PAF(0),VFR(4),o[1],0,0,0), C0,4); \
    KRD(GL,0); GAPB(o[0]=__builtin_amdgcn_mfma_f32_32x32x16_bf16(PAF(1),VFR(1),o[0],0,0,0), C0,8); \
    KRD(GL,1); GAPB(o[1]=__builtin_amdgcn_mfma_f32_32x32x16_bf16(PAF(1),VFR(5),o[1],0,0,0), C0,12); \
    KRD(GL,2); GAPB(o[0]=__builtin_amdgcn_mfma_f32_32x32x16_bf16(PAF(2),VFR(2),o[0],0,0,0), C1,0); \
    KRD(GL,3); GAPB(o[1]=__builtin_amdgcn_mfma_f32_32x32x16_bf16(PAF(2),VFR(6),o[1],0,0,0), C1,4); \
    GAPB(o[0]=__builtin_amdgcn_mfma_f32_32x32x16_bf16(PAF(3),VFR(3),o[0],0,0,0), C1,8); \
    GAPB(o[1]=__builtin_amdgcn_mfma_f32_32x32x16_bf16(PAF(3),VFR(7),o[1],0,0,0), C1,12); \
    }while(0)
  #define ENDW(tt) do{ if((tt)+3<NT){WAIT_BAR(2);} else if((tt)+2<NT){WAIT_BAR(1);} else {WAIT_BAR(0);} }while(0)
  STEP(pB0,pB1,pA0,pA1,1,true,true,true);    ENDW(1); ROT();
  STEP(pA0,pA1,pB0,pB1,2,true,true,true);    ENDW(2); ROT();
  STEP(pB0,pB1,pA0,pA1,3,false,true,true);   ENDW(3); ROT();
  STEP(pA0,pA1,pB0,pB1,4,false,true,true);   ENDW(4); ROT();
  STEP(pB0,pB1,pA0,pA1,5,false,false,false);
  { float sacc=pB0[0]+pB0[1]; _Pragma("unroll") for(int r=2;r<16;++r)sacc+=pB0[r]; _Pragma("unroll") for(int r=0;r<16;++r)sacc+=pB1[r]; l_reg+=sacc;
    pw0=(u32x4){PKW(pB0,0),PKW(pB0,2),PKW(pB0,4),PKW(pB0,6)};pw1=(u32x4){PKW(pB0,8),PKW(pB0,10),PKW(pB0,12),PKW(pB0,14)};pw2=(u32x4){PKW(pB1,0),PKW(pB1,2),PKW(pB1,4),PKW(pB1,6)};pw3=(u32x4){PKW(pB1,8),PKW(pB1,10),PKW(pB1,12),PKW(pB1,14)};
    SBAR(); pv(o,vb0+sl_cur,PAF(0),PAF(1),PAF(2),PAF(3)); }
  #undef PKW
  #undef PAF
  #undef VFR
  #undef PIN
  #undef GAPA
  #undef GAPB
  #undef EX
  #undef VRD
  #undef KRD
  #undef STEP
  #undef ENDW
  #undef DMASK
  {auto rr=__builtin_amdgcn_permlane32_swap(__float_as_uint(l_reg),__float_as_uint(l_reg),false,false);l_reg=__uint_as_float(rr[0])+__uint_as_float(rr[1]);}
  if(hi==0)wsf[32+r32]=l_reg;asm volatile("s_waitcnt lgkmcnt(0)":::"memory");
  float rli[16];
  #pragma unroll
  for(int r=0;r<16;++r)rli[r]=__builtin_amdgcn_rcpf(wsf[32+crow(r,hi)]);
  const int gidx=dsh>>1, hslot=head&3;
  { bf16*stg=(bf16*)(shm+LDS_OST)+wid*2048;
    #pragma unroll
    for(int r=0;r<16;++r){const int orow=crow(r,hi);
      #pragma unroll
      for(int d0=0;d0<2;++d0)stg[orow*64+d0*32+r32]=__float2bfloat16(o[d0][r]*rli[r]);}
    asm volatile("s_waitcnt lgkmcnt(0)":::"memory");
    #pragma unroll
    for(int i=0;i<4;++i){const int row=i*8+(lane>>3),ch=lane&7; const u32x4 v=*(const u32x4*)(stg+row*64+ch*8);
      const long tk=tok0+((long)(j0+wid*QBLK+row)<<dsh); ATTN_STORE16(OG+((long)gidx*(BATCH*SEQ)+tk)*256+hslot*64+ch*8,v);} }
  if(hi==0){ const long tk=tok0+((long)jq<<dsh); LS[((long)gidx*(BATCH*SEQ)+tk)*4+hslot]=__builtin_amdgcn_logf(l_reg); }
  asm volatile("s_waitcnt lgkmcnt(0)\n\ts_barrier":::"memory");
  #undef DMA_K
  #undef DMA_V
  #undef CLAMPJ
  #undef ROT
}
__device__ __forceinline__ void dil_phase(char*lds,const bf16*QA,const bf16*KA,const bf16*VA,bf16*OG,float*LS,int vcu,int G){
  for(int u=vcu;u<1536;u+=G){ const int rc=u&15,bh=u>>4,head=bh%12,b=bh/12,g=head>>2; const int dsh=2*g,L=SEQ>>dsh,nchunk=L>>8; const int r=rc/nchunk,chunk=rc%nchunk;
    dil_unit(b,head,dsh,r,chunk,QA,KA,VA,OG,LS,lds); }
}
constexpr float VT8_SCALE=8.0f;
typedef int v8i32a __attribute__((ext_vector_type(8)));
typedef int v4i32a __attribute__((ext_vector_type(4)));
typedef short v2i16a __attribute__((ext_vector_type(2)));
#if defined(PROBE_DMA)
  #define PROBE_DMA_HOOK(t) do{ glds16(ksrc+(long)(t)*KVBLK*DM,(unsigned)__builtin_amdgcn_readfirstlane(lds0+118784+wid*1024)); }while(0)
#else
  #define PROBE_DMA_HOOK(t) do{}while(0)
#endif
#ifndef DMA_POS
#define DMA_POS 1
#endif
#define DMA_AT(pos,GK,GV,t) do{ if((pos)==DMA_POS){ if(GK){DMA_K((t)+3,sl_cur);} if(GV){DMA_V((t)+1,sl_next);} } else if(DMA_POS==3&&(pos)==1){ if(GK){DMA_K((t)+3,sl_cur);} } }while(0)
#ifndef STAMP_TID
#define STAMP_TID 0
#endif
#if defined(PROBE_STAMP)
  #define STAMP(k) do{ __builtin_amdgcn_sched_barrier(0); unsigned long long t_; asm volatile("s_memtime %0\n\ts_waitcnt lgkmcnt(0)":"=s"(t_)::"memory"); __builtin_amdgcn_sched_barrier(0); \
      if((k)==1) segA+=t_-tprev; else if((k)==2) segB+=t_-tprev; else if((k)==3) segW+=t_-tprev; else if((k)==4) segX+=t_-tprev; tprev=t_; }while(0)
  #define WAIT_BAR2(N) do{ asm volatile("s_waitcnt vmcnt(" #N ") lgkmcnt(0)":::"memory"); STAMP(3); asm volatile("s_barrier":::"memory"); STAMP(4); }while(0)
#else
  #define STAMP(k) do{}while(0)
  #define WAIT_BAR2(N) WAIT_BAR(N)
#endif
template<bool FINAL> __device__ __forceinline__ void attn128f8_unit(int b,int qb,const bf16*Q,const bf16*__restrict__ K,const unsigned char*__restrict__ VT,bf16*O,float pscale,char*shm,const bf16*O1=nullptr,float lam=0.f,const float*subg=nullptr,float*stampout=nullptr){
  const int tid=threadIdx.x,lane=tid&63,r32=lane&31,hi=lane>>5; const int wid=__builtin_amdgcn_readfirstlane(tid>>6);
  const long rowbase=(long)b*SEQ; const int q0=qb*QB;
#if defined(PROBE_STAMP)
  unsigned long long segA=0,segB=0,segW=0,segX=0,tprev=0;
#endif
  const bf16*Qw=Q+(rowbase+q0+wid*QBLK)*DM;
  const bf16*Kh=K+rowbase*DM;
  const unsigned lds0=(unsigned)(uintptr_t)shm;
  float*wsf=(float*)(shm+LDS_WS)+wid*64;
  const int krow_=8*wid+(lane>>3);
  const bf16*ksrc=Kh+(long)krow_*DM+(((lane&7)^((krow_>>1)&7))*8);
  const int vrow_=16*wid+(lane>>2);
  const unsigned char*vsrc=VT+(long)vrow_*64+(((lane&3)^((vrow_>>2)&3))*16);
  const unsigned kdst=lds0+LDS_K+wid*1024, vdst=lds0+LDS_V+wid*1024;
  #define DMA_K(t,slot) glds16(ksrc+(long)(t)*KVBLK*DM,(unsigned)__builtin_amdgcn_readfirstlane(kdst+(slot)))
  #define DMA_V(t,slot) glds16(vsrc+(long)(t)*8192,(unsigned)__builtin_amdgcn_readfirstlane(vdst+(slot)))
  bf16x8 kf[8];
  const lds_cptr shm3=(lds_cptr)shm;
  const int kx_=(r32>>1)&7; const lds_cptr kq0=shm3+LDS_K+r32*128+(((0+hi)^kx_)*16),kq1=shm3+LDS_K+r32*128+(((2+hi)^kx_)*16),kq2=shm3+LDS_K+r32*128+(((4+hi)^kx_)*16),kq3=shm3+LDS_K+r32*128+(((6+hi)^kx_)*16);
  #define KLD(j,base,so) do{ kf[2*(j)]=*(const __attribute__((address_space(3))) bf16x8*)((base)+(so)); kf[2*(j)+1]=*(const __attribute__((address_space(3))) bf16x8*)((base)+(so)+4096); }while(0)
  const int vx_=(r32>>2)&3; const lds_cptr vq0=shm3+LDS_V+r32*64+(((2*hi)^vx_)*16), vq1=shm3+LDS_V+r32*64+(((2*hi+1)^vx_)*16);
  const int NT=SEQ/KVBLK;
  DMA_K(0,0);DMA_V(0,0);DMA_K(1,SLOTB);
  bf16x8 qr[4];
  #pragma unroll
  for(int d0=0;d0<4;++d0)qr[d0]=*reinterpret_cast<const bf16x8*>(&Qw[(long)r32*DM+d0*16+hi*8]);
  float l_reg=0.f;f32x16 o[4];o[0]=f32x16{};o[1]=f32x16{};o[2]=f32x16{};o[3]=f32x16{};
  const f32x16 zero=f32x16{};
  f32x16 pA0,pA1,pB0,pB1;
  int sl_prev=0,sl_cur=0,sl_next=SLOTB;
  #define ROT() do{sl_prev=sl_cur;sl_cur=sl_next;sl_next=(sl_next==(NSLOT-1)*SLOTB)?0:sl_next+SLOTB;}while(0)
  DMA_K(2,2*SLOTB);
  WAIT_BAR(3);
  KLD(0,kq0,0);KLD(1,kq1,0);KLD(2,kq2,0);KLD(3,kq3,0);
  pA0=__builtin_amdgcn_mfma_f32_32x32x16_bf16(kf[0],qr[0],zero,0,0,0);pA1=__builtin_amdgcn_mfma_f32_32x32x16_bf16(kf[1],qr[0],zero,0,0,0);
  _Pragma("unroll") for(int d0=1;d0<4;++d0){pA0=__builtin_amdgcn_mfma_f32_32x32x16_bf16(kf[2*d0],qr[d0],pA0,0,0,0);pA1=__builtin_amdgcn_mfma_f32_32x32x16_bf16(kf[2*d0+1],qr[d0],pA1,0,0,0);}
  _Pragma("unroll") for(int r=0;r<16;++r){pA0[r]=__builtin_amdgcn_exp2f(pA0[r]);pA1[r]=__builtin_amdgcn_exp2f(pA1[r]);}
  WAIT_BAR(0);
  DMA_K(3,0);DMA_V(1,SLOTB);
  ROT();
  KLD(0,kq0,sl_cur);KLD(1,kq1,sl_cur);KLD(2,kq2,sl_cur);KLD(3,kq3,sl_cur);
  WAIT_BAR(2);
  v8i32a vf[4]; v8i32a p8; int mxone=0x7F7F7F7F; asm volatile("":"+v"(mxone));
  #define P8CVT(P,B) __builtin_bit_cast(int,__builtin_amdgcn_cvt_scalef32_pk_fp8_f32(__builtin_amdgcn_cvt_scalef32_pk_fp8_f32((v2i16a){0,0},P[B],P[(B)+1],pscale,false),P[(B)+2],P[(B)+3],pscale,true))
  #define PIN(x) asm volatile("":"+v"(x))
  #define GAPA8(MF,A0,A1,A2,A3,W) do{ MF; sacc+=A0; sacc+=A1; sacc+=A2; sacc+=A3; PIN(sacc); W; SB128(); }while(0)
  #define EX(v) __builtin_amdgcn_exp2f(v)
  #define GAPB8(MF,X,B) do{ MF; X[B]=EX(X[B]); X[B+1]=EX(X[B+1]); X[B+2]=EX(X[B+2]); X[B+3]=EX(X[B+3]); X[B+4]=EX(X[B+4]); X[B+5]=EX(X[B+5]); X[B+6]=EX(X[B+6]); X[B+7]=EX(X[B+7]); PIN(X); SB128(); }while(0)
  #define VRDA(i) do{ const v4i32a t_=*(const __attribute__((address_space(3))) v4i32a*)(vq0+sl_prev+(i)*2048); vf[i][0]=t_[0];vf[i][1]=t_[1];vf[i][2]=t_[2];vf[i][3]=t_[3]; }while(0)
  #define VRDB(i) do{ const v4i32a t_=*(const __attribute__((address_space(3))) v4i32a*)(vq1+sl_prev+(i)*2048); vf[i][4]=t_[0];vf[i][5]=t_[1];vf[i][6]=t_[2];vf[i][7]=t_[3]; }while(0)
  #define VF8(i) vf[i]
  #define P8V() p8
  #define PVMF(i) asm volatile("s_nop 3\n\tv_mfma_scale_f32_32x32x64_f8f6f4 %0, %1, %2, %0, %3, %3 op_sel_hi:[0,0,0]":"+v"(o[i]):"v"(P8V()),"v"(VF8(i)),"v"(mxone))
  #define KRD(G,j) do{ if(G){ KLD(j,kq##j,sl_next); SB128(); } }while(0)
#if defined(A128_COARSE)
  #define STEP(C0,C1,P0,P1,t,GK,GV,GL) do{ SB128(); STAMP(0); \
    C0=__builtin_amdgcn_mfma_f32_32x32x16_bf16(kf[0],qr[0],zero,0,0,0); C1=__builtin_amdgcn_mfma_f32_32x32x16_bf16(kf[1],qr[0],zero,0,0,0); \
    C0=__builtin_amdgcn_mfma_f32_32x32x16_bf16(kf[2],qr[1],C0,0,0,0);   C1=__builtin_amdgcn_mfma_f32_32x32x16_bf16(kf[3],qr[1],C1,0,0,0); \
    C0=__builtin_amdgcn_mfma_f32_32x32x16_bf16(kf[4],qr[2],C0,0,0,0);   C1=__builtin_amdgcn_mfma_f32_32x32x16_bf16(kf[5],qr[2],C1,0,0,0); \
    C0=__builtin_amdgcn_mfma_f32_32x32x16_bf16(kf[6],qr[3],C0,0,0,0);   C1=__builtin_amdgcn_mfma_f32_32x32x16_bf16(kf[7],qr[3],C1,0,0,0); \
    SB128(); \
    VRDA(0);VRDB(0);VRDA(1);VRDB(1);VRDA(2);VRDB(2);VRDA(3);VRDB(3); \
    { float sacc=(P0[0]+P0[1]),sacd=(P1[0]+P1[1]); \
      _Pragma("unroll") for(int r_=2;r_<16;++r_){ sacc+=P0[r_]; sacd+=P1[r_]; } \
      l_reg+=sacc+sacd; } \
    p8[0]=P8CVT(P0,0);p8[1]=P8CVT(P0,4);p8[2]=P8CVT(P0,8);p8[3]=P8CVT(P0,12);p8[4]=P8CVT(P1,0);p8[5]=P8CVT(P1,4);p8[6]=P8CVT(P1,8);p8[7]=P8CVT(P1,12); \
    STAMP(1); SB128(); \
    PVMF(0);PVMF(1);PVMF(2);PVMF(3); \
    SB128(); \
    _Pragma("unroll") for(int r_=0;r_<16;++r_){ C0[r_]=EX(C0[r_]); C1[r_]=EX(C1[r_]); } \
    if(GL){ KLD(0,kq0,sl_next);KLD(1,kq1,sl_next);KLD(2,kq2,sl_next);KLD(3,kq3,sl_next); } \
    if(GK){DMA_K((t)+3,sl_cur);} if(GV){DMA_V((t)+1,sl_next);} \
    STAMP(2); SB128(); \
    }while(0)
#else
  #define STEP(C0,C1,P0,P1,t,GK,GV,GL) do{ SB128(); STAMP(0); \
    if(DMA_POS==3){ if(GV){DMA_V((t)+1,sl_next);} } \
    VRDA(0); SB128(); float sacc=(P0[0]+P0[1]); \
    GAPA8(C0=__builtin_amdgcn_mfma_f32_32x32x16_bf16(kf[0],qr[0],zero,0,0,0), P0[2],P0[3],P0[4],P0[5],     p8[0]=P8CVT(P0,0)); \
    VRDB(0); SB128(); GAPA8(C1=__builtin_amdgcn_mfma_f32_32x32x16_bf16(kf[1],qr[0],zero,0,0,0), P0[6],P0[7],P0[8],P0[9],     p8[1]=P8CVT(P0,4)); \
    VRDA(1); SB128(); GAPA8(C0=__builtin_amdgcn_mfma_f32_32x32x16_bf16(kf[2],qr[1],C0,0,0,0),   P0[10],P0[11],P0[12],P0[13], p8[2]=P8CVT(P0,8)); \
    VRDB(1); SB128(); GAPA8(C1=__builtin_amdgcn_mfma_f32_32x32x16_bf16(kf[3],qr[1],C1,0,0,0),   P0[14],P0[15],P1[0],P1[1],   p8[3]=P8CVT(P0,12)); \
    VRDA(2); SB128(); GAPA8(C0=__builtin_amdgcn_mfma_f32_32x32x16_bf16(kf[4],qr[2],C0,0,0,0),   P1[2],P1[3],P1[4],P1[5],     p8[4]=P8CVT(P1,0)); \
    VRDB(2); SB128(); GAPA8(C1=__builtin_amdgcn_mfma_f32_32x32x16_bf16(kf[5],qr[2],C1,0,0,0),   P1[6],P1[7],P1[8],P1[9],     p8[5]=P8CVT(P1,4)); \
    VRDA(3); SB128(); GAPA8(C0=__builtin_amdgcn_mfma_f32_32x32x16_bf16(kf[6],qr[3],C0,0,0,0),   P1[10],P1[11],P1[12],P1[13], p8[6]=P8CVT(P1,8)); \
    VRDB(3); SB128(); GAPA8(C1=__builtin_amdgcn_mfma_f32_32x32x16_bf16(kf[7],qr[3],C1,0,0,0),   P1[14],P1[15],0.f,0.f,       p8[7]=P8CVT(P1,12)); \
    l_reg+=sacc; STAMP(1); \
    PROBE_DMA_HOOK(t); DMA_AT(0,GK,GV,t); \
    SB128(); \
    GAPB8(PVMF(0), C0,0); \
    KRD(GL,0); KRD(GL,1); GAPB8(PVMF(1), C0,8); \
    KRD(GL,2); KRD(GL,3); GAPB8(PVMF(2), C1,0); DMA_AT(1,GK,GV,t); \
    GAPB8(PVMF(3), C1,8); DMA_AT(2,GK,GV,t); STAMP(2); \
    }while(0)
#endif
#if defined(A128_PRIO)
  if(wid>=4) __builtin_amdgcn_s_setprio(A128_PRIO);
#endif
  int t=1;
  for(;t+5<NT;t+=2){
    STEP(pB0,pB1,pA0,pA1,t,true,true,true);     WAIT_BAR2(2); ROT();
    STEP(pA0,pA1,pB0,pB1,t+1,true,true,true);   WAIT_BAR2(2); ROT();
  }
  #define ENDW(tt) do{ if((tt)+3<NT){WAIT_BAR(2);} else if((tt)+2<NT){WAIT_BAR(1);} else {WAIT_BAR(0);} }while(0)
  for(;t+1<NT;t+=2){
    STEP(pB0,pB1,pA0,pA1,t,(t+3<NT),(t+1<NT),(t+1<NT));       ENDW(t);   ROT();
    STEP(pA0,pA1,pB0,pB1,t+1,(t+4<NT),(t+2<NT),(t+2<NT));     ENDW(t+1); ROT();
  }
  STEP(pB0,pB1,pA0,pA1,NT-1,false,false,false);
  { float sacc=pB0[0]+pB0[1]; _Pragma("unroll") for(int r=2;r<16;++r)sacc+=pB0[r]; _Pragma("unroll") for(int r=0;r<16;++r)sacc+=pB1[r]; l_reg+=sacc;
    p8[0]=P8CVT(pB0,0);p8[1]=P8CVT(pB0,4);p8[2]=P8CVT(pB0,8);p8[3]=P8CVT(pB0,12);p8[4]=P8CVT(pB1,0);p8[5]=P8CVT(pB1,4);p8[6]=P8CVT(pB1,8);p8[7]=P8CVT(pB1,12);
    sl_prev=sl_cur;
    VRDA(0);VRDB(0);VRDA(1);VRDB(1);VRDA(2);VRDB(2);VRDA(3);VRDB(3);
    PVMF(0);PVMF(1);PVMF(2);PVMF(3); asm volatile("s_nop 15\n\ts_nop 15":"+v"(o[0]),"+v"(o[1]),"+v"(o[2]),"+v"(o[3])); }
  #undef P8CVT
  #undef PIN
  #undef GAPA8
  #undef GAPB8
  #undef EX
  #undef VRDA
  #undef VRDB
  #undef VF8
  #undef P8V
  #undef PVMF
  #undef KRD
  #undef KLD
  #undef STEP
  #undef ENDW
#if defined(A128_PRIO)
  __builtin_amdgcn_s_setprio(0);
#endif
  {auto rr=__builtin_amdgcn_permlane32_swap(__float_as_uint(l_reg),__float_as_uint(l_reg),false,false);l_reg=__uint_as_float(rr[0])+__uint_as_float(rr[1]);}
  if(hi==0)wsf[32+r32]=l_reg*(VT8_SCALE/pscale);asm volatile("s_waitcnt lgkmcnt(0)":::"memory");
  float rli[16];
  #pragma unroll
  for(int r=0;r<16;++r)rli[r]=__builtin_amdgcn_rcpf(wsf[32+crow(r,hi)]);
  bf16*Ow=O+(rowbase+q0+wid*QBLK)*DM;
  if constexpr(!FINAL){
  { bf16*stg=(bf16*)(shm+LDS_OST)+wid*4096;
    #pragma unroll
    for(int hh=0;hh<2;++hh){
      #pragma unroll
      for(int r=0;r<16;++r){const int orow=crow(r,hi);
        #pragma unroll
        for(int d0=0;d0<2;++d0)stg[orow*64+d0*32+r32]=__float2bfloat16(o[2*hh+d0][r]*rli[r]);}
      asm volatile("s_waitcnt lgkmcnt(0)":::"memory");
      #pragma unroll
      for(int i=0;i<4;++i){const int row=i*8+(lane>>3),ch=lane&7; const u32x4 v=*(const u32x4*)(stg+row*64+ch*8); ATTN_STORE16(Ow+(long)row*DM+hh*64+ch*8,v);}
      asm volatile("s_waitcnt lgkmcnt(0)":::"memory");
    } }
  } else {
  { bf16*stg=(bf16*)(shm+LDS_OST)+wid*4096;
    #pragma unroll
    for(int r=0;r<16;++r){const int orow=crow(r,hi);
      #pragma unroll
      for(int d0=0;d0<4;++d0)stg[orow*128+d0*32+r32]=__float2bfloat16(o[d0][r]*rli[r]);}
    asm volatile("s_waitcnt lgkmcnt(0)":::"memory");
    const float*subg2=subg; const bf16*O1b=O1; float lam2=lam; asm volatile("":"+s"(subg2),"+s"(O1b),"+v"(lam2));
    const int ch=lane&15; float sg[8];
    #pragma unroll
    for(int e=0;e<8;++e)sg[e]=subg2[ch*8+e]*0.8f;
    const bf16*O1w=O1b+(rowbase+q0+wid*QBLK)*DM;
    #pragma unroll 1
    for(int i=0;i<8;++i){const int row=i*4+(lane>>4);
      const u32x4 a2=*(const u32x4*)(stg+row*128+ch*8); const u32x4 a1=*(const u32x4*)(O1w+(long)row*DM+ch*8);
      float v[8]; const unsigned w1[4]={a1.x,a1.y,a1.z,a1.w},w2[4]={a2.x,a2.y,a2.z,a2.w};
      #pragma unroll
      for(int e=0;e<4;++e){ v[2*e]=__uint_as_float(w1[e]<<16)-lam2*__uint_as_float(w2[e]<<16); v[2*e+1]=__uint_as_float(w1[e]&0xffff0000u)-lam2*__uint_as_float(w2[e]&0xffff0000u); }
      float ss=0.f;
      #pragma unroll
      for(int e=0;e<8;++e)ss+=v[e]*v[e];
      ss+=__shfl_xor(ss,1);ss+=__shfl_xor(ss,2);ss+=__shfl_xor(ss,4);ss+=__shfl_xor(ss,8);
      const float rstd=1.f/sqrtf(ss*(1.f/128.f)+1e-6f);
      u32x4 wo; wo.x=cvtpk_s(v[0]*rstd*sg[0],v[1]*rstd*sg[1]); wo.y=cvtpk_s(v[2]*rstd*sg[2],v[3]*rstd*sg[3]); wo.z=cvtpk_s(v[4]*rstd*sg[4],v[5]*rstd*sg[5]); wo.w=cvtpk_s(v[6]*rstd*sg[6],v[7]*rstd*sg[7]);
      ATTN_STORE16(Ow+(long)row*DM+ch*8,wo); if(i&1) asm volatile("":::"memory"); }
    asm volatile("s_waitcnt lgkmcnt(0)":::"memory");
  }
  }
#if defined(PROBE_STAMP)
  if(blockIdx.x==0&&tid==STAMP_TID&&stampout){ stampout[0]+=(float)segA; stampout[1]+=(float)segB; stampout[2]+=(float)segW; stampout[3]+=(float)segX; }
#endif
  asm volatile("s_waitcnt lgkmcnt(0)\n\ts_barrier":::"memory");
  #undef DMA_K
  #undef DMA_V
  #undef ROT
}
#ifndef Q8_OLDDMA
#define Q8_OLDDMA 0
#endif
__device__ __forceinline__ void glds16_old(const void*gsrc,unsigned lds_dst,int wid){unsigned keep;
  asm volatile("s_cmp_lt_u32 %3, 4\n\ts_cbranch_scc0 1f\n\ts_mov_b32 %0, m0\n\ts_mov_b32 m0, %2\n\ts_nop 0\n\tglobal_load_lds_dwordx4 %1, off\n\ts_mov_b32 m0, %0\n1:":"=&s"(keep):"v"(gsrc),"s"(lds_dst),"s"(wid):"memory","scc");}
constexpr int Q8_KSLOT=8192  , Q8_LDS_K=0, Q8_LDS_V=3*Q8_KSLOT, Q8_LDS_WS=Q8_LDS_V+3*8192, Q8_LDS_OST=Q8_LDS_WS+NW*64*4;
typedef unsigned cu32x2 __attribute__((ext_vector_type(2)));
template<bool FINAL> __device__ __forceinline__ void attn128q8_unit(int b,int qb,const unsigned char*Q8,const unsigned char*__restrict__ K8,const unsigned char*__restrict__ VT,bf16*O,float pscale,char*shm,const bf16*O1=nullptr,float lam=0.f,const float*subg=nullptr,float*pstamp=nullptr,const bf16*cOUTG=nullptr,const float*cLSE=nullptr,bf16*cOA=nullptr,int ctok=0){
#ifdef PROBE_ATT
  const unsigned long long pa_t0=__builtin_amdgcn_s_memrealtime(); unsigned long long pa_t1=0,pa_t2=0;
#endif
  const int tid=threadIdx.x,lane=tid&63,r32=lane&31,hi=lane>>5; const int wid=__builtin_amdgcn_readfirstlane(tid>>6);
  const long rowbase=(long)b*SEQ; const int q0=qb*QB;
  const unsigned lds0=(unsigned)(uintptr_t)shm;
  float*wsf=(float*)(shm+Q8_LDS_WS)+wid*64;
#if Q8_OLDDMA
  const int krow_=16*(wid&3)+(lane>>2);
  const unsigned char*ksrc=K8+(rowbase+krow_)*DM+(((lane&3)^((krow_>>2)&3))*16);
  const int vrow_=16*(wid&3)+(lane>>2);
#else
  const int krow_=16*(wid&3)+(lane>>2);
  const unsigned char*ksrc=K8+(rowbase+(wid>>2)*64+krow_)*DM+(((lane&3)^((krow_>>2)&3))*16);
  const int vrow_=16*wid+(lane>>2);
#endif
  const unsigned char*vsrc=VT+(long)vrow_*64+(((lane&3)^((vrow_>>2)&3))*16);
#if Q8_OLDDMA
  const unsigned kdst=lds0+Q8_LDS_K+(wid&3)*1024, vdst=lds0+Q8_LDS_V+(wid&3)*1024;
#else
  const unsigned kdst=lds0+Q8_LDS_K+wid*1024, vdst=lds0+Q8_LDS_V+wid*1024;
#endif
#if Q8_OLDDMA
  #define DMA_KD(dbl,slot) do{ glds16_old(ksrc+(long)(dbl)*(2*KVBLK)*DM,(unsigned)__builtin_amdgcn_readfirstlane(kdst+(slot)),wid); glds16_old(ksrc+(long)(dbl)*(2*KVBLK)*DM+(long)KVBLK*DM,(unsigned)__builtin_amdgcn_readfirstlane(kdst+(slot)+4096),wid); }while(0)
  #define DMA_V(t,slot) do{ glds16_old(vsrc+(long)(t)*8192,(unsigned)__builtin_amdgcn_readfirstlane(vdst+(slot)),wid); glds16_old(vsrc+(long)(t)*8192+4096,(unsigned)__builtin_amdgcn_readfirstlane(vdst+(slot)+4096),wid); }while(0)
  #define WB_(a,b) WAIT_BAR(b)
#else
  #define DMA_KD(dbl,slot) glds16(ksrc+(long)(dbl)*(2*KVBLK)*DM,(unsigned)__builtin_amdgcn_readfirstlane(kdst+(slot)))
  #define DMA_V(t,slot) glds16(vsrc+(long)(t)*8192,(unsigned)__builtin_amdgcn_readfirstlane(vdst+(slot)))
  #define WB_(a,b) WAIT_BAR(a)
#endif
  const lds_cptr shm3=(lds_cptr)shm;
  const int vx_=(r32>>2)&3;
  const lds_cptr kq0=shm3+Q8_LDS_K+r32*64+(((2*hi)^vx_)*16), kq1=shm3+Q8_LDS_K+r32*64+(((2*hi+1)^vx_)*16);
  const lds_cptr vq0=shm3+Q8_LDS_V+r32*64+(((2*hi)^vx_)*16), vq1=shm3+Q8_LDS_V+r32*64+(((2*hi+1)^vx_)*16);
  constexpr int NT=SEQ/KVBLK;
  DMA_KD(0,0);DMA_V(0,0);DMA_KD(1,SLOTB);
  v8i32a qf;
  { const unsigned char*qp=Q8+(rowbase+q0+wid*QBLK+r32)*DM+hi*32; const v4i32a a_=*(const v4i32a*)qp, b_=*(const v4i32a*)(qp+16);
    qf[0]=a_[0];qf[1]=a_[1];qf[2]=a_[2];qf[3]=a_[3];qf[4]=b_[0];qf[5]=b_[1];qf[6]=b_[2];qf[7]=b_[3]; }
#if COMBINE_RIDER
  float c_ls[2][3]; cu32x2 c_v[2][3]; const int c_hs=lane>>4,c_d4=(lane&15)*4;
  if(cOA){
    #pragma unroll
    for(int r_=0;r_<2;++r_)
      #pragma unroll
      for(int g_=0;g_<3;++g_){ const long t_=(long)g_*(BATCH*SEQ)+ctok+r_; c_ls[r_][g_]=cLSE[t_*4+c_hs]; c_v[r_][g_]=*(const cu32x2*)(cOUTG+t_*256+c_hs*64+c_d4); } }
#endif
  float l_reg=0.f;f32x16 o[4];o[0]=f32x16{};o[1]=f32x16{};o[2]=f32x16{};o[3]=f32x16{};
  f32x16 pA0,pA1,pB0,pB1;
  int sl_prev=0,sl_cur=0,sl_next=SLOTB;
  #define ROT() do{sl_prev=sl_cur;sl_cur=sl_next;sl_next=(sl_next==(NSLOT-1)*SLOTB)?0:sl_next+SLOTB;}while(0)
  v8i32a kfa,kfb,vf[4],p8; int mxone=0x7F7F7F7F,mxk=0x7B7B7B7B,mxq=0x79797979; asm volatile("":"+v"(mxone),"+v"(mxk),"+v"(mxq));
  #define KLD8(so) do{ const v4i32a a_=*(const __attribute__((address_space(3))) v4i32a*)(kq0+(so)), b_=*(const __attribute__((address_space(3))) v4i32a*)(kq1+(so)), \
      c_=*(const __attribute__((address_space(3))) v4i32a*)(kq0+(so)+2048), d_=*(const __attribute__((address_space(3))) v4i32a*)(kq1+(so)+2048); \
      kfa[0]=a_[0];kfa[1]=a_[1];kfa[2]=a_[2];kfa[3]=a_[3];kfa[4]=b_[0];kfa[5]=b_[1];kfa[6]=b_[2];kfa[7]=b_[3]; kfb[0]=c_[0];kfb[1]=c_[1];kfb[2]=c_[2];kfb[3]=c_[3];kfb[4]=d_[0];kfb[5]=d_[1];kfb[6]=d_[2];kfb[7]=d_[3]; }while(0)
#if defined(Q8_PRIO)
  #define QKMF(C,KF) asm volatile("s_setprio 1\n\ts_nop 1\n\tv_mfma_scale_f32_32x32x64_f8f6f4 %0, %1, %2, 0, %3, %4 op_sel_hi:[0,0,0]\n\ts_setprio 0":"=&v"(C):"v"(KF),"v"(qf),"v"(mxk),"v"(mxq))
#else
  #define QKMF(C,KF) asm volatile("s_nop 1\n\tv_mfma_scale_f32_32x32x64_f8f6f4 %0, %1, %2, 0, %3, %4 op_sel_hi:[0,0,0]":"=&v"(C):"v"(KF),"v"(qf),"v"(mxk),"v"(mxq))
#endif
  WAIT_BAR(0);
  KLD8(0);
#if COMBINE_RIDER
  if(cOA){
    #pragma unroll
    for(int r_=0;r_<2;++r_){ const float M_=fmaxf(fmaxf(c_ls[r_][0],c_ls[r_][1]),c_ls[r_][2]); float a0_=0.f,a1_=0.f,a2_=0.f,a3_=0.f,ws_=0.f;
      #pragma unroll
      for(int g_=0;g_<3;++g_){ const float w_=__builtin_amdgcn_exp2f(c_ls[r_][g_]-M_); ws_+=w_;
        a0_+=w_*__uint_as_float(c_v[r_][g_].x<<16); a1_+=w_*__uint_as_float(c_v[r_][g_].x&0xffff0000u); a2_+=w_*__uint_as_float(c_v[r_][g_].y<<16); a3_+=w_*__uint_as_float(c_v[r_][g_].y&0xffff0000u); }
      const float iw_=__builtin_amdgcn_rcpf(ws_); cu32x2 o_; o_.x=cvtpk_s(a0_*iw_,a1_*iw_); o_.y=cvtpk_s(a2_*iw_,a3_*iw_);
      *(cu32x2*)(cOA+(long)(ctok+r_)*256+c_hs*64+c_d4)=o_; } }
#endif
  QKMF(pA0,kfa);QKMF(pA1,kfb);
  asm volatile("s_nop 15\n\ts_nop 15":"+v"(pA0),"+v"(pA1));
  _Pragma("unroll") for(int r=0;r<16;++r){pA0[r]=__builtin_amdgcn_exp2f(pA0[r]);pA1[r]=__builtin_amdgcn_exp2f(pA1[r]);}
  DMA_KD(2,2*SLOTB);DMA_V(1,SLOTB);
  ROT();
  KLD8(4096);
  WB_(2,4);
  int kcur=SLOTB,kprev=0,knext=2*SLOTB;
  v2i16a p8undef_;
  #define P8CVT(P,B) __builtin_bit_cast(int,__builtin_amdgcn_cvt_scalef32_pk_fp8_f32(__builtin_amdgcn_cvt_scalef32_pk_fp8_f32(p8undef_,P[B],P[(B)+1],pscale,false),P[(B)+2],P[(B)+3],pscale,true))
  #define EX(v) __builtin_amdgcn_exp2f(v)
  #define VRDA(i) do{ const v4i32a t_=*(const __attribute__((address_space(3))) v4i32a*)(vq0+sl_prev+(i)*2048); vf[i][0]=t_[0];vf[i][1]=t_[1];vf[i][2]=t_[2];vf[i][3]=t_[3]; }while(0)
  #define VRDB(i) do{ const v4i32a t_=*(const __attribute__((address_space(3))) v4i32a*)(vq1+sl_prev+(i)*2048); vf[i][4]=t_[0];vf[i][5]=t_[1];vf[i][6]=t_[2];vf[i][7]=t_[3]; }while(0)
#if defined(Q8_PRIO)
  #define PVMF(i) asm volatile("s_setprio 1\n\ts_nop 3\n\tv_mfma_scale_f32_32x32x64_f8f6f4 %0, %1, %2, %0, %3, %3 op_sel_hi:[0,0,0]\n\ts_setprio 0":"+v"(o[i]):"v"(p8),"v"(vf[i]),"v"(mxone))
#else
  #define PVMF(i) asm volatile("s_nop 3\n\tv_mfma_scale_f32_32x32x64_f8f6f4 %0, %1, %2, %0, %3, %3 op_sel_hi:[0,0,0]":"+v"(o[i]):"v"(p8),"v"(vf[i]),"v"(mxone))
#endif
  #define EX8(X,B) do{ X[B]=EX(X[B]); X[B+1]=EX(X[B+1]); X[B+2]=EX(X[B+2]); X[B+3]=EX(X[B+3]); X[B+4]=EX(X[B+4]); X[B+5]=EX(X[B+5]); X[B+6]=EX(X[B+6]); X[B+7]=EX(X[B+7]); }while(0)
  #define STEP(C0,C1,P0,P1,t,KOFF,GK,KD,GV,GL) do{ SB128(); \
    QKMF(C0,kfa); \
    VRDA(0);VRDB(0);VRDA(1);VRDB(1); \
    { float sacc=(P0[0]+P0[1]); _Pragma("unroll") for(int r_=2;r_<16;++r_) sacc+=P0[r_]; l_reg+=sacc; } \
    p8[0]=P8CVT(P0,0);p8[1]=P8CVT(P0,4);p8[2]=P8CVT(P0,8);p8[3]=P8CVT(P0,12); SB128(); \
    QKMF(C1,kfb); \
    VRDA(2);VRDB(2);VRDA(3);VRDB(3); \
    { float sacc=(P1[0]+P1[1]); _Pragma("unroll") for(int r_=2;r_<16;++r_) sacc+=P1[r_]; l_reg+=sacc; } \
    p8[4]=P8CVT(P1,0);p8[5]=P8CVT(P1,4);p8[6]=P8CVT(P1,8);p8[7]=P8CVT(P1,12); SB128(); \
    PVMF(0); asm volatile("s_nop 7":"+v"(C0),"+v"(C1)); EX8(C0,0); SB128(); \
    PVMF(1); EX8(C0,8); if(GL){ KLD8(KOFF); } SB128(); \
    PVMF(2); EX8(C1,0); if(GK){DMA_KD(KD,kprev);} if(GV){DMA_V((t)+1,sl_next);} SB128(); \
    PVMF(3); EX8(C1,8); SB128(); \
    }while(0)
  #define KROT() do{ const int o_=kprev; kprev=kcur; kcur=knext; knext=o_; }while(0)
#ifdef PROBE_ATT
  pa_t1=__builtin_amdgcn_s_memrealtime();
#endif
  int t=1;
  for(;t+5<NT;t+=2){
    STEP(pB0,pB1,pA0,pA1,t,  kcur,     false,0,          true,true);   WB_(1,2); ROT();
    STEP(pA0,pA1,pB0,pB1,t+1,kcur+4096,true,((t+1)>>1)+2,true,true);   WB_(2,4); ROT(); KROT();
  }
  STEP(pB0,pB1,pA0,pA1,t,  kcur,     false,0,true,true);   WB_(1,2); ROT();
  STEP(pA0,pA1,pB0,pB1,t+1,kcur+4096,false,0,true,true);   WB_(1,2); ROT(); KROT();
  STEP(pB0,pB1,pA0,pA1,t+2,kcur,     false,0,true,true);   WB_(1,2); ROT();
  STEP(pA0,pA1,pB0,pB1,t+3,kcur+4096,false,0,true,true);   WAIT_BAR(0); ROT(); KROT();
  STEP(pB0,pB1,pA0,pA1,NT-1,0,false,0,false,false);
  { float sacc=pB0[0]+pB0[1]; _Pragma("unroll") for(int r=2;r<16;++r)sacc+=pB0[r]; _Pragma("unroll") for(int r=0;r<16;++r)sacc+=pB1[r]; l_reg+=sacc;
    p8[0]=P8CVT(pB0,0);p8[1]=P8CVT(pB0,4);p8[2]=P8CVT(pB0,8);p8[3]=P8CVT(pB0,12);p8[4]=P8CVT(pB1,0);p8[5]=P8CVT(pB1,4);p8[6]=P8CVT(pB1,8);p8[7]=P8CVT(pB1,12);
    sl_prev=sl_cur;
    VRDA(0);VRDB(0);VRDA(1);VRDB(1);VRDA(2);VRDB(2);VRDA(3);VRDB(3);
    PVMF(0);PVMF(1);PVMF(2);PVMF(3); asm volatile("s_nop 15\n\ts_nop 15":"+v"(o[0]),"+v"(o[1]),"+v"(o[2]),"+v"(o[3])); }
#ifdef PROBE_ATT
  pa_t2=__builtin_amdgcn_s_memrealtime();
#endif
  #undef P8CVT
  #undef EX
  #undef EX8
  #undef VRDA
  #undef VRDB
  #undef PVMF
  #undef QKMF
  #undef KLD8
  #undef STEP
  #undef KROT
  {auto rr=__builtin_amdgcn_permlane32_swap(__float_as_uint(l_reg),__float_as_uint(l_reg),false,false);l_reg=__uint_as_float(rr[0])+__uint_as_float(rr[1]);}
  if(hi==0)wsf[32+r32]=l_reg*(VT8_SCALE/pscale);asm volatile("s_waitcnt lgkmcnt(0)":::"memory");
  float rli[16];
  #pragma unroll
  for(int r=0;r<16;++r)rli[r]=__builtin_amdgcn_rcpf(wsf[32+crow(r,hi)]);
  bf16*Ow=O+(rowbase+q0+wid*QBLK)*DM;
  if constexpr(!FINAL){
  { bf16*stg=(bf16*)(shm+Q8_LDS_OST)+wid*4096;
    #pragma unroll
    for(int hh=0;hh<2;++hh){
      #pragma unroll
      for(int r=0;r<16;++r){const int orow=crow(r,hi);
        #pragma unroll
        for(int d0=0;d0<2;++d0)stg[orow*64+d0*32+r32]=__float2bfloat16(o[2*hh+d0][r]*rli[r]);}
      asm volatile("s_waitcnt lgkmcnt(0)":::"memory");
      #pragma unroll
      for(int i=0;i<4;++i){const int row=i*8+(lane>>3),ch=lane&7; const u32x4 v=*(const u32x4*)(stg+row*64+ch*8); ATTN_STORE16(Ow+(long)row*DM+hh*64+ch*8,v);}
      asm volatile("s_waitcnt lgkmcnt(0)":::"memory");
    } }
  } else {
  { bf16*stg=(bf16*)(shm+Q8_LDS_OST)+wid*4096;
    #pragma unroll
    for(int r=0;r<16;++r){const int orow=crow(r,hi);
      #pragma unroll
      for(int d0=0;d0<4;++d0)stg[orow*128+d0*32+r32]=__float2bfloat16(o[d0][r]*rli[r]);}
    asm volatile("s_waitcnt lgkmcnt(0)":::"memory");
    const float*subg2=subg; const bf16*O1b=O1; float lam2=lam; asm volatile("":"+s"(subg2),"+s"(O1b),"+v"(lam2));
    const int ch=lane&15; float sg[8];
    #pragma unroll
    for(int e=0;e<8;++e)sg[e]=subg2[ch*8+e]*0.8f;
    const bf16*O1w=O1b+(rowbase+q0+wid*QBLK)*DM;
    u32x4 a1v[8];
    #pragma unroll
    for(int i=0;i<8;++i) a1v[i]=*(const u32x4*)(O1w+(long)(i*4+(lane>>4))*DM+ch*8);
    #pragma unroll
    for(int i=0;i<8;++i){const int row=i*4+(lane>>4);
      const u32x4 a2=*(const u32x4*)(stg+row*128+ch*8); const u32x4 a1=a1v[i];
      float v[8]; const unsigned w1[4]={a1.x,a1.y,a1.z,a1.w},w2[4]={a2.x,a2.y,a2.z,a2.w};
      #pragma unroll
      for(int e=0;e<4;++e){ v[2*e]=__uint_as_float(w1[e]<<16)-lam2*__uint_as_float(w2[e]<<16); v[2*e+1]=__uint_as_float(w1[e]&0xffff0000u)-lam2*__uint_as_float(w2[e]&0xffff0000u); }
      float ss=0.f;
      #pragma unroll
      for(int e=0;e<8;++e)ss+=v[e]*v[e];
      ss+=__int_as_float(__builtin_amdgcn_update_dpp(0,__float_as_int(ss),0xB1,0xf,0xf,true));
      ss+=__int_as_float(__builtin_amdgcn_update_dpp(0,__float_as_int(ss),0x4E,0xf,0xf,true));
      ss+=__int_as_float(__builtin_amdgcn_ds_swizzle(__float_as_int(ss),0x101F));
      ss+=__int_as_float(__builtin_amdgcn_update_dpp(0,__float_as_int(ss),0x128,0xf,0xf,true));
      const float rstd=__builtin_amdgcn_rsqf(ss*(1.f/128.f)+1e-6f);
      u32x4 wo; wo.x=cvtpk_s(v[0]*rstd*sg[0],v[1]*rstd*sg[1]); wo.y=cvtpk_s(v[2]*rstd*sg[2],v[3]*rstd*sg[3]); wo.z=cvtpk_s(v[4]*rstd*sg[4],v[5]*rstd*sg[5]); wo.w=cvtpk_s(v[6]*rstd*sg[6],v[7]*rstd*sg[7]);
      ATTN_STORE16(Ow+(long)row*DM+ch*8,wo); }
    asm volatile("s_waitcnt lgkmcnt(0)":::"memory");
  }
  }
  asm volatile("s_waitcnt lgkmcnt(0)\n\ts_barrier":::"memory");
#ifdef PROBE_ATT
  if(pstamp&&blockIdx.x==17&&tid==0){ const unsigned long long pa_t3=__builtin_amdgcn_s_memrealtime(); pstamp[0]+=(float)(pa_t1-pa_t0); pstamp[1]+=(float)(pa_t2-pa_t1); pstamp[2]+=(float)(pa_t3-pa_t2); }
#endif
  #undef DMA_KD
  #undef DMA_V
  #undef WB_
  #undef ROT
}
struct DiffFusedOrder {
  int vcu,G,blk;
  __device__ __forceinline__ explicit DiffFusedOrder(int grid,int block):vcu((block%8)*(grid/8)+block/8),G(grid),blk(block){}
  __device__ __forceinline__ bool next(int i,int&bh,int&qb)const{
    if(G==256){ if(i>=4)return false; bh=(vcu>>5)*8+2*i+((vcu>>4)&1); qb=vcu&15; return true; }
    const int L=i*G+blk; if(L>=1024)return false; bh=L>>4; qb=L&15; return true; }
};
__device__ __forceinline__ void diff128f8_phase(char*lds,const bf16*QB,const bf16*KB,const unsigned char*VT8,bf16*O1,bf16*OB,float pscale,float lam,const float*subg,const DiffFusedOrder&S,float*stampout=nullptr){
  int bh,qb;
  for(int i=0;S.next(i,bh,qb);++i){ const int h=bh&7,b=bh>>3;
    attn128f8_unit<false>(b,qb,QB+h*128,KB+h*128,VT8+(size_t)bh*(64*8192),O1+h*128,pscale,lds,nullptr,0.f,nullptr,stampout); }
  asm volatile("s_waitcnt vmcnt(0)":::"memory");
  for(int i=0;S.next(i,bh,qb);++i){ const int h=bh&7,b=bh>>3;
    attn128f8_unit<true>(b,qb,QB+h*128+64,KB+h*128+64,VT8+(size_t)bh*(64*8192),OB+h*128,pscale,lds,O1+h*128,lam,subg); }
}
__device__ __forceinline__ void diff128q8_phase(char*lds,const unsigned char*Q8,const unsigned char*K8,const unsigned char*VT8,bf16*O1,bf16*OB,float pscale,float lam,const float*subg,const DiffFusedOrder&S,float*pstamp=nullptr,const bf16*cOUTG=nullptr,const float*cLSE=nullptr,bf16*cOA=nullptr,int cbase=0){
  int bh,qb;
  for(int i=0;S.next(i,bh,qb);++i){ const int h=bh&7,b=bh>>3;
    attn128q8_unit<false>(b,qb,Q8+h*128,K8+h*128,VT8+(size_t)bh*(64*8192),O1+h*128,pscale,lds,nullptr,0.f,nullptr,pstamp,cOUTG,cLSE,cOA,cbase+2*i); }
  asm volatile("s_waitcnt vmcnt(0)":::"memory");
  for(int i=0;S.next(i,bh,qb);++i){ const int h=bh&7,b=bh>>3;
    attn128q8_unit<true>(b,qb,Q8+h*128+64,K8+h*128+64,VT8+(size_t)bh*(64*8192),OB+h*128,pscale,lds,O1+h*128,lam,subg,pstamp,cOUTG,cLSE,cOA,cbase+8+2*i); }
}
constexpr int ATTN_LDS_BYTES=LDS_BYTES;
struct AttnUnit { int pair; int qb; };
struct DiffOrder {
  int vcu,G,blk;
  __device__ __forceinline__ explicit DiffOrder(int grid,int block):vcu((block%8)*(grid/8)+block/8),G(grid),blk(block){}
  __device__ __forceinline__ bool next(int i,AttnUnit&u)const{
    if(G==256){ if(i>=16)return false; u.pair=(vcu&~31)+2*i+((vcu>>4)&1); u.qb=vcu&15; return true; }
    const int L=i*G+blk; if(L>=4096)return false; u.pair=L>>4; u.qb=L&15; return true; }
};
template<int THRL=8> __device__ __forceinline__ void diff_attn_phase(char*lds,const bf16*QB,const bf16*KB,const bf16*VB,bf16*O1,bf16*O2,const DiffOrder&S){
  AttnUnit u;
  for(int i=0;S.next(i,u);++i){ const int b=u.pair>>5,vh=u.pair&31,h=vh>>2,m=(vh>>1)&1,c=vh&1;
    attn_unit<THRL>(b,0,u.qb,QB+h*128+m*64,KB+h*128+m*64,VB+h*128+c*64,(m?O2:O1)+h*128+c*64,lds); }
}
#undef SBAR
#undef WAIT_BAR
}

constexpr int NWAVES = 8;
constexpr size_t MiB = 1u << 20;
constexpr size_t WS_CTL = 0, CTL_ZERO_BYTES = 1 * MiB;
constexpr size_t WS_MOD = 1 * MiB;
constexpr int MOD_LAM = 8 * 6144;
constexpr size_t WS_WIN = 2 * MiB, WS_WPA = 17 * MiB, WS_WPB = 18 * MiB, WS_WOUT = 20 * MiB, WS_WQ = 22 * MiB, WS_SK = 26 * MiB;
constexpr size_t WS_R1 = 32 * MiB;
constexpr size_t WS_QA = 96 * MiB, WS_KA = 144 * MiB, WS_VA = 192 * MiB;
constexpr size_t WS_O1 = 96 * MiB;
constexpr size_t WS_OB = 160 * MiB, WS_OA = 368 * MiB;
constexpr size_t WS_VT8 = 64 * MiB;
constexpr size_t WS_EU = EXPERT_TAIL ? 484 * MiB : 96 * MiB, WS_ESC = EXPERT_TAIL ? 500 * MiB : 128 * MiB;
constexpr size_t WS_EVA = EXPERT_TAIL ? 500 * MiB + 256 * 1024 : 112 * MiB, WS_EVB = EXPERT_TAIL ? 9 * MiB + 512 * 1024 : 122 * MiB;
constexpr size_t WS_QB = 240 * MiB, WS_KB = 304 * MiB, WS_VB = 368 * MiB;
constexpr size_t WS_MIX = 240 * MiB, WS_TMP = 304 * MiB;
constexpr size_t WS_QP = 240 * MiB;
constexpr size_t WS_OUTG = 432 * MiB, WS_LSE = 480 * MiB;
constexpr size_t WS_IDX = 432 * MiB, WS_GATE = 448 * MiB;
constexpr size_t WS_CS = 432 * MiB;
constexpr size_t WS_DELTA = 368 * MiB;
constexpr size_t WS_X1B = X1_BF16 ? 368 * MiB : 176 * MiB;
constexpr size_t WS_H8 = 160 * MiB;
constexpr size_t WS_END = 512 * MiB;
constexpr int CW_TMO = 0, CW_BAR = 4096, CW_AMAX = 32768;
constexpr size_t WS_SA = 1 * MiB + 256 * 1024, WS_SW = 1 * MiB + 512 * 1024;
constexpr int RING_OFF = 0, RING_BYTES = 131072;
constexpr int LDSCTL_OFF = RING_BYTES, MISC_OFF = LDSCTL_OFF + 320;
constexpr int LDS_BYTES = (U_MFMA || V_STAGE) ? 157696 : 147456;
constexpr int N_PHASES = 13 + P12_SPLIT;

#define GAS __attribute__((address_space(1)))
#define LAS __attribute__((address_space(3)))
typedef unsigned short bf16;
typedef unsigned v4u __attribute__((ext_vector_type(4)));
typedef float f32x4 __attribute__((ext_vector_type(4)));
typedef short bf16x8 __attribute__((ext_vector_type(8)));
typedef GAS unsigned gu32;
typedef GAS unsigned long long gu64;
#define RLX_AGENT __ATOMIC_RELAXED, __HIP_MEMORY_SCOPE_AGENT
#define LDS_WAIT() asm volatile("s_waitcnt lgkmcnt(0)" ::: "memory")
#define VM_WAIT() asm volatile("s_waitcnt vmcnt(0)" ::: "memory")
__device__ __forceinline__ unsigned long long rt() { return __builtin_amdgcn_s_memrealtime(); }
__device__ __forceinline__ unsigned f2bf(float f) { unsigned u = __builtin_bit_cast(unsigned, f); return (u + 0x7fffu + ((u >> 16) & 1u)) >> 16; }
__device__ __forceinline__ unsigned pk2(float lo, float hi) { return f2bf(lo) | (f2bf(hi) << 16); }

#define XB_TMO      128
#define XB_XCNT(j)  (256  + 64 * (j))
#define XB_XSUB(j)  (1280 + 64 * (j))
#define XB_XGEN(j)  (2304 + 64 * (j))
#define XB_TOP      3328
#define XB_TOPGEN   3392
#define XCD_BAR_WORDS 3456
#define XB_SPIN_CAP (1u << 18)

__device__ __forceinline__ unsigned xb_ld(unsigned* p)              { return __hip_atomic_load(p, __ATOMIC_RELAXED, __HIP_MEMORY_SCOPE_AGENT); }
__device__ __forceinline__ unsigned xb_add(unsigned* p, unsigned v) { return __hip_atomic_fetch_add(p, v, __ATOMIC_RELAXED, __HIP_MEMORY_SCOPE_AGENT); }
__device__ __forceinline__ unsigned xb_xcc_id() { return (unsigned)__builtin_amdgcn_s_getreg((3 << 11) | 20) & 0xFu; }
#define XB_SPIN(cond, bar) do { unsigned _sp = 0; while (cond) { __builtin_amdgcn_s_sleep(1); \
    if ((++_sp & 255u) == 0u) { if (xb_ld(&(bar)[XB_TMO])) break; if (_sp > XB_SPIN_CAP) { atomicAdd(&(bar)[XB_TMO], 1u); break; } } } } while (0)

struct XcdBarrier {
    unsigned* bar; unsigned x;
    volatile LAS unsigned* st;
};

__device__ __forceinline__ XcdBarrier xcd_barrier_post(unsigned* bar, volatile LAS unsigned* st) {
    XcdBarrier b; b.bar = bar; b.x = xb_xcc_id(); b.st = st;
    if (threadIdx.x == 0) (void)xb_add(&bar[XB_XCNT(b.x)], 1u);
    return b;
}
__device__ __forceinline__ void xcd_barrier_complete(unsigned* bar, unsigned x, unsigned& nloc, unsigned& nx) {
    const unsigned G = gridDim.x * gridDim.y * gridDim.z;
    unsigned sum, cnt, mine, sp = 0u;
    for (;;) {
        sum = 0u; cnt = 0u; mine = 0u;
#pragma unroll
        for (unsigned j = 0; j < 16; ++j) { const unsigned c = xb_ld(&bar[XB_XCNT(j)]); sum += c; cnt += (c > 0u) ? 1u : 0u; mine = (j == x) ? c : mine; }
        if (sum == G) break;
        __builtin_amdgcn_s_sleep(1);
        if ((++sp & 255u) == 0u) { if (xb_ld(&bar[XB_TMO])) break; if (sp > XB_SPIN_CAP) { atomicAdd(&bar[XB_TMO], 1u); break; } }
    }
    nloc = mine > 0u ? mine : 1u; nx = cnt > 0u ? cnt : 1u;
}

__device__ __forceinline__ void xcd_barrier(const XcdBarrier& b) {
    asm volatile("s_waitcnt vmcnt(0)" ::: "memory");
    __syncthreads();
    if (threadIdx.x == 0) {
        unsigned* bar = b.bar;
        __builtin_amdgcn_s_waitcnt(0);
        unsigned nloc = b.st[0], nx = b.st[1];
        if (nloc == 0u) { xcd_barrier_complete(bar, b.x, nloc, nx); b.st[0] = nloc; b.st[1] = nx; }
        const unsigned old = xb_add(&bar[XB_XSUB(b.x)], 1u);
        const unsigned gen = old / nloc;
        if (old + 1u == (gen + 1u) * nloc) {
            __builtin_amdgcn_fence(__ATOMIC_RELEASE, "agent");
            asm volatile("s_waitcnt vmcnt(0)" ::: "memory");
            const unsigned og = xb_add(&bar[XB_TOP], 1u);
            const unsigned tg = og / nx;
            if (og + 1u == (tg + 1u) * nx) xb_add(&bar[XB_TOPGEN], 1u);
            else XB_SPIN(xb_ld(&bar[XB_TOPGEN]) == tg, bar);
            __builtin_amdgcn_fence(__ATOMIC_ACQUIRE, "agent");
            xb_add(&bar[XB_XGEN(b.x)], 1u);
            asm volatile("s_waitcnt vmcnt(0)" ::: "memory");
        } else {
            XB_SPIN(xb_ld(&bar[XB_XGEN(b.x)]) == gen, bar);
            __builtin_amdgcn_fence(__ATOMIC_ACQUIRE, "agent");
            asm volatile("s_waitcnt vmcnt(0)" ::: "memory");
        }
    }
    __syncthreads();
}
__device__ __forceinline__ float wave_sum(float v) {
#pragma unroll
    for (int o = 1; o < 64; o <<= 1) v += __shfl_xor(v, o);
    return v;
}
__device__ __forceinline__ void p0_transpose_item(const float* W, int K, int N, bf16* WT, int row_off, LAS float* scr, int item, int lane, bool kblk = false) {
    const int nblk = N / 32, kb = item / nblk, nb = item % nblk, k0 = 64 * kb, n0 = 32 * nb;
    {   float t_[32];
#pragma unroll
        for (int i = 0; i < 32; ++i) t_[i] = W[(size_t)(k0 + 2 * i + (lane >> 5)) * N + n0 + (lane & 31)];
        __builtin_amdgcn_sched_barrier(0);
#pragma unroll
        for (int i = 0; i < 32; ++i) scr[(2 * i + (lane >> 5)) * 33 + (lane & 31)] = t_[i]; }
    LDS_WAIT(); asm volatile("" ::: "memory");
    const int c = lane & 7;
#pragma unroll
    for (int j = 0; j < 4; ++j) { const int n = (lane >> 3) + 8 * j; const LAS float* s = scr + (8 * c) * 33 + n;
        v4u o; o.x = pk2(s[0 * 33], s[1 * 33]); o.y = pk2(s[2 * 33], s[3 * 33]); o.z = pk2(s[4 * 33], s[5 * 33]); o.w = pk2(s[6 * 33], s[7 * 33]);
        *(GAS v4u*)(WT + (kblk ? pg8::kb_off((size_t)(row_off + n0 + n), k0 + 8 * c, K) : (size_t)(row_off + n0 + n) * K + k0 + 8 * c)) = o; }
    LDS_WAIT(); asm volatile("" ::: "memory");
}

typedef float f32x16 __attribute__((ext_vector_type(16)));
typedef unsigned u32x2 __attribute__((ext_vector_type(2)));
typedef __bf16 bf16x2v __attribute__((ext_vector_type(2)));
struct Frame {
    LAS unsigned char* lds;
    volatile LAS unsigned* MISC;
    gu32* ctl;
    int tid, lane, wave;
    int vcu, G;
};
struct Args { const void* in[25]; float* out; unsigned char* ws; int ph_lo, ph_hi, bar_region, pad; };

__device__ __forceinline__ float bflo(unsigned w) { return __uint_as_float(w << 16); }
__device__ __forceinline__ float bfhi(unsigned w) { return __uint_as_float(w & 0xffff0000u); }
__device__ __forceinline__ float dot2bf(unsigned a, unsigned b, float acc) { return __builtin_amdgcn_fdot2_f32_bf16(__builtin_bit_cast(bf16x2v, a), __builtin_bit_cast(bf16x2v, b), acc, false); }

__device__ __forceinline__ int win_slot(int col) {
    const int pn = col >> 8;
    if (pn < 6 || (pn >= 9 && pn < 17)) { const int within = col & 255; return pn * 256 + 128 * ((within >> 5) & 1) + 32 * (within >> 6) + (within & 31); }
    return col;
}
__device__ __forceinline__ void win_fp8_item(const float* W, const unsigned* amax, unsigned char* WT8, float* sW, LAS float* scr, int item, int lane) {
    constexpr int nblk = IN_W / 32; const int kb = item / nblk, nb = item % nblk, k0 = 64 * kb, n0 = 32 * nb;
    {   float t_[32];
#pragma unroll
        for (int i = 0; i < 32; ++i) t_[i] = W[(size_t)(k0 + 2 * i + (lane >> 5)) * IN_W + n0 + (lane & 31)];
        __builtin_amdgcn_sched_barrier(0);
#pragma unroll
        for (int i = 0; i < 32; ++i) scr[(2 * i + (lane >> 5)) * 33 + (lane & 31)] = t_[i]; }
    LDS_WAIT(); asm volatile("" ::: "memory");
    const int n = lane >> 1, hf = lane & 1, slot = win_slot(n0 + n);
    const float am = __uint_as_float(amax[slot]); const float sc = am > 0.f ? 240.0f / am : 1.0f;
    const LAS float* sp = scr + (hf * 32) * 33 + n;
    unsigned w[8];
#pragma unroll
    for (int j = 0; j < 8; ++j) { int t = __builtin_amdgcn_cvt_pk_fp8_f32(sp[(4 * j) * 33] * sc, sp[(4 * j + 1) * 33] * sc, 0, false); t = __builtin_amdgcn_cvt_pk_fp8_f32(sp[(4 * j + 2) * 33] * sc, sp[(4 * j + 3) * 33] * sc, t, true); w[j] = (unsigned)t; }
    unsigned char* dp = WT8 + (size_t)slot * 1024 + k0 + hf * 32;
    *(GAS v4u*)dp = (v4u){w[0], w[1], w[2], w[3]}; *(GAS v4u*)(dp + 16) = (v4u){w[4], w[5], w[6], w[7]};
    if (kb == 0 && hf == 0) sW[slot] = am > 0.f ? am * (1.0f / 240.0f) : 1.0f;
    LDS_WAIT(); asm volatile("" ::: "memory");
}

__device__ __forceinline__ void p0_prologue(Frame& F, const Args& a) {
    float* modp = (float*)(a.ws + WS_MOD);
    {
        LAS float* sc = (LAS float*)F.lds;
        LAS float* red = (LAS float*)(F.lds + 32768);
        const float* c = (const float*)a.in[1]; const float* w_ada = (const float*)a.in[3]; const float* b_ada = (const float*)a.in[4];
        bool did = false;
        for (int u = F.vcu; u < 192; u += F.G) {
            if (!did) { for (int i = F.tid; i < 8192; i += NWAVES * 64) { const float v = c[i]; sc[i] = v / (1.f + __expf(-v)); } __syncthreads(); did = true; }
            const int cc = F.tid & 31, kg = F.tid >> 5, col = u * 32 + cc;
            float acc[8];
#pragma unroll
            for (int b = 0; b < 8; ++b) acc[b] = 0.f;
            float wv[64];
#pragma unroll
            for (int i = 0; i < 64; ++i) wv[i] = w_ada[(size_t)(kg * 64 + i) * 6144 + col];
            __builtin_amdgcn_sched_barrier(0);
#pragma unroll
            for (int i = 0; i < 64; ++i) {
#pragma unroll
                for (int b = 0; b < 8; ++b) acc[b] += sc[b * 1024 + kg * 64 + i] * wv[i]; }
#pragma unroll
            for (int b = 0; b < 8; ++b) red[(kg * 8 + b) * 32 + cc] = acc[b];
            __syncthreads();
            if (F.tid < 256) { const int b = F.tid >> 5; float s = b_ada[col];
#pragma unroll
                for (int g = 0; g < 16; ++g) s += red[(g * 8 + b) * 32 + cc];
                modp[b * 6144 + col] = s; }
            __syncthreads();
        }
        if (F.vcu == F.G - 1 && F.wave == 0) {
            const float p1 = ((const float*)a.in[13])[F.lane] * ((const float*)a.in[14])[F.lane];
            const float p2 = ((const float*)a.in[15])[F.lane] * ((const float*)a.in[16])[F.lane];
            const float s1 = wave_sum(p1), s2 = wave_sum(p2);
            if (F.lane == 0) { modp[MOD_LAM] = expf(s1) - expf(s2) + LAM_INIT; modp[MOD_LAM + 16] = 0.f; modp[MOD_LAM + 17] = 0.f; modp[MOD_LAM + 18] = 0.f; modp[MOD_LAM + 19] = 0.f; modp[MOD_LAM + 24] = 0.f; modp[MOD_LAM + 25] = 0.f; }
        }
        __syncthreads();
    }
    { const float* w_in = (const float*)a.in[6]; unsigned* amax = (unsigned*)(a.ws + WS_CTL) + CW_AMAX;
      for (int u = F.vcu; u < 4 * (IN_W / 128); u += F.G) { const int cu = u % (IN_W / 128), kq = u / (IN_W / 128);
          const int col = cu * 128 + (F.tid & 127), kb = kq * 256 + (F.tid >> 7) * 64; float m = 0.f;
          float wv[64];
#pragma unroll
          for (int i = 0; i < 64; ++i) wv[i] = w_in[(size_t)(kb + i) * IN_W + col];
          __builtin_amdgcn_sched_barrier(0);
#pragma unroll
          for (int i = 0; i < 64; ++i) m = fmaxf(m, fabsf(wv[i]));
          atomicMax(amax + win_slot(col), __float_as_uint(m)); } }
    LAS float* scr = (LAS float*)(F.lds + RING_OFF + F.wave * 16384);
    const int gw = F.vcu * NWAVES + F.wave, NGW = F.G * NWAVES;
    constexpr int I_PA = (DIL_OUT / 64) * (D / 32), I_PB = (D / 64) * (D / 32), I_OUT = I_PB, I_Q = (D / 64) * (PEER_QW / 32);
    constexpr int NITEMS = I_PA + I_PB + I_OUT + I_Q;
    for (int it = gw; it < NITEMS; it += NGW) {
        int r = it;
        if (r < I_PA) { p0_transpose_item((const float*)a.in[10], DIL_OUT, D, (bf16*)(a.ws + WS_WPA), 0, scr, r, F.lane); continue; } r -= I_PA;
        if (r < I_PB) { p0_transpose_item((const float*)a.in[18], D, D, (bf16*)(a.ws + WS_WPB), 0, scr, r, F.lane); continue; } r -= I_PB;
        if (r < I_OUT) { p0_transpose_item((const float*)a.in[19], D, D, (bf16*)(a.ws + WS_WOUT), 0, scr, r, F.lane, MIX_KB); continue; } r -= I_OUT;
        p0_transpose_item((const float*)a.in[21], D, PEER_QW, (bf16*)(a.ws + WS_WQ), 0, scr, r, F.lane);
    }
    { const float* sk = (const float*)a.in[22]; bf16* o = (bf16*)(a.ws + WS_SK);
      for (int i = (F.vcu * NWAVES * 64 + F.tid); i < 8 * 2 * 128 * 128 / 8; i += F.G * NWAVES * 64) {
          const f32x4 v0 = *(const GAS f32x4*)(sk + (size_t)i * 8), v1 = *(const GAS f32x4*)(sk + (size_t)i * 8 + 4);
          v4u w; w.x = pk2(v0.x, v0.y); w.y = pk2(v0.z, v0.w); w.z = pk2(v1.x, v1.y); w.w = pk2(v1.z, v1.w);
          const int row = i >> 4, grp = i & 15, hh = row >> 7, n = row & 127;
          const size_t dst = ((((size_t)hh * 4 + (n >> 5)) * 8 + (grp >> 1)) * 64 + (grp & 1) * 32 + (n & 31)) * 8;
          *(GAS v4u*)(o + dst) = w; } }
}

__device__ __forceinline__ void convert_bf16(Frame& F, const float* src, bf16* dst, size_t n8) {
    for (size_t i = (size_t)F.vcu * NWAVES * 64 + F.tid; i < n8; i += (size_t)F.G * NWAVES * 64) {
        const f32x4 v0 = *(const GAS f32x4*)(src + i * 8), v1 = *(const GAS f32x4*)(src + i * 8 + 4);
        v4u w; w.x = pk2(v0.x, v0.y); w.y = pk2(v0.z, v0.w); w.z = pk2(v1.x, v1.y); w.w = pk2(v1.z, v1.w);
        *(GAS v4u*)(dst + i * 8) = w; }
}

typedef float f32x2v __attribute__((ext_vector_type(2)));
template <bool IS_V> __device__ __forceinline__ size_t expert_slice_off(int s) {
    if constexpr (!IS_V) return WS_EU + (size_t)s * (2 * MiB);
    else return s < 5 ? WS_EVA + (size_t)s * (2 * MiB) : WS_EVB + (size_t)(s - 5) * (2 * MiB);
}
template <bool IS_V> __device__ __forceinline__ void convert_fp8_row(const f32x4 (&v)[4], unsigned char* ws, float* scale, int e, int l) {
    float am = fmaxf(fmaxf(fmaxf(fabsf(v[0].x), fabsf(v[0].y)), fmaxf(fabsf(v[0].z), fabsf(v[0].w))), fmaxf(fmaxf(fabsf(v[1].x), fabsf(v[1].y)), fmaxf(fabsf(v[1].z), fabsf(v[1].w))));
    am = fmaxf(am, fmaxf(fmaxf(fmaxf(fabsf(v[2].x), fabsf(v[2].y)), fmaxf(fabsf(v[2].z), fabsf(v[2].w))), fmaxf(fmaxf(fabsf(v[3].x), fabsf(v[3].y)), fmaxf(fabsf(v[3].z), fabsf(v[3].w)))));
#pragma unroll
    for (int o = 1; o < 64; o <<= 1) am = fmaxf(am, __shfl_xor(am, o));
    const float sc = am > 0.f ? 256.0f / am : 1.0f;
    v4u w; unsigned ww[4];
#pragma unroll
    for (int j = 0; j < 4; ++j) { int t = __builtin_amdgcn_cvt_pk_fp8_f32(v[j].x * sc, v[j].y * sc, 0, false); t = __builtin_amdgcn_cvt_pk_fp8_f32(v[j].z * sc, v[j].w * sc, t, true); ww[j] = (unsigned)t; }
    w.x = ww[0]; w.y = ww[1]; w.z = ww[2]; w.w = ww[3];
    *(GAS v4u*)(ws + expert_slice_off<IS_V>(l >> 3) + (size_t)e * 128 + (l & 7) * 16) = w;
    if (l == 0) scale[e] = am > 0.f ? am * (1.0f / 256.0f) : 1.0f;
}
#ifndef CONV_R
#define CONV_R 2
#endif
__device__ __forceinline__ void convert_fp8_pack(const f32x4 (&v)[4], v4u& w, float& am_out) {
    float am = fmaxf(fmaxf(fmaxf(fabsf(v[0].x), fabsf(v[0].y)), fmaxf(fabsf(v[0].z), fabsf(v[0].w))), fmaxf(fmaxf(fabsf(v[1].x), fabsf(v[1].y)), fmaxf(fabsf(v[1].z), fabsf(v[1].w))));
    am = fmaxf(am, fmaxf(fmaxf(fmaxf(fabsf(v[2].x), fabsf(v[2].y)), fmaxf(fabsf(v[2].z), fabsf(v[2].w))), fmaxf(fmaxf(fabsf(v[3].x), fabsf(v[3].y)), fmaxf(fabsf(v[3].z), fabsf(v[3].w)))));
#pragma unroll
    for (int o = 1; o < 64; o <<= 1) am = fmaxf(am, __shfl_xor(am, o));
    const float sc = am > 0.f ? 256.0f / am : 1.0f;
    unsigned ww[4];
#pragma unroll
    for (int j = 0; j < 4; ++j) { int t = __builtin_amdgcn_cvt_pk_fp8_f32(v[j].x * sc, v[j].y * sc, 0, false); t = __builtin_amdgcn_cvt_pk_fp8_f32(v[j].z * sc, v[j].w * sc, t, true); ww[j] = (unsigned)t; }
    w.x = ww[0]; w.y = ww[1]; w.z = ww[2]; w.w = ww[3]; am_out = am;
}
template <bool IS_V> __device__ __forceinline__ void convert_fp8_rows(const float* src, unsigned char* ws, float* scale, int e_begin, int e_end, int worker, int nworkers, int l) {
    f32x4 v[CONV_R][4] = {};
    auto issue = [&](int e0) {
#pragma unroll
        for (int r = 0; r < CONV_R; ++r) if (e0 + r < e_end) { const GAS f32x4* rp = (const GAS f32x4*)(src + (size_t)(e0 + r) * 1024 + l * 16); v[r][0] = rp[0]; v[r][1] = rp[1]; v[r][2] = rp[2]; v[r][3] = rp[3]; } };
    { const int e0 = e_begin + CONV_R * worker; if (e0 < e_end) issue(e0); }
    for (int e0 = e_begin + CONV_R * worker; e0 < e_end; e0 += CONV_R * nworkers) {
        v4u w[CONV_R]; float am[CONV_R];
#pragma unroll
        for (int r = 0; r < CONV_R; ++r) { w[r] = (v4u){0u, 0u, 0u, 0u}; am[r] = 0.f; if (e0 + r < e_end) convert_fp8_pack(v[r], w[r], am[r]); }
        __builtin_amdgcn_sched_barrier(0);
        if (e0 + CONV_R * nworkers < e_end) issue(e0 + CONV_R * nworkers);
        __builtin_amdgcn_sched_barrier(0);
#pragma unroll
        for (int r = 0; r < CONV_R; ++r) if (e0 + r < e_end) { const int e = e0 + r;
            *(GAS v4u*)(ws + expert_slice_off<IS_V>(l >> 3) + (size_t)e * 128 + (l & 7) * 16) = w[r];
            if (l == 0) scale[e] = am[r] > 0.f ? am[r] * (1.0f / 256.0f) : 1.0f; }
    }
}
template <bool IS_V> __device__ __forceinline__ void convert_fp8_slices(Frame& F, const float* src, unsigned char* ws, float* scale, int e_begin = 0) {
    convert_fp8_rows<IS_V>(src, ws, scale, e_begin, NEXP, F.vcu * NWAVES + F.wave, F.G * NWAVES, F.lane);
}

template <bool FP8OUT>
__device__ __forceinline__ void norm_mod_rows(Frame& F, const float* xin, const float* g, const float* modp, int sh_off, int sc_off, bf16* out, const int* positions = nullptr, float* CS = nullptr, float* sA = nullptr, const bf16* delta = nullptr, unsigned char* h8 = nullptr, bf16* x1b = nullptr) {
    const int gw = F.vcu * NWAVES + F.wave, NGW = F.G * NWAVES;
    f32x4 gg[4];
#pragma unroll
    for (int j = 0; j < 4; ++j) gg[j] = ((const GAS f32x4*)g)[F.lane + 64 * j];
    f32x4 xv[4] = {}; u32x2 dv[4] = {};
    auto issue_row = [&](int m) {
        if (xin) { const GAS f32x4* xr = (const GAS f32x4*)(xin + (size_t)m * D) + F.lane;
#pragma unroll
            for (int j = 0; j < 4; ++j) xv[j] = xr[64 * j]; }
        if (delta) {
#pragma unroll
            for (int j = 0; j < 4; ++j) dv[j] = *((const GAS u32x2*)(delta + (size_t)m * D) + F.lane + 64 * j); } };
    if (gw < T) issue_row(gw);
    for (int m = gw; m < T; m += NGW) {
        const int b = m >> 12;
        f32x4 v[4]; float s = 0.f;
#pragma unroll
        for (int j = 0; j < 4; ++j) { v[j] = xin ? xv[j] : (f32x4){0.f, 0.f, 0.f, 0.f};
            if (delta) { const u32x2 dl = dv[j]; v[j].x += bflo(dl.x); v[j].y += bfhi(dl.x); v[j].z += bflo(dl.y); v[j].w += bfhi(dl.y); }
            s += (v[j].x * v[j].x + v[j].y * v[j].y) + (v[j].z * v[j].z + v[j].w * v[j].w);
            if (x1b) ((GAS unsigned long long*)(x1b + (size_t)m * D))[F.lane + 64 * j] = (unsigned long long)pk2(v[j].x, v[j].y) | ((unsigned long long)pk2(v[j].z, v[j].w) << 32); }
        f32x4 scv[4], shv[4];
        { const GAS f32x4* shq = (const GAS f32x4*)(modp + (size_t)b * 6144 + sh_off) + F.lane; const GAS f32x4* scq = (const GAS f32x4*)(modp + (size_t)b * 6144 + sc_off) + F.lane;
#pragma unroll
          for (int j = 0; j < 4; ++j) { scv[j] = scq[64 * j]; shv[j] = shq[64 * j]; } }
        __builtin_amdgcn_sched_barrier(0);
        if (m + NGW < T) { issue_row(m + NGW); __builtin_amdgcn_sched_barrier(0); }
        const float rstd = 1.f / sqrtf(wave_sum(s) * (1.f / D) + EPS);
        const GAS f32x4* shp = (const GAS f32x4*)(modp + (size_t)b * 6144 + sh_off) + F.lane;
        const GAS f32x4* scp = (const GAS f32x4*)(modp + (size_t)b * 6144 + sc_off) + F.lane;
        GAS unsigned long long* o8 = (GAS unsigned long long*)(out + (size_t)m * D) + F.lane;
        if constexpr (FP8OUT) {
            f32x4 y[4]; float am = 0.f;
#pragma unroll
            for (int j = 0; j < 4; ++j) { const f32x4 sc = scv[j], sh = shv[j]; y[j] = v[j] * rstd * gg[j] * (sc + 1.0f) + sh;
                am = fmaxf(am, fmaxf(fmaxf(fabsf(y[j].x), fabsf(y[j].y)), fmaxf(fabsf(y[j].z), fabsf(y[j].w)))); }
#pragma unroll
            for (int o = 1; o < 64; o <<= 1) am = fmaxf(am, __shfl_xor(am, o));
            const float qs = am > 0.f ? 240.0f / am : 1.0f;
            GAS unsigned* o4 = (GAS unsigned*)((unsigned char*)out + (size_t)m * D) + F.lane;
#pragma unroll
            for (int j = 0; j < 4; ++j) { int t = __builtin_amdgcn_cvt_pk_fp8_f32(y[j].x * qs, y[j].y * qs, 0, false); t = __builtin_amdgcn_cvt_pk_fp8_f32(y[j].z * qs, y[j].w * qs, t, true); o4[64 * j] = (unsigned)t; }
            if (F.lane == 0) sA[m] = am > 0.f ? am * (1.0f / 240.0f) : 1.0f;
        } else {
#pragma unroll
        for (int j = 0; j < 4; ++j) { const f32x4 sc = scv[j], sh = shv[j];
            const f32x4 y = v[j] * rstd * gg[j] * (sc + 1.0f) + sh;
            o8[64 * j] = (unsigned long long)pk2(y.x, y.y) | ((unsigned long long)pk2(y.z, y.w) << 32);
            if (h8) {
#define H8C(v) __builtin_amdgcn_fmed3f((v) * 16.f, -448.f, 448.f)
                int t = __builtin_amdgcn_cvt_pk_fp8_f32(H8C(y.x), H8C(y.y), 0, false); t = __builtin_amdgcn_cvt_pk_fp8_f32(H8C(y.z), H8C(y.w), t, true);
#undef H8C
                ((GAS unsigned*)(h8 + (size_t)m * D))[F.lane + 64 * j] = (unsigned)t; } }
        }
        if (CS) {
            constexpr float L2T = 13.287712379549449f / 32.f;
            const int i = F.lane & 31; const float ang = (float)positions[m] * exp2f(-(float)i * L2T);
            float sn, cs; sincosf(ang, &sn, &cs);
            CS[(size_t)m * 64 + F.lane] = (F.lane < 32) ? cs : sn; }
    }
}

template <int NIT>
__device__ __forceinline__ void normrope_buf(bf16* base, int hq, int dd, const float (&g)[4], float c0, float s0, float c1, float s1, float qs) {
    unsigned lo[NIT], hi[NIT];
#pragma unroll
    for (int it = 0; it < NIT; ++it) { const bf16* p = base + (it * 4 + hq) * 64 + dd; lo[it] = *(const GAS unsigned*)p; hi[it] = *(const GAS unsigned*)(p + 32); }
#pragma unroll
    for (int it = 0; it < NIT; ++it) {
        const float x1a = bflo(lo[it]), x1b = bfhi(lo[it]), x2a = bflo(hi[it]), x2b = bfhi(hi[it]);
        float ss = (x1a * x1a + x1b * x1b) + (x2a * x2a + x2b * x2b);
        ss += __shfl_xor(ss, 1); ss += __shfl_xor(ss, 2); ss += __shfl_xor(ss, 4); ss += __shfl_xor(ss, 8);
        const float rstd = 1.f / sqrtf(ss * (1.f / 64.f) + EPS);
        const float y1a = x1a * rstd * g[0], y1b = x1b * rstd * g[1], y2a = x2a * rstd * g[2], y2b = x2b * rstd * g[3];
        const float o1a = (y1a * c0 - y2a * s0) * qs, o2a = (y2a * c0 + y1a * s0) * qs;
        const float o1b = (y1b * c1 - y2b * s1) * qs, o2b = (y2b * c1 + y1b * s1) * qs;
        bf16* p = base + (it * 4 + hq) * 64 + dd;
        *(GAS unsigned*)p = pk2(o1a, o1b); *(GAS unsigned*)(p + 32) = pk2(o2a, o2b);
    }
}
__device__ __forceinline__ void p3_normrope(Frame& F, const Args& a) {
    const int gw = F.vcu * NWAVES + F.wave, NGW = F.G * NWAVES;
    const int sub = F.lane & 15, hq = F.lane >> 4, dd = 2 * sub;
    bf16* QA = (bf16*)(a.ws + WS_QA); bf16* KA = (bf16*)(a.ws + WS_KA); bf16* QB = (bf16*)(a.ws + WS_QB); bf16* KB = (bf16*)(a.ws + WS_KB);
    const int* positions = (const int*)a.in[2];
    float g[4][4];
    { const float* gp[4] = {(const float*)a.in[8], (const float*)a.in[9], (const float*)a.in[11], (const float*)a.in[12]};
#pragma unroll
      for (int i = 0; i < 4; ++i) { g[i][0] = gp[i][dd]; g[i][1] = gp[i][dd + 1]; g[i][2] = gp[i][dd + 32]; g[i][3] = gp[i][dd + 33]; } }
    constexpr float L2T = 13.287712379549449f / 32.f;
    const float f0 = exp2f(-(float)dd * L2T), f1 = exp2f(-(float)(dd + 1) * L2T);
    for (int t = gw; t < T; t += NGW) {
        const float pos = (float)positions[t];
        float s0, c0, s1, c1; sincosf(pos * f0, &s0, &c0); sincosf(pos * f1, &s1, &c1);
        normrope_buf<3>(QA + (size_t)t * 768, hq, dd, g[0], c0, s0, c1, s1, QSCALE);
        normrope_buf<3>(KA + (size_t)t * 768, hq, dd, g[1], c0, s0, c1, s1, 1.0f);
        normrope_buf<4>(QB + (size_t)t * 1024, hq, dd, g[2], c0, s0, c1, s1, QSCALE);
        normrope_buf<4>(KB + (size_t)t * 1024, hq, dd, g[3], c0, s0, c1, s1, 1.0f);
    }
}

__device__ __forceinline__ void p4_dilated(Frame& F, const Args& a) {
    constexpr int ROWB = 144;
    const bf16* QA = (const bf16*)(a.ws + WS_QA); const bf16* KA = (const bf16*)(a.ws + WS_KA); const bf16* VA = (const bf16*)(a.ws + WS_VA);
    bf16* OUTG = (bf16*)(a.ws + WS_OUTG); float* LSE = (float*)(a.ws + WS_LSE);
    LAS unsigned char* Ks = F.lds; LAS unsigned char* Vs = F.lds + 384 * ROWB;
    const int tid = F.tid, l = F.lane, qi = F.wave * 32 + (l & 31), hf = l >> 5;
    for (int u = F.vcu; u < 1536; u += F.G) {
        const int rc = u & 15, bh = u >> 4, head = bh % 12, b = bh / 12, g = head >> 2, hslot = head & 3;
        const int dsh = 2 * g, L = SEQ >> dsh, nchunk = L >> 8;
        const int r = rc / nchunk, chunk = rc % nchunk, j0 = chunk << 8;
#pragma unroll
        for (int p = 0; p < 6; ++p) { const int row = p * 64 + (tid >> 3), ch = tid & 7, jj = j0 - 64 + row;
            v4u kv = (v4u){0u, 0u, 0u, 0u}, vv = (v4u){0u, 0u, 0u, 0u};
            if ((unsigned)jj < (unsigned)L) { const size_t tok = (size_t)b * SEQ + r + ((size_t)jj << dsh);
                kv = *(const GAS v4u*)(KA + tok * 768 + head * 64 + ch * 8); vv = *(const GAS v4u*)(VA + tok * 768 + head * 64 + ch * 8); }
            *(LAS v4u*)(Ks + row * ROWB + ch * 16) = kv; *(LAS v4u*)(Vs + row * ROWB + ch * 16) = vv; }
        const int j = j0 + qi; const size_t qtok = (size_t)b * SEQ + r + ((size_t)j << dsh);
        unsigned q[32];
#pragma unroll
        for (int c = 0; c < 8; ++c) { const v4u t4 = *(const GAS v4u*)(QA + qtok * 768 + head * 64 + c * 8); q[4 * c] = t4.x; q[4 * c + 1] = t4.y; q[4 * c + 2] = t4.z; q[4 * c + 3] = t4.w; }
        __syncthreads();
        float m = -INFINITY, lsum = 0.f; float o[64];
#pragma unroll
        for (int i = 0; i < 64; ++i) o[i] = 0.f;
        const int rowbase = qi + hf * 64, nk = 64 + hf;
        for (int kk = 0; kk < nk; ++kk) {
            const int row = rowbase + kk, jj = j0 - 64 + row;
            if ((unsigned)jj < (unsigned)L) {
                const LAS v4u* kp = (const LAS v4u*)(Ks + row * ROWB);
                float s0 = 0.f, s1 = 0.f, s2 = 0.f, s3 = 0.f;
#pragma unroll
                for (int c = 0; c < 8; ++c) { const v4u kv = kp[c]; s0 = dot2bf(kv.x, q[4 * c], s0); s1 = dot2bf(kv.y, q[4 * c + 1], s1); s2 = dot2bf(kv.z, q[4 * c + 2], s2); s3 = dot2bf(kv.w, q[4 * c + 3], s3); }
                const float s = (s0 + s1) + (s2 + s3);
                if (s > m + 8.f) { const float f = exp2f(m - s); lsum *= f;
#pragma unroll
                    for (int i = 0; i < 64; ++i) o[i] *= f;
                    m = s; }
                const float p = exp2f(s - m); lsum += p;
                const LAS v4u* vp = (const LAS v4u*)(Vs + row * ROWB);
#pragma unroll
                for (int c = 0; c < 8; ++c) { const v4u vv = vp[c];
                    o[8 * c + 0] += p * bflo(vv.x); o[8 * c + 1] += p * bfhi(vv.x); o[8 * c + 2] += p * bflo(vv.y); o[8 * c + 3] += p * bfhi(vv.y);
                    o[8 * c + 4] += p * bflo(vv.z); o[8 * c + 5] += p * bfhi(vv.z); o[8 * c + 6] += p * bflo(vv.w); o[8 * c + 7] += p * bfhi(vv.w); }
            }
        }
        const float mo = __shfl_xor(m, 32), M = fmaxf(m, mo);
        const float f = exp2f(m - M);
        float lt = lsum * f; lt += __shfl_xor(lt, 32);
        const float inv = 1.f / lt;
        unsigned pk[16];
#pragma unroll
        for (int i = 0; i < 32; i += 2) {
            float a0 = o[i] * f, a1 = o[i + 1] * f, b0 = o[32 + i] * f, b1 = o[33 + i] * f;
            a0 += __shfl_xor(a0, 32); a1 += __shfl_xor(a1, 32); b0 += __shfl_xor(b0, 32); b1 += __shfl_xor(b1, 32);
            pk[i >> 1] = hf ? pk2(b0 * inv, b1 * inv) : pk2(a0 * inv, a1 * inv);
        }
        bf16* op = OUTG + ((size_t)g * T + qtok) * 256 + hslot * 64 + hf * 32;
#pragma unroll
        for (int c = 0; c < 4; ++c) *(GAS v4u*)(op + c * 8) = (v4u){pk[4 * c], pk[4 * c + 1], pk[4 * c + 2], pk[4 * c + 3]};
        if (hf == 0) LSE[((size_t)g * T + qtok) * 4 + hslot] = M + log2f(lt);
        __syncthreads();
    }
}

__device__ __forceinline__ void p3_vt8(Frame& F, const Args& a) {
    const unsigned char* VB8 = (const unsigned char*)(a.ws + WS_VB); unsigned char* VT8 = (unsigned char*)(a.ws + WS_VT8);
    LAS unsigned char* img = F.lds + F.wave * 8192;
    const int l = F.lane;
    v4u rr[8] = {};
    auto issue_tile = [&](int u) { const int tile = u & 63, bh = u >> 6, h = bh & 7, b = bh >> 3;
        const unsigned char* src = VB8 + ((size_t)b * SEQ + tile * 64) * 1024 + h * 128;
#pragma unroll
        for (int i = 0; i < 8; ++i) { const int key = i * 8 + (l >> 3), ch = l & 7;
            rr[i] = *(const GAS v4u*)(src + (size_t)key * 1024 + ch * 16); } };
    { const int u0 = F.vcu * NWAVES + F.wave; if (u0 < BATCH * 8 * 64) issue_tile(u0); }
    for (int u = F.vcu * NWAVES + F.wave; u < BATCH * 8 * 64; u += F.G * NWAVES) {
        const int tile = u & 63, bh = u >> 6;
#pragma unroll
        for (int i = 0; i < 8; ++i) { const int key = i * 8 + (l >> 3), ch = l & 7; *(LAS v4u*)(img + key * 128 + ch * 16) = rr[i]; }
        LDS_WAIT(); asm volatile("" ::: "memory");
        if (u + F.G * NWAVES < BATCH * 8 * 64) { issue_tile(u + F.G * NWAVES); __builtin_amdgcn_sched_barrier(0); }
#pragma unroll
        for (int dd = 0; dd < 2; ++dd) { const int d = l + 64 * dd;
            unsigned w[16];
#pragma unroll
            for (int j = 0; j < 16; ++j) { unsigned x = 0;
#pragma unroll
                for (int e = 0; e < 4; ++e) { const int pp = 4 * j + e; const int key = 32 * ((pp >> 4) & 1) + 8 * ((pp & 15) >> 2) + 4 * (pp >> 5) + (pp & 3);
                    x |= (unsigned)img[key * 128 + d] << (8 * e); }
                w[j] = x; }
            unsigned char* dst = VT8 + ((size_t)bh * 64 + tile) * 8192 + d * 64;
#pragma unroll
            for (int c = 0; c < 4; ++c) *(GAS v4u*)(dst + c * 16) = (v4u){w[4 * c], w[4 * c + 1], w[4 * c + 2], w[4 * c + 3]}; }
        LDS_WAIT(); asm volatile("" ::: "memory");
    }
}

__device__ __forceinline__ void p6_combine(Frame& F, const Args& a) {
    const int gw = F.vcu * NWAVES + F.wave, NGW = F.G * NWAVES, l = F.lane;
    const bf16* OUTG = (const bf16*)(a.ws + WS_OUTG); const float* LSE = (const float*)(a.ws + WS_LSE);
    bf16* OA = (bf16*)(a.ws + WS_OA);
    const int hslot = l >> 4, d4 = (l & 15) * 4;
    float ls[3] = {0.f, 0.f, 0.f}; u32x2 vv[3] = {};
    auto issue_tok = [&](int t) {
#pragma unroll
        for (int g = 0; g < 3; ++g) { ls[g] = LSE[((size_t)g * T + t) * 4 + hslot]; vv[g] = *(const GAS u32x2*)(OUTG + ((size_t)g * T + t) * 256 + hslot * 64 + d4); } };
    if (gw < T) issue_tok(gw);
    for (int t = gw; t < T; t += NGW) {
        const float M = fmaxf(fmaxf(ls[0], ls[1]), ls[2]);
        float acc0 = 0.f, acc1 = 0.f, acc2 = 0.f, acc3 = 0.f, wsum = 0.f;
#pragma unroll
        for (int g = 0; g < 3; ++g) { const float w = exp2f(ls[g] - M); wsum += w; const u32x2 v = vv[g];
            acc0 += w * bflo(v.x); acc1 += w * bfhi(v.x); acc2 += w * bflo(v.y); acc3 += w * bfhi(v.y); }
        const float iw = 1.f / wsum;
        u32x2 w2; w2.x = pk2(acc0 * iw, acc1 * iw); w2.y = pk2(acc2 * iw, acc3 * iw);
        __builtin_amdgcn_sched_barrier(0);
        if (t + NGW < T) issue_tok(t + NGW);
        __builtin_amdgcn_sched_barrier(0);
        *(GAS u32x2*)(OA + (size_t)t * 256 + hslot * 64 + d4) = w2;
    }
}

#ifndef IDLE_PREFETCH
#define IDLE_PREFETCH 0
#endif
#ifndef PF_STEP_TICKS
#define PF_STEP_TICKS 120
#endif
__device__ __forceinline__ void l2_prefetch_operands(const Frame& F, const char* A, const char* Bt, int pitchA, int pitchB) {
    const int x = (int)blockIdx.x & 7, j = ((int)blockIdx.x - 128) >> 3;
    const int g = j * (NWAVES * 64) + F.tid;
    const char* p = nullptr;
    if (g < 2048) p = A + (size_t)(2048 * (x >> 1) + g) * pitchA;
    else if (g < 2560) p = Bt + (size_t)(512 * (x & 1) + (g - 2048)) * pitchB;
    if (!p) return;
    const unsigned long long t0 = __builtin_amdgcn_s_memrealtime();
    unsigned d_ = 0;
    for (int kt = 0; kt < pitchA / 128; ++kt) {
        while (__builtin_amdgcn_s_memrealtime() - t0 < (unsigned long long)(kt * PF_STEP_TICKS)) __builtin_amdgcn_s_sleep(8);
        asm volatile("global_load_dword %0, %1, off" : "+v"(d_) : "v"(p + kt * 128) : "memory");
    }
    asm volatile("s_waitcnt vmcnt(0)" : "+v"(d_) :: "memory");
}

#define CE_DESC(a, b) do { const float hi_ = fmaxf(a, b), lo_ = fminf(a, b); a = hi_; b = lo_; } while (0)
#define CE_ASC(a, b)  do { const float hi_ = fmaxf(a, b), lo_ = fminf(a, b); a = lo_; b = hi_; } while (0)
template <int N> __device__ __forceinline__ void bitonic_sort_desc(float (&v)[N]) {
#pragma unroll
    for (int k = 2; k <= N; k <<= 1)
#pragma unroll
        for (int j = k >> 1; j > 0; j >>= 1)
#pragma unroll
            for (int i = 0; i < N; ++i) { const int l = i ^ j; if (l > i) { if ((i & k) == 0) CE_DESC(v[i], v[l]); else CE_ASC(v[i], v[l]); } }
}
template <int X> __device__ __forceinline__ void merge_top16(float (&a)[16]) {
    float c[16];
#pragma unroll
    for (int i = 0; i < 16; ++i) c[i] = fmaxf(a[i], __shfl_xor(a[15 - i], X));
#pragma unroll
    for (int j = 8; j > 0; j >>= 1)
#pragma unroll
        for (int i = 0; i < 16; ++i) { const int l = i ^ j; if (l > i) CE_DESC(c[i], c[l]); }
#pragma unroll
    for (int i = 0; i < 16; ++i) a[i] = c[i];
}
template <int X> __device__ __forceinline__ void merge_8_8(const float (&a)[8], float (&c)[16]) {
#pragma unroll
    for (int i = 0; i < 8; ++i) { c[i] = a[i]; c[8 + i] = __shfl_xor(a[7 - i], X); }
#pragma unroll
    for (int j = 8; j > 0; j >>= 1)
#pragma unroll
        for (int i = 0; i < 16; ++i) { const int l = i ^ j; if (l > i) CE_DESC(c[i], c[l]); }
}
struct P11Frags { bf16x8 a0[8], a1[8], b[8]; };
__device__ __forceinline__ void p11_load_a(P11Frags& R, const bf16* QF, int u, int w, int l) {
    const int h = u & 7, rb = (u >> 3) * 2, half = w >> 2;
    const bf16* ap0 = QF + ((((size_t)(rb * 8 + h) * 2 + half) * 8) * 64 + l) * 8;
    const bf16* ap1 = QF + ((((size_t)((rb + 1) * 8 + h) * 2 + half) * 8) * 64 + l) * 8;
#pragma unroll
    for (int s = 0; s < 8; ++s) { R.a0[s] = *(const GAS bf16x8*)(ap0 + s * 512); R.a1[s] = *(const GAS bf16x8*)(ap1 + s * 512); }
}
__device__ __forceinline__ void p11_load_b(P11Frags& R, const bf16* SKF, int h, int w, int l) {
    const int half = w >> 2, kt = w & 3;
    const bf16* bp = SKF + ((((size_t)(h * 2 + half) * 4 + kt) * 8) * 64 + l) * 8;
#pragma unroll
    for (int s = 0; s < 8; ++s) R.b[s] = *(const GAS bf16x8*)(bp + s * 512);
}
__device__ __forceinline__ void p11_peer_topk(Frame& F, const Args& a) {
    constexpr int RS = 132;
    const bf16* QF = (const bf16*)(a.ws + WS_QP); const bf16* SKF = (const bf16*)(a.ws + WS_SK);
    int* IDX = (int*)(a.ws + WS_IDX); float* GATE = (float*)(a.ws + WS_GATE);
    LAS float* sc = (LAS float*)F.lds;
    LAS float* tv = (LAS float*)(F.lds + 67584);
    LAS unsigned char* tab = (LAS unsigned char*)(F.lds + 67584 + 8192);
    const int tid = F.tid, l = F.lane, w = F.wave;
    if (tid < 64) {
        int q = tid, ci = 255, n = 0;
        for (int i = 0; i < 16; ++i) for (int j = 0; j < 16; ++j) if ((i + 1) * (j + 1) <= 16) { if (n == q) ci = i * 16 + j; ++n; }
        tab[tid] = (unsigned char)ci;
    }
    __syncthreads();
#define LDS_BAR() do { asm volatile("s_waitcnt lgkmcnt(0)" ::: "memory"); __builtin_amdgcn_s_barrier(); asm volatile("" ::: "memory"); } while (0)
#ifdef PROBE11
    const int pm_ = a.pad;
#else
    constexpr int pm_ = 0;
#endif
    P11Frags R;
    int hcur = F.vcu & 7;
    if (F.vcu < 4096) { p11_load_b(R, SKF, hcur, w, l); p11_load_a(R, QF, F.vcu, w, l); }
    const bool vride = V_IN_P11 && (F.G * NWAVES * 8 == NEXP);
    int it_ = 0; f32x4 cv[4] = {};
    for (int u = F.vcu; u < 4096; u += F.G, ++it_) {
        const int h = u & 7, t0 = (u >> 3) * 64;
        if (h != hcur) { hcur = h; p11_load_b(R, SKF, h, w, l); }
        if (!(pm_ & 4)) {   const int half = w >> 2, kt = w & 3, r32 = l & 31, hi = l >> 5;
            f32x16 acc0, acc1;
#pragma unroll
            for (int i = 0; i < 16; ++i) { acc0[i] = 0.f; acc1[i] = 0.f; }
#pragma unroll
            for (int s = 0; s < 8; ++s) {
                acc0 = __builtin_amdgcn_mfma_f32_32x32x16_bf16(R.a0[s], R.b[s], acc0, 0, 0, 0);
                acc1 = __builtin_amdgcn_mfma_f32_32x32x16_bf16(R.a1[s], R.b[s], acc1, 0, 0, 0);
            }
#pragma unroll
            for (int r = 0; r < 16; ++r) { const int row = (r & 3) + 8 * (r >> 2) + 4 * hi;
                sc[(half * 64 + row) * RS + kt * 32 + r32] = acc0[r]; sc[(half * 64 + 32 + row) * RS + kt * 32 + r32] = acc1[r]; }
        }
        if (u + F.G < 4096) p11_load_a(R, QF, u + F.G, w, l);
        if (vride && it_ >= 1 && it_ <= 8) convert_fp8_row<true>(cv, a.ws, (float*)(a.ws + WS_ESC) + NEXP, ((it_ - 1) * (int)F.G + (int)F.vcu) * NWAVES + w, l);
        if (vride && it_ < 8) { const int ce = (it_ * (int)F.G + (int)F.vcu) * NWAVES + w;
            const GAS f32x4* rp = (const GAS f32x4*)((const float*)a.in[24] + (size_t)ce * 1024 + l * 16); cv[0] = rp[0]; cv[1] = rp[1]; cv[2] = rp[2]; cv[3] = rp[3]; }
        __builtin_amdgcn_sched_barrier(0);
        LDS_BAR();
        if (!(pm_ & 1)) {
            const int row = tid >> 2, part = tid & 3;
            float v[32];
#pragma unroll
            for (int k = 0; k < 32; ++k) v[k] = __uint_as_float((__float_as_uint(sc[row * RS + 4 * k + part]) & ~0x7Fu) | (unsigned)(127 - (4 * k + part)));
            bitonic_sort_desc<32>(v);
            float t16[16];
#pragma unroll
            for (int i = 0; i < 16; ++i) t16[i] = v[i];
            merge_top16<1>(t16); merge_top16<2>(t16);
            if (part == 0) {
#pragma unroll
                for (int i = 0; i < 4; ++i) *(LAS f32x4*)(tv + row * 16 + 4 * i) = (f32x4){t16[4 * i], t16[4 * i + 1], t16[4 * i + 2], t16[4 * i + 3]}; }
        }
        LDS_BAR();
        if (!(pm_ & 2)) {
            const int tok = tid >> 3, part = tid & 7;
            float c8[8];
#pragma unroll
            for (int k = 0; k < 8; ++k) { const int ci = tab[part * 8 + k]; const int ii = (ci >> 4) & 15, jj = ci & 15;
                const float sum = tv[tok * 16 + ii] + tv[(64 + tok) * 16 + jj];
                c8[k] = (ci == 255) ? -INFINITY : __uint_as_float((__float_as_uint(sum) & ~0xFFu) | (unsigned)(255 - ci)); }
            bitonic_sort_desc<8>(c8);
            float c[16];
            merge_8_8<1>(c8, c); merge_top16<2>(c); merge_top16<4>(c);
            const float mx = c[0]; float den = 0.f;
#pragma unroll
            for (int k = 0; k < 16; ++k) den += __expf(c[k] - mx);
            const float iden = 1.f / den;
            int ev[2]; float gv[2];
#pragma unroll
            for (int kk = 0; kk < 2; ++kk) {
                float val = c[0];
#pragma unroll
                for (int k = 0; k < 16; ++k) val = (k == part * 2 + kk) ? c[k] : val;
                const int ci = 255 - (int)(__float_as_uint(val) & 0xFFu);
                const int e1 = 127 - (int)(__float_as_uint(tv[tok * 16 + (ci >> 4)]) & 0x7Fu), e2 = 127 - (int)(__float_as_uint(tv[(64 + tok) * 16 + (ci & 15)]) & 0x7Fu);
                ev[kk] = e1 * 128 + e2; gv[kk] = __expf(val - mx) * iden; }
            if (pm_ == 0) {
                const size_t o = ((size_t)h * T + t0 + tok) * 16 + 2 * part;
                *(GAS u32x2*)(IDX + o) = (u32x2){(unsigned)ev[0], (unsigned)ev[1]}; *(GAS f32x2v*)(GATE + o) = (f32x2v){gv[0], gv[1]}; }
            else if (pm_ & 8) { if (ev[0] == 12345 && gv[1] == 7.f) IDX[0] = ev[1]; }
        }
        LDS_BAR();
    }
}

#undef LDS_BAR
typedef int v4i __attribute__((ext_vector_type(4)));
__device__ __forceinline__ float gelu_erf(float x) { return 0.5f * x * (1.0f + erff(x * 0.70710678118654752f)); }
__device__ __forceinline__ float xl_swap32_sum(float a, float b) { const auto r = __builtin_amdgcn_permlane32_swap(__float_as_uint(a), __float_as_uint(b), false, false); return __uint_as_float(r[0]) + __uint_as_float(r[1]); }
__device__ __forceinline__ float xl_swap16_sum(float a, float b) { const auto r = __builtin_amdgcn_permlane16_swap(__float_as_uint(a), __float_as_uint(b), false, false); return __uint_as_float(r[0]) + __uint_as_float(r[1]); }
template <int CTRL> __device__ __forceinline__ float xl_dpp(float v) { return __int_as_float(__builtin_amdgcn_update_dpp(0, __float_as_int(v), CTRL, 0xf, 0xf, true)); }
__device__ __forceinline__ float xl_xor4(float v) { return __int_as_float(__builtin_amdgcn_ds_swizzle(__float_as_int(v), 0x101F)); }
struct GBuf { v4u r[16]; v4u h0, h1; unsigned dl; f32x2v xv, gv; };
__device__ __forceinline__ v4u h_stage_load(const bf16* H2, int tbase, int grp, int l) {
    return __builtin_nontemporal_load((const GAS v4u*)(H2 + (size_t)(tbase + 4 * (grp & 3) + (l >> 4)) * 1024 + (grp >> 2) * 128 + (l & 15) * 8));
}
template <bool WITH_H> __device__ __forceinline__ void peer_issue(GBuf& B, const unsigned char* tab, const LAS unsigned char* H2, const LAS int* il, int tbase, int it, int g, int c) {
    const int s = it >> 4, tt = it & 15;
    const LAS v4i* ip = (const LAS v4i*)(il + tt * 128 + g * 16);
    const v4i i0 = ip[0], i1 = ip[1], i2 = ip[2], i3 = ip[3];
    const int e[16] = {i0.x, i0.y, i0.z, i0.w, i1.x, i1.y, i1.z, i1.w, i2.x, i2.y, i2.z, i2.w, i3.x, i3.y, i3.z, i3.w};
    const unsigned char* ts = tab + expert_slice_off<!WITH_H>(s);
    if (WITH_H) { const LAS unsigned char* hs = (const LAS unsigned char*)H2 + (it & 3) * 256 + c * 32; B.h0 = *(const LAS v4u*)hs; B.h1 = *(const LAS v4u*)(hs + 16); }
#pragma unroll
    for (int i = 0; i < 16; ++i) { B.r[i] = *(const GAS v4u*)(ts + (((unsigned)e[i] << 7) | (unsigned)(c * 16))); __builtin_amdgcn_sched_barrier(0); }
}
template <bool REFILL, int PH> __device__ __forceinline__ void peer_u_compute(GBuf& B, LAS float* wl, int it, int g, int c, v4u& hreg, LAS unsigned char* hst, const unsigned char* tab = nullptr, const bf16* H2 = nullptr, const LAS int* il = nullptr, int tbase = 0, int itn = 0, bool stage_next = false) {
    const int tt = it & 15;
    const unsigned hw[8] = {B.h0.x, B.h0.y, B.h0.z, B.h0.w, B.h1.x, B.h1.y, B.h1.z, B.h1.w};
    int en[16]; const unsigned char* tsn = nullptr;
    if constexpr (REFILL) { const LAS v4i* ip = (const LAS v4i*)(il + (itn & 15) * 128 + g * 16); const v4i i0 = ip[0], i1 = ip[1], i2 = ip[2], i3 = ip[3];
        en[0] = i0.x; en[1] = i0.y; en[2] = i0.z; en[3] = i0.w; en[4] = i1.x; en[5] = i1.y; en[6] = i1.z; en[7] = i1.w; en[8] = i2.x; en[9] = i2.y; en[10] = i2.z; en[11] = i2.w; en[12] = i3.x; en[13] = i3.y; en[14] = i3.z; en[15] = i3.w;
        tsn = tab + expert_slice_off<false>(itn >> 4); }
    if constexpr (REFILL) { __builtin_amdgcn_sched_barrier(0);
        if constexpr (PH == 0) { if (stage_next) hreg = h_stage_load(H2, tbase, (it >> 2) + 1, g * 8 + c); }
        if constexpr (PH == 2) *(LAS v4u*)(hst + (g * 8 + c) * 16) = hreg;
        const LAS unsigned char* hs = hst + (itn & 3) * 256 + c * 32; B.h0 = *(const LAS v4u*)hs; B.h1 = *(const LAS v4u*)(hs + 16);
        __builtin_amdgcn_sched_barrier(0); }
    float d[16];
#pragma unroll
    for (int i = 0; i < 16; i += 4) {
#pragma unroll
        for (int j = 0; j < 4; ++j) {
            unsigned tl[4], th[4];
#pragma unroll
            for (int r = 0; r < 4; ++r) { const unsigned w_ = j == 0 ? B.r[i + r].x : j == 1 ? B.r[i + r].y : j == 2 ? B.r[i + r].z : B.r[i + r].w;
                tl[r] = __builtin_bit_cast(unsigned, __builtin_amdgcn_cvt_scalef32_pk_bf16_fp8(w_, 1.0f, false)); th[r] = __builtin_bit_cast(unsigned, __builtin_amdgcn_cvt_scalef32_pk_bf16_fp8(w_, 1.0f, true)); }
#pragma unroll
            for (int r = 0; r < 4; ++r) { if (j == 0) asm volatile("v_dot2_f32_bf16 %0, %1, %2, 0" : "=v"(d[i + r]) : "v"(tl[r]), "v"(hw[0]));
                                          else asm volatile("v_dot2c_f32_bf16 %0, %1, %2" : "+v"(d[i + r]) : "v"(tl[r]), "v"(hw[2 * j])); }
#pragma unroll
            for (int r = 0; r < 4; ++r) asm volatile("v_dot2c_f32_bf16 %0, %1, %2" : "+v"(d[i + r]) : "v"(th[r]), "v"(hw[2 * j + 1]));
        }
        if constexpr (REFILL) { __builtin_amdgcn_sched_barrier(0);
#pragma unroll
            for (int r = 0; r < 4; ++r) B.r[i + r] = *(const GAS v4u*)(tsn + (((unsigned)en[i + r] << 7) | (unsigned)(c * 16)));
            __builtin_amdgcn_sched_barrier(0); }
    }
    const bool u4 = (c & 4) != 0, u2 = (c & 2) != 0, u1 = (c & 1) != 0;
    float r8[8], r4[4], r2[2];
#pragma unroll
    for (int j = 0; j < 8; ++j) { const float keep = u4 ? d[8 + j] : d[j], send = u4 ? d[j] : d[8 + j]; r8[j] = keep + xl_xor4(send); }
#pragma unroll
    for (int j = 0; j < 4; ++j) { const float keep = u2 ? r8[4 + j] : r8[j], send = u2 ? r8[j] : r8[4 + j]; r4[j] = keep + xl_dpp<0x4E>(send); }
#pragma unroll
    for (int j = 0; j < 2; ++j) { const float keep = u1 ? r4[2 + j] : r4[j], send = u1 ? r4[j] : r4[2 + j]; r2[j] = keep + xl_dpp<0xB1>(send); }
    LAS f32x2v* wp = (LAS f32x2v*)(wl + tt * 128 + g * 16 + 2 * c);
    f32x2v cur = *wp; cur.x += r2[0]; cur.y += r2[1]; *wp = cur;
}
typedef int v8i32p __attribute__((ext_vector_type(8)));
struct MBuf { v4u r[16]; };
__device__ __forceinline__ void peer4_offsets(unsigned (&off)[16], const LAS int* il, int it, int r, int c) {
    const LAS v4i* ip = (const LAS v4i*)(il + (it & 15) * 128 + r * 16);
    const v4i i0 = ip[0], i1 = ip[1], i2 = ip[2], i3 = ip[3];
    const int e[16] = {i0.x, i0.y, i0.z, i0.w, i1.x, i1.y, i1.z, i1.w, i2.x, i2.y, i2.z, i2.w, i3.x, i3.y, i3.z, i3.w};
#pragma unroll
    for (int k = 0; k < 16; ++k) off[k] = ((unsigned)e[k] << 7) | (unsigned)(c * 16);
}
__device__ __forceinline__ v4u h8_stage_load(const unsigned char* H8, int tbase, int grp, int l) {
    return __builtin_nontemporal_load((const GAS v4u*)(H8 + (size_t)(tbase + 4 * (grp & 3) + ((l >> 3) & 3)) * 1024 + (grp >> 2) * 128 + (l & 7) * 16));
}
template <bool REFILL, int PH> __device__ __forceinline__ void peer4_step(MBuf& B, LAS float* wl, int it, int l, v4u& hreg, LAS unsigned char* hst, LAS unsigned char* tile,
                                                                           const unsigned char* tab = nullptr, const unsigned char* H8 = nullptr, const LAS int* il = nullptr, int tbase = 0, int itn = 0, bool stage_next = false) {
    const int tt = it & 15, r = l >> 3, c = l & 7, i = l & 15, q = l >> 4;
    const LAS unsigned char* hs = hst + (it & 3) * 128 + q * 32; const v4u h0 = *(const LAS v4u*)hs, h1 = *(const LAS v4u*)(hs + 16);
    const v8i32p hop = (v8i32p){(int)h0.x, (int)h0.y, (int)h0.z, (int)h0.w, (int)h1.x, (int)h1.y, (int)h1.z, (int)h1.w};
    unsigned off[16]; const unsigned char* tsn = nullptr;
    if constexpr (REFILL) { peer4_offsets(off, il, itn, r, c); tsn = tab + (size_t)(itn >> 4) * NEXP * 128;
        if constexpr (PH == 0) { if (stage_next) hreg = h8_stage_load(H8, tbase, (it >> 2) + 1, l); } }
    LAS unsigned char* w0 = tile + r * 128 + ((c ^ ((r >> 1) & 7)) * 16); LAS unsigned char* w1 = tile + (8 + r) * 128 + ((c ^ (((8 + r) >> 1) & 7)) * 16);
    const LAS unsigned char* r0 = tile + i * 128 + (((2 * q) ^ ((i >> 1) & 7)) * 16); const LAS unsigned char* r1 = tile + i * 128 + (((2 * q + 1) ^ ((i >> 1) & 7)) * 16);
    float acc[8];
    *(LAS v4u*)w0 = B.r[0]; *(LAS v4u*)w1 = B.r[1];
    v4u x0 = *(const LAS v4u*)r0, x1 = *(const LAS v4u*)r1;
#pragma unroll
    for (int G = 0; G < 8; ++G) {
        v4u n0 = x0, n1 = x1;
        if (G < 7) { *(LAS v4u*)w0 = B.r[2 * G + 2]; *(LAS v4u*)w1 = B.r[2 * G + 3]; n0 = *(const LAS v4u*)r0; n1 = *(const LAS v4u*)r1; }
        if constexpr (REFILL) { __builtin_amdgcn_sched_barrier(0); B.r[2 * G] = *(const GAS v4u*)(tsn + off[2 * G]); B.r[2 * G + 1] = *(const GAS v4u*)(tsn + off[2 * G + 1]); __builtin_amdgcn_sched_barrier(0); }
        const v8i32p xop = (v8i32p){(int)x0.x, (int)x0.y, (int)x0.z, (int)x0.w, (int)x1.x, (int)x1.y, (int)x1.z, (int)x1.w};
        const f32x4 D = __builtin_amdgcn_mfma_scale_f32_16x16x128_f8f6f4(hop, xop, (f32x4){0.f, 0.f, 0.f, 0.f}, 0, 0, 0, 0x7F7F7F7F, 0, 0x7F7F7F7F);
        float d0 = D[0]; asm volatile("" : "+v"(d0));
        acc[G] = d0; x0 = n0; x1 = n1;
    }
    if constexpr (REFILL && PH == 3) { if (l < 32) *(LAS v4u*)(hst + l * 16) = hreg; }
    if (q == 0) {
#pragma unroll
        for (int G = 0; G < 8; ++G) wl[tt * 128 + G * 16 + i] += acc[G]; }
}
#if V_STAGE
#define VRES_T const LAS unsigned char*
__device__ __forceinline__ void x1_stage_load(v4u (&vreg)[2], const bf16* X1B, int tbase, int grp8, int l) {
    const bf16* p_ = X1B + (size_t)(tbase + 8 * (grp8 & 1) + (l >> 3)) * 1024 + (grp8 >> 1) * 128 + (l & 7) * 16;
    vreg[0] = __builtin_nontemporal_load((const GAS v4u*)p_); vreg[1] = __builtin_nontemporal_load((const GAS v4u*)(p_ + 8));
}
__device__ __forceinline__ void peer_v_resid(GBuf& B, const float* modp, const LAS unsigned char* vst, const bf16*, int tbase, int it, int g, int c) {
    const int s = it >> 4, t = tbase + (it & 15); const int b = t >> 12; const int col = s * 128 + c * 16 + 2 * g;
    B.gv = *(const GAS f32x2v*)(modp + (size_t)b * 6144 + 5120 + col);
    B.dl = *(const LAS unsigned*)(vst + (it & 7) * 256 + c * 32 + 4 * g); B.xv = (f32x2v){0.f, 0.f};
    __builtin_amdgcn_sched_barrier(0);
}
#else
#define VRES_T const float*
__device__ __forceinline__ void peer_v_resid(GBuf& B, const float* modp, const float* xin, const bf16* delta, int tbase, int it, int g, int c) {
    const int s = it >> 4, t = tbase + (it & 15); const int b = t >> 12; const int col = s * 128 + c * 16 + 2 * g;
    B.gv = *(const GAS f32x2v*)(modp + (size_t)b * 6144 + 5120 + col);
    B.xv = X1_BF16 ? (f32x2v){0.f, 0.f} : __builtin_nontemporal_load((const GAS f32x2v*)(xin + (size_t)t * 1024 + col)); B.dl = __builtin_nontemporal_load((const GAS unsigned*)(delta + (size_t)t * 1024 + col));
    __builtin_amdgcn_sched_barrier(0);
}
#endif
template <bool REFILL> __device__ __forceinline__ void peer_v_compute(GBuf& B, const LAS float* wl, float* out, const float* modp, VRES_T xin, const bf16* delta, int tbase, int it, int g, int c, const unsigned char* tab = nullptr, const LAS int* il = nullptr, int itn = 0) {
    const int s = it >> 4, tt = it & 15, t = tbase + tt;
    int en[16]; const unsigned char* tsn = nullptr;
    if constexpr (REFILL) { const LAS v4i* ip = (const LAS v4i*)(il + (itn & 15) * 128 + g * 16); const v4i i0 = ip[0], i1 = ip[1], i2 = ip[2], i3 = ip[3];
        en[0] = i0.x; en[1] = i0.y; en[2] = i0.z; en[3] = i0.w; en[4] = i1.x; en[5] = i1.y; en[6] = i1.z; en[7] = i1.w; en[8] = i2.x; en[9] = i2.y; en[10] = i2.z; en[11] = i2.w; en[12] = i3.x; en[13] = i3.y; en[14] = i3.z; en[15] = i3.w;
        tsn = tab + expert_slice_off<true>(itn >> 4); }
    const int col = s * 128 + c * 16 + 2 * g;
    GAS f32x2v* op = (GAS f32x2v*)(out + (size_t)t * 1024 + col);
    const LAS f32x4* wp = (const LAS f32x4*)(wl + tt * 128 + g * 16);
    const f32x4 w0 = wp[0], w1 = wp[1], w2 = wp[2], w3 = wp[3];
    const float w[16] = {w0.x, w0.y, w0.z, w0.w, w1.x, w1.y, w1.z, w1.w, w2.x, w2.y, w2.z, w2.w, w3.x, w3.y, w3.z, w3.w};
    f32x2v o2[8];
#pragma unroll
    for (int j = 0; j < 8; ++j) o2[j] = (f32x2v){0.f, 0.f};
#pragma unroll
    for (int i = 0; i < 16; ++i) {
        const unsigned vw[4] = {B.r[i].x, B.r[i].y, B.r[i].z, B.r[i].w}; const f32x2v ww = (f32x2v){w[i], w[i]};
#pragma unroll
        for (int j = 0; j < 4; ++j) {
            o2[2 * j] = __builtin_elementwise_fma(__builtin_amdgcn_cvt_pk_f32_fp8((int)vw[j], false), ww, o2[2 * j]);
            o2[2 * j + 1] = __builtin_elementwise_fma(__builtin_amdgcn_cvt_pk_f32_fp8((int)vw[j], true), ww, o2[2 * j + 1]); }
#ifdef PROBE_V2X
        {   f32x2v zw_ = (f32x2v){0.f, 0.f}; asm volatile("" : "+v"(zw_));
#pragma unroll
            for (int j = 0; j < 4; ++j) {
                o2[2 * j] = __builtin_elementwise_fma(__builtin_amdgcn_cvt_pk_f32_fp8((int)vw[j], false), zw_, o2[2 * j]);
                o2[2 * j + 1] = __builtin_elementwise_fma(__builtin_amdgcn_cvt_pk_f32_fp8((int)vw[j], true), zw_, o2[2 * j + 1]); } }
#endif
        if constexpr (REFILL) { __builtin_amdgcn_sched_barrier(0); B.r[i] = *(const GAS v4u*)(tsn + (((unsigned)en[i] << 7) | (unsigned)(c * 16))); __builtin_amdgcn_sched_barrier(0); }
    }
    float o[16];
#pragma unroll
    for (int j = 0; j < 8; ++j) { o[2 * j] = o2[j].x; o[2 * j + 1] = o2[j].y; }
    const bool u1 = (g & 1) != 0;
    float r8[8], r4[4], r2[2];
#pragma unroll
    for (int j = 0; j < 8; ++j) r8[j] = xl_swap32_sum(o[j], o[8 + j]);
#pragma unroll
    for (int j = 0; j < 4; ++j) r4[j] = xl_swap16_sum(r8[j], r8[4 + j]);
#pragma unroll
    for (int j = 0; j < 2; ++j) { const float keep = u1 ? r4[2 + j] : r4[j], send = u1 ? r4[j] : r4[2 + j]; r2[j] = keep + xl_dpp<0x128>(send); }
    f32x2v xv = B.xv; xv.x += bflo(B.dl) + B.gv.x * r2[0]; xv.y += bfhi(B.dl) + B.gv.y * r2[1]; __builtin_nontemporal_store(xv, op);
    if constexpr (REFILL) { __builtin_amdgcn_sched_barrier(0); peer_v_resid(B, modp, xin, delta, tbase, itn, g, c); }
}
#if P12_PREFETCH
template <bool IS_V> __device__ __forceinline__ void p12_prefetch_slice(const unsigned char* ws, int s_next, int wave, int lane, unsigned lds_dummy) {
    const unsigned char* src = ws + expert_slice_off<IS_V>(s_next) + (size_t)(((int)blockIdx.x >> 3) * NWAVES + wave) * 8192 + lane * 16;
#pragma unroll
    for (int k = 0; k < 8; ++k) attn_body::glds16(src + k * 1024, lds_dummy);
}
#endif
template <int MODE> __device__ __forceinline__ void p12_gather(Frame& F, const Args& a) {
#ifdef PROBE_LOOP
    unsigned long long pl_u0 = 0, pl_u1 = 0, pl_v0 = 0;
#endif
    const int l = F.lane, g = l >> 3, c = l & 7;
    const bf16* H2 = (const bf16*)(a.ws + WS_R1); const unsigned char* H8 = (const unsigned char*)(a.ws + WS_H8); const int* IDX = (const int*)(a.ws + WS_IDX); const float* GATE = (const float*)(a.ws + WS_GATE);
    const unsigned char* EU = (const unsigned char*)a.ws; const unsigned char* EV = (const unsigned char*)a.ws;
    const float* SU = (const float*)(a.ws + WS_ESC); const float* SV = SU + NEXP;
    const float* modp = (const float*)(a.ws + WS_MOD); float* out = a.out; const float* xin = (const float*)a.in[0]; const bf16* delta = (const bf16*)(a.ws + WS_DELTA); const bf16* x1b = (const bf16*)(a.ws + WS_X1B);
    LAS float* wl = (LAS float*)(F.lds + F.wave * 8192);
    LAS int* il = (LAS int*)(F.lds + 65536 + F.wave * 8192);
#ifdef PROBE_UV
    const unsigned long long uv_t0 = __builtin_amdgcn_s_memrealtime(); unsigned long long uv_t1 = 0;
#endif
    for (int tbase = (F.vcu * NWAVES + F.wave) * 16; tbase < T; tbase += F.G * NWAVES * 16) {
        if constexpr (MODE != 2) {
#pragma unroll
        for (int tt = 0; tt < 16; ++tt) {
#if U_MFMA
            il[tt * 128 + (l & 7) * 16 + (l >> 4) * 2 + ((l >> 3) & 1)] = IDX[((size_t)(l >> 4) * T + tbase + tt) * 16 + (l & 15)]; il[tt * 128 + (l & 7) * 16 + (4 + (l >> 4)) * 2 + ((l >> 3) & 1)] = IDX[((size_t)(4 + (l >> 4)) * T + tbase + tt) * 16 + (l & 15)];
#else
            il[tt * 128 + l] = IDX[((size_t)(l >> 4) * T + tbase + tt) * 16 + (l & 15)]; il[tt * 128 + 64 + l] = IDX[((size_t)(4 + (l >> 4)) * T + tbase + tt) * 16 + (l & 15)];
#endif
            wl[tt * 128 + l] = 0.f; wl[tt * 128 + 64 + l] = 0.f; }
#if U_MFMA
        {   MBuf b0, b1; LAS unsigned char* hst = F.lds + 133120 + F.wave * 512; LAS unsigned char* tile = F.lds + 137216 + F.wave * 2048; v4u hreg = h8_stage_load(H8, tbase, 0, l);
            if (l < 32) *(LAS v4u*)(hst + l * 16) = hreg;
            {   unsigned off[16]; peer4_offsets(off, il, 0, l >> 3, l & 7);
#pragma unroll
                for (int k = 0; k < 16; ++k) { b0.r[k] = *(const GAS v4u*)(EU + off[k]); __builtin_amdgcn_sched_barrier(0); }
                peer4_offsets(off, il, 1, l >> 3, l & 7);
#pragma unroll
                for (int k = 0; k < 16; ++k) { b1.r[k] = *(const GAS v4u*)(EU + off[k]); __builtin_amdgcn_sched_barrier(0); } }
            for (int it = 0; it < 124; it += 4) {
                peer4_step<true, 0>(b0, wl, it, l, hreg, hst, tile, EU, H8, il, tbase, it + 2, true);
                peer4_step<true, 1>(b1, wl, it + 1, l, hreg, hst, tile, EU, H8, il, tbase, it + 3);
                peer4_step<true, 2>(b0, wl, it + 2, l, hreg, hst, tile, EU, H8, il, tbase, it + 4);
                peer4_step<true, 3>(b1, wl, it + 3, l, hreg, hst, tile, EU, H8, il, tbase, it + 5);
            }
            peer4_step<true, 0>(b0, wl, 124, l, hreg, hst, tile, EU, H8, il, tbase, 126, false); peer4_step<true, 1>(b1, wl, 125, l, hreg, hst, tile, EU, H8, il, tbase, 127);
            peer4_step<false, 2>(b0, wl, 126, l, hreg, hst, tile); peer4_step<false, 3>(b1, wl, 127, l, hreg, hst, tile);
        }
#pragma unroll 4
        for (int tt = 0; tt < 16; ++tt) { il[tt * 128 + l] = IDX[((size_t)(l >> 4) * T + tbase + tt) * 16 + (l & 15)]; il[tt * 128 + 64 + l] = IDX[((size_t)(4 + (l >> 4)) * T + tbase + tt) * 16 + (l & 15)]; }
#else
        {   GBuf b0, b1; LAS unsigned char* hst = F.lds + 133120 + F.wave * 1024; v4u hreg = h_stage_load(H2, tbase, 0, l);
            *(LAS v4u*)(hst + l * 16) = hreg;
            peer_issue<true>(b0, EU, hst, il, tbase, 0, g, c); peer_issue<true>(b1, EU, hst, il, tbase, 1, g, c);
#ifdef PROBE_LOOP
            pl_u0 = __builtin_amdgcn_s_memrealtime();
#endif
            for (int it = 0; it < 124; it += 4) {
#if P12_PREFETCH
                if ((it & 15) == 8 && it + 16 < 128 && F.G == 256) p12_prefetch_slice<false>(a.ws, (it >> 4) + 1, F.wave, l, (unsigned)(uintptr_t)(F.lds + 141312));
#endif
#if P12_ALTPRIO
                if (((it >> 4) ^ (F.wave >> 2)) & 1) __builtin_amdgcn_s_setprio(1); else __builtin_amdgcn_s_setprio(0);
#endif
                peer_u_compute<true, 0>(b0, wl, it, g, c, hreg, hst, EU, H2, il, tbase, it + 2, true);
                peer_u_compute<true, 1>(b1, wl, it + 1, g, c, hreg, hst, EU, H2, il, tbase, it + 3);
                peer_u_compute<true, 2>(b0, wl, it + 2, g, c, hreg, hst, EU, H2, il, tbase, it + 4);
                peer_u_compute<true, 3>(b1, wl, it + 3, g, c, hreg, hst, EU, H2, il, tbase, it + 5);
            }
            peer_u_compute<true, 0>(b0, wl, 124, g, c, hreg, hst, EU, H2, il, tbase, 126, false); peer_u_compute<true, 1>(b1, wl, 125, g, c, hreg, hst, EU, H2, il, tbase, 127);
            peer_u_compute<false, 2>(b0, wl, 126, g, c, hreg, hst); peer_u_compute<false, 3>(b1, wl, 127, g, c, hreg, hst);
        }
#ifdef PROBE_LOOP
        pl_u1 = __builtin_amdgcn_s_memrealtime();
#endif
#endif
#pragma unroll 1
        for (int t8 = 0; t8 < 16; t8 += 8) {
            f32x2v ga[8]; float su[8][2], sv[8][2];
#pragma unroll
            for (int q = 0; q < 8; ++q) { const int tt = t8 + q; const LAS int* ep = il + tt * 128 + g * 16 + 2 * c; const int e0 = ep[0], e1 = ep[1];
                ga[q] = *(const GAS f32x2v*)(GATE + ((size_t)g * T + tbase + tt) * 16 + 2 * c); su[q][0] = SU[e0]; su[q][1] = SU[e1]; sv[q][0] = SV[e0]; sv[q][1] = SV[e1]; }
#pragma unroll
            for (int q = 0; q < 8; ++q) { const int tt = t8 + q; LAS f32x2v* wp = (LAS f32x2v*)(wl + tt * 128 + g * 16 + 2 * c); f32x2v w = *wp;
                w.x = ga[q].x * gelu_erf(w.x * (U_MFMA ? 0.0625f : 1.0f) * su[q][0]) * sv[q][0]; w.y = ga[q].y * gelu_erf(w.y * (U_MFMA ? 0.0625f : 1.0f) * su[q][1]) * sv[q][1]; *wp = w; } }
        }
        if constexpr (MODE != 1) {
#ifdef PROBE_UV
        uv_t1 = __builtin_amdgcn_s_memrealtime();
#endif
#if V_STAGE
        {   GBuf b0, b1; LAS unsigned char* vst = F.lds + 141312 + F.wave * 2048; v4u vreg[2];
            x1_stage_load(vreg, x1b, tbase, 0, l); *(LAS v4u*)(vst + l * 32) = vreg[0]; *(LAS v4u*)(vst + l * 32 + 16) = vreg[1];
            peer_issue<false>(b0, EV, nullptr, il, tbase, 0, g, c); peer_v_resid(b0, modp, vst, nullptr, tbase, 0, g, c); peer_issue<false>(b1, EV, nullptr, il, tbase, 1, g, c); peer_v_resid(b1, modp, vst, nullptr, tbase, 1, g, c);
            for (int it = 0; it < 126; it += 2) {
                if ((it & 7) == 0 && it + 8 < 128) x1_stage_load(vreg, x1b, tbase, (it >> 3) + 1, l);
                if ((it & 7) == 6 && it + 2 < 128) { *(LAS v4u*)(vst + l * 32) = vreg[0]; *(LAS v4u*)(vst + l * 32 + 16) = vreg[1]; }
                peer_v_compute<true>(b0, wl, out, modp, vst, nullptr, tbase, it, g, c, EV, il, it + 2);
                peer_v_compute<true>(b1, wl, out, modp, vst, nullptr, tbase, it + 1, g, c, EV, il, it + 3);
            }
            peer_v_compute<false>(b0, wl, out, modp, vst, nullptr, tbase, 126, g, c); peer_v_compute<false>(b1, wl, out, modp, vst, nullptr, tbase, 127, g, c);
        }
#else
        {   GBuf b0, b1;
            peer_issue<false>(b0, EV, nullptr, il, tbase, 0, g, c); peer_v_resid(b0, modp, xin, delta, tbase, 0, g, c); peer_issue<false>(b1, EV, nullptr, il, tbase, 1, g, c); peer_v_resid(b1, modp, xin, delta, tbase, 1, g, c);
#ifdef PROBE_LOOP
            pl_v0 = __builtin_amdgcn_s_memrealtime();
#endif
            for (int it = 0; it < 126; it += 2) {
#if P12_PREFETCH
                if ((it & 15) == 8 && it + 16 < 128 && F.G == 256) p12_prefetch_slice<true>(a.ws, (it >> 4) + 1, F.wave, l, (unsigned)(uintptr_t)(F.lds + 141312));
#endif
#if P12_ALTPRIO
                if (((it >> 4) ^ (F.wave >> 2)) & 1) __builtin_amdgcn_s_setprio(1); else __builtin_amdgcn_s_setprio(0);
#endif
                peer_v_compute<true>(b0, wl, out, modp, xin, delta, tbase, it, g, c, EV, il, it + 2);
                peer_v_compute<true>(b1, wl, out, modp, xin, delta, tbase, it + 1, g, c, EV, il, it + 3);
            }
            peer_v_compute<false>(b0, wl, out, modp, xin, delta, tbase, 126, g, c); peer_v_compute<false>(b1, wl, out, modp, xin, delta, tbase, 127, g, c);
        }
#endif
#ifdef PROBE_LOOP
        {   const unsigned long long pl_v1 = __builtin_amdgcn_s_memrealtime(); asm volatile("s_waitcnt vmcnt(0)" ::: "memory"); __syncthreads();
            if (blockIdx.x == 17 && F.wave == (PROBE_LOOP & 7) && F.lane == 0) { const float tk = (PROBE_LOOP & 8) ? (float)(pl_v1 - pl_v0) : (float)(pl_u1 - pl_u0);
                a.out[0] = rintf(tk * (1.0f / 3200.f)) * 25.f; } }
#endif
        }
    }
#ifdef PROBE_UV
    asm volatile("s_waitcnt vmcnt(0)" ::: "memory"); __syncthreads();
    if (blockIdx.x == 17 && F.tid == 0) { const unsigned long long t2 = __builtin_amdgcn_s_memrealtime(); const float fr = (float)(uv_t1 - uv_t0) / (float)(t2 - uv_t0); a.out[0] = rintf(fr * 20.f) * 5.f; }
#endif
#if P12_ALTPRIO
    __builtin_amdgcn_s_setprio(0);
#endif
}


__global__ void __launch_bounds__(NWAVES * 64, 2) fwd_kernel(Args args) {
    extern __shared__ __attribute__((aligned(16))) unsigned char lds[];
    Frame F;
    F.lds = (LAS unsigned char*)lds;
    F.MISC = (volatile LAS unsigned*)(F.lds + MISC_OFF);
    F.tid = threadIdx.x; F.lane = F.tid & 63; F.wave = __builtin_amdgcn_readfirstlane(F.tid >> 6);
    F.G = gridDim.x; { const int bx = blockIdx.x; F.vcu = (F.G % 8 == 0) ? (bx % 8) * (F.G / 8) + bx / 8 : bx; }
    unsigned char* ws = args.ws;
    F.ctl = (gu32*)(ws + WS_CTL);
    for (int u = F.tid; u < (LDS_BYTES - LDSCTL_OFF) / 4; u += NWAVES * 64) ((LAS unsigned*)(F.lds + LDSCTL_OFF))[u] = 0u;
    __syncthreads();
    const int lo = args.ph_lo, hi = args.ph_hi;
    const bool fused = (hi - lo) > 1;
    XcdBarrier bar; bar.bar = (unsigned*)(F.ctl + CW_BAR) + args.bar_region * XCD_BAR_WORDS; bar.x = 0; bar.st = nullptr;
    if (fused) bar = xcd_barrier_post((unsigned*)(F.ctl + CW_BAR) + args.bar_region * XCD_BAR_WORDS, F.MISC + 8);
#ifndef PHASE_MASK
#define PHASE_MASK 0xFFFF
#endif
#define IN(k) (((PHASE_MASK >> (k)) & 1) && lo <= (k) && (k) < hi)
#ifdef PROBE_BAR2
#define SEAM(k) do { if (IN(k) && IN((k) + 1)) { xcd_barrier(bar); xcd_barrier(bar); } } while (0)
#elif defined(PROBE_PHT)
    unsigned long long pht_prev = __builtin_amdgcn_s_memrealtime(); float pht_val = 0.f;
#define SEAM(k) do { if (IN(k) && IN((k) + 1)) { xcd_barrier(bar); const unsigned long long now_ = __builtin_amdgcn_s_memrealtime(); if ((k) == PROBE_PHT) pht_val = (float)(now_ - pht_prev) * 0.001f; pht_prev = now_; } } while (0)
#else
#define SEAM(k) do { if (IN(k) && IN((k) + 1)) xcd_barrier(bar); } while (0)
#endif
#ifdef PROBE_DOUBLE
    int two_ = 2; asm volatile("" : "+s"(two_));
#define REP(k) for (int rep_ = 0; rep_ < ((k) == PROBE_DOUBLE ? two_ : 1); ++rep_, ((k) == PROBE_DOUBLE && rep_ == 1 && fused ? xcd_barrier(bar) : (void)0))
#else
#define REP(k)
#endif

    bf16* XN = (bf16*)(ws + WS_R1);
    float* modp = (float*)(ws + WS_MOD);

#ifdef PROBE_ATT
    if (blockIdx.x == 17 && F.tid == 0) { modp[MOD_LAM + 40] = 0.f; modp[MOD_LAM + 41] = 0.f; modp[MOD_LAM + 42] = 0.f; }
#endif
    REP(0) if (IN(0)) { p0_prologue(F, args); } SEAM(0);
    REP(1) if (IN(1)) {
        norm_mod_rows<true>(F, (const float*)args.in[0], (const float*)args.in[5], modp, 0, 1024, XN, (const int*)args.in[2], (float*)(ws + WS_CS), (float*)(ws + WS_SA));
        {
            LAS float* scr = (LAS float*)(F.lds + RING_OFF + F.wave * 16384);
            for (int it = F.vcu * NWAVES + F.wave; it < (D / 64) * (IN_W / 32); it += F.G * NWAVES)
                win_fp8_item((const float*)args.in[6], (const unsigned*)(ws + WS_CTL) + CW_AMAX, (unsigned char*)(ws + WS_WIN), (float*)(ws + WS_SW), scr, it, F.lane); }
    } SEAM(1);
    REP(2) if (IN(2)) {
#if defined(P2_STAGGER)
        {
            const unsigned long long t0_ = __builtin_amdgcn_s_memrealtime(); const unsigned long long wait_ = (unsigned long long)((F.vcu & 3) * P2_STAGGER) * 100ull;
            while (__builtin_amdgcn_s_memrealtime() - t0_ < wait_) __builtin_amdgcn_s_sleep(32);
        }
#endif
        int kdim = D / 2; asm volatile("" : "+s"(kdim));
        pg8::Gemm g{XN, (const bf16*)(ws + WS_WIN), T, IN_W, kdim}; pg8::StaticOrder S; S.init(T, IN_W, F.G, (int)blockIdx.x);
        pg8::EpiInProj E{(bf16*)(ws + WS_QA), (bf16*)(ws + WS_KA), (bf16*)(ws + WS_VA), (bf16*)(ws + WS_QB), (bf16*)(ws + WS_KB), (bf16*)(ws + WS_VB), (bf16*)args.out, (const float*)args.in[7],
                          (const float*)args.in[8], (const float*)args.in[9], (const float*)args.in[11], (const float*)args.in[12], (const float*)(ws + WS_CS), QSCALE, (const float*)(ws + WS_SA), (const float*)(ws + WS_SW)};
        pg8::gemm_phase<pg8::EpiInProj, pg8::StaticOrder, true, true, true>(F.lds + RING_OFF, g, S, E
#ifdef PROBE_GSTAMP
            , modp + MOD_LAM + 24
#endif
            );
#if EXPERT_TAIL
        if (F.G == 256 && blockIdx.x >= 128) { const int wk_ = ((int)blockIdx.x - 128) * NWAVES + F.wave;
            convert_fp8_rows<false>((const float*)args.in[23], ws, (float*)(ws + WS_ESC), 0, EXPERT_TAIL, wk_, 128 * NWAVES, F.lane);
            convert_fp8_rows<true>((const float*)args.in[24], ws, (float*)(ws + WS_ESC) + NEXP, 0, EXPERT_TAIL_V, wk_, 128 * NWAVES, F.lane); }
#endif
    } SEAM(2);
    REP(4) if (IN(4)) {
        p3_vt8(F, args); __syncthreads();
        attn_body::dil_phase((char*)lds + RING_OFF, (const attn_body::bf16*)(ws + WS_QA), (const attn_body::bf16*)(ws + WS_KA), (const attn_body::bf16*)(ws + WS_VA),
                             (attn_body::bf16*)(ws + WS_OUTG), (float*)(ws + WS_LSE), F.vcu, F.G);
    } SEAM(4);
    REP(5) if (IN(5)) {
        const bool ride_ = COMBINE_RIDER && F.G == 256;
        if (!ride_) p6_combine(F, args);
        const attn_body::DiffFusedOrder S((int)F.G, (int)blockIdx.x);
        float pscale;
        { const float gq = fabsf(((const float*)args.in[11])[F.lane]), gk = fabsf(((const float*)args.in[12])[F.lane]);
          float mq = gq, mk = gk;
#pragma unroll
          for (int o = 1; o < 64; o <<= 1) { mq = fmaxf(mq, __shfl_xor(mq, o)); mk = fmaxf(mk, __shfl_xor(mk, o)); }
          const float smax = 64.0f * QSCALE * mq * mk * 1.02f;
          pscale = exp2f(fmaxf(0.0f, ceilf(smax - 8.5f))); }
#if QK_FP8
        attn_body::diff128q8_phase((char*)lds + RING_OFF, (const unsigned char*)(ws + WS_QB), (const unsigned char*)(ws + WS_KB), (const unsigned char*)(ws + WS_VT8),
                                   (attn_body::bf16*)(ws + WS_O1), (attn_body::bf16*)(ws + WS_OB), pscale, modp[MOD_LAM], (const float*)args.in[17], S,
#ifdef PROBE_ATT
                                   modp + MOD_LAM + 40,
#else
                                   nullptr,
#endif
                                   ride_ ? (const attn_body::bf16*)(ws + WS_OUTG) : nullptr, (const float*)(ws + WS_LSE), ride_ ? (attn_body::bf16*)(ws + WS_OA) : nullptr, (F.vcu * NWAVES + F.wave) * 16);
#else
        attn_body::diff128f8_phase((char*)lds + RING_OFF, (const attn_body::bf16*)(ws + WS_QB), (const attn_body::bf16*)(ws + WS_KB), (const unsigned char*)(ws + WS_VT8),
                                   (attn_body::bf16*)(ws + WS_O1), (attn_body::bf16*)(ws + WS_OB), pscale, modp[MOD_LAM], (const float*)args.in[17], S
#ifdef PROBE_STAMP
                                   , modp + MOD_LAM + 16
#endif
                                   );
#endif
    } SEAM(5);
    REP(7) if (IN(7)) {
#ifdef PROBE7
        if (!(args.pad & 1))
#endif
        { int kdim = DIL_OUT; asm volatile("" : "+s"(kdim));
          pg8::Gemm g{(const bf16*)(ws + WS_OA), (const bf16*)(ws + WS_WPA), T, D, kdim}; pg8::StaticOrder S; S.init(T, D, F.G, (int)blockIdx.x);
          pg8::EpiBf16 E{(bf16*)(ws + WS_TMP), D};
          pg8::gemm_phase<pg8::EpiBf16, pg8::StaticOrder, true, true>(F.lds + RING_OFF, g, S, E); }
#ifdef PROBE7
        if (!(args.pad & 2))
#endif
        { pg8::Gemm g{(const bf16*)(ws + WS_OB), (const bf16*)(ws + WS_WPB), T, D, D}; pg8::StaticOrder S; S.init(T, D, F.G, (int)blockIdx.x);
          pg8::EpiBranchB E{(const bf16*)(ws + WS_TMP), (const unsigned char*)args.out, (bf16*)(ws + WS_MIX)};
          pg8::gemm_phase<pg8::EpiBranchB, pg8::StaticOrder, true, true>(F.lds + RING_OFF, g, S, E); }
    } SEAM(7);
    REP(8) if (IN(8)) {
        pg8::Gemm g{(const bf16*)(ws + WS_MIX), (const bf16*)(ws + WS_WOUT), T, D, D, MIX_KB}; pg8::StaticOrder S; S.init(T, D, F.G, (int)blockIdx.x);
        pg8::EpiOut E{modp, (bf16*)(ws + WS_DELTA), X1_BF16 ? (const float*)args.in[0] : nullptr};
#if defined(PROBE_TWICE) && PROBE_TWICE == 8
        { pg8::TwiceOrder S2{S}; pg8::gemm_phase<pg8::EpiOut, pg8::TwiceOrder, true, true>(F.lds + RING_OFF, g, S2, E); }
#else
        pg8::gemm_phase<pg8::EpiOut, pg8::StaticOrder, true, true>(F.lds + RING_OFF, g, S, E);
#endif
#if IDLE_PREFETCH
        if (F.G == 256 && blockIdx.x >= 128) l2_prefetch_operands(F, (const char*)(ws + WS_MIX), (const char*)(ws + WS_WOUT), D * 2, D * 2);
#endif
    } SEAM(8);
    REP(9) if (IN(9)) {
        const bool cfirst_ = P9_MIX && ((F.wave & 1) != 0);
        for (int s_ = 0; s_ < 2; ++s_) {
            if ((s_ == 0) != cfirst_) {
            norm_mod_rows<false>(F, X1_BF16 ? nullptr : (const float*)args.in[0], (const float*)args.in[20], modp, 3072, 4096, XN, nullptr, nullptr, nullptr, (const bf16*)(ws + WS_DELTA), U_MFMA ? (unsigned char*)(ws + WS_H8) : nullptr, (V_STAGE && !X1_BF16) ? (bf16*)(ws + WS_X1B) : nullptr);
            } else {
            convert_fp8_slices<false>(F, (const float*)args.in[23], ws, (float*)(ws + WS_ESC), (EXPERT_TAIL && F.G == 256) ? EXPERT_TAIL : 0);
            convert_fp8_slices<true>(F, (const float*)args.in[24], ws, (float*)(ws + WS_ESC) + NEXP, (V_IN_P11 && F.G * NWAVES * 8 == NEXP) ? NEXP : (EXPERT_TAIL && F.G == 256) ? EXPERT_TAIL_V : 0);
            }
        }
    } SEAM(9);
    REP(10) if (IN(10)) {
        pg8::Gemm g{XN, (const bf16*)(ws + WS_WQ), T, PEER_QW, D}; pg8::StaticOrder S; S.init(T, PEER_QW, F.G, (int)blockIdx.x);
        pg8::EpiQF E{(bf16*)(ws + WS_QP)};
#if defined(PROBE_TWICE) && PROBE_TWICE == 10
        { pg8::TwiceOrder S2{S}; pg8::gemm_phase<pg8::EpiQF, pg8::TwiceOrder, true, true>(F.lds + RING_OFF, g, S2, E); }
#else
        pg8::gemm_phase<pg8::EpiQF, pg8::StaticOrder, true, true>(F.lds + RING_OFF, g, S, E);
#endif
    } SEAM(10);
    REP(11) if (IN(11)) { p11_peer_topk(F, args); } SEAM(11);
    const bool p12_split = P12_SPLIT && (F.G * NWAVES * 16 >= T);
    REP(12) if (IN(12)) { if (p12_split) p12_gather<1>(F, args); else p12_gather<0>(F, args); }
#if P12_SPLIT
    SEAM(12);
    if (IN(13)) { if (p12_split) p12_gather<2>(F, args); }
#endif
#ifdef PROBE_ATT
    if (fused) { xcd_barrier(bar);
        if (blockIdx.x == 0 && F.tid == 0) { const float p0_ = modp[MOD_LAM + 40], p1_ = modp[MOD_LAM + 41], p2_ = modp[MOD_LAM + 42]; const float fr = (PROBE_ATT == 0 ? p0_ : PROBE_ATT == 1 ? p1_ : p2_) / (p0_ + p1_ + p2_);
            args.out[0] = rintf(fr * 50.f) * 2.f; } }
#endif
#ifdef PROBE_PHT
    if (fused) { xcd_barrier(bar); const unsigned long long now_ = __builtin_amdgcn_s_memrealtime(); if (PROBE_PHT == 12) pht_val = (float)(now_ - pht_prev) * 0.001f;
        if (blockIdx.x == 0 && F.tid == 0) args.out[0] = pht_val < 16.f ? rintf(pht_val * 4.f) * 0.25f : rintf(pht_val * 0.5f) * 2.f; }
#endif
#ifdef PROBE_GSTAMP
    if (fused) { xcd_barrier(bar);
        if (blockIdx.x == 0 && F.tid == 0) { const float e_ = modp[MOD_LAM + 24], u_ = modp[MOD_LAM + 25];
            args.out[0] = (PROBE_GSTAMP == 0) ? 10.0f + 89.0f * e_ / u_ : 10.0f + u_ * (1.0f / (15.0f * 1000.0f)); } }
#endif
#ifdef PROBE_STAMP
    if (fused) { xcd_barrier(bar);
        if (blockIdx.x == 0 && F.tid == 0) { const float a_ = modp[MOD_LAM + 16], b_ = modp[MOD_LAM + 17], w_ = (PROBE_STAMP == 4) ? modp[MOD_LAM + 19] : modp[MOD_LAM + 18]; const float tot = a_ + b_ + modp[MOD_LAM + 18] + modp[MOD_LAM + 19];
            const float v = (PROBE_STAMP == 0) ? a_ / tot : (PROBE_STAMP == 1) ? b_ / tot : (PROBE_STAMP == 2 || PROBE_STAMP == 4) ? w_ / tot : tot * (1.0f / (4.0f * 60.0f * 100.0f));
            args.out[0] = 10.0f + 89.0f * (PROBE_STAMP != 3 ? v : 0.f) + (PROBE_STAMP == 3 ? v : 0.f); } }
#endif
#undef IN
#undef SEAM
}

extern "C" void kernel_launch(void* const* d_in, const int* in_sizes, int n_in, void* d_out, int out_size, void* d_ws, size_t ws_size, hipStream_t stream) {
    static int grid = 0;
    if (grid == 0) {
        if (n_in != 25 || in_sizes[0] != T * D || out_size != T * D || ws_size < WS_END) {
            fprintf(stderr, "kernel_launch: built for 25 inputs, x and out of %d floats, >= %zu bytes of workspace; got n_in %d, in0 %d, out %d, ws %zu; nothing launched\n", T * D, (size_t)WS_END, n_in, n_in > 0 ? in_sizes[0] : -1, out_size, ws_size); grid = -1; return; }
        int dev = 0, cus = 0, per_cu = 0;
        if (hipGetDevice(&dev) != hipSuccess || hipDeviceGetAttribute(&cus, hipDeviceAttributeMultiprocessorCount, dev) != hipSuccess) { fprintf(stderr, "kernel_launch: hipGetDevice / hipDeviceGetAttribute failed\n"); grid = -1; return; }
        if (hipFuncSetAttribute((const void*)fwd_kernel, hipFuncAttributeMaxDynamicSharedMemorySize, LDS_BYTES) != hipSuccess) { fprintf(stderr, "kernel_launch: hipFuncSetAttribute failed\n"); grid = -1; return; }
        if (hipOccupancyMaxActiveBlocksPerMultiprocessor(&per_cu, (const void*)fwd_kernel, NWAVES * 64, LDS_BYTES) != hipSuccess || per_cu < 1)
            fprintf(stderr, "kernel_launch: note: occupancy query reports %d workgroups per CU\n", per_cu);
        (void)hipGetLastError();
        grid = cus;
    }
    if (grid < 0) return;
    if (hipMemsetAsync((char*)d_ws + WS_CTL, 0, CTL_ZERO_BYTES, stream) != hipSuccess) { fprintf(stderr, "kernel_launch: hipMemsetAsync failed\n"); return; }
    Args a{};
    for (int i = 0; i < 25; ++i) a.in[i] = d_in[i];
    a.out = (float*)d_out; a.ws = (unsigned char*)d_ws;
#if defined(PROBE_RELAUNCH)
    a.ph_lo = 0; a.ph_hi = PROBE_RELAUNCH + 1; hipLaunchKernelGGL(fwd_kernel, dim3(grid), dim3(NWAVES * 64), LDS_BYTES, stream, a);
    a.bar_region = 1; a.ph_lo = PROBE_RELAUNCH; a.ph_hi = PROBE_RELAUNCH + 1;
#ifdef PROBE11
    a.pad = PROBE11;
#endif
#ifdef PROBE7
    a.pad = PROBE7;
#endif
    hipLaunchKernelGGL(fwd_kernel, dim3(grid), dim3(NWAVES * 64), LDS_BYTES, stream, a);
    a.pad = 0;
    if (PROBE_RELAUNCH + 1 < N_PHASES) { a.bar_region = 2; a.ph_lo = PROBE_RELAUNCH + 1; a.ph_hi = N_PHASES; hipLaunchKernelGGL(fwd_kernel, dim3(grid), dim3(NWAVES * 64), LDS_BYTES, stream, a); }
#elif MK_N_LAUNCHES == 1
    a.ph_lo = 0; a.ph_hi = N_PHASES;
    hipLaunchKernelGGL(fwd_kernel, dim3(grid), dim3(NWAVES * 64), LDS_BYTES, stream, a);
#else
    for (int p = 0; p < N_PHASES; ++p) { a.ph_lo = p; a.ph_hi = p + 1;
        hipLaunchKernelGGL(fwd_kernel, dim3(grid), dim3(NWAVES * 64), LDS_BYTES, stream, a); }
#endif
    const hipError_t le = hipPeekAtLastError();
    if (le != hipSuccess) fprintf(stderr, "kernel_launch: launch failed: %s\n", hipGetErrorName(le));
}
```
